# Optimizing an MI355X kernel written in HIP

```python
import math
import jax, jax.numpy as jnp
from jax import lax
import numpy as np

D_MODEL = 2048
BATCH = 4
SEQ = 2048
DEPTH = 1
DEC_BATCH = 128
DEC_SEQ = 4
PAST_LEN = 16384
PAGE_SIZE = 128

MIX_WIDTH = D_MODEL
S5_WIDTH = MIX_WIDTH // 2
S5_GROUP = 16
S5_GROUPS = S5_WIDTH // S5_GROUP
S5_STATE = 64
GDN_WIDTH = MIX_WIDTH - S5_WIDTH
GDN_HEAD_DIM = 128
GDN_HEADS = GDN_WIDTH // GDN_HEAD_DIM
GDN_CONV = 4
GDN_CHUNK = 64
D_FF = ((8 * D_MODEL // 3 + 255) // 256) * 256
OFF_QKV = S5_WIDTH
OFF_GATE = OFF_QKV + 3 * GDN_WIDTH
OFF_BETA = OFF_GATE + GDN_WIDTH
OFF_DECAY = OFF_BETA + GDN_HEADS
MIX_IN_COLS = OFF_DECAY + GDN_HEADS
DEEP_ALPHA = (2.0 * DEPTH) ** 0.25
DEEP_BETA = (8.0 * DEPTH) ** -0.25
LN_EPS = 1e-5
NORM_EPS = 1e-6
F32 = jnp.float32

kernel_name = 'hymba_s5_gdn_macaron_deepnorm_step'


def layer_norm(x, g, b):
    x = x.astype(F32)
    mu = jnp.mean(x, -1, keepdims=True)
    var = jnp.mean(jnp.square(x - mu), -1, keepdims=True)
    return (x - mu) * lax.rsqrt(var + LN_EPS) * g.astype(F32) + b.astype(F32)


def swiglu(x, w_in, w_out):
    gate, up = jnp.split(x @ w_in, 2, axis=-1)
    return (jax.nn.silu(gate) * up) @ w_out


def s5_discretize(lam_re, lam_im, log_dt, b_re, b_im):
    dt = jnp.exp(log_dt.astype(F32))[:, None]
    lr, li = lam_re.astype(F32), lam_im.astype(F32)
    mag = jnp.exp(lr * dt)
    ab_re = mag * jnp.cos(li * dt)
    ab_im = mag * jnp.sin(li * dt)
    nr, ni = ab_re - 1.0, ab_im
    den = lr * lr + li * li
    c_re = (nr * lr + ni * li) / den
    c_im = (ni * lr - nr * li) / den
    b_re, b_im = b_re.astype(F32), b_im.astype(F32)
    bb_re = c_re[..., None] * b_re - c_im[..., None] * b_im
    bb_im = c_re[..., None] * b_im + c_im[..., None] * b_re
    return ab_re, ab_im, bb_re, bb_im


def s5_combine(e1, e2):
    a1r, a1i, b1r, b1i = e1
    a2r, a2i, b2r, b2i = e2
    return (a2r * a1r - a2i * a1i, a2r * a1i + a2i * a1r,
            a2r * b1r - a2i * b1i + b2r, a2r * b1i + a2i * b1r + b2i)


def s5_mixer(u, h0_re, h0_im, w):
    bn, t, _ = u.shape
    ug = u.reshape(bn, t, S5_GROUPS, S5_GROUP)
    ab_re, ab_im, bb_re, bb_im = s5_discretize(w['s5_lambda_re'], w['s5_lambda_im'], w['s5_log_dt'], w['s5_b_re'], w['s5_b_im'])
    bu_re = jnp.einsum('btgh,gph->btgp', ug, bb_re)
    bu_im = jnp.einsum('btgh,gph->btgp', ug, bb_im)
    h0_re, h0_im = h0_re.astype(F32), h0_im.astype(F32)
    bu_re = bu_re.at[:, 0].add(ab_re * h0_re - ab_im * h0_im)
    bu_im = bu_im.at[:, 0].add(ab_re * h0_im + ab_im * h0_re)
    a_re = jnp.broadcast_to(ab_re, bu_re.shape)
    a_im = jnp.broadcast_to(ab_im, bu_im.shape)
    _, _, h_re, h_im = lax.associative_scan(s5_combine, (a_re, a_im, bu_re, bu_im), axis=1)
    d = w['s5_d'].astype(F32).reshape(S5_GROUPS, S5_GROUP)
    y = (jnp.einsum('btgp,ghp->btgh', h_re, w['s5_c_re'].astype(F32))
         - jnp.einsum('btgp,ghp->btgh', h_im, w['s5_c_im'].astype(F32)) + d * ug)
    z = jax.nn.gelu(y.reshape(bn, t, S5_WIDTH))
    out = z * jax.nn.sigmoid(z @ w['s5_glu_w'] + w['s5_glu_b'])
    return out, h_re[:, -1], h_im[:, -1]


def causal_short_conv(x, buf, cw):
    t = x.shape[1]
    xp = jnp.concatenate([buf.astype(F32), x], axis=1)
    out = xp[:, 0:t] * cw[0]
    for j in range(1, GDN_CONV):
        out = out + xp[:, j:j + t] * cw[j]
    return out, xp[:, -(GDN_CONV - 1):]


def l2norm(x):
    return x * lax.rsqrt(jnp.sum(x * x, -1, keepdims=True) + NORM_EPS)


def gated_delta_chunked(q, k, v, g, beta, s0):
    bn, t, nh, dk = q.shape
    c = min(GDN_CHUNK, t)
    n = -(-t // c)
    pad = n * c - t

    def blocks(a):
        a = jnp.moveaxis(a, 2, 1)
        if pad:
            a = jnp.pad(a, [(0, 0), (0, 0), (0, pad)] + [(0, 0)] * (a.ndim - 3))
        return a.reshape(a.shape[:2] + (n, c) + a.shape[3:])

    q, k, v, g, beta = (blocks(a) for a in (q, k, v, g, beta))
    gc = jnp.cumsum(g, axis=-1)
    pos = jnp.arange(c)
    causal = pos[:, None] >= pos[None, :]
    strict = (pos[:, None] > pos[None, :]).astype(F32)
    decay = jnp.exp(jnp.where(causal, gc[..., :, None] - gc[..., None, :], -jnp.inf))
    kb = k * beta[..., None]
    m = jnp.einsum('bhnid,bhnjd->bhnij', kb, k) * decay * strict
    eye = jnp.eye(c, dtype=F32)
    tinv = lax.linalg.triangular_solve(eye + m, jnp.broadcast_to(eye, m.shape), left_side=True, lower=True)
    u = tinv @ (v * beta[..., None])
    wk = tinv @ (kb * jnp.exp(gc)[..., None])
    attn = jnp.einsum('bhnid,bhnjd->bhnij', q, k) * decay
    qg = q * jnp.exp(gc)[..., None]
    kd = k * jnp.exp(gc[..., -1:] - gc)[..., None]
    glast = jnp.exp(gc[..., -1])

    def step(s, xs):
        u_i, w_i, qg_i, kd_i, a_i, gl_i = xs
        v_new = u_i - w_i @ s
        o_i = qg_i @ s + a_i @ v_new
        s = s * gl_i[..., None, None] + jnp.einsum('bhcd,bhce->bhde', kd_i, v_new)
        return s, o_i

    xs = tuple(jnp.moveaxis(a, 2, 0) for a in (u, wk, qg, kd, attn, glast))
    s_fin, o = lax.scan(step, s0.astype(F32), xs)
    o = jnp.moveaxis(o, 0, 2).reshape(bn, nh, n * c, -1)[:, :, :t]
    return jnp.moveaxis(o, 1, 2), s_fin


def gdn_mixer(qkv, gate, b_raw, a_raw, s0, conv_buf, w):
    bn, t, _ = qkv.shape
    qkv_c, new_buf = causal_short_conv(qkv, conv_buf, w['gdn_conv_w'].astype(F32))
    q, k, v = jnp.split(jax.nn.silu(qkv_c), 3, axis=-1)
    shp = (bn, t, GDN_HEADS, GDN_HEAD_DIM)
    q = l2norm(q.reshape(shp)) * (GDN_HEAD_DIM ** -0.5)
    k = l2norm(k.reshape(shp))
    v = v.reshape(shp)
    beta = jax.nn.sigmoid(b_raw)
    g = -jnp.exp(w['gdn_a_log'].astype(F32)) * jax.nn.softplus(a_raw + w['gdn_dt_bias'].astype(F32))
    o, s_fin = gated_delta_chunked(q, k, v, g, beta, s0)
    o = o * lax.rsqrt(jnp.mean(o * o, -1, keepdims=True) + NORM_EPS) * w['gdn_norm_w'].astype(F32)
    o = o * jax.nn.silu(gate.reshape(shp))
    return o.reshape(bn, t, GDN_WIDTH), s_fin, new_buf


def decoder_layer(x, s5_re, s5_im, gdn_s, conv_buf, w):
    x = layer_norm(DEEP_ALPHA * x + 0.5 * swiglu(x, w['ffn1_w_in'], w['ffn1_w_out']), w['ln1_g'], w['ln1_b'])
    proj = x @ w['w_mix_in']
    y_s5, n_re, n_im = s5_mixer(proj[..., :S5_WIDTH], s5_re, s5_im, w)
    y_gdn, n_s, n_buf = gdn_mixer(proj[..., OFF_QKV:OFF_GATE], proj[..., OFF_GATE:OFF_BETA],
                                  proj[..., OFF_BETA:OFF_DECAY], proj[..., OFF_DECAY:MIX_IN_COLS],
                                  gdn_s, conv_buf, w)
    mix = jnp.concatenate([y_s5, y_gdn], axis=-1) @ w['w_mix_out']
    x = layer_norm(DEEP_ALPHA * x + mix, w['ln2_g'], w['ln2_b'])
    x = layer_norm(DEEP_ALPHA * x + 0.5 * swiglu(x, w['ffn2_w_in'], w['ffn2_w_out']), w['ln3_g'], w['ln3_b'])
    return x, n_re, n_im, n_s, n_buf


def setup_inputs(seed: int = 0) -> dict:
    key = jax.random.key(seed)
    ks = iter(jax.random.split(key, 40))
    L = DEPTH
    nrm = lambda shape, s: jax.random.normal(next(ks), shape, F32) * s
    gain = lambda shape: 1.0 + nrm(shape, 0.02)
    lam_im = jnp.pi * jnp.arange(S5_STATE, dtype=F32)
    dt = jnp.exp(jax.random.uniform(next(ks), (L, GDN_HEADS), F32, math.log(1e-3), math.log(1e-1)))
    return {
        'x_prompt': nrm((BATCH, SEQ, D_MODEL), 1.0),
        'x_sample': nrm((DEC_BATCH, DEC_SEQ, D_MODEL), 1.0),
        'state_s5_re': nrm((L, DEC_BATCH, S5_GROUPS, S5_STATE), 0.1),
        'state_s5_im': nrm((L, DEC_BATCH, S5_GROUPS, S5_STATE), 0.1),
        'state_gdn': nrm((L, DEC_BATCH, GDN_HEADS, GDN_HEAD_DIM, GDN_HEAD_DIM), 0.3),
        'state_conv': nrm((L, DEC_BATCH, GDN_CONV - 1, 3 * GDN_WIDTH), 1.0),
        'ln1_g': gain((L, D_MODEL)),
        'ln1_b': nrm((L, D_MODEL), 0.02),
        'ffn1_w_in': nrm((L, D_MODEL, 2 * D_FF), D_MODEL ** -0.5),
        'ffn1_w_out': nrm((L, D_FF, D_MODEL), D_FF ** -0.5 * DEEP_BETA),
        'w_mix_in': nrm((L, D_MODEL, MIX_IN_COLS), D_MODEL ** -0.5),
        's5_lambda_re': -0.5 + nrm((L, S5_GROUPS, S5_STATE), 0.01),
        's5_lambda_im': lam_im + nrm((L, S5_GROUPS, S5_STATE), 0.01),
        's5_log_dt': jax.random.uniform(next(ks), (L, S5_GROUPS), F32, math.log(1e-3), math.log(1e-1)),
        's5_b_re': nrm((L, S5_GROUPS, S5_STATE, S5_GROUP), (2 * S5_GROUP) ** -0.5),
        's5_b_im': nrm((L, S5_GROUPS, S5_STATE, S5_GROUP), (2 * S5_GROUP) ** -0.5),
        's5_c_re': nrm((L, S5_GROUPS, S5_GROUP, S5_STATE), (2 * S5_STATE) ** -0.5),
        's5_c_im': nrm((L, S5_GROUPS, S5_GROUP, S5_STATE), (2 * S5_STATE) ** -0.5),
        's5_d': nrm((L, S5_WIDTH), 1.0),
        's5_glu_w': nrm((L, S5_WIDTH, S5_WIDTH), S5_WIDTH ** -0.5),
        's5_glu_b': nrm((L, S5_WIDTH), 0.02),
        'gdn_conv_w': nrm((L, GDN_CONV, 3 * GDN_WIDTH), GDN_CONV ** -0.5),
        'gdn_a_log': jnp.log(jax.random.uniform(next(ks), (L, GDN_HEADS), F32, 1.0, 16.0)),
        'gdn_dt_bias': dt + jnp.log(-jnp.expm1(-dt)),
        'gdn_norm_w': gain((L, GDN_HEAD_DIM)),
        'w_mix_out': nrm((L, MIX_WIDTH, D_MODEL), MIX_WIDTH ** -0.5 * DEEP_BETA),
        'ln2_g': gain((L, D_MODEL)),
        'ln2_b': nrm((L, D_MODEL), 0.02),
        'ffn2_w_in': nrm((L, D_MODEL, 2 * D_FF), D_MODEL ** -0.5),
        'ffn2_w_out': nrm((L, D_FF, D_MODEL), D_FF ** -0.5 * DEEP_BETA),
        'ln3_g': gain((L, D_MODEL)),
        'ln3_b': nrm((L, D_MODEL), 0.02),
    }


def reference(x_prompt, x_sample, state_s5_re, state_s5_im, state_gdn, state_conv,
              ln1_g, ln1_b, ffn1_w_in, ffn1_w_out, w_mix_in,
              s5_lambda_re, s5_lambda_im, s5_log_dt, s5_b_re, s5_b_im, s5_c_re, s5_c_im,
              s5_d, s5_glu_w, s5_glu_b, gdn_conv_w, gdn_a_log, gdn_dt_bias, gdn_norm_w,
              w_mix_out, ln2_g, ln2_b, ffn2_w_in, ffn2_w_out, ln3_g, ln3_b):
    bp = x_prompt.shape[0]
    yp = x_prompt.astype(F32)
    ys = x_sample.astype(F32)
    p_re, p_im, p_s, p_buf = [], [], [], []
    s_re, s_im, s_s, s_buf = [], [], [], []
    for l in range(DEPTH):
        w = {
            'ln1_g': ln1_g[l], 'ln1_b': ln1_b[l], 'ffn1_w_in': ffn1_w_in[l], 'ffn1_w_out': ffn1_w_out[l],
            'w_mix_in': w_mix_in[l], 's5_lambda_re': s5_lambda_re[l], 's5_lambda_im': s5_lambda_im[l],
            's5_log_dt': s5_log_dt[l], 's5_b_re': s5_b_re[l], 's5_b_im': s5_b_im[l],
            's5_c_re': s5_c_re[l], 's5_c_im': s5_c_im[l], 's5_d': s5_d[l],
            's5_glu_w': s5_glu_w[l], 's5_glu_b': s5_glu_b[l], 'gdn_conv_w': gdn_conv_w[l],
            'gdn_a_log': gdn_a_log[l], 'gdn_dt_bias': gdn_dt_bias[l], 'gdn_norm_w': gdn_norm_w[l],
            'w_mix_out': w_mix_out[l], 'ln2_g': ln2_g[l], 'ln2_b': ln2_b[l],
            'ffn2_w_in': ffn2_w_in[l], 'ffn2_w_out': ffn2_w_out[l], 'ln3_g': ln3_g[l], 'ln3_b': ln3_b[l],
        }
        z_ssm = jnp.zeros((bp, S5_GROUPS, S5_STATE), F32)
        z_gdn = jnp.zeros((bp, GDN_HEADS, GDN_HEAD_DIM, GDN_HEAD_DIM), F32)
        z_buf = jnp.zeros((bp, GDN_CONV - 1, 3 * GDN_WIDTH), F32)
        yp, a, b, c, d = decoder_layer(yp, z_ssm, z_ssm, z_gdn, z_buf, w)
        p_re.append(a); p_im.append(b); p_s.append(c); p_buf.append(d)
        ys, a, b, c, d = decoder_layer(ys, state_s5_re[l], state_s5_im[l], state_gdn[l], state_conv[l], w)
        s_re.append(a); s_im.append(b); s_s.append(c); s_buf.append(d)
    return (yp.astype(x_prompt.dtype), ys.astype(x_sample.dtype),
            jnp.stack(p_re), jnp.stack(p_im), jnp.stack(p_s), jnp.stack(p_buf),
            jnp.stack(s_re), jnp.stack(s_im), jnp.stack(s_s), jnp.stack(s_buf))
```

```cpp
#include <hip/hip_runtime.h>
#include <hip/hip_cooperative_groups.h>
#include <cstdio>
namespace cg = cooperative_groups;

#define LAS __attribute__((address_space(3)))
typedef unsigned short bf16_t;
typedef short bf16x8 __attribute__((ext_vector_type(8)));
typedef float f32x4 __attribute__((ext_vector_type(4)));
typedef float f32x16 __attribute__((ext_vector_type(16)));
typedef unsigned u32x4 __attribute__((ext_vector_type(4)));
typedef unsigned u32x2 __attribute__((ext_vector_type(2)));

#ifndef STOP_AFTER
#define STOP_AFTER 99
#endif

constexpr int NTOK = 8704, NPR = 8192, DM = 2048, DFF = 5632, NMIX = 5136, NMIXP = 5376, NPB = 5120;
constexpr float ALPHA = 1.189207115002721f;

constexpr size_t O_Y = 0, O_PRE = 17825792, O_PIM = 17842176, O_PGDN = 17858560, O_PCONV = 18382848,
                 O_SRE = 18419712, O_SIM = 18944000, O_SGDN = 19468288, O_SCONV = 36245504;

constexpr size_t SZ_W1T = (size_t)11264 * 2048 * 2, SZ_W1O = (size_t)2048 * 5632 * 2;
constexpr size_t OFF_W1T = 0;
constexpr size_t OFF_W1O = OFF_W1T + SZ_W1T;
constexpr size_t OFF_WMI = OFF_W1O + SZ_W1O;
constexpr size_t OFF_GLU = OFF_WMI + (size_t)NMIXP * 2048 * 2;
constexpr size_t OFF_WMO = OFF_GLU + (size_t)1024 * 1024 * 2;
constexpr size_t OFF_XNB = OFF_WMO + (size_t)2048 * 2048 * 2;
constexpr size_t OFF_XN  = OFF_XNB + (size_t)NTOK * 2048 * 2;
constexpr size_t OFF_R   = OFF_XN + (size_t)NTOK * 2048 * 4;
constexpr size_t OFF_H   = OFF_R + (size_t)NTOK * 2048 * 4;
constexpr size_t OFF_KDT = OFF_H + (size_t)NTOK * DFF * 2;
constexpr size_t SZ_CH   = (size_t)1024 * 64 * 128 * 2;
constexpr size_t OFF_TBT = OFF_KDT + SZ_CH;
constexpr size_t OFF_O   = OFF_TBT + (size_t)1024 * 64 * 64 * 2;
constexpr size_t OFF_ZB  = OFF_O + (size_t)NTOK * 1024 * 2;
constexpr size_t OFF_BBT = OFF_ZB + (size_t)NTOK * 1024 * 2;
constexpr size_t OFF_CT  = OFF_BBT + 262144;
constexpr size_t OFF_ABAR = OFF_CT + 262144;
constexpr size_t OFF_GLAST = OFF_ABAR + 32768;
constexpr size_t OFF_BAR = OFF_GLAST + 4096;
constexpr size_t OFF_PART = OFF_BAR + 16384;
constexpr size_t WS_END  = OFF_PART + (size_t)4 * 512 * 2048 * 4;
constexpr size_t OFF_PROJB = OFF_H;
constexpr size_t OFF_YMIX = OFF_XNB;
constexpr size_t OFF_QN = OFF_R, OFF_KN = OFF_QN + (size_t)NPR * 1024 * 2, OFF_VV = OFF_KN + (size_t)NPR * 1024 * 2;
constexpr size_t OFF_G = OFF_VV + (size_t)NPR * 1024 * 4;
constexpr size_t OFF_BETA = OFF_G + (size_t)NTOK * 8 * 4;
constexpr size_t OFF_BD = OFF_BETA + (size_t)NTOK * 8 * 4;
constexpr size_t OFF_KT = OFF_W1T, OFF_ATT = OFF_KT + SZ_CH, OFF_QG = OFF_ATT + (size_t)1024 * 64 * 64 * 2, OFF_KG = OFF_QG + SZ_CH;
constexpr size_t OFF_QKVS = OFF_KG + SZ_CH;
static_assert(OFF_BD + (size_t)NTOK * 16 * 4 <= OFF_H, "R alias overflow");
static_assert(OFF_QKVS + (size_t)512 * 3072 * 4 <= OFF_WMI, "W1 alias overflow");

struct Params { const float* in[32]; float* out; unsigned char* ws; };

typedef __bf16 bf16v2_t __attribute__((ext_vector_type(2)));
typedef float f32v2_t __attribute__((ext_vector_type(2)));
__device__ __forceinline__ unsigned pk2(float lo, float hi) { f32v2_t v = {lo, hi}; bf16v2_t b = __builtin_convertvector(v, bf16v2_t); return __builtin_bit_cast(unsigned, b); }
__device__ __forceinline__ bf16_t f2bf(float f) { return (bf16_t)(pk2(f, 0.f) & 0xffffu); }
__device__ __forceinline__ float bf2f(bf16_t b) { return __uint_as_float(((unsigned)b) << 16); }
__device__ __forceinline__ float bflo(unsigned u) { return __uint_as_float(u << 16); }
__device__ __forceinline__ float bfhi(unsigned u) { return __uint_as_float(u & 0xffff0000u); }
__device__ __forceinline__ float wave_sum(float v) {
#pragma unroll
    for (int o = 1; o < 64; o <<= 1) v += __shfl_xor(v, o);
    return v;
}
__device__ __forceinline__ float siluf(float x) { return x / (1.f + __expf(-x)); }
__device__ __forceinline__ float sigmf(float x) { return 1.f / (1.f + __expf(-x)); }
__device__ __forceinline__ float gelu_tanh(float y) {
    const float t = 0.7978845608028654f * (y + 0.044715f * y * y * y);
    const float th = 1.f - 2.f / (1.f + __expf(2.f * t));
    return 0.5f * y * (1.f + th);
}
#define WSYNC() asm volatile("s_waitcnt lgkmcnt(0)" ::: "memory")

namespace pg8 {
constexpr int BM = 256, BK = 64, HALF = 128, HTB = HALF * BK * 2, STAGE_BYTES = 8 * HTB, NXCD = 8, WGM = 8;
__host__ __device__ __forceinline__ int lds_byte(int r, int c) { const int st = (r >> 4) * 2 + (c >> 5), rr = r & 15, cc = c & 31, ob = rr * 64 + cc * 2; return st * 1024 + (ob ^ (((ob >> 9) & 1) << 5)); }
__host__ __device__ __forceinline__ void stage_rc(int b, int& R, int& C) { const int st = b / 1024, sb = b % 1024, swz = sb ^ (((sb >> 9) & 1) << 5); R = (st >> 1) * 16 + swz / 64; C = (st & 1) * 32 + (swz % 64) / 2; }
__host__ __device__ __forceinline__ int perm32(int rho) { const int n = rho >> 4, i = rho & 15; return 8 * (i >> 2) + 4 * n + (i & 3); }
struct Unit { int pm, pn, k0, nk, part, sp; };
struct Gemm { const bf16_t* A; const bf16_t* Bt; int M, N, K; };
struct StaticOrder {
    int nM, nN, nwg, G, c, ntK, mode, rbase, rcount;
    __device__ __forceinline__ void init(int M, int N, int K, int G_, int c_, bool split) {
        nM = M / BM; nN = N / BM; nwg = nM * nN; G = G_; c = c_; ntK = K / BK;
        mode = (split && G == 256 && nM == 34 && nN == 8 && (ntK % 8) == 0) ? 1 : 0; rbase = 0; rcount = 1 << 20;
    }
    __device__ __forceinline__ void map(int L, Unit& u, int nMl) const {
        const int nw = nMl * nN;
        int wgid = L; { const int q = nw / NXCD, r = nw % NXCD, xcd = wgid % NXCD, off = wgid / NXCD; wgid = (xcd < r ? xcd * (q + 1) : r * (q + 1) + (xcd - r) * q) + off; }
        const int nig = WGM * nN, gid = wgid / nig, fm = gid * WGM, gsz = (nMl - fm) < WGM ? (nMl - fm) : WGM;
        u.pm = fm + ((wgid % nig) % gsz); u.pn = (wgid % nig) / gsz;
    }
    __device__ __forceinline__ int tail_busy() const { return mode == 1 ? 64 : (((nwg % G) * 2 <= G) ? (nwg % G) : 0); }
    __device__ __forceinline__ bool next_(int i, Unit& u) const {
        u.pm = 0; u.pn = 0; u.k0 = 0; u.nk = ntK; u.part = 0; u.sp = 0;
        if (i >= rcount) return false;
        i += rbase;
        if (mode == 0) { const long L = (long)i * G + c; if (L >= nwg) return false; map((int)L, u, nM); return true; }
        if (i == 0) { map(c, u, 32); return true; }
        if (i == 1 && c < 64) { const int tt = c >> 2; u.pm = 32 + (tt & 1); u.pn = tt >> 1; u.sp = c & 3; u.nk = ntK / 4; u.k0 = u.sp * u.nk; u.part = 1; return true; }
        return false;
    }
    __device__ __forceinline__ bool next(int i, Unit& u) const {
        const bool ok = next_(i, u);
        u.pm = __builtin_amdgcn_readfirstlane(u.pm); u.pn = __builtin_amdgcn_readfirstlane(u.pn); u.k0 = __builtin_amdgcn_readfirstlane(u.k0);
        u.nk = __builtin_amdgcn_readfirstlane(u.nk); u.part = __builtin_amdgcn_readfirstlane(u.part); u.sp = __builtin_amdgcn_readfirstlane(u.sp);
        return __builtin_amdgcn_readfirstlane((int)ok) != 0;
    }
};

template <class Epi>
__device__ __forceinline__ void gemm_phase(LAS unsigned char* lds, const Gemm g, const StaticOrder& S, const Epi& E) {
    int tid = threadIdx.x; asm volatile("" : "+v"(tid));
    const int wid = __builtin_amdgcn_readfirstlane(tid >> 6), lane = tid & 63, wr = wid >> 2, wc = wid & 3, fr = lane & 15, fq = lane >> 4;
    const int K = g.K;
    unsigned voffA[2], voffB[2];
#pragma unroll
    for (int i = 0; i < 2; ++i) { int R, C; stage_rc(tid * 16 + i * 8192, R, C); const int Rb = Epi::PERM ? ((R & ~31) + perm32(R & 31)) : R;
        voffA[i] = (unsigned)(R * K + C) * 2u; voffB[i] = (unsigned)(Rb * K + C) * 2u; }
    const size_t kstep = (size_t)(BK * 2);
    const size_t hstep = (size_t)HALF * K * 2;
    const size_t tstep = 2 * hstep;
    const unsigned ldsw = (unsigned)wid * 1024u;
    const int aoff = lds_byte(wr * 64 + fr, fq * 8), boff = lds_byte(wc * 32 + fr, fq * 8);
#define PG8_SA(b, h) (((b) * 2 + (h)) * HTB)
#define PG8_SB(b, h) ((4 + (b) * 2 + (h)) * HTB)
#define PG8_STAGE(bufoff, gbase, voff) do { _Pragma("unroll") for (int _i = 0; _i < 2; ++_i) \
        __builtin_amdgcn_global_load_lds((const unsigned*)((const char*)(gbase) + (voff)[_i]), (LAS unsigned*)(lds + (bufoff) + ldsw + _i * 8192), 16, 0, 0); } while (0)
#define PG8_LDA(dst, b, h) do { _Pragma("unroll") for (int m = 0; m < 4; ++m) _Pragma("unroll") for (int k = 0; k < 2; ++k) dst[m][k] = *(const LAS bf16x8*)(lds + PG8_SA(b, h) + aoff + m * 2048 + k * 1024); } while (0)
#define PG8_LDB(dst, b, h) do { _Pragma("unroll") for (int n = 0; n < 2; ++n) _Pragma("unroll") for (int k = 0; k < 2; ++k) dst[n][k] = *(const LAS bf16x8*)(lds + PG8_SB(b, h) + boff + n * 2048 + k * 1024); } while (0)
#define PG8_MMA(ai, bj, At, Bt) do { __builtin_amdgcn_s_setprio(1); _Pragma("unroll") for (int m = 0; m < 4; ++m) _Pragma("unroll") for (int n = 0; n < 2; ++n) _Pragma("unroll") for (int k = 0; k < 2; ++k) \
        acc[ai][bj][m][n] = __builtin_amdgcn_mfma_f32_16x16x32_bf16(Bt[n][k], At[m][k], acc[ai][bj][m][n], 0, 0, 0); __builtin_amdgcn_s_setprio(0); } while (0)
#define PG8_WAIT_V(n) asm volatile("s_waitcnt vmcnt(" #n ")" ::: "memory")
#define PG8_WAIT_L(n) asm volatile("s_waitcnt lgkmcnt(" #n ")" ::: "memory")
#define PG8_BAR __builtin_amdgcn_s_barrier()
#define PG8_SCHED __builtin_amdgcn_sched_barrier(0)
    Unit cur, nxt; int ui = 0;
    if (!S.next(0, cur)) return;
    f32x4 acc[2][2][4][2];
#pragma unroll
    for (int a = 0; a < 2; ++a)
#pragma unroll
        for (int b = 0; b < 2; ++b)
#pragma unroll
            for (int m = 0; m < 4; ++m)
#pragma unroll
                for (int n = 0; n < 2; ++n) acc[a][b][m][n] = (f32x4){0.f, 0.f, 0.f, 0.f};
    bf16x8 At[4][2], B0[2][2], B1[2][2];
    const char* cA = (const char*)g.A + (size_t)cur.pm * tstep + (size_t)cur.k0 * kstep; const char* cB = (const char*)g.Bt + (size_t)cur.pn * tstep + (size_t)cur.k0 * kstep;
    PG8_STAGE(PG8_SB(0, 0), cB, voffB); PG8_STAGE(PG8_SA(0, 0), cA, voffA); PG8_STAGE(PG8_SB(0, 1), cB + hstep, voffB); PG8_STAGE(PG8_SA(0, 1), cA + hstep, voffA);
    if (wr == 1) PG8_BAR;
    PG8_WAIT_V(4); PG8_BAR;
    PG8_STAGE(PG8_SB(1, 0), cB + kstep, voffB); PG8_STAGE(PG8_SA(1, 0), cA + kstep, voffA); PG8_STAGE(PG8_SB(1, 1), cB + hstep + kstep, voffB);
    PG8_WAIT_V(6); PG8_BAR;
    for (;;) {
        const bool has_next = S.next(ui + 1, nxt);
        const char* nA = has_next ? (const char*)g.A + (size_t)nxt.pm * tstep + (size_t)nxt.k0 * kstep : cA; const char* nB = has_next ? (const char*)g.Bt + (size_t)nxt.pn * tstep + (size_t)nxt.k0 * kstep : cB;
        const int nt = cur.nk;
        for (int t = 0; t < nt; t += 2) {
            const bool last = (t == nt - 2);
            const char* a1 = cA + (size_t)(t + 1) * kstep;
            const char* a2 = last ? nA : cA + (size_t)(t + 2) * kstep; const char* b2 = last ? nB : cB + (size_t)(t + 2) * kstep;
            const char* a3 = a2 + kstep; const char* b3 = b2 + kstep;
            PG8_LDB(B0, 0, 0); PG8_SCHED; PG8_LDA(At, 0, 0); PG8_STAGE(PG8_SA(1, 1), a1 + hstep, voffA);
            PG8_WAIT_L(8); PG8_BAR; PG8_WAIT_L(0); PG8_MMA(0, 0, At, B0); PG8_BAR; PG8_SCHED;
            PG8_LDB(B1, 0, 1); PG8_STAGE(PG8_SB(0, 0), b2, voffB);
            PG8_BAR; PG8_WAIT_L(0); PG8_MMA(0, 1, At, B1); PG8_BAR;
            PG8_LDA(At, 0, 1); PG8_STAGE(PG8_SA(0, 0), a2, voffA);
            PG8_BAR; PG8_WAIT_L(0); PG8_MMA(1, 0, At, B0); PG8_BAR; PG8_SCHED;
            PG8_STAGE(PG8_SB(0, 1), b2 + hstep, voffB);
            PG8_WAIT_V(6); PG8_BAR; PG8_MMA(1, 1, At, B1); PG8_BAR;
            PG8_LDB(B0, 1, 0); PG8_SCHED; PG8_LDA(At, 1, 0); PG8_STAGE(PG8_SA(0, 1), a2 + hstep, voffA);
            PG8_WAIT_L(8); PG8_BAR; PG8_WAIT_L(0); PG8_MMA(0, 0, At, B0); PG8_BAR; PG8_SCHED;
            PG8_LDB(B1, 1, 1); PG8_STAGE(PG8_SB(1, 0), b3, voffB);
            PG8_BAR; PG8_WAIT_L(0); PG8_MMA(0, 1, At, B1); PG8_BAR;
            PG8_LDA(At, 1, 1); PG8_STAGE(PG8_SA(1, 0), a3, voffA);
            PG8_BAR; PG8_WAIT_L(0); PG8_MMA(1, 0, At, B0); PG8_BAR; PG8_SCHED;
            PG8_STAGE(PG8_SB(1, 1), b3 + hstep, voffB);
            PG8_WAIT_V(6); PG8_BAR; PG8_MMA(1, 1, At, B1); PG8_BAR;
        }
        E(acc, cur, wr, wc, fr, fq);
        if (!has_next) break;
#pragma unroll
        for (int a = 0; a < 2; ++a)
#pragma unroll
            for (int b = 0; b < 2; ++b)
#pragma unroll
                for (int m = 0; m < 4; ++m)
#pragma unroll
                    for (int n = 0; n < 2; ++n) acc[a][b][m][n] = (f32x4){0.f, 0.f, 0.f, 0.f};
        cur = nxt; cA = nA; cB = nB; ++ui;
    }
    PG8_WAIT_V(0);
    if (wr == 0) PG8_BAR;
    PG8_BAR;
#undef PG8_SA
#undef PG8_SB
#undef PG8_STAGE
#undef PG8_LDA
#undef PG8_LDB
#undef PG8_MMA
#undef PG8_WAIT_V
#undef PG8_WAIT_L
#undef PG8_BAR
#undef PG8_SCHED
}
}
using pg8::Unit;

struct EpiSwiglu {
    static constexpr bool PERM = true;
    bf16_t* H;
    __device__ __forceinline__ void operator()(const f32x4 (&acc)[2][2][4][2], const Unit& u, int wr, int wc, int fr, int fq) const {
        const int row0 = u.pm * 256 + wr * 64 + fr, col0 = u.pn * 128 + wc * 32 + 8 * fq;
#pragma unroll
        for (int ai = 0; ai < 2; ++ai)
#pragma unroll
            for (int m = 0; m < 4; ++m) {
                const f32x4 g0 = acc[ai][0][m][0], g1 = acc[ai][0][m][1], u0 = acc[ai][1][m][0], u1 = acc[ai][1][m][1];
                u32x4 o;
                o.x = pk2(siluf(g0[0]) * u0[0], siluf(g0[1]) * u0[1]); o.y = pk2(siluf(g0[2]) * u0[2], siluf(g0[3]) * u0[3]);
                o.z = pk2(siluf(g1[0]) * u1[0], siluf(g1[1]) * u1[1]); o.w = pk2(siluf(g1[2]) * u1[2], siluf(g1[3]) * u1[3]);
                *(u32x4*)(H + (size_t)(row0 + ai * 128 + m * 16) * DFF + col0) = o;
            }
    }
};
struct EpiResid {
    static constexpr bool PERM = false;
    float* R; const float* X0; const float* X1; float* P; float scale;
    __device__ __forceinline__ void operator()(const f32x4 (&acc)[2][2][4][2], const Unit& u, int wr, int wc, int fr, int fq) const {
        const int row0 = u.pm * 256 + wr * 64 + fr, col0 = u.pn * 256 + wc * 32 + 4 * fq;
#pragma unroll
        for (int ai = 0; ai < 2; ++ai)
#pragma unroll
            for (int m = 0; m < 4; ++m) {
                const int row = row0 + ai * 128 + m * 16;
                const float* xr = (row < NPR ? X0 + (size_t)row * DM : X1 + (size_t)(row - NPR) * DM) + col0;
                float* rp = R + (size_t)row * DM + col0;
#pragma unroll
                for (int bj = 0; bj < 2; ++bj)
#pragma unroll
                    for (int n = 0; n < 2; ++n) {
                        if (!u.part) {
                            const f32x4 xv = *(const f32x4*)(xr + bj * 128 + n * 16);
                            *(f32x4*)(rp + bj * 128 + n * 16) = xv * ALPHA + acc[ai][bj][m][n] * scale;
                        } else {
                            *(f32x4*)(P + ((size_t)u.sp * 512 + (row - NPR)) * DM + col0 + bj * 128 + n * 16) = acc[ai][bj][m][n] * scale;
                        }
                    }
            }
    }
};
struct EpiMixIn {
    static constexpr bool PERM = true;
    bf16_t* PB; float* BD;
    __device__ __forceinline__ void operator()(const f32x4 (&acc)[2][2][4][2], const Unit& u, int wr, int wc, int fr, int fq) const {
        const int row0 = u.pm * 256 + wr * 64 + fr;
        if (u.pn < 20) {
            const int col0 = u.pn * 256 + wc * 32 + 8 * fq;
#pragma unroll
            for (int ai = 0; ai < 2; ++ai)
#pragma unroll
                for (int m = 0; m < 4; ++m)
#pragma unroll
                    for (int bj = 0; bj < 2; ++bj) {
                        const f32x4 v0 = acc[ai][bj][m][0], v1 = acc[ai][bj][m][1];
                        u32x4 o; o.x = pk2(v0[0], v0[1]); o.y = pk2(v0[2], v0[3]); o.z = pk2(v1[0], v1[1]); o.w = pk2(v1[2], v1[3]);
                        *(u32x4*)(PB + (size_t)(row0 + ai * 128 + m * 16) * NPB + col0 + bj * 128) = o;
                    }
        } else if (wc == 0 && fq < 2) {
#pragma unroll
            for (int ai = 0; ai < 2; ++ai)
#pragma unroll
                for (int m = 0; m < 4; ++m) {
                    float* bp = BD + (size_t)(row0 + ai * 128 + m * 16) * 16 + 8 * fq;
                    *(f32x4*)(bp) = acc[ai][0][m][0]; *(f32x4*)(bp + 4) = acc[ai][0][m][1];
                }
        }
    }
};
struct EpiGlu {
    static constexpr bool PERM = true;
    bf16_t* YM; const bf16_t* ZB; const float* bias;
    __device__ __forceinline__ void operator()(const f32x4 (&acc)[2][2][4][2], const Unit& u, int wr, int wc, int fr, int fq) const {
        const int row0 = u.pm * 256 + wr * 64 + fr, col0 = u.pn * 256 + wc * 32 + 8 * fq;
#pragma unroll
        for (int bj = 0; bj < 2; ++bj) {
            const f32x4 b0 = *(const f32x4*)(bias + col0 + bj * 128), b1 = *(const f32x4*)(bias + col0 + bj * 128 + 4);
#pragma unroll
            for (int ai = 0; ai < 2; ++ai)
#pragma unroll
                for (int m = 0; m < 4; ++m) {
                    const int row = row0 + ai * 128 + m * 16;
                    const u32x4 zz = *(const u32x4*)(ZB + (size_t)row * 1024 + col0 + bj * 128);
                    const f32x4 v0 = acc[ai][bj][m][0] + b0, v1 = acc[ai][bj][m][1] + b1;
                    u32x4 o;
                    o.x = pk2(bflo(zz.x) * sigmf(v0[0]), bfhi(zz.x) * sigmf(v0[1])); o.y = pk2(bflo(zz.y) * sigmf(v0[2]), bfhi(zz.y) * sigmf(v0[3]));
                    o.z = pk2(bflo(zz.z) * sigmf(v1[0]), bfhi(zz.z) * sigmf(v1[1])); o.w = pk2(bflo(zz.w) * sigmf(v1[2]), bfhi(zz.w) * sigmf(v1[3]));
                    *(u32x4*)(YM + (size_t)row * DM + col0 + bj * 128) = o;
                }
        }
    }
};

__device__ __forceinline__ void transpose_tile(const float* __restrict__ W, int K, int N, bf16_t* __restrict__ WT, int kt, int nt, int mode, LAS float* tile) {
    int tid = threadIdx.x; asm volatile("" : "+v"(tid));
    const int k0 = kt * 64, n0 = nt * 256;
    f32x4 v[8];
#pragma unroll
    for (int i = 0; i < 8; ++i) {
        const int idx = tid + 512 * i, rr = idx >> 6, c4 = (idx & 63) * 4;
        v[i] = (f32x4){0.f, 0.f, 0.f, 0.f};
        if (n0 + c4 < N) v[i] = *(const f32x4*)(W + (size_t)(k0 + rr) * N + n0 + c4);
    }
#pragma unroll
    for (int i = 0; i < 8; ++i) {
        const int idx = tid + 512 * i, rr = idx >> 6, c4 = (idx & 63) * 4;
        tile[rr * 257 + c4 + 0] = v[i][0]; tile[rr * 257 + c4 + 1] = v[i][1]; tile[rr * 257 + c4 + 2] = v[i][2]; tile[rr * 257 + c4 + 3] = v[i][3];
    }
    __syncthreads();
#pragma unroll
    for (int j = 0; j < 4; ++j) {
        const int id = tid + 512 * j, n = id >> 3, kc = id & 7;
        float f[8];
#pragma unroll
        for (int e = 0; e < 8; ++e) f[e] = tile[(kc * 8 + e) * 257 + n];
        const int nn = n0 + n; int drow = nn;
        if (mode == 1) { const int isup = nn >= DFF; const int jj = isup ? nn - DFF : nn; drow = (jj >> 7) * 256 + isup * 128 + (jj & 127); }
        u32x4 o; o.x = pk2(f[0], f[1]); o.y = pk2(f[2], f[3]); o.z = pk2(f[4], f[5]); o.w = pk2(f[6], f[7]);
        *(u32x4*)(WT + (size_t)drow * K + k0 + kc * 8) = o;
    }
    __syncthreads();
}
__device__ __forceinline__ void transpose_matrix(const float* W, int K, int N, bf16_t* WT, int mode, LAS float* tile, int b0 = 0) {
    const int nkt = K / 64, nnt = (N + 255) / 256, tot = nkt * nnt;
    if ((int)blockIdx.x < b0) return;
    for (int t = blockIdx.x - b0; t < tot; t += gridDim.x - b0) transpose_tile(W, K, N, WT, t / nnt, t % nnt, mode, tile);
}

__device__ __forceinline__ void phase_convert0(const Params& p, LAS unsigned char* lds) {
    unsigned char* ws = p.ws;
    LAS float* tile = (LAS float*)lds;
    transpose_matrix(p.in[8], DM, 2 * DFF, (bf16_t*)(ws + OFF_W1T), 1, tile);
    transpose_matrix(p.in[9], DFF, DM, (bf16_t*)(ws + OFF_W1O), 0, tile);
    const size_t gtid = (size_t)blockIdx.x * 512 + threadIdx.x, gsz = (size_t)gridDim.x * 512;
    { bf16_t* xb = (bf16_t*)(ws + OFF_XNB); const size_t n8 = (size_t)NTOK * DM / 8, np8 = (size_t)NPR * DM / 8;
      for (size_t i = gtid; i < n8; i += gsz) {
          const float* s = (i < np8) ? p.in[0] + i * 8 : p.in[1] + (i - np8) * 8;
          const f32x4 a = *(const f32x4*)s, b = *(const f32x4*)(s + 4);
          u32x4 o; o.x = pk2(a[0], a[1]); o.y = pk2(a[2], a[3]); o.z = pk2(b[0], b[1]); o.w = pk2(b[2], b[3]);
          *(u32x4*)(xb + i * 8) = o; } }
    if (gtid < 4096) {
        const int g = (int)(gtid >> 6), pp = (int)(gtid & 63);
        const double dt = exp((double)p.in[13][g]);
        const double lr = (double)p.in[11][g * 64 + pp], li = (double)p.in[12][g * 64 + pp];
        const double mag = exp(lr * dt), abr = mag * cos(li * dt), abi = mag * sin(li * dt);
        const double nr = abr - 1.0, ni = abi, den = lr * lr + li * li;
        const double cr = (nr * lr + ni * li) / den, ci = (ni * lr - nr * li) / den;
        bf16_t* bbt = (bf16_t*)(ws + OFF_BBT) + (size_t)g * 128 * 16;
        for (int h = 0; h < 16; ++h) {
            const double bre = (double)p.in[14][(g * 64 + pp) * 16 + h], bim = (double)p.in[15][(g * 64 + pp) * 16 + h];
            bbt[pp * 16 + h] = f2bf((float)(cr * bre - ci * bim));
            bbt[(64 + pp) * 16 + h] = f2bf((float)(cr * bim + ci * bre));
        }
        float* ab = (float*)(ws + OFF_ABAR); ab[(g * 64 + pp) * 2] = (float)abr; ab[(g * 64 + pp) * 2 + 1] = (float)abi;
        bf16_t* ct = (bf16_t*)(ws + OFF_CT) + (size_t)g * 16 * 128;
        for (int o = 0; o < 16; ++o) {
            ct[o * 128 + pp] = f2bf(p.in[16][(g * 16 + o) * 64 + pp]);
            ct[o * 128 + 64 + pp] = f2bf(-p.in[17][(g * 16 + o) * 64 + pp]);
        }
    }
}
__device__ __forceinline__ void phase_convert_mid(const Params& p, LAS unsigned char* lds, int b0) {
    unsigned char* ws = p.ws;
    LAS float* tile = (LAS float*)lds;
    transpose_matrix(p.in[10], DM, NMIX, (bf16_t*)(ws + OFF_WMI), 0, tile, b0);
    transpose_matrix(p.in[19], 1024, 1024, (bf16_t*)(ws + OFF_GLU), 0, tile, b0);
    transpose_matrix(p.in[25], DM, DM, (bf16_t*)(ws + OFF_WMO), 0, tile, b0);
}
__device__ __forceinline__ void phase_convert1(const Params& p, LAS unsigned char* lds, int b0) {
    LAS float* tile = (LAS float*)lds;
    transpose_matrix(p.in[28], DM, 2 * DFF, (bf16_t*)(p.ws + OFF_W1T), 1, tile, b0);
    transpose_matrix(p.in[29], DFF, DM, (bf16_t*)(p.ws + OFF_W1O), 0, tile, b0);
}

__device__ __forceinline__ void phase_ln(const float* R, const float* gam, const float* bet, float* outf, bf16_t* outb, const float* P, const float* XS, int row0 = 0, int row1 = NTOK, int b0 = 0) {
    int lane = threadIdx.x; asm volatile("" : "+v"(lane)); lane &= 63;
    const int wave = __builtin_amdgcn_readfirstlane(threadIdx.x >> 6);
    if ((int)blockIdx.x < b0) return;
    for (int row = row0 + ((int)blockIdx.x - b0) * 8 + wave; row < row1; row += ((int)gridDim.x - b0) * 8) {
        const f32x4* rp = (const f32x4*)(R + (size_t)row * DM) + lane;
        f32x4 v[8]; float s = 0.f;
        if (P != nullptr && row >= NPR) {
            const f32x4* xs = (const f32x4*)(XS + (size_t)(row - NPR) * DM) + lane;
            const f32x4* pp = (const f32x4*)(P + (size_t)(row - NPR) * DM) + lane;
#pragma unroll
            for (int j = 0; j < 8; ++j) v[j] = xs[64 * j] * ALPHA + ((pp[64 * j] + pp[64 * j + 512 * 512]) + (pp[64 * j + 2 * 512 * 512] + pp[64 * j + 3 * 512 * 512]));
        } else {
#pragma unroll
            for (int j = 0; j < 8; ++j) v[j] = rp[64 * j];
        }
#pragma unroll
        for (int j = 0; j < 8; ++j) s += (v[j][0] + v[j][1]) + (v[j][2] + v[j][3]);
        const float mean = wave_sum(s) * (1.f / DM); float s2 = 0.f;
#pragma unroll
        for (int j = 0; j < 8; ++j) { v[j] = v[j] - mean; s2 += (v[j][0] * v[j][0] + v[j][1] * v[j][1]) + (v[j][2] * v[j][2] + v[j][3] * v[j][3]); }
        const float rstd = 1.f / sqrtf(wave_sum(s2) * (1.f / DM) + 1e-5f);
#pragma unroll
        for (int j = 0; j < 8; ++j) {
            const int col = 4 * (lane + 64 * j);
            const f32x4 gg = *(const f32x4*)(gam + col), bb = *(const f32x4*)(bet + col);
            const f32x4 y = v[j] * rstd * gg + bb;
            *(f32x4*)(outf + (size_t)row * DM + col) = y;
            if (outb) { u32x2 o; o.x = pk2(y[0], y[1]); o.y = pk2(y[2], y[3]); *(u32x2*)(outb + (size_t)row * DM + col) = o; }
        }
    }
}

__device__ __forceinline__ void phase_conv(const Params& p) {
    unsigned char* ws = p.ws;
    int lane = threadIdx.x; asm volatile("" : "+v"(lane)); lane &= 63;
    const int wave = __builtin_amdgcn_readfirstlane(threadIdx.x >> 6);
    const bf16_t* PB = (const bf16_t*)(ws + OFF_PROJB);
    const float* BD = (const float*)(ws + OFF_BD);
    const float* cw = p.in[21];
    float* G = (float*)(ws + OFF_G); float* BT = (float*)(ws + OFF_BETA);
    bf16_t* QN = (bf16_t*)(ws + OFF_QN); bf16_t* KN = (bf16_t*)(ws + OFF_KN); float* VV = (float*)(ws + OFF_VV);
    bf16_t* KT = (bf16_t*)(ws + OFF_KT);
    float* QKVS = (float*)(ws + OFF_QKVS);
    const int NIT = 8192 + 1024;
    for (int it = blockIdx.x * 8 + wave; it < NIT; it += gridDim.x * 8) {
        if (it < 8192) {
            const int h = it & 7, tg = (it >> 3) & 255, b = it >> 11;
            const int t0 = tg * 8, tok0 = b * 2048 + t0;
            if (lane < 8) {
                const int tok = tok0 + lane;
                const float braw = BD[(size_t)tok * 16 + h], araw = BD[(size_t)tok * 16 + 8 + h];
                const float xx = araw + p.in[23][h];
                const float sp = xx > 20.f ? xx : log1pf(expf(xx));
                G[(size_t)tok * 8 + h] = -expf(p.in[22][h]) * sp;
                BT[(size_t)tok * 8 + h] = 1.f / (1.f + expf(-braw));
            }
            float x0[3][11], x1[3][11], w0[3][4], w1[3][4];
#pragma unroll
            for (int st = 0; st < 3; ++st) {
                const int col = st * 1024 + h * 128 + 2 * lane;
#pragma unroll
                for (int j = 0; j < 11; ++j) {
                    const int t = t0 - 3 + j;
                    unsigned v = 0u;
                    if (t >= 0) v = *(const unsigned*)(PB + (size_t)(b * 2048 + t) * NPB + 1024 + col);
                    x0[st][j] = bflo(v); x1[st][j] = bfhi(v);
                }
#pragma unroll
                for (int j = 0; j < 4; ++j) { w0[st][j] = cw[j * 3072 + col]; w1[st][j] = cw[j * 3072 + col + 1]; }
            }
            float y0[3][8], y1[3][8];
#pragma unroll
            for (int st = 0; st < 3; ++st)
#pragma unroll
                for (int t = 0; t < 8; ++t) {
                    float a0 = 0.f, a1 = 0.f;
#pragma unroll
                    for (int j = 0; j < 4; ++j) { a0 += x0[st][t + j] * w0[st][j]; a1 += x1[st][t + j] * w1[st][j]; }
                    y0[st][t] = siluf(a0); y1[st][t] = siluf(a1);
                }
            float ss[2][8];
#pragma unroll
            for (int st = 0; st < 2; ++st)
#pragma unroll
                for (int t = 0; t < 8; ++t) ss[st][t] = y0[st][t] * y0[st][t] + y1[st][t] * y1[st][t];
#pragma unroll
            for (int o = 1; o < 64; o <<= 1)
#pragma unroll
                for (int st = 0; st < 2; ++st)
#pragma unroll
                    for (int t = 0; t < 8; ++t) ss[st][t] += __shfl_xor(ss[st][t], o);
#pragma unroll
            for (int st = 0; st < 2; ++st)
#pragma unroll
                for (int t = 0; t < 8; ++t) {
                    float sc = 1.f / sqrtf(ss[st][t] + 1e-6f);
                    if (st == 0) sc *= 0.08838834764831845f;
                    y0[st][t] *= sc; y1[st][t] *= sc;
                }
#pragma unroll
            for (int t = 0; t < 8; ++t) {
                *(unsigned*)(QN + (size_t)(tok0 + t) * 1024 + h * 128 + 2 * lane) = pk2(y0[0][t], y1[0][t]);
                *(unsigned*)(KN + (size_t)(tok0 + t) * 1024 + h * 128 + 2 * lane) = pk2(y0[1][t], y1[1][t]);
                float* o = VV + (size_t)(tok0 + t) * 1024 + h * 128 + 2 * lane; o[0] = y0[2][t]; o[1] = y1[2][t];
            }
            {
                const int chunk = t0 >> 6, c0 = t0 & 63;
                bf16_t* base = KT + ((size_t)((b * 8 + h) * 32 + chunk) * 128 + 2 * lane) * 64 + c0;
                u32x4 o0, o1;
                o0.x = pk2(y0[1][0], y0[1][1]); o0.y = pk2(y0[1][2], y0[1][3]); o0.z = pk2(y0[1][4], y0[1][5]); o0.w = pk2(y0[1][6], y0[1][7]);
                o1.x = pk2(y1[1][0], y1[1][1]); o1.y = pk2(y1[1][2], y1[1][3]); o1.z = pk2(y1[1][4], y1[1][5]); o1.w = pk2(y1[1][6], y1[1][7]);
                *(u32x4*)base = o0; *(u32x4*)(base + 64) = o1;
            }
            if (tg == 255) {
#pragma unroll
                for (int st = 0; st < 3; ++st)
#pragma unroll
                    for (int j = 0; j < 3; ++j) {
                        float* o = p.out + O_PCONV + (size_t)(b * 3 + j) * 3072 + st * 1024 + h * 128 + 2 * lane;
                        o[0] = x0[st][8 + j]; o[1] = x1[st][8 + j];
                    }
            }
        } else {
            const int si = it - 8192, h = si & 7, b = si >> 3;
            const int tok0 = NPR + b * 4;
            if (lane < 4) {
                const int tok = tok0 + lane;
                const float braw = BD[(size_t)tok * 16 + h], araw = BD[(size_t)tok * 16 + 8 + h];
                const float xx = araw + p.in[23][h];
                const float sp = xx > 20.f ? xx : log1pf(expf(xx));
                G[(size_t)tok * 8 + h] = -expf(p.in[22][h]) * sp;
                BT[(size_t)tok * 8 + h] = 1.f / (1.f + expf(-braw));
            }
#pragma unroll
            for (int st = 0; st < 3; ++st) {
                const int col = st * 1024 + h * 128 + 2 * lane;
                float x0[7], x1[7];
#pragma unroll
                for (int j = 0; j < 3; ++j) { const float* s = p.in[5] + (size_t)(b * 3 + j) * 3072 + col; x0[j] = s[0]; x1[j] = s[1]; }
#pragma unroll
                for (int j = 0; j < 4; ++j) { const unsigned v = *(const unsigned*)(PB + (size_t)(tok0 + j) * NPB + 1024 + col); x0[3 + j] = bflo(v); x1[3 + j] = bfhi(v); }
                float w0[4], w1[4];
#pragma unroll
                for (int j = 0; j < 4; ++j) { w0[j] = cw[j * 3072 + col]; w1[j] = cw[j * 3072 + col + 1]; }
#pragma unroll
                for (int t = 0; t < 4; ++t) {
                    float a0 = 0.f, a1 = 0.f;
#pragma unroll
                    for (int j = 0; j < 4; ++j) { a0 += x0[t + j] * w0[j]; a1 += x1[t + j] * w1[j]; }
                    float y0 = siluf(a0), y1 = siluf(a1);
                    if (st < 2) {
                        const float ss = wave_sum(y0 * y0 + y1 * y1);
                        float sc = 1.f / sqrtf(ss + 1e-6f);
                        if (st == 0) sc *= 0.08838834764831845f;
                        y0 *= sc; y1 *= sc;
                    }
                    float* o = QKVS + (size_t)(b * 4 + t) * 3072 + col; o[0] = y0; o[1] = y1;
                }
#pragma unroll
                for (int j = 0; j < 3; ++j) {
                    float* o = p.out + O_SCONV + (size_t)(b * 3 + j) * 3072 + col;
                    o[0] = x0[4 + j]; o[1] = x1[4 + j];
                }
            }
        }
    }
}

__device__ __forceinline__ f32x16 mfma32(bf16x8 a, bf16x8 b, f32x16 c) { return __builtin_amdgcn_mfma_f32_32x32x16_bf16(a, b, c, 0, 0, 0); }
__device__ __forceinline__ f32x4 mfma16(bf16x8 a, bf16x8 b, f32x4 c) { return __builtin_amdgcn_mfma_f32_16x16x32_bf16(a, b, c, 0, 0, 0); }
__device__ __forceinline__ bf16x8 mk8(unsigned a, unsigned b, unsigned c, unsigned d) { u32x4 t = {a, b, c, d}; return __builtin_bit_cast(bf16x8, t); }
constexpr int MTP = 36;

template <int C> __device__ __forceinline__ void solve_col(float (&t)[64], const LAS float* MT, int lane) {
    float a0 = 0.f, a1 = 0.f, a2 = 0.f, a3 = 0.f;
    int mb = 0; if (C < 63) asm volatile("" : "+v"(mb) : "v"(t[C + 1]));
#pragma unroll
    for (int jj = (C + 1) / 4; jj < 16; ++jj) {
        const int j4 = jj * 4;
        if (jj == 8 && (C + 1) / 4 < 8) asm volatile("" : "+v"(mb) : "v"(a0), "v"(a1), "v"(a2), "v"(a3));
        const int ti = (j4 >> 5) + (C >> 5);
        const f32x4 m = *(const LAS f32x4*)(MT + mb + ti * 32 * MTP + (C & 31) * MTP + (j4 & 31));
        if (j4 + 0 > C) a0 += t[j4 + 0] * m[0];
        if (j4 + 1 > C) a1 += t[j4 + 1] * m[1];
        if (j4 + 2 > C) a2 += t[j4 + 2] * m[2];
        if (j4 + 3 > C) a3 += t[j4 + 3] * m[3];
    }
    t[C] = ((lane == C) ? 1.f : 0.f) - ((a0 + a1) + (a2 + a3));
    if constexpr (C > 0) solve_col<C - 1>(t, MT, lane);
}

__device__ __forceinline__ void gdn_prep_item(const Params& p, int it, LAS unsigned char* wl, LAS float* gcl_) {
    unsigned char* ws = p.ws;
    int lane = threadIdx.x; asm volatile("" : "+v"(lane)); lane &= 63;
    const int r = lane & 31, hh = lane >> 5;
    const int n = it & 31, bh = it >> 5, h = bh & 7, b = bh >> 3;
    const int tok0 = b * 2048 + n * 64;
    LAS float* MT = (LAS float*)wl;
    LAS float* gcL = gcl_;
    LAS float* btL = gcL + 64;
    const float* G = (const float*)(ws + OFF_G); const float* BT = (const float*)(ws + OFF_BETA);
    float gc = G[(size_t)(tok0 + lane) * 8 + h];
    const float bv = BT[(size_t)(tok0 + lane) * 8 + h];
#pragma unroll
    for (int o = 1; o < 64; o <<= 1) { const float t = __int_as_float(__builtin_amdgcn_ds_bpermute((lane - o) << 2, __float_as_int(gc))); if (lane >= o) gc += t; }
    const float gl = __int_as_float(__builtin_amdgcn_readlane(__float_as_int(gc), 63));
    gcL[lane] = gc; btL[lane] = bv;
    if (lane == 0) ((float*)(ws + OFF_GLAST))[it] = __expf(gl);
    WSYNC();
    const bf16_t* kp = (const bf16_t*)(ws + OFF_KN) + (size_t)tok0 * 1024 + h * 128;
    const bf16_t* qp = (const bf16_t*)(ws + OFF_QN) + (size_t)tok0 * 1024 + h * 128;
    bf16x8 Kf[2][8];
#pragma unroll
    for (int mt = 0; mt < 2; ++mt)
#pragma unroll
        for (int ks = 0; ks < 8; ++ks) Kf[mt][ks] = *(const bf16x8*)(kp + (size_t)(mt * 32 + r) * 1024 + ks * 16 + hh * 8);
    {
        bf16_t* KG = (bf16_t*)(ws + OFF_KG) + (size_t)it * 8192;
#pragma unroll
        for (int mt = 0; mt < 2; ++mt) {
            const float e = -__expf(gcL[mt * 32 + r]);
#pragma unroll
            for (int ks = 0; ks < 8; ++ks) {
                const u32x4 v = __builtin_bit_cast(u32x4, Kf[mt][ks]);
                u32x2 o0, o1; o0.x = pk2(bflo(v.x) * e, bfhi(v.x) * e); o0.y = pk2(bflo(v.y) * e, bfhi(v.y) * e);
                o1.x = pk2(bflo(v.z) * e, bfhi(v.z) * e); o1.y = pk2(bflo(v.w) * e, bfhi(v.w) * e);
                bf16_t* fp = KG + (mt * 8 + ks) * 512 + r * 8 + 4 * hh;
                *(u32x2*)fp = o0; *(u32x2*)(fp + 256) = o1;
            }
        }
    }
    __builtin_amdgcn_sched_barrier(0);
#pragma unroll
    for (int ti = 0; ti < 3; ++ti) {
        __builtin_amdgcn_sched_barrier(0);
        const int mi = (ti >= 1), ni = (ti == 2);
        f32x16 a = {};
#pragma unroll
        for (int ks = 0; ks < 8; ++ks) a = mfma32(Kf[mi][ks], Kf[ni][ks], a);
        const int j = ni * 32 + r; const float gcj = gcL[j];
#pragma unroll
        for (int qq = 0; qq < 4; ++qq) {
            const int i0 = mi * 32 + 8 * qq + 4 * hh;
            const f32x4 gci = *(const LAS f32x4*)(gcL + i0), bti = *(const LAS f32x4*)(btL + i0);
            f32x4 mv;
#pragma unroll
            for (int e = 0; e < 4; ++e) {
                const int i = i0 + e;
                const float dec = __expf(fminf(gci[e] - gcj, 0.f));
                mv[e] = (i > j) ? bti[e] * a[qq * 4 + e] * dec : 0.f;
            }
            *(LAS f32x4*)(MT + ti * 32 * MTP + r * MTP + 8 * qq + 4 * hh) = mv;
        }
    }
    bf16_t* ATT = (bf16_t*)(ws + OFF_ATT) + (size_t)it * 4096;
    bf16_t* QG = (bf16_t*)(ws + OFF_QG) + (size_t)it * 8192;
#pragma unroll
    for (int mi = 0; mi < 2; ++mi) {
        __builtin_amdgcn_sched_barrier(0);
        bf16x8 Qf[8];
#pragma unroll
        for (int ks = 0; ks < 8; ++ks) Qf[ks] = *(const bf16x8*)(qp + (size_t)(mi * 32 + r) * 1024 + ks * 16 + hh * 8);
#pragma unroll
        for (int ni = 0; ni <= mi; ++ni) {
            __builtin_amdgcn_sched_barrier(0);
            f32x16 q = {};
#pragma unroll
            for (int ks = 0; ks < 8; ++ks) q = mfma32(Qf[ks], Kf[ni][ks], q);
            const int j = ni * 32 + r; const float gcj = gcL[j];
#pragma unroll
            for (int qq = 0; qq < 4; ++qq) {
                const int i0 = mi * 32 + 8 * qq + 4 * hh;
                const f32x4 gci = *(const LAS f32x4*)(gcL + i0);
#pragma unroll
                for (int e = 0; e < 4; ++e) {
                    const int i = i0 + e;
                    const float dec = __expf(fminf(gci[e] - gcj, 0.f));
                    ATT[((mi * 2 + ni) * 2 + (r >> 4)) * 512 + (((r >> 2) & 1) * 32 + (i & 31)) * 8 + 4 * ((r >> 3) & 1) + (r & 3)] = f2bf((i >= j) ? q[qq * 4 + e] * dec : 0.f);
                }
            }
        }
        __builtin_amdgcn_sched_barrier(0);
        const float e = __expf(gcL[mi * 32 + r]);
#pragma unroll
        for (int ks = 0; ks < 8; ++ks) {
            const u32x4 v = __builtin_bit_cast(u32x4, Qf[ks]);
            u32x2 o0, o1; o0.x = pk2(bflo(v.x) * e, bfhi(v.x) * e); o0.y = pk2(bflo(v.y) * e, bfhi(v.y) * e);
            o1.x = pk2(bflo(v.z) * e, bfhi(v.z) * e); o1.y = pk2(bflo(v.w) * e, bfhi(v.w) * e);
            bf16_t* fp = QG + (mi * 8 + ks) * 512 + r * 8 + 4 * hh;
            *(u32x2*)fp = o0; *(u32x2*)(fp + 256) = o1;
        }
    }
    WSYNC();
    float t[64];
    solve_col<63>(t, MT, lane);
    WSYNC();
    int lane5 = lane; asm volatile("" : "+v"(lane5) : "v"(t[0]));
    const int r5 = lane5 & 31, h5 = lane5 >> 5;
    {
        bf16_t* TBt = (bf16_t*)(ws + OFF_TBT) + (size_t)it * 4096 + ((lane5 >> 5) * 4) * 512 + (lane5 & 31) * 8;
#pragma unroll
        for (int m2 = 0; m2 < 2; ++m2)
#pragma unroll
            for (int sx = 0; sx < 2; ++sx) {
                const int c0 = m2 * 32 + 16 * sx;
                const f32x4 b0 = *(const LAS f32x4*)(btL + c0), b1 = *(const LAS f32x4*)(btL + c0 + 4), b2 = *(const LAS f32x4*)(btL + c0 + 8), b3 = *(const LAS f32x4*)(btL + c0 + 12);
                u32x4 oa, ob;
                oa.x = pk2(t[c0 + 0] * b0[0], t[c0 + 1] * b0[1]); oa.y = pk2(t[c0 + 2] * b0[2], t[c0 + 3] * b0[3]);
                oa.z = pk2(t[c0 + 8] * b2[0], t[c0 + 9] * b2[1]); oa.w = pk2(t[c0 + 10] * b2[2], t[c0 + 11] * b2[3]);
                ob.x = pk2(t[c0 + 4] * b1[0], t[c0 + 5] * b1[1]); ob.y = pk2(t[c0 + 6] * b1[2], t[c0 + 7] * b1[3]);
                ob.z = pk2(t[c0 + 12] * b3[0], t[c0 + 13] * b3[1]); ob.w = pk2(t[c0 + 14] * b3[2], t[c0 + 15] * b3[3]);
                bf16_t* fp = TBt + (m2 * 2 + sx) * 512;
                *(u32x4*)fp = oa; *(u32x4*)(fp + 256) = ob;
            }
    }
    {
        const bf16_t* KT = (const bf16_t*)(ws + OFF_KT) + (size_t)it * 8192;
        bf16_t* KDT = (bf16_t*)(ws + OFF_KDT) + (size_t)it * 8192;
#pragma unroll
        for (int nt = 0; nt < 4; ++nt) {
            __builtin_amdgcn_sched_barrier(0);
#pragma unroll
            for (int ks = 0; ks < 4; ++ks) {
                const u32x4 v = *(const u32x4*)(KT + (size_t)(nt * 32 + r5) * 64 + ks * 16 + h5 * 8);
                const f32x4 g0 = *(const LAS f32x4*)(gcL + ks * 16 + h5 * 8), g1 = *(const LAS f32x4*)(gcL + ks * 16 + h5 * 8 + 4);
                u32x2 o0, o1;
                o0.x = pk2(bflo(v.x) * __expf(gl - g0[0]), bfhi(v.x) * __expf(gl - g0[1])); o0.y = pk2(bflo(v.y) * __expf(gl - g0[2]), bfhi(v.y) * __expf(gl - g0[3]));
                o1.x = pk2(bflo(v.z) * __expf(gl - g1[0]), bfhi(v.z) * __expf(gl - g1[1])); o1.y = pk2(bflo(v.w) * __expf(gl - g1[2]), bfhi(v.w) * __expf(gl - g1[3]));
                bf16_t* fp = KDT + (nt * 4 + ks) * 512 + r5 * 8 + 4 * h5;
                *(u32x2*)fp = o0; *(u32x2*)(fp + 256) = o1;
            }
        }
    }
    WSYNC();
}

__device__ __forceinline__ void gdn_sample_item(const Params& p, int it, LAS unsigned char* wl) {
    unsigned char* ws = p.ws;
    int lane = threadIdx.x; asm volatile("" : "+v"(lane)); lane &= 63;
    const int c = lane & 31, hh = lane >> 5;
    const int qd = it & 3, bh = it >> 2, h = bh & 7, b = bh >> 3;
    const int dv = qd * 32 + c;
    float s[64];
    { const float* sp = p.in[4] + (size_t)bh * 16384 + (size_t)(hh * 64) * 128 + dv;
#pragma unroll
      for (int i = 0; i < 64; ++i) s[i] = sp[i * 128]; }
    LAS float* kq = (LAS float*)wl;
    const float* QKVS = (const float*)(ws + OFF_QKVS);
    const float* G = (const float*)(ws + OFF_G); const float* BT = (const float*)(ws + OFF_BETA);
    bf16_t* O = (bf16_t*)(ws + OFF_O);
#pragma unroll
    for (int t = 0; t < 4; ++t) {
        const float* row = QKVS + (size_t)(b * 4 + t) * 3072 + h * 128;
        kq[t * 256 + lane] = row[1024 + lane]; kq[t * 256 + 64 + lane] = row[1024 + 64 + lane];
        kq[t * 256 + 128 + lane] = row[lane]; kq[t * 256 + 192 + lane] = row[64 + lane];
    }
    WSYNC();
#pragma unroll 1
    for (int t = 0; t < 4; ++t) {
        const int tok = NPR + b * 4 + t;
        const float al = __expf(G[(size_t)tok * 8 + h]), be = BT[(size_t)tok * 8 + h];
        const float v = QKVS[(size_t)(b * 4 + t) * 3072 + 2048 + h * 128 + dv];
        float d0 = 0.f, d1 = 0.f, d2 = 0.f, d3 = 0.f;
        int kb = t * 256 + hh * 64;
#pragma unroll
        for (int i = 0; i < 64; i += 4) {
            if ((i & 15) == 0) asm volatile("" : "+v"(kb) : "v"(d0), "v"(d1), "v"(d2), "v"(d3));
            const f32x4 kk = *(const LAS f32x4*)(kq + kb + i);
            s[i] *= al; s[i + 1] *= al; s[i + 2] *= al; s[i + 3] *= al;
            d0 += kk[0] * s[i]; d1 += kk[1] * s[i + 1]; d2 += kk[2] * s[i + 2]; d3 += kk[3] * s[i + 3];
        }
        float dd = (d0 + d1) + (d2 + d3);
        dd += __shfl_xor(dd, 32);
        const float rr = be * (v - dd);
        float o0 = 0.f, o1 = 0.f, o2 = 0.f, o3 = 0.f;
        asm volatile("" : "+v"(kb) : "v"(rr));
#pragma unroll
        for (int i = 0; i < 64; i += 4) {
            if ((i & 15) == 0) asm volatile("" : "+v"(kb) : "v"(o0), "v"(o1), "v"(o2), "v"(o3));
            const f32x4 kk = *(const LAS f32x4*)(kq + kb + i);
            const f32x4 qq = *(const LAS f32x4*)(kq + kb + 128 + i);
            s[i] += rr * kk[0]; s[i + 1] += rr * kk[1]; s[i + 2] += rr * kk[2]; s[i + 3] += rr * kk[3];
            o0 += qq[0] * s[i]; o1 += qq[1] * s[i + 1]; o2 += qq[2] * s[i + 2]; o3 += qq[3] * s[i + 3];
        }
        float oo = (o0 + o1) + (o2 + o3);
        oo += __shfl_xor(oo, 32);
        if (hh == 0) O[(size_t)tok * 1024 + h * 128 + dv] = f2bf(oo);
    }
    int dv2 = dv; asm volatile("" : "+v"(dv2));
    float* So = p.out + O_SGDN + (size_t)bh * 16384 + (size_t)(hh * 64) * 128 + dv2;
#pragma unroll
    for (int i = 0; i < 64; ++i) So[i * 128] = s[i];
    WSYNC();
}

__device__ __forceinline__ void s5_unit(const Params& p, int g, int tok_base, int nsub, bool sample, int b0, LAS unsigned char* wl, int hb_off);
__device__ __forceinline__ void phase_gdn_prep(const Params& p, LAS unsigned char* lds) {
    const int wave = __builtin_amdgcn_readfirstlane(threadIdx.x >> 6);
    LAS unsigned char* wl = lds + wave * 16384;
    if (wave < 4) { for (int it = blockIdx.x * 4 + wave; it < 1024; it += gridDim.x * 4) gdn_prep_item(p, it, wl, (LAS float*)(lds + 143360 + wave * 512)); }
    else {
        for (int it = blockIdx.x * 4 + (wave - 4); it < 4096; it += gridDim.x * 4) gdn_sample_item(p, it, wl);
        for (int u = blockIdx.x * 4 + (wave - 4); u < 2048; u += gridDim.x * 4) { const int g = u & 63, bq = u >> 6; s5_unit(p, g, NPR + bq * 16, 1, true, bq * 4, wl, 8192); }
    }
}

__device__ __forceinline__ bf16x8 ldperm(const bf16_t* p8, int hh) {
    const u32x2 lo = *(const u32x2*)(p8 + 4 * hh), hi = *(const u32x2*)(p8 + 8 + 4 * hh);
    return mk8(lo.x, lo.y, hi.x, hi.y);
}
constexpr int GDN_BUF = 61440, GDN_LDS0 = 21504;
__device__ __forceinline__ void gdn_dma_chunk(const unsigned char* ws, int it, LAS unsigned char* buf, int lane) {
    const bf16_t* KG = (const bf16_t*)(ws + OFF_KG) + (size_t)it * 8192 + lane * 8;
    const bf16_t* QG = (const bf16_t*)(ws + OFF_QG) + (size_t)it * 8192 + lane * 8;
    const bf16_t* KDT = (const bf16_t*)(ws + OFF_KDT) + (size_t)it * 8192 + lane * 8;
#pragma unroll
    for (int f = 0; f < 16; ++f) __builtin_amdgcn_global_load_lds((const unsigned*)(KG + f * 512), (LAS unsigned*)(buf + f * 1024), 16, 0, 0);
#pragma unroll
    for (int f = 0; f < 16; ++f) __builtin_amdgcn_global_load_lds((const unsigned*)(QG + f * 512), (LAS unsigned*)(buf + 16384 + f * 1024), 16, 0, 0);
#pragma unroll
    for (int f = 0; f < 16; ++f) __builtin_amdgcn_global_load_lds((const unsigned*)(KDT + f * 512), (LAS unsigned*)(buf + 32768 + f * 1024), 16, 0, 0);
    const bf16_t* TBt = (const bf16_t*)(ws + OFF_TBT) + (size_t)it * 4096 + lane * 8;
    const bf16_t* ATT = (const bf16_t*)(ws + OFF_ATT) + (size_t)it * 4096 + lane * 8;
#pragma unroll
    for (int k = 0; k < 6; ++k) { const int f = (k < 2) ? k : k + 2;
        __builtin_amdgcn_global_load_lds((const unsigned*)(TBt + f * 512), (LAS unsigned*)(buf + 49152 + k * 1024), 16, 0, 0);
        __builtin_amdgcn_global_load_lds((const unsigned*)(ATT + f * 512), (LAS unsigned*)(buf + 55296 + k * 1024), 16, 0, 0); }
}
template <int PAR>
__device__ __forceinline__ void gdn_chunk(const Params& p, LAS unsigned char* gb, int n, int bh, int b, int h, int dv, int hh, int lane, f32x16 (&S)[4]) {
    unsigned char* ws = p.ws;
    asm volatile("s_waitcnt vmcnt(0)" ::: "memory");
    const int it = bh * 32 + n;
    const LAS unsigned char* cb = gb + PAR * GDN_BUF + lane * 16;
    const float* VV = (const float*)(ws + OFF_VV) + (size_t)(b * 2048 + n * 64) * 1024 + h * 128 + dv;
    bf16_t* O = (bf16_t*)(ws + OFF_O);
    const float gl = ((const float*)(ws + OFF_GLAST))[it];
    f32x16 v0, v1;
#pragma unroll
    for (int q = 0; q < 16; ++q) { const int i = 8 * (q >> 2) + 4 * hh + (q & 3); v0[q] = VV[(size_t)i * 1024]; v1[q] = VV[(size_t)(32 + i) * 1024]; }
    float pf8 = 0.f;
    if (n + 1 < 32) pf8 = VV[(size_t)(64 + lane) * 1024];
    if (n + 1 < 32) gdn_dma_chunk(ws, it + 1, gb + (1 - PAR) * GDN_BUF, lane);
    bf16x8 Sb[4][2];
#pragma unroll
    for (int kt = 0; kt < 4; ++kt)
#pragma unroll
        for (int s = 0; s < 2; ++s)
            Sb[kt][s] = mk8(pk2(S[kt][8 * s + 0], S[kt][8 * s + 1]), pk2(S[kt][8 * s + 2], S[kt][8 * s + 3]), pk2(S[kt][8 * s + 4], S[kt][8 * s + 5]), pk2(S[kt][8 * s + 6], S[kt][8 * s + 7]));
    bf16x8 Eb[2][2];
    {
        f32x16 a0 = {}, a1 = {};
#pragma unroll
        for (int kt = 0; kt < 4; ++kt)
#pragma unroll
            for (int s = 0; s < 2; ++s) {
                const u32x4 hv = __builtin_bit_cast(u32x4, Sb[kt][s]);
                const bf16x8 lo = mk8(pk2(S[kt][8 * s + 0] - bflo(hv.x), S[kt][8 * s + 1] - bfhi(hv.x)), pk2(S[kt][8 * s + 2] - bflo(hv.y), S[kt][8 * s + 3] - bfhi(hv.y)),
                                      pk2(S[kt][8 * s + 4] - bflo(hv.z), S[kt][8 * s + 5] - bfhi(hv.z)), pk2(S[kt][8 * s + 6] - bflo(hv.w), S[kt][8 * s + 7] - bfhi(hv.w)));
                const bf16x8 A0 = *(const LAS bf16x8*)(cb + (kt * 2 + s) * 1024);
                const bf16x8 A1 = *(const LAS bf16x8*)(cb + (8 + kt * 2 + s) * 1024);
                a0 = mfma32(A0, Sb[kt][s], a0); a1 = mfma32(A1, Sb[kt][s], a1);
                a0 = mfma32(A0, lo, a0); a1 = mfma32(A1, lo, a1);
            }
        a0 += v0; a1 += v1;
#pragma unroll
        for (int s = 0; s < 2; ++s) {
            Eb[0][s] = mk8(pk2(a0[8 * s + 0], a0[8 * s + 1]), pk2(a0[8 * s + 2], a0[8 * s + 3]), pk2(a0[8 * s + 4], a0[8 * s + 5]), pk2(a0[8 * s + 6], a0[8 * s + 7]));
            Eb[1][s] = mk8(pk2(a1[8 * s + 0], a1[8 * s + 1]), pk2(a1[8 * s + 2], a1[8 * s + 3]), pk2(a1[8 * s + 4], a1[8 * s + 5]), pk2(a1[8 * s + 6], a1[8 * s + 7]));
        }
    }
    bf16x8 Vb[2][2];
#pragma unroll
    for (int mt = 0; mt < 2; ++mt) {
        f32x16 a = {};
#pragma unroll
        for (int m2 = 0; m2 <= mt; ++m2)
#pragma unroll
            for (int s = 0; s < 2; ++s) a = mfma32(*(const LAS bf16x8*)(cb + 49152 + ((mt == 0) ? s : 2 + m2 * 2 + s) * 1024), Eb[m2][s], a);
#pragma unroll
        for (int s = 0; s < 2; ++s)
            Vb[mt][s] = mk8(pk2(a[8 * s + 0], a[8 * s + 1]), pk2(a[8 * s + 2], a[8 * s + 3]), pk2(a[8 * s + 4], a[8 * s + 5]), pk2(a[8 * s + 6], a[8 * s + 7]));
    }
#pragma unroll
    for (int mt = 0; mt < 2; ++mt) {
        f32x16 a = {};
#pragma unroll
        for (int kt = 0; kt < 4; ++kt)
#pragma unroll
            for (int s = 0; s < 2; ++s) a = mfma32(*(const LAS bf16x8*)(cb + 16384 + ((mt * 4 + kt) * 2 + s) * 1024), Sb[kt][s], a);
#pragma unroll
        for (int m2 = 0; m2 <= mt; ++m2)
#pragma unroll
            for (int s = 0; s < 2; ++s) a = mfma32(*(const LAS bf16x8*)(cb + 55296 + ((mt == 0) ? s : 2 + m2 * 2 + s) * 1024), Vb[m2][s], a);
#pragma unroll
        for (int q = 0; q < 16; ++q) { const int i = mt * 32 + 8 * (q >> 2) + 4 * hh + (q & 3);
            O[(size_t)(b * 2048 + n * 64 + i) * 1024 + h * 128 + dv] = f2bf(a[q]); }
    }
#pragma unroll
    for (int kt = 0; kt < 4; ++kt) {
        f32x16 a = S[kt] * gl;
#pragma unroll
        for (int m2 = 0; m2 < 2; ++m2)
#pragma unroll
            for (int s = 0; s < 2; ++s) a = mfma32(*(const LAS bf16x8*)(cb + 32768 + ((kt * 2 + m2) * 2 + s) * 1024), Vb[m2][s], a);
        S[kt] = a;
    }
    asm volatile("" :: "v"(pf8));
}
__device__ __forceinline__ void gdn_scan_unit(const Params& p, int unit, LAS unsigned char* gb) {
    int lane = threadIdx.x; asm volatile("" : "+v"(lane)); lane &= 63;
    const int r = lane & 31, hh = lane >> 5;
    const int sl = unit & 3, bh = unit >> 2, h = bh & 7, b = bh >> 3;
    const int dv = sl * 32 + r;
    f32x16 S[4];
#pragma unroll
    for (int kt = 0; kt < 4; ++kt) S[kt] = (f32x16){};
    gdn_dma_chunk(p.ws, bh * 32, gb, lane);
#pragma unroll 1
    for (int n = 0; n < 32; n += 2) {
        gdn_chunk<0>(p, gb, n, bh, b, h, dv, hh, lane, S);
        gdn_chunk<1>(p, gb, n + 1, bh, b, h, dv, hh, lane, S);
    }
    int lane6 = threadIdx.x; asm volatile("" : "+v"(lane6)); lane6 &= 63;
    float* So = p.out + O_PGDN + (size_t)bh * 16384 + (sl * 32 + (lane6 & 31)) + (size_t)(4 * (lane6 >> 5)) * 128;
#pragma unroll
    for (int kt = 0; kt < 4; ++kt)
#pragma unroll
        for (int q = 0; q < 16; ++q) { const int dk = kt * 32 + 8 * (q >> 2) + (q & 3); So[(size_t)dk * 128] = S[kt][q]; }
}

__device__ __forceinline__ void s5_unit(const Params& p, int g, int tok_base, int nsub, bool sample, int b0, LAS unsigned char* wl, int hb_off) {
    unsigned char* ws = p.ws;
    int lane = threadIdx.x; asm volatile("" : "+v"(lane)); lane &= 63;
    const int l15 = lane & 15, l4 = lane >> 4;
    LAS bf16_t* HB = (LAS bf16_t*)(wl + hb_off);
    const bf16_t* PB = (const bf16_t*)(ws + OFF_PROJB);
    bf16_t* ZB = (bf16_t*)(ws + OFF_ZB);
    const float* AB = (const float*)(ws + OFF_ABAR);
    const float ar = AB[(g * 64 + lane) * 2], ai = AB[(g * 64 + lane) * 2 + 1];
    const bf16_t* bbt = (const bf16_t*)(ws + OFF_BBT) + (size_t)g * 2048;
    const bf16_t* ct = (const bf16_t*)(ws + OFF_CT) + (size_t)g * 2048;
    bf16x8 Bf[8], Cf[4];
    const bf16x8 zero8 = {0, 0, 0, 0, 0, 0, 0, 0};
#pragma unroll
    for (int nt = 0; nt < 8; ++nt) Bf[nt] = (l4 < 2) ? *(const bf16x8*)(bbt + (nt * 16 + l15) * 16 + 8 * l4) : zero8;
#pragma unroll
    for (int s = 0; s < 4; ++s) Cf[s] = *(const bf16x8*)(ct + l15 * 128 + 32 * s + 8 * l4);
    const float dskip = p.in[18][g * 16 + l15];
    float hr = 0.f, hi = 0.f;
    const int last_tok = tok_base + (nsub - 1) * 16;
    {
        const bf16x8 A0 = (l4 < 2) ? *(const bf16x8*)(PB + (size_t)(tok_base + l15) * NPB + g * 16 + 8 * l4) : zero8;
        LAS float* BU = (LAS float*)wl;
#pragma unroll
        for (int nt = 0; nt < 8; ++nt) {
            f32x4 a = {0.f, 0.f, 0.f, 0.f};
            a = mfma16(A0, Bf[nt], a);
#pragma unroll
            for (int q = 0; q < 4; ++q) BU[(4 * l4 + q) * 128 + nt * 16 + l15] = a[q];
        }
    }
    const int tok1 = (nsub > 1) ? tok_base + 16 : tok_base;
    bf16x8 Au = (l4 < 2) ? *(const bf16x8*)(PB + (size_t)(tok1 + l15) * NPB + g * 16 + 8 * l4) : zero8;
    float uu[4];
#pragma unroll
    for (int q = 0; q < 4; ++q) uu[q] = bf2f(PB[(size_t)(tok_base + 4 * l4 + q) * NPB + g * 16 + l15]);
    WSYNC();
#pragma unroll 1
    for (int sc = 0; sc < nsub; ++sc) {
        const int tok0 = tok_base + sc * 16;
        LAS float* BU = (LAS float*)(wl + (sc & 1) * 8192);
        LAS float* BUn = (LAS float*)(wl + ((sc + 1) & 1) * 8192);
        const int tok2 = (tok0 + 32 <= last_tok) ? tok0 + 32 : last_tok;
        const int tokn = (tok0 + 16 <= last_tok) ? tok0 + 16 : last_tok;
        const bf16x8 Au_n = (l4 < 2) ? *(const bf16x8*)(PB + (size_t)(tok2 + l15) * NPB + g * 16 + 8 * l4) : zero8;
        float uu_n[4];
#pragma unroll
        for (int q = 0; q < 4; ++q) uu_n[q] = bf2f(PB[(size_t)(tokn + 4 * l4 + q) * NPB + g * 16 + l15]);
        if (sc + 1 < nsub) {
#pragma unroll
            for (int nt = 0; nt < 8; ++nt) {
                f32x4 a = {0.f, 0.f, 0.f, 0.f};
                a = mfma16(Au, Bf[nt], a);
#pragma unroll
                for (int q = 0; q < 4; ++q) BUn[(4 * l4 + q) * 128 + nt * 16 + l15] = a[q];
            }
        }
#pragma unroll
        for (int t = 0; t < 16; ++t) {
            if (sample && (t & 3) == 0) {
                const int bb = b0 + (t >> 2);
                hr = p.in[2][((size_t)bb * 64 + g) * 64 + lane]; hi = p.in[3][((size_t)bb * 64 + g) * 64 + lane];
            }
            const float br = BU[t * 128 + lane], bi = BU[t * 128 + 64 + lane];
            const float nr = ar * hr - ai * hi + br, ni = ar * hi + ai * hr + bi;
            hr = nr; hi = ni;
            HB[t * 136 + lane] = f2bf(hr); HB[t * 136 + 64 + lane] = f2bf(hi);
            if (sample && (t & 3) == 3) {
                const int bb = b0 + (t >> 2);
                p.out[O_SRE + ((size_t)bb * 64 + g) * 64 + lane] = hr; p.out[O_SIM + ((size_t)bb * 64 + g) * 64 + lane] = hi;
            }
        }
        WSYNC();
        f32x4 y = {0.f, 0.f, 0.f, 0.f};
#pragma unroll
        for (int s = 0; s < 4; ++s) {
            const bf16x8 Ah = *(const LAS bf16x8*)(HB + l15 * 136 + 32 * s + 8 * l4);
            y = mfma16(Ah, Cf[s], y);
        }
#pragma unroll
        for (int q = 0; q < 4; ++q) {
            const int tok = tok0 + 4 * l4 + q;
            ZB[(size_t)tok * 1024 + g * 16 + l15] = f2bf(gelu_tanh(y[q] + dskip * uu[q]));
        }
        WSYNC();
        Au = Au_n;
#pragma unroll
        for (int q = 0; q < 4; ++q) uu[q] = uu_n[q];
    }
    if (!sample) {
        const int b = tok_base >> 11;
        p.out[O_PRE + ((size_t)b * 64 + g) * 64 + lane] = hr; p.out[O_PIM + ((size_t)b * 64 + g) * 64 + lane] = hi;
    }
}

__device__ __forceinline__ void phase_scan(const Params& p, LAS unsigned char* lds) {
    const int wave = __builtin_amdgcn_readfirstlane(threadIdx.x >> 6);
    if (wave == 0) {
        for (int B = blockIdx.x; B < 128; B += gridDim.x) { const int xi = B & 7, idx = B >> 3; gdn_scan_unit(p, ((xi * 4 + (idx >> 2)) << 2) + (idx & 3), lds + GDN_LDS0); }
    }
    else if (wave == 1) { for (int u = blockIdx.x; u < 256; u += gridDim.x) s5_unit(p, u & 63, (u >> 6) * 2048, 128, false, 0, lds, 16384); }
}

__device__ __forceinline__ void phase_onorm(const Params& p) {
    unsigned char* ws = p.ws;
    int lane = threadIdx.x; asm volatile("" : "+v"(lane)); lane &= 63;
    const int wave = __builtin_amdgcn_readfirstlane(threadIdx.x >> 6);
    const bf16_t* O = (const bf16_t*)(ws + OFF_O); const bf16_t* PB = (const bf16_t*)(ws + OFF_PROJB);
    bf16_t* YM = (bf16_t*)(ws + OFF_YMIX);
    const float nw0 = p.in[24][2 * lane], nw1 = p.in[24][2 * lane + 1];
    for (int it4 = blockIdx.x * 8 + wave; it4 < NTOK * 2; it4 += gridDim.x * 8) {
        unsigned ov[4], gv[4];
#pragma unroll
        for (int j = 0; j < 4; ++j) {
            const int it = it4 * 4 + j, h = it & 7, tok = it >> 3;
            ov[j] = *(const unsigned*)(O + (size_t)tok * 1024 + h * 128 + 2 * lane);
            gv[j] = *(const unsigned*)(PB + (size_t)tok * NPB + 4096 + h * 128 + 2 * lane);
        }
        float ss[4];
#pragma unroll
        for (int j = 0; j < 4; ++j) { const float o0 = bflo(ov[j]), o1 = bfhi(ov[j]); ss[j] = o0 * o0 + o1 * o1; }
#pragma unroll
        for (int o = 1; o < 64; o <<= 1) {
#pragma unroll
            for (int j = 0; j < 4; ++j) ss[j] += __shfl_xor(ss[j], o);
        }
#pragma unroll
        for (int j = 0; j < 4; ++j) {
            const int it = it4 * 4 + j, h = it & 7, tok = it >> 3;
            const float o0 = bflo(ov[j]), o1 = bfhi(ov[j]);
            const float rs = 1.f / sqrtf(ss[j] * (1.f / 128.f) + 1e-6f);
            *(unsigned*)(YM + (size_t)tok * DM + 1024 + h * 128 + 2 * lane) = pk2(o0 * rs * nw0 * siluf(bflo(gv[j])), o1 * rs * nw1 * siluf(bfhi(gv[j])));
        }
    }
}

#define XB_TMO      128
#define XB_XCNT(j)  (256  + 64 * (j))
#define XB_XSUB(j)  (1280 + 64 * (j))
#define XB_XGEN(j)  (2304 + 64 * (j))
#define XB_TOP      3328
#define XB_TOPGEN   3392
#define XCD_BAR_WORDS 3456
#define XB_SPIN_CAP (1u << 18)
__device__ __forceinline__ unsigned xb_ld(unsigned* p)              { return __hip_atomic_load(p, __ATOMIC_RELAXED, __HIP_MEMORY_SCOPE_AGENT); }
__device__ __forceinline__ unsigned xb_add(unsigned* p, unsigned v) { return __hip_atomic_fetch_add(p, v, __ATOMIC_RELAXED, __HIP_MEMORY_SCOPE_AGENT); }
__device__ __forceinline__ unsigned xb_xcc_id() { return (unsigned)__builtin_amdgcn_s_getreg((3 << 11) | 20) & 0xFu; }
#define XB_SPIN(cond, bar) do { unsigned _sp = 0; while (cond) { __builtin_amdgcn_s_sleep(1); \
    if ((++_sp & 255u) == 0u) { if (xb_ld(&(bar)[XB_TMO])) break; if (_sp > XB_SPIN_CAP) { atomicAdd(&(bar)[XB_TMO], 1u); break; } } } } while (0)
struct XcdBarrier { unsigned* bar; unsigned x; volatile LAS unsigned* st; };
__device__ __forceinline__ XcdBarrier xcd_barrier_post(unsigned* bar, volatile LAS unsigned* st) {
    XcdBarrier b; b.bar = bar; b.x = xb_xcc_id(); b.st = st;
    if (threadIdx.x == 0) (void)xb_add(&bar[XB_XCNT(b.x)], 1u);
    return b;
}
__device__ __forceinline__ void xcd_barrier_complete(unsigned* bar, unsigned x, unsigned& nloc, unsigned& nx) {
    const unsigned G = gridDim.x * gridDim.y * gridDim.z;
    unsigned sum, cnt, mine, sp = 0u;
    for (;;) {
        sum = 0u; cnt = 0u; mine = 0u;
#pragma unroll
        for (unsigned j = 0; j < 16; ++j) { const unsigned c = xb_ld(&bar[XB_XCNT(j)]); sum += c; cnt += (c > 0u) ? 1u : 0u; mine = (j == x) ? c : mine; }
        if (sum == G) break;
        __builtin_amdgcn_s_sleep(1);
        if ((++sp & 255u) == 0u) { if (xb_ld(&bar[XB_TMO])) break; if (sp > XB_SPIN_CAP) { atomicAdd(&bar[XB_TMO], 1u); break; } }
    }
    nloc = mine > 0u ? mine : 1u; nx = cnt > 0u ? cnt : 1u;
}
__device__ __forceinline__ void xcd_barrier(const XcdBarrier& b) {
    asm volatile("s_waitcnt vmcnt(0)" ::: "memory");
    __syncthreads();
    if (threadIdx.x == 0) {
        unsigned* bar = b.bar;
        __builtin_amdgcn_s_waitcnt(0);
        unsigned nloc = b.st[0], nx = b.st[1];
        if (nloc == 0u) { xcd_barrier_complete(bar, b.x, nloc, nx); b.st[0] = nloc; b.st[1] = nx; }
        const unsigned old = xb_add(&bar[XB_XSUB(b.x)], 1u);
        const unsigned gen = old / nloc;
        if (old + 1u == (gen + 1u) * nloc) {
            __builtin_amdgcn_fence(__ATOMIC_RELEASE, "agent");
            asm volatile("s_waitcnt vmcnt(0)" ::: "memory");
            const unsigned og = xb_add(&bar[XB_TOP], 1u);
            const unsigned tg = og / nx;
            if (og + 1u == (tg + 1u) * nx) xb_add(&bar[XB_TOPGEN], 1u);
            else XB_SPIN(xb_ld(&bar[XB_TOPGEN]) == tg, bar);
            __builtin_amdgcn_fence(__ATOMIC_ACQUIRE, "agent");
            xb_add(&bar[XB_XGEN(b.x)], 1u);
            asm volatile("s_waitcnt vmcnt(0)" ::: "memory");
        } else {
            XB_SPIN(xb_ld(&bar[XB_XGEN(b.x)]) == gen, bar);
            __builtin_amdgcn_fence(__ATOMIC_ACQUIRE, "agent");
            asm volatile("s_waitcnt vmcnt(0)" ::: "memory");
        }
    }
    __syncthreads();
}

__global__ void __launch_bounds__(512, 2) fwd_megakernel(Params p) {
    extern __shared__ __attribute__((aligned(16))) unsigned char shm[];
    LAS unsigned char* lds = (LAS unsigned char*)shm;
    cg::grid_group grid = cg::this_grid();
    unsigned char* ws = p.ws;
    pg8::StaticOrder S;
    volatile LAS unsigned* bst = (volatile LAS unsigned*)(lds + 147456 - 16);
    if (threadIdx.x == 0) { bst[0] = 0u; bst[1] = 0u; }
    __syncthreads();
    const XcdBarrier xb = xcd_barrier_post((unsigned*)(ws + OFF_BAR), bst);
    phase_convert0(p, lds);
    grid.sync();
    if (STOP_AFTER <= 0) return;
    { S.init(NTOK, 2 * DFF, DM, gridDim.x, blockIdx.x, false); pg8::Gemm g{(const bf16_t*)(ws + OFF_XNB), (const bf16_t*)(ws + OFF_W1T), NTOK, 2 * DFF, DM};
      EpiSwiglu E{(bf16_t*)(ws + OFF_H)}; pg8::gemm_phase(lds, g, S, E); }
    xcd_barrier(xb);
    { S.init(NTOK, DM, DFF, gridDim.x, blockIdx.x, true); pg8::Gemm g{(const bf16_t*)(ws + OFF_H), (const bf16_t*)(ws + OFF_W1O), NTOK, DM, DFF};
      EpiResid E{(float*)(ws + OFF_R), p.in[0], p.in[1], (float*)(ws + OFF_PART), 0.5f}; pg8::gemm_phase(lds, g, S, E); }
    __syncthreads();
    phase_convert_mid(p, lds, S.tail_busy());
    xcd_barrier(xb);
    phase_ln((const float*)(ws + OFF_R), p.in[6], p.in[7], (float*)(ws + OFF_XN), (bf16_t*)(ws + OFF_XNB), S.mode == 1 ? (const float*)(ws + OFF_PART) : nullptr, p.in[1]);
    xcd_barrier(xb);
    if (STOP_AFTER <= 3) return;
    { S.init(NTOK, NMIXP, DM, gridDim.x, blockIdx.x, false); pg8::Gemm g{(const bf16_t*)(ws + OFF_XNB), (const bf16_t*)(ws + OFF_WMI), NTOK, NMIXP, DM};
      EpiMixIn E{(bf16_t*)(ws + OFF_PROJB), (float*)(ws + OFF_BD)}; pg8::gemm_phase(lds, g, S, E); }
    xcd_barrier(xb);
    phase_conv(p);
    xcd_barrier(xb);
    if (STOP_AFTER <= 4) return;
    phase_gdn_prep(p, lds);
    xcd_barrier(xb);
    phase_scan(p, lds);
    xcd_barrier(xb);
    if (STOP_AFTER <= 5) return;
    phase_onorm(p);
    __syncthreads();
    { S.init(NTOK, 1024, 1024, gridDim.x, blockIdx.x, false); pg8::Gemm g{(const bf16_t*)(ws + OFF_ZB), (const bf16_t*)(ws + OFF_GLU), NTOK, 1024, 1024};
      EpiGlu E{(bf16_t*)(ws + OFF_YMIX), (const bf16_t*)(ws + OFF_ZB), p.in[20]}; pg8::gemm_phase(lds, g, S, E); }
    xcd_barrier(xb);
    { S.init(NTOK, DM, DM, gridDim.x, blockIdx.x, true); pg8::Gemm g{(const bf16_t*)(ws + OFF_YMIX), (const bf16_t*)(ws + OFF_WMO), NTOK, DM, DM};
      const float* xn = (const float*)(ws + OFF_XN);
      EpiResid E{(float*)(ws + OFF_R), xn, xn + (size_t)NPR * DM, (float*)(ws + OFF_PART), 1.0f}; pg8::gemm_phase(lds, g, S, E); }
    __syncthreads();
    phase_convert1(p, lds, S.tail_busy());
    xcd_barrier(xb);
    phase_ln((const float*)(ws + OFF_R), p.in[26], p.in[27], (float*)(ws + OFF_XN), (bf16_t*)(ws + OFF_XNB), S.mode == 1 ? (const float*)(ws + OFF_PART) : nullptr, (const float*)(ws + OFF_XN) + (size_t)NPR * DM);
    xcd_barrier(xb);
    { S.init(NTOK, 2 * DFF, DM, gridDim.x, blockIdx.x, false); pg8::Gemm g{(const bf16_t*)(ws + OFF_XNB), (const bf16_t*)(ws + OFF_W1T), NTOK, 2 * DFF, DM};
      EpiSwiglu E{(bf16_t*)(ws + OFF_H)}; pg8::gemm_phase(lds, g, S, E); }
    xcd_barrier(xb);
    { S.init(NTOK, DM, DFF, gridDim.x, blockIdx.x, true); pg8::Gemm g{(const bf16_t*)(ws + OFF_H), (const bf16_t*)(ws + OFF_W1O), NTOK, DM, DFF};
      const float* xn = (const float*)(ws + OFF_XN);
      EpiResid E{(float*)(ws + OFF_R), xn, xn + (size_t)NPR * DM, (float*)(ws + OFF_PART), 0.5f};
      if (S.mode == 1) {
          S.rcount = 1; pg8::gemm_phase(lds, g, S, E);
          xcd_barrier(xb);
          S.rbase = 1; pg8::gemm_phase(lds, g, S, E);
          __syncthreads();
          phase_ln((const float*)(ws + OFF_R), p.in[30], p.in[31], p.out + O_Y, nullptr, nullptr, nullptr, 0, NPR, 64);
          xcd_barrier(xb);
          phase_ln((const float*)(ws + OFF_R), p.in[30], p.in[31], p.out + O_Y, nullptr, (const float*)(ws + OFF_PART), xn + (size_t)NPR * DM, NPR, NTOK, 0);
      } else {
          pg8::gemm_phase(lds, g, S, E);
          xcd_barrier(xb);
          phase_ln((const float*)(ws + OFF_R), p.in[30], p.in[31], p.out + O_Y, nullptr, nullptr, nullptr);
      }
    }
}

extern "C" void kernel_launch(void* const* d_in, const int* in_sizes, int n_in, void* d_out, int out_size, void* d_ws, size_t ws_size, hipStream_t stream) {
    constexpr int LDS_BYTES = 147456;
    static int grid_blocks = 0;
    if (grid_blocks == 0) {
        int dev = 0, cus = 0, per_cu = 0;
        hipGetDevice(&dev);
        hipDeviceGetAttribute(&cus, hipDeviceAttributeMultiprocessorCount, dev);
        hipFuncSetAttribute((const void*)fwd_megakernel, hipFuncAttributeMaxDynamicSharedMemorySize, LDS_BYTES);
        hipOccupancyMaxActiveBlocksPerMultiprocessor(&per_cu, (const void*)fwd_megakernel, 512, LDS_BYTES);
        if (per_cu < 1) { fprintf(stderr, "occupancy query returned %d\n", per_cu); per_cu = 1; }
        grid_blocks = cus * 1;
        if (ws_size < WS_END) fprintf(stderr, "workspace too small: %zu < %zu\n", ws_size, (size_t)WS_END);
    }
    (void)hipMemsetAsync((unsigned char*)d_ws + OFF_BAR, 0, XCD_BAR_WORDS * 4, stream);
    Params p{};
    for (int i = 0; i < 32; ++i) p.in[i] = (const float*)d_in[i];
    p.out = (float*)d_out; p.ws = (unsigned char*)d_ws;
    void* args[] = {&p};
    hipError_t e = hipLaunchCooperativeKernel((const void*)fwd_megakernel, dim3(grid_blocks), dim3(512), args, LDS_BYTES, stream);
    if (e != hipSuccess) fprintf(stderr, "cooperative launch failed: %s (grid %d)\n", hipGetErrorString(e), grid_blocks);
}
```

```cpp
#include <hip/hip_runtime.h>
#include <hip/hip_cooperative_groups.h>
#include <cstdio>
namespace cg = cooperative_groups;

#define LAS __attribute__((address_space(3)))
typedef unsigned short bf16_t;
typedef short bf16x8 __attribute__((ext_vector_type(8)));
typedef float f32x4 __attribute__((ext_vector_type(4)));
typedef float f32x16 __attribute__((ext_vector_type(16)));
typedef unsigned u32x4 __attribute__((ext_vector_type(4)));
typedef unsigned u32x2 __attribute__((ext_vector_type(2)));

#ifndef STOP_AFTER
#define STOP_AFTER 99
#endif

constexpr int NTOK = 8704, NPR = 8192, DM = 2048, DFF = 5632, NMIX = 5136, NMIXP = 5376, NPB = 5120;
constexpr float ALPHA = 1.189207115002721f;

constexpr size_t O_Y = 0, O_PRE = 17825792, O_PIM = 17842176, O_PGDN = 17858560, O_PCONV = 18382848,
                 O_SRE = 18419712, O_SIM = 18944000, O_SGDN = 19468288, O_SCONV = 36245504;

constexpr size_t SZ_W1T = (size_t)11264 * 2048 * 2, SZ_W1O = (size_t)2048 * 5632 * 2;
constexpr size_t OFF_W1T = 0;
constexpr size_t OFF_W1O = OFF_W1T + SZ_W1T;
constexpr size_t OFF_WMI = OFF_W1O + SZ_W1O;
constexpr size_t OFF_GLU = OFF_WMI + (size_t)NMIXP * 2048 * 2;
constexpr size_t OFF_WMO = OFF_GLU + (size_t)1024 * 1024 * 2;
constexpr size_t OFF_XNB = OFF_WMO + (size_t)2048 * 2048 * 2;
constexpr size_t OFF_XN  = OFF_XNB + (size_t)NTOK * 2048 * 2;
constexpr size_t OFF_R   = OFF_XN + (size_t)NTOK * 2048 * 4;
constexpr size_t OFF_H   = OFF_R + (size_t)NTOK * 2048 * 4;
constexpr size_t OFF_KDT = OFF_H + (size_t)NTOK * DFF * 2;
constexpr size_t SZ_CH   = (size_t)1024 * 64 * 128 * 2;
constexpr size_t OFF_TBT = OFF_KDT + SZ_CH;
constexpr size_t OFF_O   = OFF_TBT + (size_t)1024 * 64 * 64 * 2;
constexpr size_t OFF_ZB  = OFF_O + (size_t)NTOK * 1024 * 2;
constexpr size_t OFF_BBT = OFF_ZB + (size_t)NTOK * 1024 * 2;
constexpr size_t OFF_CT  = OFF_BBT + 262144;
constexpr size_t OFF_ABAR = OFF_CT + 262144;
constexpr size_t OFF_GLAST = OFF_ABAR + 32768;
constexpr size_t OFF_BAR = OFF_GLAST + 4096;
constexpr size_t OFF_PART = OFF_BAR + 16384;
constexpr size_t WS_END  = OFF_PART + (size_t)4 * 512 * 2048 * 4;
constexpr size_t OFF_PROJB = OFF_H;
constexpr size_t OFF_XRB = OFF_XN;
constexpr size_t OFF_YMIX = OFF_XN + (size_t)NTOK * 2048 * 2;
constexpr size_t OFF_QN = OFF_R, OFF_KN = OFF_QN + (size_t)NPR * 1024 * 2, OFF_VV = OFF_KN + (size_t)NPR * 1024 * 2;
constexpr size_t OFF_G = OFF_VV + (size_t)NPR * 1024 * 4;
constexpr size_t OFF_BETA = OFF_G + (size_t)NTOK * 8 * 4;
constexpr size_t OFF_BD = OFF_BETA + (size_t)NTOK * 8 * 4;
constexpr size_t OFF_KT = OFF_W1T, OFF_ATT = OFF_KT + SZ_CH, OFF_QG = OFF_ATT + (size_t)1024 * 64 * 64 * 2, OFF_KG = OFF_QG + SZ_CH;
constexpr size_t OFF_QKVS = OFF_KG + SZ_CH;
static_assert(OFF_BD + (size_t)NTOK * 16 * 4 <= OFF_H, "R alias overflow");
static_assert(OFF_QKVS + (size_t)512 * 3072 * 4 <= OFF_WMI, "W1 alias overflow");

struct Params { const float* in[32]; float* out; unsigned char* ws; };

typedef __bf16 bf16v2_t __attribute__((ext_vector_type(2)));
typedef float f32v2_t __attribute__((ext_vector_type(2)));
__device__ __forceinline__ unsigned pk2(float lo, float hi) { f32v2_t v = {lo, hi}; bf16v2_t b = __builtin_convertvector(v, bf16v2_t); return __builtin_bit_cast(unsigned, b); }
__device__ __forceinline__ bf16_t f2bf(float f) { return (bf16_t)(pk2(f, 0.f) & 0xffffu); }
__device__ __forceinline__ float bf2f(bf16_t b) { return __uint_as_float(((unsigned)b) << 16); }
__device__ __forceinline__ float bflo(unsigned u) { return __uint_as_float(u << 16); }
__device__ __forceinline__ float bfhi(unsigned u) { return __uint_as_float(u & 0xffff0000u); }
__device__ __forceinline__ float wave_sum(float v) {
#pragma unroll
    for (int o = 1; o < 64; o <<= 1) v += __shfl_xor(v, o);
    return v;
}
__device__ __forceinline__ float siluf(float x) { return x / (1.f + __expf(-x)); }
__device__ __forceinline__ float sigmf(float x) { return 1.f / (1.f + __expf(-x)); }
__device__ __forceinline__ float gelu_tanh(float y) {
    const float t = 0.7978845608028654f * (y + 0.044715f * y * y * y);
    const float th = 1.f - 2.f / (1.f + __expf(2.f * t));
    return 0.5f * y * (1.f + th);
}
#define WSYNC() asm volatile("s_waitcnt lgkmcnt(0)" ::: "memory")

namespace pg8 {
constexpr int BM = 256, BK = 64, HALF = 128, HTB = HALF * BK * 2, STAGE_BYTES = 8 * HTB, NXCD = 8, WGM = 8;
__host__ __device__ __forceinline__ int lds_byte(int r, int c) { const int st = (r >> 4) * 2 + (c >> 5), rr = r & 15, cc = c & 31, ob = rr * 64 + cc * 2; return st * 1024 + (ob ^ (((ob >> 9) & 1) << 5)); }
__host__ __device__ __forceinline__ void stage_rc(int b, int& R, int& C) { const int st = b / 1024, sb = b % 1024, swz = sb ^ (((sb >> 9) & 1) << 5); R = (st >> 1) * 16 + swz / 64; C = (st & 1) * 32 + (swz % 64) / 2; }
__host__ __device__ __forceinline__ int perm32(int rho) { const int n = rho >> 4, i = rho & 15; return 8 * (i >> 2) + 4 * n + (i & 3); }
struct Unit { int pm, pn, k0, nk, part, sp; };
struct Gemm { const bf16_t* A; const bf16_t* Bt; int M, N, K; };
struct StaticOrder {
    int nM, nN, nwg, G, c, ntK, mode;
    __device__ __forceinline__ void init(int M, int N, int K, int G_, int c_, bool split) {
        nM = M / BM; nN = N / BM; nwg = nM * nN; G = G_; c = c_; ntK = K / BK;
        mode = (split && G == 256 && nM == 34 && nN == 8 && (ntK % 8) == 0) ? 1 : 0;
    }
    __device__ __forceinline__ void map(int L, Unit& u, int nMl) const {
        const int nw = nMl * nN;
        int wgid = L; { const int q = nw / NXCD, r = nw % NXCD, xcd = wgid % NXCD, off = wgid / NXCD; wgid = (xcd < r ? xcd * (q + 1) : r * (q + 1) + (xcd - r) * q) + off; }
        const int nig = WGM * nN, gid = wgid / nig, fm = gid * WGM, gsz = (nMl - fm) < WGM ? (nMl - fm) : WGM;
        u.pm = fm + ((wgid % nig) % gsz); u.pn = (wgid % nig) / gsz;
    }
    __device__ __forceinline__ int tail_busy() const { return mode == 1 ? 64 : (((nwg % G) * 2 <= G) ? (nwg % G) : 0); }
    __device__ __forceinline__ bool next_(int i, Unit& u) const {
        u.pm = 0; u.pn = 0; u.k0 = 0; u.nk = ntK; u.part = 0; u.sp = 0;
        if (mode == 0) { const long L = (long)i * G + c; if (L >= nwg) return false; map((int)L, u, nM); return true; }
        if (i == 0) { map(c, u, 32); return true; }
        if (i == 1 && c < 64) { const int tt = c >> 2; u.pm = 32 + (tt & 1); u.pn = tt >> 1; u.sp = c & 3; u.nk = ntK / 4; u.k0 = u.sp * u.nk; u.part = 1; return true; }
        return false;
    }
    __device__ __forceinline__ bool next(int i, Unit& u) const {
        const bool ok = next_(i, u);
        u.pm = __builtin_amdgcn_readfirstlane(u.pm); u.pn = __builtin_amdgcn_readfirstlane(u.pn); u.k0 = __builtin_amdgcn_readfirstlane(u.k0);
        u.nk = __builtin_amdgcn_readfirstlane(u.nk); u.part = __builtin_amdgcn_readfirstlane(u.part); u.sp = __builtin_amdgcn_readfirstlane(u.sp);
        return __builtin_amdgcn_readfirstlane((int)ok) != 0;
    }
};

template <class Epi>
__device__ __forceinline__ void gemm_phase(LAS unsigned char* lds, const Gemm g, const StaticOrder& S, const Epi& E) {
    int tid = threadIdx.x; asm volatile("" : "+v"(tid));
    const int wid = __builtin_amdgcn_readfirstlane(tid >> 6), lane = tid & 63, wr = wid >> 2, wc = wid & 3, fr = lane & 15, fq = lane >> 4;
    const int K = g.K;
    unsigned voffA[2], voffB[2];
#pragma unroll
    for (int i = 0; i < 2; ++i) { int R, C; stage_rc(tid * 16 + i * 8192, R, C); const int Rb = Epi::PERM ? ((R & ~31) + perm32(R & 31)) : R;
        voffA[i] = (unsigned)(R * K + C) * 2u; voffB[i] = (unsigned)(Rb * K + C) * 2u; }
    const size_t kstep = (size_t)(BK * 2);
    const size_t hstep = (size_t)HALF * K * 2;
    const size_t tstep = 2 * hstep;
    const unsigned ldsw = (unsigned)wid * 1024u;
    const int aoff = lds_byte(wr * 64 + fr, fq * 8), boff = lds_byte(wc * 32 + fr, fq * 8);
#define PG8_SA(b, h) (((b) * 2 + (h)) * HTB)
#define PG8_SB(b, h) ((4 + (b) * 2 + (h)) * HTB)
#define PG8_STAGE(bufoff, gbase, voff) do { _Pragma("unroll") for (int _i = 0; _i < 2; ++_i) \
        __builtin_amdgcn_global_load_lds((const unsigned*)((const char*)(gbase) + (voff)[_i]), (LAS unsigned*)(lds + (bufoff) + ldsw + _i * 8192), 16, 0, 0); } while (0)
#define PG8_LDA(dst, b, h) do { _Pragma("unroll") for (int m = 0; m < 4; ++m) _Pragma("unroll") for (int k = 0; k < 2; ++k) dst[m][k] = *(const LAS bf16x8*)(lds + PG8_SA(b, h) + aoff + m * 2048 + k * 1024); } while (0)
#define PG8_LDB(dst, b, h) do { _Pragma("unroll") for (int n = 0; n < 2; ++n) _Pragma("unroll") for (int k = 0; k < 2; ++k) dst[n][k] = *(const LAS bf16x8*)(lds + PG8_SB(b, h) + boff + n * 2048 + k * 1024); } while (0)
#define PG8_MMA(ai, bj, At, Bt) do { __builtin_amdgcn_s_setprio(1); _Pragma("unroll") for (int m = 0; m < 4; ++m) _Pragma("unroll") for (int n = 0; n < 2; ++n) _Pragma("unroll") for (int k = 0; k < 2; ++k) \
        acc[ai][bj][m][n] = __builtin_amdgcn_mfma_f32_16x16x32_bf16(Bt[n][k], At[m][k], acc[ai][bj][m][n], 0, 0, 0); __builtin_amdgcn_s_setprio(0); } while (0)
#define PG8_WAIT_V(n) asm volatile("s_waitcnt vmcnt(" #n ")" ::: "memory")
#define PG8_WAIT_L(n) asm volatile("s_waitcnt lgkmcnt(" #n ")" ::: "memory")
#define PG8_BAR __builtin_amdgcn_s_barrier()
#define PG8_SCHED __builtin_amdgcn_sched_barrier(0)
    Unit cur, nxt; int ui = 0;
    if (!S.next(0, cur)) return;
    f32x4 acc[2][2][4][2];
#pragma unroll
    for (int a = 0; a < 2; ++a)
#pragma unroll
        for (int b = 0; b < 2; ++b)
#pragma unroll
            for (int m = 0; m < 4; ++m)
#pragma unroll
                for (int n = 0; n < 2; ++n) acc[a][b][m][n] = (f32x4){0.f, 0.f, 0.f, 0.f};
    bf16x8 At[4][2], B0[2][2], B1[2][2];
    const char* cA = (const char*)g.A + (size_t)cur.pm * tstep + (size_t)cur.k0 * kstep; const char* cB = (const char*)g.Bt + (size_t)cur.pn * tstep + (size_t)cur.k0 * kstep;
    PG8_STAGE(PG8_SB(0, 0), cB, voffB); PG8_STAGE(PG8_SA(0, 0), cA, voffA); PG8_STAGE(PG8_SB(0, 1), cB + hstep, voffB); PG8_STAGE(PG8_SA(0, 1), cA + hstep, voffA);
    if (wr == 1) PG8_BAR;
    PG8_WAIT_V(4); PG8_BAR;
    PG8_STAGE(PG8_SB(1, 0), cB + kstep, voffB); PG8_STAGE(PG8_SA(1, 0), cA + kstep, voffA); PG8_STAGE(PG8_SB(1, 1), cB + hstep + kstep, voffB);
    PG8_WAIT_V(6); PG8_BAR;
    for (;;) {
        const bool has_next = S.next(ui + 1, nxt);
        const char* nA = has_next ? (const char*)g.A + (size_t)nxt.pm * tstep + (size_t)nxt.k0 * kstep : cA; const char* nB = has_next ? (const char*)g.Bt + (size_t)nxt.pn * tstep + (size_t)nxt.k0 * kstep : cB;
        const int nt = cur.nk;
        for (int t = 0; t < nt; t += 2) {
            const bool last = (t == nt - 2);
            const char* a1 = cA + (size_t)(t + 1) * kstep;
            const char* a2 = last ? nA : cA + (size_t)(t + 2) * kstep; const char* b2 = last ? nB : cB + (size_t)(t + 2) * kstep;
            const char* a3 = a2 + kstep; const char* b3 = b2 + kstep;
            PG8_LDB(B0, 0, 0); PG8_SCHED; PG8_LDA(At, 0, 0); PG8_STAGE(PG8_SA(1, 1), a1 + hstep, voffA);
            PG8_WAIT_L(8); PG8_BAR; PG8_WAIT_L(0); PG8_MMA(0, 0, At, B0); PG8_BAR; PG8_SCHED;
            PG8_LDB(B1, 0, 1); PG8_STAGE(PG8_SB(0, 0), b2, voffB);
            PG8_BAR; PG8_WAIT_L(0); PG8_MMA(0, 1, At, B1); PG8_BAR;
            PG8_LDA(At, 0, 1); PG8_STAGE(PG8_SA(0, 0), a2, voffA);
            PG8_BAR; PG8_WAIT_L(0); PG8_MMA(1, 0, At, B0); PG8_BAR; PG8_SCHED;
            PG8_STAGE(PG8_SB(0, 1), b2 + hstep, voffB);
            PG8_WAIT_V(6); PG8_BAR; PG8_MMA(1, 1, At, B1); PG8_BAR;
            PG8_LDB(B0, 1, 0); PG8_SCHED; PG8_LDA(At, 1, 0); PG8_STAGE(PG8_SA(0, 1), a2 + hstep, voffA);
            PG8_WAIT_L(8); PG8_BAR; PG8_WAIT_L(0); PG8_MMA(0, 0, At, B0); PG8_BAR; PG8_SCHED;
            PG8_LDB(B1, 1, 1); PG8_STAGE(PG8_SB(1, 0), b3, voffB);
            PG8_BAR; PG8_WAIT_L(0); PG8_MMA(0, 1, At, B1); PG8_BAR;
            PG8_LDA(At, 1, 1); PG8_STAGE(PG8_SA(1, 0), a3, voffA);
            PG8_BAR; PG8_WAIT_L(0); PG8_MMA(1, 0, At, B0); PG8_BAR; PG8_SCHED;
            PG8_STAGE(PG8_SB(1, 1), b3 + hstep, voffB);
            PG8_WAIT_V(6); PG8_BAR; PG8_MMA(1, 1, At, B1); PG8_BAR;
        }
        E(acc, cur, wr, wc, fr, fq);
        if (!has_next) break;
#pragma unroll
        for (int a = 0; a < 2; ++a)
#pragma unroll
            for (int b = 0; b < 2; ++b)
#pragma unroll
                for (int m = 0; m < 4; ++m)
#pragma unroll
                    for (int n = 0; n < 2; ++n) acc[a][b][m][n] = (f32x4){0.f, 0.f, 0.f, 0.f};
        cur = nxt; cA = nA; cB = nB; ++ui;
    }
    PG8_WAIT_V(0);
    if (wr == 0) PG8_BAR;
    PG8_BAR;
#undef PG8_SA
#undef PG8_SB
#undef PG8_STAGE
#undef PG8_LDA
#undef PG8_LDB
#undef PG8_MMA
#undef PG8_WAIT_V
#undef PG8_WAIT_L
#undef PG8_BAR
#undef PG8_SCHED
}
}
using pg8::Unit;

struct EpiSwiglu {
    static constexpr bool PERM = true;
    bf16_t* H;
    __device__ __forceinline__ void operator()(const f32x4 (&acc)[2][2][4][2], const Unit& u, int wr, int wc, int fr, int fq) const {
        const int row0 = u.pm * 256 + wr * 64 + fr, col0 = u.pn * 128 + wc * 32 + 8 * fq;
#pragma unroll
        for (int ai = 0; ai < 2; ++ai)
#pragma unroll
            for (int m = 0; m < 4; ++m) {
                const f32x4 g0 = acc[ai][0][m][0], g1 = acc[ai][0][m][1], u0 = acc[ai][1][m][0], u1 = acc[ai][1][m][1];
                u32x4 o;
                o.x = pk2(siluf(g0[0]) * u0[0], siluf(g0[1]) * u0[1]); o.y = pk2(siluf(g0[2]) * u0[2], siluf(g0[3]) * u0[3]);
                o.z = pk2(siluf(g1[0]) * u1[0], siluf(g1[1]) * u1[1]); o.w = pk2(siluf(g1[2]) * u1[2], siluf(g1[3]) * u1[3]);
                *(u32x4*)(H + (size_t)(row0 + ai * 128 + m * 16) * DFF + col0) = o;
            }
    }
};
struct EpiResid {
    static constexpr bool PERM = false;
    float* R; const float* X0; const float* X1; float* P; const bf16_t* XB; float scale;
    __device__ __forceinline__ void operator()(const f32x4 (&acc)[2][2][4][2], const Unit& u, int wr, int wc, int fr, int fq) const {
        const int row0 = u.pm * 256 + wr * 64 + fr, col0 = u.pn * 256 + wc * 32 + 4 * fq;
#pragma unroll
        for (int ai = 0; ai < 2; ++ai)
#pragma unroll
            for (int m = 0; m < 4; ++m) {
                const int row = row0 + ai * 128 + m * 16;
                const float* xr = (XB != nullptr) ? nullptr : (row < NPR ? X0 + (size_t)row * DM : X1 + (size_t)(row - NPR) * DM) + col0;
                float* rp = R + (size_t)row * DM + col0;
#pragma unroll
                for (int bj = 0; bj < 2; ++bj)
#pragma unroll
                    for (int n = 0; n < 2; ++n) {
                        if (!u.part) {
                            f32x4 xv;
                            if (XB != nullptr) { const u32x2 xb2 = *(const u32x2*)(XB + (size_t)row * DM + col0 + bj * 128 + n * 16); xv = (f32x4){bflo(xb2.x), bfhi(xb2.x), bflo(xb2.y), bfhi(xb2.y)}; }
                            else xv = *(const f32x4*)(xr + bj * 128 + n * 16);
                            *(f32x4*)(rp + bj * 128 + n * 16) = xv * ALPHA + acc[ai][bj][m][n] * scale;
                        } else {
                            *(f32x4*)(P + ((size_t)u.sp * 512 + (row - NPR)) * DM + col0 + bj * 128 + n * 16) = acc[ai][bj][m][n] * scale;
                        }
                    }
            }
    }
};
struct EpiMixIn {
    static constexpr bool PERM = true;
    bf16_t* PB; float* BD;
    __device__ __forceinline__ void operator()(const f32x4 (&acc)[2][2][4][2], const Unit& u, int wr, int wc, int fr, int fq) const {
        const int row0 = u.pm * 256 + wr * 64 + fr;
        if (u.pn < 20) {
            const int col0 = u.pn * 256 + wc * 32 + 8 * fq;
#pragma unroll
            for (int ai = 0; ai < 2; ++ai)
#pragma unroll
                for (int m = 0; m < 4; ++m)
#pragma unroll
                    for (int bj = 0; bj < 2; ++bj) {
                        const f32x4 v0 = acc[ai][bj][m][0], v1 = acc[ai][bj][m][1];
                        u32x4 o; o.x = pk2(v0[0], v0[1]); o.y = pk2(v0[2], v0[3]); o.z = pk2(v1[0], v1[1]); o.w = pk2(v1[2], v1[3]);
                        *(u32x4*)(PB + (size_t)(row0 + ai * 128 + m * 16) * NPB + col0 + bj * 128) = o;
                    }
        } else if (wc == 0 && fq < 2) {
#pragma unroll
            for (int ai = 0; ai < 2; ++ai)
#pragma unroll
                for (int m = 0; m < 4; ++m) {
                    float* bp = BD + (size_t)(row0 + ai * 128 + m * 16) * 16 + 8 * fq;
                    *(f32x4*)(bp) = acc[ai][0][m][0]; *(f32x4*)(bp + 4) = acc[ai][0][m][1];
                }
        }
    }
};
struct EpiGlu {
    static constexpr bool PERM = true;
    bf16_t* YM; const bf16_t* ZB; const float* bias;
    __device__ __forceinline__ void operator()(const f32x4 (&acc)[2][2][4][2], const Unit& u, int wr, int wc, int fr, int fq) const {
        const int row0 = u.pm * 256 + wr * 64 + fr, col0 = u.pn * 256 + wc * 32 + 8 * fq;
#pragma unroll
        for (int bj = 0; bj < 2; ++bj) {
            const f32x4 b0 = *(const f32x4*)(bias + col0 + bj * 128), b1 = *(const f32x4*)(bias + col0 + bj * 128 + 4);
#pragma unroll
            for (int ai = 0; ai < 2; ++ai)
#pragma unroll
                for (int m = 0; m < 4; ++m) {
                    const int row = row0 + ai * 128 + m * 16;
                    const u32x4 zz = *(const u32x4*)(ZB + (size_t)row * 1024 + col0 + bj * 128);
                    const f32x4 v0 = acc[ai][bj][m][0] + b0, v1 = acc[ai][bj][m][1] + b1;
                    u32x4 o;
                    o.x = pk2(bflo(zz.x) * sigmf(v0[0]), bfhi(zz.x) * sigmf(v0[1])); o.y = pk2(bflo(zz.y) * sigmf(v0[2]), bfhi(zz.y) * sigmf(v0[3]));
                    o.z = pk2(bflo(zz.z) * sigmf(v1[0]), bfhi(zz.z) * sigmf(v1[1])); o.w = pk2(bflo(zz.w) * sigmf(v1[2]), bfhi(zz.w) * sigmf(v1[3]));
                    *(u32x4*)(YM + (size_t)row * DM + col0 + bj * 128) = o;
                }
        }
    }
};

__device__ __forceinline__ void transpose_tile(const float* __restrict__ W, int K, int N, bf16_t* __restrict__ WT, int kt, int nt, int mode, LAS float* tile) {
    int tid = threadIdx.x; asm volatile("" : "+v"(tid));
    const int k0 = kt * 64, n0 = nt * 256;
    f32x4 v[8];
#pragma unroll
    for (int i = 0; i < 8; ++i) {
        const int idx = tid + 512 * i, rr = idx >> 6, c4 = (idx & 63) * 4;
        v[i] = (f32x4){0.f, 0.f, 0.f, 0.f};
        if (n0 + c4 < N) v[i] = *(const f32x4*)(W + (size_t)(k0 + rr) * N + n0 + c4);
    }
#pragma unroll
    for (int i = 0; i < 8; ++i) {
        const int idx = tid + 512 * i, rr = idx >> 6, c4 = (idx & 63) * 4;
        tile[rr * 257 + c4 + 0] = v[i][0]; tile[rr * 257 + c4 + 1] = v[i][1]; tile[rr * 257 + c4 + 2] = v[i][2]; tile[rr * 257 + c4 + 3] = v[i][3];
    }
    __syncthreads();
#pragma unroll
    for (int j = 0; j < 4; ++j) {
        const int id = tid + 512 * j, n = id >> 3, kc = id & 7;
        float f[8];
#pragma unroll
        for (int e = 0; e < 8; ++e) f[e] = tile[(kc * 8 + e) * 257 + n];
        const int nn = n0 + n; int drow = nn;
        if (mode == 1) { const int isup = nn >= DFF; const int jj = isup ? nn - DFF : nn; drow = (jj >> 7) * 256 + isup * 128 + (jj & 127); }
        u32x4 o; o.x = pk2(f[0], f[1]); o.y = pk2(f[2], f[3]); o.z = pk2(f[4], f[5]); o.w = pk2(f[6], f[7]);
        *(u32x4*)(WT + (size_t)drow * K + k0 + kc * 8) = o;
    }
    __syncthreads();
}
__device__ __forceinline__ void transpose_matrix(const float* W, int K, int N, bf16_t* WT, int mode, LAS float* tile, int b0 = 0) {
    const int nkt = K / 64, nnt = (N + 255) / 256, tot = nkt * nnt;
    if ((int)blockIdx.x < b0) return;
    for (int t = blockIdx.x - b0; t < tot; t += gridDim.x - b0) transpose_tile(W, K, N, WT, t / nnt, t % nnt, mode, tile);
}

__device__ __forceinline__ void phase_convert0(const Params& p, LAS unsigned char* lds) {
    unsigned char* ws = p.ws;
    LAS float* tile = (LAS float*)lds;
    transpose_matrix(p.in[8], DM, 2 * DFF, (bf16_t*)(ws + OFF_W1T), 1, tile);
    transpose_matrix(p.in[9], DFF, DM, (bf16_t*)(ws + OFF_W1O), 0, tile);
    const size_t gtid = (size_t)blockIdx.x * 512 + threadIdx.x, gsz = (size_t)gridDim.x * 512;
    { bf16_t* xb = (bf16_t*)(ws + OFF_XNB); const size_t n8 = (size_t)NTOK * DM / 8, np8 = (size_t)NPR * DM / 8;
      for (size_t i = gtid; i < n8; i += gsz) {
          const float* s = (i < np8) ? p.in[0] + i * 8 : p.in[1] + (i - np8) * 8;
          const f32x4 a = *(const f32x4*)s, b = *(const f32x4*)(s + 4);
          u32x4 o; o.x = pk2(a[0], a[1]); o.y = pk2(a[2], a[3]); o.z = pk2(b[0], b[1]); o.w = pk2(b[2], b[3]);
          *(u32x4*)(xb + i * 8) = o; } }
    if (gtid < 4096) {
        const int g = (int)(gtid >> 6), pp = (int)(gtid & 63);
        const double dt = exp((double)p.in[13][g]);
        const double lr = (double)p.in[11][g * 64 + pp], li = (double)p.in[12][g * 64 + pp];
        const double mag = exp(lr * dt), abr = mag * cos(li * dt), abi = mag * sin(li * dt);
        const double nr = abr - 1.0, ni = abi, den = lr * lr + li * li;
        const double cr = (nr * lr + ni * li) / den, ci = (ni * lr - nr * li) / den;
        bf16_t* bbt = (bf16_t*)(ws + OFF_BBT) + (size_t)g * 128 * 16;
        for (int h = 0; h < 16; ++h) {
            const double bre = (double)p.in[14][(g * 64 + pp) * 16 + h], bim = (double)p.in[15][(g * 64 + pp) * 16 + h];
            bbt[pp * 16 + h] = f2bf((float)(cr * bre - ci * bim));
            bbt[(64 + pp) * 16 + h] = f2bf((float)(cr * bim + ci * bre));
        }
        float* ab = (float*)(ws + OFF_ABAR); ab[(g * 64 + pp) * 2] = (float)abr; ab[(g * 64 + pp) * 2 + 1] = (float)abi;
        bf16_t* ct = (bf16_t*)(ws + OFF_CT) + (size_t)g * 16 * 128;
        for (int o = 0; o < 16; ++o) {
            ct[o * 128 + pp] = f2bf(p.in[16][(g * 16 + o) * 64 + pp]);
            ct[o * 128 + 64 + pp] = f2bf(-p.in[17][(g * 16 + o) * 64 + pp]);
        }
    }
}
__device__ __forceinline__ void phase_convert_mid(const Params& p, LAS unsigned char* lds, int b0) {
    unsigned char* ws = p.ws;
    LAS float* tile = (LAS float*)lds;
    transpose_matrix(p.in[10], DM, NMIX, (bf16_t*)(ws + OFF_WMI), 0, tile, b0);
    transpose_matrix(p.in[19], 1024, 1024, (bf16_t*)(ws + OFF_GLU), 0, tile, b0);
    transpose_matrix(p.in[25], DM, DM, (bf16_t*)(ws + OFF_WMO), 0, tile, b0);
}
__device__ __forceinline__ void phase_convert1(const Params& p, LAS unsigned char* lds, int b0) {
    LAS float* tile = (LAS float*)lds;
    transpose_matrix(p.in[28], DM, 2 * DFF, (bf16_t*)(p.ws + OFF_W1T), 1, tile, b0);
    transpose_matrix(p.in[29], DFF, DM, (bf16_t*)(p.ws + OFF_W1O), 0, tile, b0);
}

__device__ __forceinline__ void phase_ln(const float* R, const float* gam, const float* bet, float* outf, bf16_t* outb, const float* P, const float* XS, const bf16_t* XSB) {
    int lane = threadIdx.x; asm volatile("" : "+v"(lane)); lane &= 63;
    const int wave = __builtin_amdgcn_readfirstlane(threadIdx.x >> 6);
    for (int row = blockIdx.x * 8 + wave; row < NTOK; row += gridDim.x * 8) {
        const f32x4* rp = (const f32x4*)(R + (size_t)row * DM) + lane;
        f32x4 v[8]; float s = 0.f;
        if (P != nullptr && row >= NPR) {
            const f32x4* pp = (const f32x4*)(P + (size_t)(row - NPR) * DM) + lane;
#pragma unroll
            for (int j = 0; j < 8; ++j) {
                f32x4 xv;
                if (XSB != nullptr) { const u32x2 xb2 = *((const u32x2*)(XSB + (size_t)(row - NPR) * DM) + lane + 64 * j); xv = (f32x4){bflo(xb2.x), bfhi(xb2.x), bflo(xb2.y), bfhi(xb2.y)}; }
                else xv = ((const f32x4*)(XS + (size_t)(row - NPR) * DM) + lane)[64 * j];
                v[j] = xv * ALPHA + ((pp[64 * j] + pp[64 * j + 512 * 512]) + (pp[64 * j + 2 * 512 * 512] + pp[64 * j + 3 * 512 * 512]));
            }
        } else {
#pragma unroll
            for (int j = 0; j < 8; ++j) v[j] = rp[64 * j];
        }
#pragma unroll
        for (int j = 0; j < 8; ++j) s += (v[j][0] + v[j][1]) + (v[j][2] + v[j][3]);
        const float mean = wave_sum(s) * (1.f / DM); float s2 = 0.f;
#pragma unroll
        for (int j = 0; j < 8; ++j) { v[j] = v[j] - mean; s2 += (v[j][0] * v[j][0] + v[j][1] * v[j][1]) + (v[j][2] * v[j][2] + v[j][3] * v[j][3]); }
        const float rstd = 1.f / sqrtf(wave_sum(s2) * (1.f / DM) + 1e-5f);
#pragma unroll
        for (int j = 0; j < 8; ++j) {
            const int col = 4 * (lane + 64 * j);
            const f32x4 gg = *(const f32x4*)(gam + col), bb = *(const f32x4*)(bet + col);
            const f32x4 y = v[j] * rstd * gg + bb;
            if (outf) *(f32x4*)(outf + (size_t)row * DM + col) = y;
            if (outb) { u32x2 o; o.x = pk2(y[0], y[1]); o.y = pk2(y[2], y[3]); *(u32x2*)(outb + (size_t)row * DM + col) = o; }
        }
    }
}

__device__ __forceinline__ void phase_conv(const Params& p) {
    unsigned char* ws = p.ws;
    int lane = threadIdx.x; asm volatile("" : "+v"(lane)); lane &= 63;
    const int wave = __builtin_amdgcn_readfirstlane(threadIdx.x >> 6);
    const bf16_t* PB = (const bf16_t*)(ws + OFF_PROJB);
    const float* BD = (const float*)(ws + OFF_BD);
    const float* cw = p.in[21];
    float* G = (float*)(ws + OFF_G); float* BT = (float*)(ws + OFF_BETA);
    bf16_t* QN = (bf16_t*)(ws + OFF_QN); bf16_t* KN = (bf16_t*)(ws + OFF_KN); float* VV = (float*)(ws + OFF_VV);
    bf16_t* KT = (bf16_t*)(ws + OFF_KT);
    float* QKVS = (float*)(ws + OFF_QKVS);
    const int NIT = 8192 + 1024;
    for (int it = blockIdx.x * 8 + wave; it < NIT; it += gridDim.x * 8) {
        if (it < 8192) {
            const int h = it & 7, tg = (it >> 3) & 255, b = it >> 11;
            const int t0 = tg * 8, tok0 = b * 2048 + t0;
            if (lane < 8) {
                const int tok = tok0 + lane;
                const float braw = BD[(size_t)tok * 16 + h], araw = BD[(size_t)tok * 16 + 8 + h];
                const float xx = araw + p.in[23][h];
                const float sp = xx > 20.f ? xx : log1pf(expf(xx));
                G[(size_t)tok * 8 + h] = -expf(p.in[22][h]) * sp;
                BT[(size_t)tok * 8 + h] = 1.f / (1.f + expf(-braw));
            }
            float x0[3][11], x1[3][11], w0[3][4], w1[3][4];
#pragma unroll
            for (int st = 0; st < 3; ++st) {
                const int col = st * 1024 + h * 128 + 2 * lane;
#pragma unroll
                for (int j = 0; j < 11; ++j) {
                    const int t = t0 - 3 + j;
                    unsigned v = 0u;
                    if (t >= 0) v = *(const unsigned*)(PB + (size_t)(b * 2048 + t) * NPB + 1024 + col);
                    x0[st][j] = bflo(v); x1[st][j] = bfhi(v);
                }
#pragma unroll
                for (int j = 0; j < 4; ++j) { w0[st][j] = cw[j * 3072 + col]; w1[st][j] = cw[j * 3072 + col + 1]; }
            }
            float y0[3][8], y1[3][8];
#pragma unroll
            for (int st = 0; st < 3; ++st)
#pragma unroll
                for (int t = 0; t < 8; ++t) {
                    float a0 = 0.f, a1 = 0.f;
#pragma unroll
                    for (int j = 0; j < 4; ++j) { a0 += x0[st][t + j] * w0[st][j]; a1 += x1[st][t + j] * w1[st][j]; }
                    y0[st][t] = siluf(a0); y1[st][t] = siluf(a1);
                }
            float ss[2][8];
#pragma unroll
            for (int st = 0; st < 2; ++st)
#pragma unroll
                for (int t = 0; t < 8; ++t) ss[st][t] = y0[st][t] * y0[st][t] + y1[st][t] * y1[st][t];
#pragma unroll
            for (int o = 1; o < 64; o <<= 1)
#pragma unroll
                for (int st = 0; st < 2; ++st)
#pragma unroll
                    for (int t = 0; t < 8; ++t) ss[st][t] += __shfl_xor(ss[st][t], o);
#pragma unroll
            for (int st = 0; st < 2; ++st)
#pragma unroll
                for (int t = 0; t < 8; ++t) {
                    float sc = 1.f / sqrtf(ss[st][t] + 1e-6f);
                    if (st == 0) sc *= 0.08838834764831845f;
                    y0[st][t] *= sc; y1[st][t] *= sc;
                }
#pragma unroll
            for (int t = 0; t < 8; ++t) {
                *(unsigned*)(QN + (size_t)(tok0 + t) * 1024 + h * 128 + 2 * lane) = pk2(y0[0][t], y1[0][t]);
                *(unsigned*)(KN + (size_t)(tok0 + t) * 1024 + h * 128 + 2 * lane) = pk2(y0[1][t], y1[1][t]);
                float* o = VV + (size_t)(tok0 + t) * 1024 + h * 128 + 2 * lane; o[0] = y0[2][t]; o[1] = y1[2][t];
            }
            {
                const int chunk = t0 >> 6, c0 = t0 & 63;
                bf16_t* base = KT + ((size_t)((b * 8 + h) * 32 + chunk) * 128 + 2 * lane) * 64 + c0;
                u32x4 o0, o1;
                o0.x = pk2(y0[1][0], y0[1][1]); o0.y = pk2(y0[1][2], y0[1][3]); o0.z = pk2(y0[1][4], y0[1][5]); o0.w = pk2(y0[1][6], y0[1][7]);
                o1.x = pk2(y1[1][0], y1[1][1]); o1.y = pk2(y1[1][2], y1[1][3]); o1.z = pk2(y1[1][4], y1[1][5]); o1.w = pk2(y1[1][6], y1[1][7]);
                *(u32x4*)base = o0; *(u32x4*)(base + 64) = o1;
            }
            if (tg == 255) {
#pragma unroll
                for (int st = 0; st < 3; ++st)
#pragma unroll
                    for (int j = 0; j < 3; ++j) {
                        float* o = p.out + O_PCONV + (size_t)(b * 3 + j) * 3072 + st * 1024 + h * 128 + 2 * lane;
                        o[0] = x0[st][8 + j]; o[1] = x1[st][8 + j];
                    }
            }
        } else {
            const int si = it - 8192, h = si & 7, b = si >> 3;
            const int tok0 = NPR + b * 4;
            if (lane < 4) {
                const int tok = tok0 + lane;
                const float braw = BD[(size_t)tok * 16 + h], araw = BD[(size_t)tok * 16 + 8 + h];
                const float xx = araw + p.in[23][h];
                const float sp = xx > 20.f ? xx : log1pf(expf(xx));
                G[(size_t)tok * 8 + h] = -expf(p.in[22][h]) * sp;
                BT[(size_t)tok * 8 + h] = 1.f / (1.f + expf(-braw));
            }
#pragma unroll
            for (int st = 0; st < 3; ++st) {
                const int col = st * 1024 + h * 128 + 2 * lane;
                float x0[7], x1[7];
#pragma unroll
                for (int j = 0; j < 3; ++j) { const float* s = p.in[5] + (size_t)(b * 3 + j) * 3072 + col; x0[j] = s[0]; x1[j] = s[1]; }
#pragma unroll
                for (int j = 0; j < 4; ++j) { const unsigned v = *(const unsigned*)(PB + (size_t)(tok0 + j) * NPB + 1024 + col); x0[3 + j] = bflo(v); x1[3 + j] = bfhi(v); }
                float w0[4], w1[4];
#pragma unroll
                for (int j = 0; j < 4; ++j) { w0[j] = cw[j * 3072 + col]; w1[j] = cw[j * 3072 + col + 1]; }
#pragma unroll
                for (int t = 0; t < 4; ++t) {
                    float a0 = 0.f, a1 = 0.f;
#pragma unroll
                    for (int j = 0; j < 4; ++j) { a0 += x0[t + j] * w0[j]; a1 += x1[t + j] * w1[j]; }
                    float y0 = siluf(a0), y1 = siluf(a1);
                    if (st < 2) {
                        const float ss = wave_sum(y0 * y0 + y1 * y1);
                        float sc = 1.f / sqrtf(ss + 1e-6f);
                        if (st == 0) sc *= 0.08838834764831845f;
                        y0 *= sc; y1 *= sc;
                    }
                    float* o = QKVS + (size_t)(b * 4 + t) * 3072 + col; o[0] = y0; o[1] = y1;
                }
#pragma unroll
                for (int j = 0; j < 3; ++j) {
                    float* o = p.out + O_SCONV + (size_t)(b * 3 + j) * 3072 + col;
                    o[0] = x0[4 + j]; o[1] = x1[4 + j];
                }
            }
        }
    }
}

__device__ __forceinline__ f32x16 mfma32(bf16x8 a, bf16x8 b, f32x16 c) { return __builtin_amdgcn_mfma_f32_32x32x16_bf16(a, b, c, 0, 0, 0); }
__device__ __forceinline__ f32x4 mfma16(bf16x8 a, bf16x8 b, f32x4 c) { return __builtin_amdgcn_mfma_f32_16x16x32_bf16(a, b, c, 0, 0, 0); }
__device__ __forceinline__ bf16x8 mk8(unsigned a, unsigned b, unsigned c, unsigned d) { u32x4 t = {a, b, c, d}; return __builtin_bit_cast(bf16x8, t); }
constexpr int MTP = 36;

template <int C> __device__ __forceinline__ void solve_col(float (&t)[64], const LAS float* MT, int lane) {
    float a0 = 0.f, a1 = 0.f, a2 = 0.f, a3 = 0.f;
    int mb = 0; if (C < 63) asm volatile("" : "+v"(mb) : "v"(t[C + 1]));
#pragma unroll
    for (int jj = (C + 1) / 4; jj < 16; ++jj) {
        const int j4 = jj * 4;
        if (jj == 8 && (C + 1) / 4 < 8) asm volatile("" : "+v"(mb) : "v"(a0), "v"(a1), "v"(a2), "v"(a3));
        const int ti = (j4 >> 5) + (C >> 5);
        const f32x4 m = *(const LAS f32x4*)(MT + mb + ti * 32 * MTP + (C & 31) * MTP + (j4 & 31));
        if (j4 + 0 > C) a0 += t[j4 + 0] * m[0];
        if (j4 + 1 > C) a1 += t[j4 + 1] * m[1];
        if (j4 + 2 > C) a2 += t[j4 + 2] * m[2];
        if (j4 + 3 > C) a3 += t[j4 + 3] * m[3];
    }
    t[C] = ((lane == C) ? 1.f : 0.f) - ((a0 + a1) + (a2 + a3));
    if constexpr (C > 0) solve_col<C - 1>(t, MT, lane);
}

__device__ __forceinline__ void gdn_prep_item(const Params& p, int it, LAS unsigned char* wl, LAS float* gcl_) {
    unsigned char* ws = p.ws;
    int lane = threadIdx.x; asm volatile("" : "+v"(lane)); lane &= 63;
    const int r = lane & 31, hh = lane >> 5;
    const int n = it & 31, bh = it >> 5, h = bh & 7, b = bh >> 3;
    const int tok0 = b * 2048 + n * 64;
    LAS float* MT = (LAS float*)wl;
    LAS float* gcL = gcl_;
    LAS float* btL = gcL + 64;
    const float* G = (const float*)(ws + OFF_G); const float* BT = (const float*)(ws + OFF_BETA);
    float gc = G[(size_t)(tok0 + lane) * 8 + h];
    const float bv = BT[(size_t)(tok0 + lane) * 8 + h];
#pragma unroll
    for (int o = 1; o < 64; o <<= 1) { const float t = __int_as_float(__builtin_amdgcn_ds_bpermute((lane - o) << 2, __float_as_int(gc))); if (lane >= o) gc += t; }
    const float gl = __int_as_float(__builtin_amdgcn_readlane(__float_as_int(gc), 63));
    gcL[lane] = gc; btL[lane] = bv;
    if (lane == 0) ((float*)(ws + OFF_GLAST))[it] = __expf(gl);
    WSYNC();
    const bf16_t* kp = (const bf16_t*)(ws + OFF_KN) + (size_t)tok0 * 1024 + h * 128;
    const bf16_t* qp = (const bf16_t*)(ws + OFF_QN) + (size_t)tok0 * 1024 + h * 128;
    bf16x8 Kf[2][8];
#pragma unroll
    for (int mt = 0; mt < 2; ++mt)
#pragma unroll
        for (int ks = 0; ks < 8; ++ks) Kf[mt][ks] = *(const bf16x8*)(kp + (size_t)(mt * 32 + r) * 1024 + ks * 16 + hh * 8);
    {
        bf16_t* KG = (bf16_t*)(ws + OFF_KG) + (size_t)it * 8192;
#pragma unroll
        for (int mt = 0; mt < 2; ++mt) {
            const float e = -__expf(gcL[mt * 32 + r]);
#pragma unroll
            for (int ks = 0; ks < 8; ++ks) {
                const u32x4 v = __builtin_bit_cast(u32x4, Kf[mt][ks]);
                u32x2 o0, o1; o0.x = pk2(bflo(v.x) * e, bfhi(v.x) * e); o0.y = pk2(bflo(v.y) * e, bfhi(v.y) * e);
                o1.x = pk2(bflo(v.z) * e, bfhi(v.z) * e); o1.y = pk2(bflo(v.w) * e, bfhi(v.w) * e);
                bf16_t* fp = KG + (mt * 8 + ks) * 512 + r * 8 + 4 * hh;
                *(u32x2*)fp = o0; *(u32x2*)(fp + 256) = o1;
            }
        }
    }
    __builtin_amdgcn_sched_barrier(0);
#pragma unroll
    for (int ti = 0; ti < 3; ++ti) {
        __builtin_amdgcn_sched_barrier(0);
        const int mi = (ti >= 1), ni = (ti == 2);
        f32x16 a = {};
#pragma unroll
        for (int ks = 0; ks < 8; ++ks) a = mfma32(Kf[mi][ks], Kf[ni][ks], a);
        const int j = ni * 32 + r; const float gcj = gcL[j];
#pragma unroll
        for (int qq = 0; qq < 4; ++qq) {
            const int i0 = mi * 32 + 8 * qq + 4 * hh;
            const f32x4 gci = *(const LAS f32x4*)(gcL + i0), bti = *(const LAS f32x4*)(btL + i0);
            f32x4 mv;
#pragma unroll
            for (int e = 0; e < 4; ++e) {
                const int i = i0 + e;
                const float dec = __expf(fminf(gci[e] - gcj, 0.f));
                mv[e] = (i > j) ? bti[e] * a[qq * 4 + e] * dec : 0.f;
            }
            *(LAS f32x4*)(MT + ti * 32 * MTP + r * MTP + 8 * qq + 4 * hh) = mv;
        }
    }
    bf16_t* ATT = (bf16_t*)(ws + OFF_ATT) + (size_t)it * 4096;
    bf16_t* QG = (bf16_t*)(ws + OFF_QG) + (size_t)it * 8192;
#pragma unroll
    for (int mi = 0; mi < 2; ++mi) {
        __builtin_amdgcn_sched_barrier(0);
        bf16x8 Qf[8];
#pragma unroll
        for (int ks = 0; ks < 8; ++ks) Qf[ks] = *(const bf16x8*)(qp + (size_t)(mi * 32 + r) * 1024 + ks * 16 + hh * 8);
#pragma unroll
        for (int ni = 0; ni <= mi; ++ni) {
            __builtin_amdgcn_sched_barrier(0);
            f32x16 q = {};
#pragma unroll
            for (int ks = 0; ks < 8; ++ks) q = mfma32(Qf[ks], Kf[ni][ks], q);
            const int j = ni * 32 + r; const float gcj = gcL[j];
#pragma unroll
            for (int qq = 0; qq < 4; ++qq) {
                const int i0 = mi * 32 + 8 * qq + 4 * hh;
                const f32x4 gci = *(const LAS f32x4*)(gcL + i0);
#pragma unroll
                for (int e = 0; e < 4; ++e) {
                    const int i = i0 + e;
                    const float dec = __expf(fminf(gci[e] - gcj, 0.f));
                    ATT[((mi * 2 + ni) * 2 + (r >> 4)) * 512 + (((r >> 2) & 1) * 32 + (i & 31)) * 8 + 4 * ((r >> 3) & 1) + (r & 3)] = f2bf((i >= j) ? q[qq * 4 + e] * dec : 0.f);
                }
            }
        }
        __builtin_amdgcn_sched_barrier(0);
        const float e = __expf(gcL[mi * 32 + r]);
#pragma unroll
        for (int ks = 0; ks < 8; ++ks) {
            const u32x4 v = __builtin_bit_cast(u32x4, Qf[ks]);
            u32x2 o0, o1; o0.x = pk2(bflo(v.x) * e, bfhi(v.x) * e); o0.y = pk2(bflo(v.y) * e, bfhi(v.y) * e);
            o1.x = pk2(bflo(v.z) * e, bfhi(v.z) * e); o1.y = pk2(bflo(v.w) * e, bfhi(v.w) * e);
            bf16_t* fp = QG + (mi * 8 + ks) * 512 + r * 8 + 4 * hh;
            *(u32x2*)fp = o0; *(u32x2*)(fp + 256) = o1;
        }
    }
    WSYNC();
    float t[64];
    solve_col<63>(t, MT, lane);
    WSYNC();
    int lane5 = lane; asm volatile("" : "+v"(lane5) : "v"(t[0]));
    const int r5 = lane5 & 31, h5 = lane5 >> 5;
    {
        bf16_t* TBt = (bf16_t*)(ws + OFF_TBT) + (size_t)it * 4096 + ((lane5 >> 5) * 4) * 512 + (lane5 & 31) * 8;
#pragma unroll
        for (int m2 = 0; m2 < 2; ++m2)
#pragma unroll
            for (int sx = 0; sx < 2; ++sx) {
                const int c0 = m2 * 32 + 16 * sx;
                const f32x4 b0 = *(const LAS f32x4*)(btL + c0), b1 = *(const LAS f32x4*)(btL + c0 + 4), b2 = *(const LAS f32x4*)(btL + c0 + 8), b3 = *(const LAS f32x4*)(btL + c0 + 12);
                u32x4 oa, ob;
                oa.x = pk2(t[c0 + 0] * b0[0], t[c0 + 1] * b0[1]); oa.y = pk2(t[c0 + 2] * b0[2], t[c0 + 3] * b0[3]);
                oa.z = pk2(t[c0 + 8] * b2[0], t[c0 + 9] * b2[1]); oa.w = pk2(t[c0 + 10] * b2[2], t[c0 + 11] * b2[3]);
                ob.x = pk2(t[c0 + 4] * b1[0], t[c0 + 5] * b1[1]); ob.y = pk2(t[c0 + 6] * b1[2], t[c0 + 7] * b1[3]);
                ob.z = pk2(t[c0 + 12] * b3[0], t[c0 + 13] * b3[1]); ob.w = pk2(t[c0 + 14] * b3[2], t[c0 + 15] * b3[3]);
                bf16_t* fp = TBt + (m2 * 2 + sx) * 512;
                *(u32x4*)fp = oa; *(u32x4*)(fp + 256) = ob;
            }
    }
    {
        const bf16_t* KT = (const bf16_t*)(ws + OFF_KT) + (size_t)it * 8192;
        bf16_t* KDT = (bf16_t*)(ws + OFF_KDT) + (size_t)it * 8192;
#pragma unroll
        for (int nt = 0; nt < 4; ++nt) {
            __builtin_amdgcn_sched_barrier(0);
#pragma unroll
            for (int ks = 0; ks < 4; ++ks) {
                const u32x4 v = *(const u32x4*)(KT + (size_t)(nt * 32 + r5) * 64 + ks * 16 + h5 * 8);
                const f32x4 g0 = *(const LAS f32x4*)(gcL + ks * 16 + h5 * 8), g1 = *(const LAS f32x4*)(gcL + ks * 16 + h5 * 8 + 4);
                u32x2 o0, o1;
                o0.x = pk2(bflo(v.x) * __expf(gl - g0[0]), bfhi(v.x) * __expf(gl - g0[1])); o0.y = pk2(bflo(v.y) * __expf(gl - g0[2]), bfhi(v.y) * __expf(gl - g0[3]));
                o1.x = pk2(bflo(v.z) * __expf(gl - g1[0]), bfhi(v.z) * __expf(gl - g1[1])); o1.y = pk2(bflo(v.w) * __expf(gl - g1[2]), bfhi(v.w) * __expf(gl - g1[3]));
                bf16_t* fp = KDT + (nt * 4 + ks) * 512 + r5 * 8 + 4 * h5;
                *(u32x2*)fp = o0; *(u32x2*)(fp + 256) = o1;
            }
        }
    }
    WSYNC();
}

__device__ __forceinline__ void gdn_sample_item(const Params& p, int it, LAS unsigned char* wl) {
    unsigned char* ws = p.ws;
    int lane = threadIdx.x; asm volatile("" : "+v"(lane)); lane &= 63;
    const int c = lane & 31, hh = lane >> 5;
    const int qd = it & 3, bh = it >> 2, h = bh & 7, b = bh >> 3;
    const int dv = qd * 32 + c;
    float s[64];
    { const float* sp = p.in[4] + (size_t)bh * 16384 + (size_t)(hh * 64) * 128 + dv;
#pragma unroll
      for (int i = 0; i < 64; ++i) s[i] = sp[i * 128]; }
    LAS float* kq = (LAS float*)wl;
    const float* QKVS = (const float*)(ws + OFF_QKVS);
    const float* G = (const float*)(ws + OFF_G); const float* BT = (const float*)(ws + OFF_BETA);
    bf16_t* O = (bf16_t*)(ws + OFF_O);
#pragma unroll
    for (int t = 0; t < 4; ++t) {
        const float* row = QKVS + (size_t)(b * 4 + t) * 3072 + h * 128;
        kq[t * 256 + lane] = row[1024 + lane]; kq[t * 256 + 64 + lane] = row[1024 + 64 + lane];
        kq[t * 256 + 128 + lane] = row[lane]; kq[t * 256 + 192 + lane] = row[64 + lane];
    }
    WSYNC();
#pragma unroll 1
    for (int t = 0; t < 4; ++t) {
        const int tok = NPR + b * 4 + t;
        const float al = __expf(G[(size_t)tok * 8 + h]), be = BT[(size_t)tok * 8 + h];
        const float v = QKVS[(size_t)(b * 4 + t) * 3072 + 2048 + h * 128 + dv];
        float d0 = 0.f, d1 = 0.f, d2 = 0.f, d3 = 0.f;
        int kb = t * 256 + hh * 64;
#pragma unroll
        for (int i = 0; i < 64; i += 4) {
            if ((i & 15) == 0) asm volatile("" : "+v"(kb) : "v"(d0), "v"(d1), "v"(d2), "v"(d3));
            const f32x4 kk = *(const LAS f32x4*)(kq + kb + i);
            s[i] *= al; s[i + 1] *= al; s[i + 2] *= al; s[i + 3] *= al;
            d0 += kk[0] * s[i]; d1 += kk[1] * s[i + 1]; d2 += kk[2] * s[i + 2]; d3 += kk[3] * s[i + 3];
        }
        float dd = (d0 + d1) + (d2 + d3);
        dd += __shfl_xor(dd, 32);
        const float rr = be * (v - dd);
        float o0 = 0.f, o1 = 0.f, o2 = 0.f, o3 = 0.f;
        asm volatile("" : "+v"(kb) : "v"(rr));
#pragma unroll
        for (int i = 0; i < 64; i += 4) {
            if ((i & 15) == 0) asm volatile("" : "+v"(kb) : "v"(o0), "v"(o1), "v"(o2), "v"(o3));
            const f32x4 kk = *(const LAS f32x4*)(kq + kb + i);
            const f32x4 qq = *(const LAS f32x4*)(kq + kb + 128 + i);
            s[i] += rr * kk[0]; s[i + 1] += rr * kk[1]; s[i + 2] += rr * kk[2]; s[i + 3] += rr * kk[3];
            o0 += qq[0] * s[i]; o1 += qq[1] * s[i + 1]; o2 += qq[2] * s[i + 2]; o3 += qq[3] * s[i + 3];
        }
        float oo = (o0 + o1) + (o2 + o3);
        oo += __shfl_xor(oo, 32);
        if (hh == 0) O[(size_t)tok * 1024 + h * 128 + dv] = f2bf(oo);
    }
    int dv2 = dv; asm volatile("" : "+v"(dv2));
    float* So = p.out + O_SGDN + (size_t)bh * 16384 + (size_t)(hh * 64) * 128 + dv2;
#pragma unroll
    for (int i = 0; i < 64; ++i) So[i * 128] = s[i];
    WSYNC();
}

__device__ __forceinline__ void s5_unit(const Params& p, int g, int tok_base, int nsub, bool sample, int b0, LAS unsigned char* wl, int hb_off);
__device__ __forceinline__ void phase_gdn_prep(const Params& p, LAS unsigned char* lds) {
    const int wave = __builtin_amdgcn_readfirstlane(threadIdx.x >> 6);
    LAS unsigned char* wl = lds + wave * 16384;
    if (wave < 4) { for (int it = blockIdx.x * 4 + wave; it < 1024; it += gridDim.x * 4) gdn_prep_item(p, it, wl, (LAS float*)(lds + 143360 + wave * 512)); }
    else {
        for (int it = blockIdx.x * 4 + (wave - 4); it < 4096; it += gridDim.x * 4) gdn_sample_item(p, it, wl);
        for (int u = blockIdx.x * 4 + (wave - 4); u < 2048; u += gridDim.x * 4) { const int g = u & 63, bq = u >> 6; s5_unit(p, g, NPR + bq * 16, 1, true, bq * 4, wl, 8192); }
    }
}

__device__ __forceinline__ bf16x8 ldperm(const bf16_t* p8, int hh) {
    const u32x2 lo = *(const u32x2*)(p8 + 4 * hh), hi = *(const u32x2*)(p8 + 8 + 4 * hh);
    return mk8(lo.x, lo.y, hi.x, hi.y);
}
constexpr int GDN_BUF = 61440, GDN_LDS0 = 21504;
__device__ __forceinline__ void gdn_dma_chunk(const unsigned char* ws, int it, LAS unsigned char* buf, int lane) {
    const bf16_t* KG = (const bf16_t*)(ws + OFF_KG) + (size_t)it * 8192 + lane * 8;
    const bf16_t* QG = (const bf16_t*)(ws + OFF_QG) + (size_t)it * 8192 + lane * 8;
    const bf16_t* KDT = (const bf16_t*)(ws + OFF_KDT) + (size_t)it * 8192 + lane * 8;
#pragma unroll
    for (int f = 0; f < 16; ++f) __builtin_amdgcn_global_load_lds((const unsigned*)(KG + f * 512), (LAS unsigned*)(buf + f * 1024), 16, 0, 0);
#pragma unroll
    for (int f = 0; f < 16; ++f) __builtin_amdgcn_global_load_lds((const unsigned*)(QG + f * 512), (LAS unsigned*)(buf + 16384 + f * 1024), 16, 0, 0);
#pragma unroll
    for (int f = 0; f < 16; ++f) __builtin_amdgcn_global_load_lds((const unsigned*)(KDT + f * 512), (LAS unsigned*)(buf + 32768 + f * 1024), 16, 0, 0);
    const bf16_t* TBt = (const bf16_t*)(ws + OFF_TBT) + (size_t)it * 4096 + lane * 8;
    const bf16_t* ATT = (const bf16_t*)(ws + OFF_ATT) + (size_t)it * 4096 + lane * 8;
#pragma unroll
    for (int k = 0; k < 6; ++k) { const int f = (k < 2) ? k : k + 2;
        __builtin_amdgcn_global_load_lds((const unsigned*)(TBt + f * 512), (LAS unsigned*)(buf + 49152 + k * 1024), 16, 0, 0);
        __builtin_amdgcn_global_load_lds((const unsigned*)(ATT + f * 512), (LAS unsigned*)(buf + 55296 + k * 1024), 16, 0, 0); }
}
template <int PAR>
__device__ __forceinline__ void gdn_chunk(const Params& p, LAS unsigned char* gb, int n, int bh, int b, int h, int dv, int hh, int lane, f32x16 (&S)[4]) {
    unsigned char* ws = p.ws;
    asm volatile("s_waitcnt vmcnt(0)" ::: "memory");
    const int it = bh * 32 + n;
    const LAS unsigned char* cb = gb + PAR * GDN_BUF + lane * 16;
    const float* VV = (const float*)(ws + OFF_VV) + (size_t)(b * 2048 + n * 64) * 1024 + h * 128 + dv;
    bf16_t* O = (bf16_t*)(ws + OFF_O);
    const float gl = ((const float*)(ws + OFF_GLAST))[it];
    f32x16 v0, v1;
#pragma unroll
    for (int q = 0; q < 16; ++q) { const int i = 8 * (q >> 2) + 4 * hh + (q & 3); v0[q] = VV[(size_t)i * 1024]; v1[q] = VV[(size_t)(32 + i) * 1024]; }
    float pf8 = 0.f;
    if (n + 1 < 32) pf8 = VV[(size_t)(64 + lane) * 1024];
    if (n + 1 < 32) gdn_dma_chunk(ws, it + 1, gb + (1 - PAR) * GDN_BUF, lane);
    bf16x8 Sb[4][2];
#pragma unroll
    for (int kt = 0; kt < 4; ++kt)
#pragma unroll
        for (int s = 0; s < 2; ++s)
            Sb[kt][s] = mk8(pk2(S[kt][8 * s + 0], S[kt][8 * s + 1]), pk2(S[kt][8 * s + 2], S[kt][8 * s + 3]), pk2(S[kt][8 * s + 4], S[kt][8 * s + 5]), pk2(S[kt][8 * s + 6], S[kt][8 * s + 7]));
    bf16x8 Eb[2][2];
    {
        f32x16 a0 = {}, a1 = {};
#pragma unroll
        for (int kt = 0; kt < 4; ++kt)
#pragma unroll
            for (int s = 0; s < 2; ++s) {
                const u32x4 hv = __builtin_bit_cast(u32x4, Sb[kt][s]);
                const bf16x8 lo = mk8(pk2(S[kt][8 * s + 0] - bflo(hv.x), S[kt][8 * s + 1] - bfhi(hv.x)), pk2(S[kt][8 * s + 2] - bflo(hv.y), S[kt][8 * s + 3] - bfhi(hv.y)),
                                      pk2(S[kt][8 * s + 4] - bflo(hv.z), S[kt][8 * s + 5] - bfhi(hv.z)), pk2(S[kt][8 * s + 6] - bflo(hv.w), S[kt][8 * s + 7] - bfhi(hv.w)));
                const bf16x8 A0 = *(const LAS bf16x8*)(cb + (kt * 2 + s) * 1024);
                const bf16x8 A1 = *(const LAS bf16x8*)(cb + (8 + kt * 2 + s) * 1024);
                a0 = mfma32(A0, Sb[kt][s], a0); a1 = mfma32(A1, Sb[kt][s], a1);
                a0 = mfma32(A0, lo, a0); a1 = mfma32(A1, lo, a1);
            }
        a0 += v0; a1 += v1;
#pragma unroll
        for (int s = 0; s < 2; ++s) {
            Eb[0][s] = mk8(pk2(a0[8 * s + 0], a0[8 * s + 1]), pk2(a0[8 * s + 2], a0[8 * s + 3]), pk2(a0[8 * s + 4], a0[8 * s + 5]), pk2(a0[8 * s + 6], a0[8 * s + 7]));
            Eb[1][s] = mk8(pk2(a1[8 * s + 0], a1[8 * s + 1]), pk2(a1[8 * s + 2], a1[8 * s + 3]), pk2(a1[8 * s + 4], a1[8 * s + 5]), pk2(a1[8 * s + 6], a1[8 * s + 7]));
        }
    }
    bf16x8 Vb[2][2];
#pragma unroll
    for (int mt = 0; mt < 2; ++mt) {
        f32x16 a = {};
#pragma unroll
        for (int m2 = 0; m2 <= mt; ++m2)
#pragma unroll
            for (int s = 0; s < 2; ++s) a = mfma32(*(const LAS bf16x8*)(cb + 49152 + ((mt == 0) ? s : 2 + m2 * 2 + s) * 1024), Eb[m2][s], a);
#pragma unroll
        for (int s = 0; s < 2; ++s)
            Vb[mt][s] = mk8(pk2(a[8 * s + 0], a[8 * s + 1]), pk2(a[8 * s + 2], a[8 * s + 3]), pk2(a[8 * s + 4], a[8 * s + 5]), pk2(a[8 * s + 6], a[8 * s + 7]));
    }
#pragma unroll
    for (int mt = 0; mt < 2; ++mt) {
        f32x16 a = {};
#pragma unroll
        for (int kt = 0; kt < 4; ++kt)
#pragma unroll
            for (int s = 0; s < 2; ++s) a = mfma32(*(const LAS bf16x8*)(cb + 16384 + ((mt * 4 + kt) * 2 + s) * 1024), Sb[kt][s], a);
#pragma unroll
        for (int m2 = 0; m2 <= mt; ++m2)
#pragma unroll
            for (int s = 0; s < 2; ++s) a = mfma32(*(const LAS bf16x8*)(cb + 55296 + ((mt == 0) ? s : 2 + m2 * 2 + s) * 1024), Vb[m2][s], a);
#pragma unroll
        for (int q = 0; q < 16; ++q) { const int i = mt * 32 + 8 * (q >> 2) + 4 * hh + (q & 3);
            O[(size_t)(b * 2048 + n * 64 + i) * 1024 + h * 128 + dv] = f2bf(a[q]); }
    }
#pragma unroll
    for (int kt = 0; kt < 4; ++kt) {
        f32x16 a = S[kt] * gl;
#pragma unroll
        for (int m2 = 0; m2 < 2; ++m2)
#pragma unroll
            for (int s = 0; s < 2; ++s) a = mfma32(*(const LAS bf16x8*)(cb + 32768 + ((kt * 2 + m2) * 2 + s) * 1024), Vb[m2][s], a);
        S[kt] = a;
    }
    asm volatile("" :: "v"(pf8));
}
__device__ __forceinline__ void gdn_scan_unit(const Params& p, int unit, LAS unsigned char* gb) {
    int lane = threadIdx.x; asm volatile("" : "+v"(lane)); lane &= 63;
    const int r = lane & 31, hh = lane >> 5;
    const int sl = unit & 3, bh = unit >> 2, h = bh & 7, b = bh >> 3;
    const int dv = sl * 32 + r;
    f32x16 S[4];
#pragma unroll
    for (int kt = 0; kt < 4; ++kt) S[kt] = (f32x16){};
    gdn_dma_chunk(p.ws, bh * 32, gb, lane);
#pragma unroll 1
    for (int n = 0; n < 32; n += 2) {
        gdn_chunk<0>(p, gb, n, bh, b, h, dv, hh, lane, S);
        gdn_chunk<1>(p, gb, n + 1, bh, b, h, dv, hh, lane, S);
    }
    int lane6 = threadIdx.x; asm volatile("" : "+v"(lane6)); lane6 &= 63;
    float* So = p.out + O_PGDN + (size_t)bh * 16384 + (sl * 32 + (lane6 & 31)) + (size_t)(4 * (lane6 >> 5)) * 128;
#pragma unroll
    for (int kt = 0; kt < 4; ++kt)
#pragma unroll
        for (int q = 0; q < 16; ++q) { const int dk = kt * 32 + 8 * (q >> 2) + (q & 3); So[(size_t)dk * 128] = S[kt][q]; }
}

__device__ __forceinline__ void s5_unit(const Params& p, int g, int tok_base, int nsub, bool sample, int b0, LAS unsigned char* wl, int hb_off) {
    unsigned char* ws = p.ws;
    int lane = threadIdx.x; asm volatile("" : "+v"(lane)); lane &= 63;
    const int l15 = lane & 15, l4 = lane >> 4;
    LAS bf16_t* HB = (LAS bf16_t*)(wl + hb_off);
    const bf16_t* PB = (const bf16_t*)(ws + OFF_PROJB);
    bf16_t* ZB = (bf16_t*)(ws + OFF_ZB);
    const float* AB = (const float*)(ws + OFF_ABAR);
    const float ar = AB[(g * 64 + lane) * 2], ai = AB[(g * 64 + lane) * 2 + 1];
    const bf16_t* bbt = (const bf16_t*)(ws + OFF_BBT) + (size_t)g * 2048;
    const bf16_t* ct = (const bf16_t*)(ws + OFF_CT) + (size_t)g * 2048;
    bf16x8 Bf[8], Cf[4];
    const bf16x8 zero8 = {0, 0, 0, 0, 0, 0, 0, 0};
#pragma unroll
    for (int nt = 0; nt < 8; ++nt) Bf[nt] = (l4 < 2) ? *(const bf16x8*)(bbt + (nt * 16 + l15) * 16 + 8 * l4) : zero8;
#pragma unroll
    for (int s = 0; s < 4; ++s) Cf[s] = *(const bf16x8*)(ct + l15 * 128 + 32 * s + 8 * l4);
    const float dskip = p.in[18][g * 16 + l15];
    float hr = 0.f, hi = 0.f;
    const int last_tok = tok_base + (nsub - 1) * 16;
    {
        const bf16x8 A0 = (l4 < 2) ? *(const bf16x8*)(PB + (size_t)(tok_base + l15) * NPB + g * 16 + 8 * l4) : zero8;
        LAS float* BU = (LAS float*)wl;
#pragma unroll
        for (int nt = 0; nt < 8; ++nt) {
            f32x4 a = {0.f, 0.f, 0.f, 0.f};
            a = mfma16(A0, Bf[nt], a);
#pragma unroll
            for (int q = 0; q < 4; ++q) BU[(4 * l4 + q) * 128 + nt * 16 + l15] = a[q];
        }
    }
    const int tok1 = (nsub > 1) ? tok_base + 16 : tok_base;
    bf16x8 Au = (l4 < 2) ? *(const bf16x8*)(PB + (size_t)(tok1 + l15) * NPB + g * 16 + 8 * l4) : zero8;
    float uu[4];
#pragma unroll
    for (int q = 0; q < 4; ++q) uu[q] = bf2f(PB[(size_t)(tok_base + 4 * l4 + q) * NPB + g * 16 + l15]);
    WSYNC();
#pragma unroll 1
    for (int sc = 0; sc < nsub; ++sc) {
        const int tok0 = tok_base + sc * 16;
        LAS float* BU = (LAS float*)(wl + (sc & 1) * 8192);
        LAS float* BUn = (LAS float*)(wl + ((sc + 1) & 1) * 8192);
        const int tok2 = (tok0 + 32 <= last_tok) ? tok0 + 32 : last_tok;
        const int tokn = (tok0 + 16 <= last_tok) ? tok0 + 16 : last_tok;
        const bf16x8 Au_n = (l4 < 2) ? *(const bf16x8*)(PB + (size_t)(tok2 + l15) * NPB + g * 16 + 8 * l4) : zero8;
        float uu_n[4];
#pragma unroll
        for (int q = 0; q < 4; ++q) uu_n[q] = bf2f(PB[(size_t)(tokn + 4 * l4 + q) * NPB + g * 16 + l15]);
        if (sc + 1 < nsub) {
#pragma unroll
            for (int nt = 0; nt < 8; ++nt) {
                f32x4 a = {0.f, 0.f, 0.f, 0.f};
                a = mfma16(Au, Bf[nt], a);
#pragma unroll
                for (int q = 0; q < 4; ++q) BUn[(4 * l4 + q) * 128 + nt * 16 + l15] = a[q];
            }
        }
#pragma unroll
        for (int t = 0; t < 16; ++t) {
            if (sample && (t & 3) == 0) {
                const int bb = b0 + (t >> 2);
                hr = p.in[2][((size_t)bb * 64 + g) * 64 + lane]; hi = p.in[3][((size_t)bb * 64 + g) * 64 + lane];
            }
            const float br = BU[t * 128 + lane], bi = BU[t * 128 + 64 + lane];
            const float nr = ar * hr - ai * hi + br, ni = ar * hi + ai * hr + bi;
            hr = nr; hi = ni;
            HB[t * 136 + lane] = f2bf(hr); HB[t * 136 + 64 + lane] = f2bf(hi);
            if (sample && (t & 3) == 3) {
                const int bb = b0 + (t >> 2);
                p.out[O_SRE + ((size_t)bb * 64 + g) * 64 + lane] = hr; p.out[O_SIM + ((size_t)bb * 64 + g) * 64 + lane] = hi;
            }
        }
        WSYNC();
        f32x4 y = {0.f, 0.f, 0.f, 0.f};
#pragma unroll
        for (int s = 0; s < 4; ++s) {
            const bf16x8 Ah = *(const LAS bf16x8*)(HB + l15 * 136 + 32 * s + 8 * l4);
            y = mfma16(Ah, Cf[s], y);
        }
#pragma unroll
        for (int q = 0; q < 4; ++q) {
            const int tok = tok0 + 4 * l4 + q;
            ZB[(size_t)tok * 1024 + g * 16 + l15] = f2bf(gelu_tanh(y[q] + dskip * uu[q]));
        }
        WSYNC();
        Au = Au_n;
#pragma unroll
        for (int q = 0; q < 4; ++q) uu[q] = uu_n[q];
    }
    if (!sample) {
        const int b = tok_base >> 11;
        p.out[O_PRE + ((size_t)b * 64 + g) * 64 + lane] = hr; p.out[O_PIM + ((size_t)b * 64 + g) * 64 + lane] = hi;
    }
}

__device__ __forceinline__ void phase_scan(const Params& p, LAS unsigned char* lds) {
    const int wave = __builtin_amdgcn_readfirstlane(threadIdx.x >> 6);
    if (wave == 0) {
        for (int B = blockIdx.x; B < 128; B += gridDim.x) { const int xi = B & 7, idx = B >> 3; gdn_scan_unit(p, ((xi * 4 + (idx >> 2)) << 2) + (idx & 3), lds + GDN_LDS0); }
    }
    else if (wave == 1) { for (int u = blockIdx.x; u < 256; u += gridDim.x) s5_unit(p, u & 63, (u >> 6) * 2048, 128, false, 0, lds, 16384); }
}

__device__ __forceinline__ void phase_onorm(const Params& p) {
    unsigned char* ws = p.ws;
    int lane = threadIdx.x; asm volatile("" : "+v"(lane)); lane &= 63;
    const int wave = __builtin_amdgcn_readfirstlane(threadIdx.x >> 6);
    const bf16_t* O = (const bf16_t*)(ws + OFF_O); const bf16_t* PB = (const bf16_t*)(ws + OFF_PROJB);
    bf16_t* YM = (bf16_t*)(ws + OFF_YMIX);
    const float nw0 = p.in[24][2 * lane], nw1 = p.in[24][2 * lane + 1];
    for (int it4 = blockIdx.x * 8 + wave; it4 < NTOK * 2; it4 += gridDim.x * 8) {
        unsigned ov[4], gv[4];
#pragma unroll
        for (int j = 0; j < 4; ++j) {
            const int it = it4 * 4 + j, h = it & 7, tok = it >> 3;
            ov[j] = *(const unsigned*)(O + (size_t)tok * 1024 + h * 128 + 2 * lane);
            gv[j] = *(const unsigned*)(PB + (size_t)tok * NPB + 4096 + h * 128 + 2 * lane);
        }
        float ss[4];
#pragma unroll
        for (int j = 0; j < 4; ++j) { const float o0 = bflo(ov[j]), o1 = bfhi(ov[j]); ss[j] = o0 * o0 + o1 * o1; }
#pragma unroll
        for (int o = 1; o < 64; o <<= 1) {
#pragma unroll
            for (int j = 0; j < 4; ++j) ss[j] += __shfl_xor(ss[j], o);
        }
#pragma unroll
        for (int j = 0; j < 4; ++j) {
            const int it = it4 * 4 + j, h = it & 7, tok = it >> 3;
            const float o0 = bflo(ov[j]), o1 = bfhi(ov[j]);
            const float rs = 1.f / sqrtf(ss[j] * (1.f / 128.f) + 1e-6f);
            *(unsigned*)(YM + (size_t)tok * DM + 1024 + h * 128 + 2 * lane) = pk2(o0 * rs * nw0 * siluf(bflo(gv[j])), o1 * rs * nw1 * siluf(bfhi(gv[j])));
        }
    }
}

#define XB_TMO      128
#define XB_XCNT(j)  (256  + 64 * (j))
#define XB_XSUB(j)  (1280 + 64 * (j))
#define XB_XGEN(j)  (2304 + 64 * (j))
#define XB_TOP      3328
#define XB_TOPGEN   3392
#define XCD_BAR_WORDS 3456
#define XB_SPIN_CAP (1u << 18)
__device__ __forceinline__ unsigned xb_ld(unsigned* p)              { return __hip_atomic_load(p, __ATOMIC_RELAXED, __HIP_MEMORY_SCOPE_AGENT); }
__device__ __forceinline__ unsigned xb_add(unsigned* p, unsigned v) { return __hip_atomic_fetch_add(p, v, __ATOMIC_RELAXED, __HIP_MEMORY_SCOPE_AGENT); }
__device__ __forceinline__ unsigned xb_xcc_id() { return (unsigned)__builtin_amdgcn_s_getreg((3 << 11) | 20) & 0xFu; }
#define XB_SPIN(cond, bar) do { unsigned _sp = 0; while (cond) { __builtin_amdgcn_s_sleep(1); \
    if ((++_sp & 255u) == 0u) { if (xb_ld(&(bar)[XB_TMO])) break; if (_sp > XB_SPIN_CAP) { atomicAdd(&(bar)[XB_TMO], 1u); break; } } } } while (0)
struct XcdBarrier { unsigned* bar; unsigned x; volatile LAS unsigned* st; };
__device__ __forceinline__ XcdBarrier xcd_barrier_post(unsigned* bar, volatile LAS unsigned* st) {
    XcdBarrier b; b.bar = bar; b.x = xb_xcc_id(); b.st = st;
    if (threadIdx.x == 0) (void)xb_add(&bar[XB_XCNT(b.x)], 1u);
    return b;
}
__device__ __forceinline__ void xcd_barrier_complete(unsigned* bar, unsigned x, unsigned& nloc, unsigned& nx) {
    const unsigned G = gridDim.x * gridDim.y * gridDim.z;
    unsigned sum, cnt, mine, sp = 0u;
    for (;;) {
        sum = 0u; cnt = 0u; mine = 0u;
#pragma unroll
        for (unsigned j = 0; j < 16; ++j) { const unsigned c = xb_ld(&bar[XB_XCNT(j)]); sum += c; cnt += (c > 0u) ? 1u : 0u; mine = (j == x) ? c : mine; }
        if (sum == G) break;
        __builtin_amdgcn_s_sleep(1);
        if ((++sp & 255u) == 0u) { if (xb_ld(&bar[XB_TMO])) break; if (sp > XB_SPIN_CAP) { atomicAdd(&bar[XB_TMO], 1u); break; } }
    }
    nloc = mine > 0u ? mine : 1u; nx = cnt > 0u ? cnt : 1u;
}
__device__ __forceinline__ void xcd_barrier(const XcdBarrier& b) {
    asm volatile("s_waitcnt vmcnt(0)" ::: "memory");
    __syncthreads();
    if (threadIdx.x == 0) {
        unsigned* bar = b.bar;
        __builtin_amdgcn_s_waitcnt(0);
        unsigned nloc = b.st[0], nx = b.st[1];
        if (nloc == 0u) { xcd_barrier_complete(bar, b.x, nloc, nx); b.st[0] = nloc; b.st[1] = nx; }
        const unsigned old = xb_add(&bar[XB_XSUB(b.x)], 1u);
        const unsigned gen = old / nloc;
        if (old + 1u == (gen + 1u) * nloc) {
            __builtin_amdgcn_fence(__ATOMIC_RELEASE, "agent");
            asm volatile("s_waitcnt vmcnt(0)" ::: "memory");
            const unsigned og = xb_add(&bar[XB_TOP], 1u);
            const unsigned tg = og / nx;
            if (og + 1u == (tg + 1u) * nx) xb_add(&bar[XB_TOPGEN], 1u);
            else XB_SPIN(xb_ld(&bar[XB_TOPGEN]) == tg, bar);
            __builtin_amdgcn_fence(__ATOMIC_ACQUIRE, "agent");
            xb_add(&bar[XB_XGEN(b.x)], 1u);
            asm volatile("s_waitcnt vmcnt(0)" ::: "memory");
        } else {
            XB_SPIN(xb_ld(&bar[XB_XGEN(b.x)]) == gen, bar);
            __builtin_amdgcn_fence(__ATOMIC_ACQUIRE, "agent");
            asm volatile("s_waitcnt vmcnt(0)" ::: "memory");
        }
    }
    __syncthreads();
}

__global__ void __launch_bounds__(512, 2) fwd_megakernel(Params p) {
    extern __shared__ __attribute__((aligned(16))) unsigned char shm[];
    LAS unsigned char* lds = (LAS unsigned char*)shm;
    cg::grid_group grid = cg::this_grid();
    unsigned char* ws = p.ws;
    pg8::StaticOrder S;
    volatile LAS unsigned* bst = (volatile LAS unsigned*)(lds + 147456 - 16);
    if (threadIdx.x == 0) { bst[0] = 0u; bst[1] = 0u; }
    __syncthreads();
    const XcdBarrier xb = xcd_barrier_post((unsigned*)(ws + OFF_BAR), bst);
    phase_convert0(p, lds);
    grid.sync();
    if (STOP_AFTER <= 0) return;
    { S.init(NTOK, 2 * DFF, DM, gridDim.x, blockIdx.x, false); pg8::Gemm g{(const bf16_t*)(ws + OFF_XNB), (const bf16_t*)(ws + OFF_W1T), NTOK, 2 * DFF, DM};
      EpiSwiglu E{(bf16_t*)(ws + OFF_H)}; pg8::gemm_phase(lds, g, S, E); }
    xcd_barrier(xb);
    { S.init(NTOK, DM, DFF, gridDim.x, blockIdx.x, true); pg8::Gemm g{(const bf16_t*)(ws + OFF_H), (const bf16_t*)(ws + OFF_W1O), NTOK, DM, DFF};
      EpiResid E{(float*)(ws + OFF_R), p.in[0], p.in[1], (float*)(ws + OFF_PART), nullptr, 0.5f}; pg8::gemm_phase(lds, g, S, E); }
    __syncthreads();
    phase_convert_mid(p, lds, S.tail_busy());
    xcd_barrier(xb);
    phase_ln((const float*)(ws + OFF_R), p.in[6], p.in[7], nullptr, (bf16_t*)(ws + OFF_XRB), S.mode == 1 ? (const float*)(ws + OFF_PART) : nullptr, p.in[1], nullptr);
    xcd_barrier(xb);
    if (STOP_AFTER <= 3) return;
    { S.init(NTOK, NMIXP, DM, gridDim.x, blockIdx.x, false); pg8::Gemm g{(const bf16_t*)(ws + OFF_XRB), (const bf16_t*)(ws + OFF_WMI), NTOK, NMIXP, DM};
      EpiMixIn E{(bf16_t*)(ws + OFF_PROJB), (float*)(ws + OFF_BD)}; pg8::gemm_phase(lds, g, S, E); }
    xcd_barrier(xb);
    phase_conv(p);
    xcd_barrier(xb);
    if (STOP_AFTER <= 4) return;
    phase_gdn_prep(p, lds);
    xcd_barrier(xb);
    phase_scan(p, lds);
    xcd_barrier(xb);
    if (STOP_AFTER <= 5) return;
    phase_onorm(p);
    __syncthreads();
    { S.init(NTOK, 1024, 1024, gridDim.x, blockIdx.x, false); pg8::Gemm g{(const bf16_t*)(ws + OFF_ZB), (const bf16_t*)(ws + OFF_GLU), NTOK, 1024, 1024};
      EpiGlu E{(bf16_t*)(ws + OFF_YMIX), (const bf16_t*)(ws + OFF_ZB), p.in[20]}; pg8::gemm_phase(lds, g, S, E); }
    xcd_barrier(xb);
    { S.init(NTOK, DM, DM, gridDim.x, blockIdx.x, true); pg8::Gemm g{(const bf16_t*)(ws + OFF_YMIX), (const bf16_t*)(ws + OFF_WMO), NTOK, DM, DM};
      EpiResid E{(float*)(ws + OFF_R), nullptr, nullptr, (float*)(ws + OFF_PART), (const bf16_t*)(ws + OFF_XRB), 1.0f}; pg8::gemm_phase(lds, g, S, E); }
    __syncthreads();
    phase_convert1(p, lds, S.tail_busy());
    xcd_barrier(xb);
    phase_ln((const float*)(ws + OFF_R), p.in[26], p.in[27], nullptr, (bf16_t*)(ws + OFF_XRB), S.mode == 1 ? (const float*)(ws + OFF_PART) : nullptr, nullptr, (const bf16_t*)(ws + OFF_XRB) + (size_t)NPR * DM);
    xcd_barrier(xb);
    { S.init(NTOK, 2 * DFF, DM, gridDim.x, blockIdx.x, false); pg8::Gemm g{(const bf16_t*)(ws + OFF_XRB), (const bf16_t*)(ws + OFF_W1T), NTOK, 2 * DFF, DM};
      EpiSwiglu E{(bf16_t*)(ws + OFF_H)}; pg8::gemm_phase(lds, g, S, E); }
    xcd_barrier(xb);
    { S.init(NTOK, DM, DFF, gridDim.x, blockIdx.x, true); pg8::Gemm g{(const bf16_t*)(ws + OFF_H), (const bf16_t*)(ws + OFF_W1O), NTOK, DM, DFF};
      EpiResid E{(float*)(ws + OFF_R), nullptr, nullptr, (float*)(ws + OFF_PART), (const bf16_t*)(ws + OFF_XRB), 0.5f}; pg8::gemm_phase(lds, g, S, E); }
    xcd_barrier(xb);
    phase_ln((const float*)(ws + OFF_R), p.in[30], p.in[31], p.out + O_Y, nullptr, S.mode == 1 ? (const float*)(ws + OFF_PART) : nullptr, nullptr, (const bf16_t*)(ws + OFF_XRB) + (size_t)NPR * DM);
}

extern "C" void kernel_launch(void* const* d_in, const int* in_sizes, int n_in, void* d_out, int out_size, void* d_ws, size_t ws_size, hipStream_t stream) {
    constexpr int LDS_BYTES = 147456;
    static int grid_blocks = 0;
    if (grid_blocks == 0) {
        int dev = 0, cus = 0, per_cu = 0;
        hipGetDevice(&dev);
        hipDeviceGetAttribute(&cus, hipDeviceAttributeMultiprocessorCount, dev);
        hipFuncSetAttribute((const void*)fwd_megakernel, hipFuncAttributeMaxDynamicSharedMemorySize, LDS_BYTES);
        hipOccupancyMaxActiveBlocksPerMultiprocessor(&per_cu, (const void*)fwd_megakernel, 512, LDS_BYTES);
        if (per_cu < 1) { fprintf(stderr, "occupancy query returned %d\n", per_cu); per_cu = 1; }
        grid_blocks = cus * 1;
        if (ws_size < WS_END) fprintf(stderr, "workspace too small: %zu < %zu\n", ws_size, (size_t)WS_END);
    }
    (void)hipMemsetAsync((unsigned char*)d_ws + OFF_BAR, 0, XCD_BAR_WORDS * 4, stream);
    Params p{};
    for (int i = 0; i < 32; ++i) p.in[i] = (const float*)d_in[i];
    p.out = (float*)d_out; p.ws = (unsigned char*)d_ws;
    void* args[] = {&p};
    hipError_t e = hipLaunchCooperativeKernel((const void*)fwd_megakernel, dim3(grid_blocks), dim3(512), args, LDS_BYTES, stream);
    if (e != hipSuccess) fprintf(stderr, "cooperative launch failed: %s (grid %d)\n", hipGetErrorString(e), grid_blocks);
}
```

```cpp
#include <hip/hip_runtime.h>
#include <hip/hip_cooperative_groups.h>
#include <cstdio>
namespace cg = cooperative_groups;

#define LAS __attribute__((address_space(3)))
typedef unsigned short bf16_t;
typedef short bf16x8 __attribute__((ext_vector_type(8)));
typedef float f32x4 __attribute__((ext_vector_type(4)));
typedef float f32x16 __attribute__((ext_vector_type(16)));
typedef unsigned u32x4 __attribute__((ext_vector_type(4)));
typedef unsigned u32x2 __attribute__((ext_vector_type(2)));

#ifndef STOP_AFTER
#define STOP_AFTER 99
#endif

constexpr int NTOK = 8704, NPR = 8192, DM = 2048, DFF = 5632, NMIX = 5136, NMIXP = 5376, NPB = 5120;
constexpr float ALPHA = 1.189207115002721f;

constexpr size_t O_Y = 0, O_PRE = 17825792, O_PIM = 17842176, O_PGDN = 17858560, O_PCONV = 18382848,
                 O_SRE = 18419712, O_SIM = 18944000, O_SGDN = 19468288, O_SCONV = 36245504;

constexpr size_t SZ_W1T = (size_t)11264 * 2048 * 2, SZ_W1O = (size_t)2048 * 5632 * 2;
constexpr size_t OFF_W1T = 0;
constexpr size_t OFF_W1O = OFF_W1T + SZ_W1T;
constexpr size_t OFF_WMI = OFF_W1O + SZ_W1O;
constexpr size_t OFF_GLU = OFF_WMI + (size_t)NMIXP * 2048 * 2;
constexpr size_t OFF_WMO = OFF_GLU + (size_t)1024 * 1024 * 2;
constexpr size_t OFF_XNB = OFF_WMO + (size_t)2048 * 2048 * 2;
constexpr size_t OFF_XN  = OFF_XNB + (size_t)NTOK * 2048 * 2;
constexpr size_t OFF_R   = OFF_XN + (size_t)NTOK * 2048 * 4;
constexpr size_t OFF_H   = OFF_R + (size_t)NTOK * 2048 * 4;
constexpr size_t OFF_KDT = OFF_H + (size_t)NTOK * DFF * 2;
constexpr size_t SZ_CH   = (size_t)1024 * 64 * 128 * 2;
constexpr size_t OFF_TBT = OFF_KDT + SZ_CH;
constexpr size_t OFF_O   = OFF_TBT + (size_t)1024 * 64 * 64 * 2;
constexpr size_t OFF_ZB  = OFF_O + (size_t)NTOK * 1024 * 2;
constexpr size_t OFF_BBT = OFF_ZB + (size_t)NTOK * 1024 * 2;
constexpr size_t OFF_CT  = OFF_BBT + 262144;
constexpr size_t OFF_ABAR = OFF_CT + 262144;
constexpr size_t OFF_GLAST = OFF_ABAR + 32768;
constexpr size_t OFF_BAR = OFF_GLAST + 4096;
constexpr size_t OFF_PART = OFF_BAR + 16384;
constexpr size_t WS_END  = OFF_PART + (size_t)4 * 512 * 2048 * 4;
constexpr size_t OFF_PROJB = OFF_H;
constexpr size_t OFF_XRB = OFF_XN;
constexpr size_t OFF_YMIX = OFF_XN + (size_t)NTOK * 2048 * 2;
constexpr size_t OFF_QN = OFF_R, OFF_KN = OFF_QN + (size_t)NPR * 1024 * 2, OFF_VV = OFF_KN + (size_t)NPR * 1024 * 2;
constexpr size_t OFF_G = OFF_VV + (size_t)NPR * 1024 * 4;
constexpr size_t OFF_BETA = OFF_G + (size_t)NTOK * 8 * 4;
constexpr size_t OFF_BD = OFF_BETA + (size_t)NTOK * 8 * 4;
constexpr size_t OFF_KT = OFF_W1T, OFF_ATT = OFF_KT + SZ_CH, OFF_QG = OFF_ATT + (size_t)1024 * 64 * 64 * 2, OFF_KG = OFF_QG + SZ_CH;
constexpr size_t OFF_QKVS = OFF_KG + SZ_CH;
static_assert(OFF_BD + (size_t)NTOK * 16 * 4 <= OFF_H, "R alias overflow");
static_assert(OFF_QKVS + (size_t)512 * 3072 * 4 <= OFF_WMI, "W1 alias overflow");

struct Params { const float* in[32]; float* out; unsigned char* ws; };

typedef __bf16 bf16v2_t __attribute__((ext_vector_type(2)));
typedef float f32v2_t __attribute__((ext_vector_type(2)));
__device__ __forceinline__ unsigned pk2(float lo, float hi) { f32v2_t v = {lo, hi}; bf16v2_t b = __builtin_convertvector(v, bf16v2_t); return __builtin_bit_cast(unsigned, b); }
__device__ __forceinline__ bf16_t f2bf(float f) { return (bf16_t)(pk2(f, 0.f) & 0xffffu); }
__device__ __forceinline__ float bf2f(bf16_t b) { return __uint_as_float(((unsigned)b) << 16); }
__device__ __forceinline__ float bflo(unsigned u) { return __uint_as_float(u << 16); }
__device__ __forceinline__ float bfhi(unsigned u) { return __uint_as_float(u & 0xffff0000u); }
__device__ __forceinline__ float wave_sum(float v) {
#pragma unroll
    for (int o = 1; o < 64; o <<= 1) v += __shfl_xor(v, o);
    return v;
}
__device__ __forceinline__ float siluf(float x) { return x / (1.f + __expf(-x)); }
__device__ __forceinline__ float sigmf(float x) { return 1.f / (1.f + __expf(-x)); }
__device__ __forceinline__ float gelu_tanh(float y) {
    const float t = 0.7978845608028654f * (y + 0.044715f * y * y * y);
    const float th = 1.f - 2.f / (1.f + __expf(2.f * t));
    return 0.5f * y * (1.f + th);
}
#define WSYNC() asm volatile("s_waitcnt lgkmcnt(0)" ::: "memory")

namespace pg8 {
constexpr int BM = 256, BK = 64, HALF = 128, HTB = HALF * BK * 2, STAGE_BYTES = 8 * HTB, NXCD = 8, WGM = 8;
__host__ __device__ __forceinline__ int lds_byte(int r, int c) { const int st = (r >> 4) * 2 + (c >> 5), rr = r & 15, cc = c & 31, ob = rr * 64 + cc * 2; return st * 1024 + (ob ^ (((ob >> 9) & 1) << 5)); }
__host__ __device__ __forceinline__ void stage_rc(int b, int& R, int& C) { const int st = b / 1024, sb = b % 1024, swz = sb ^ (((sb >> 9) & 1) << 5); R = (st >> 1) * 16 + swz / 64; C = (st & 1) * 32 + (swz % 64) / 2; }
__host__ __device__ __forceinline__ int perm32(int rho) { const int n = rho >> 4, i = rho & 15; return 8 * (i >> 2) + 4 * n + (i & 3); }
struct Unit { int pm, pn, k0, nk, part, sp; };
struct Gemm { const bf16_t* A; const bf16_t* Bt; int M, N, K; };
struct StaticOrder {
    int nM, nN, nwg, G, c, ntK, mode;
    __device__ __forceinline__ void init(int M, int N, int K, int G_, int c_, bool split) {
        nM = M / BM; nN = N / BM; nwg = nM * nN; G = G_; c = c_; ntK = K / BK;
        mode = (split && G == 256 && nM == 34 && nN == 8 && (ntK % 8) == 0) ? 1 : 0;
    }
    __device__ __forceinline__ void map(int L, Unit& u, int nMl) const {
        const int nw = nMl * nN;
        int wgid = L; { const int q = nw / NXCD, r = nw % NXCD, xcd = wgid % NXCD, off = wgid / NXCD; wgid = (xcd < r ? xcd * (q + 1) : r * (q + 1) + (xcd - r) * q) + off; }
        const int nig = WGM * nN, gid = wgid / nig, fm = gid * WGM, gsz = (nMl - fm) < WGM ? (nMl - fm) : WGM;
        u.pm = fm + ((wgid % nig) % gsz); u.pn = (wgid % nig) / gsz;
    }
    __device__ __forceinline__ int tail_busy() const { return mode == 1 ? 64 : (((nwg % G) * 2 <= G) ? (nwg % G) : 0); }
    __device__ __forceinline__ bool next_(int i, Unit& u) const {
        u.pm = 0; u.pn = 0; u.k0 = 0; u.nk = ntK; u.part = 0; u.sp = 0;
        if (mode == 0) { const long L = (long)i * G + c; if (L >= nwg) return false; map((int)L, u, nM); return true; }
        if (i == 0) { map(c, u, 32); return true; }
        if (i == 1 && c < 64) { const int tt = c >> 2; u.pm = 32 + (tt & 1); u.pn = tt >> 1; u.sp = c & 3; u.nk = ntK / 4; u.k0 = u.sp * u.nk; u.part = 1; return true; }
        return false;
    }
    __device__ __forceinline__ bool next(int i, Unit& u) const {
        const bool ok = next_(i, u);
        u.pm = __builtin_amdgcn_readfirstlane(u.pm); u.pn = __builtin_amdgcn_readfirstlane(u.pn); u.k0 = __builtin_amdgcn_readfirstlane(u.k0);
        u.nk = __builtin_amdgcn_readfirstlane(u.nk); u.part = __builtin_amdgcn_readfirstlane(u.part); u.sp = __builtin_amdgcn_readfirstlane(u.sp);
        return __builtin_amdgcn_readfirstlane((int)ok) != 0;
    }
};

template <class Epi>
__device__ __forceinline__ void gemm_phase(LAS unsigned char* lds, const Gemm g, const StaticOrder& S, const Epi& E) {
    int tid = threadIdx.x; asm volatile("" : "+v"(tid));
    const int wid = __builtin_amdgcn_readfirstlane(tid >> 6), lane = tid & 63, wr = wid >> 2, wc = wid & 3, fr = lane & 15, fq = lane >> 4;
    const int K = g.K;
    unsigned voffA[2], voffB[2];
#pragma unroll
    for (int i = 0; i < 2; ++i) { int R, C; stage_rc(tid * 16 + i * 8192, R, C); const int Rb = Epi::PERM ? ((R & ~31) + perm32(R & 31)) : R;
        voffA[i] = (unsigned)(R * K + C) * 2u; voffB[i] = (unsigned)(Rb * K + C) * 2u; }
    const size_t kstep = (size_t)(BK * 2);
    const size_t hstep = (size_t)HALF * K * 2;
    const size_t tstep = 2 * hstep;
    const unsigned ldsw = (unsigned)wid * 1024u;
    const int aoff = lds_byte(wr * 64 + fr, fq * 8), boff = lds_byte(wc * 32 + fr, fq * 8);
#define PG8_SA(b, h) (((b) * 2 + (h)) * HTB)
#define PG8_SB(b, h) ((4 + (b) * 2 + (h)) * HTB)
#define PG8_STAGE(bufoff, gbase, voff) do { _Pragma("unroll") for (int _i = 0; _i < 2; ++_i) \
        __builtin_amdgcn_global_load_lds((const unsigned*)((const char*)(gbase) + (voff)[_i]), (LAS unsigned*)(lds + (bufoff) + ldsw + _i * 8192), 16, 0, 0); } while (0)
#define PG8_LDA(dst, b, h) do { _Pragma("unroll") for (int m = 0; m < 4; ++m) _Pragma("unroll") for (int k = 0; k < 2; ++k) dst[m][k] = *(const LAS bf16x8*)(lds + PG8_SA(b, h) + aoff + m * 2048 + k * 1024); } while (0)
#define PG8_LDB(dst, b, h) do { _Pragma("unroll") for (int n = 0; n < 2; ++n) _Pragma("unroll") for (int k = 0; k < 2; ++k) dst[n][k] = *(const LAS bf16x8*)(lds + PG8_SB(b, h) + boff + n * 2048 + k * 1024); } while (0)
#define PG8_MMA(ai, bj, At, Bt) do { __builtin_amdgcn_s_setprio(1); _Pragma("unroll") for (int m = 0; m < 4; ++m) _Pragma("unroll") for (int n = 0; n < 2; ++n) _Pragma("unroll") for (int k = 0; k < 2; ++k) \
        acc[ai][bj][m][n] = __builtin_amdgcn_mfma_f32_16x16x32_bf16(Bt[n][k], At[m][k], acc[ai][bj][m][n], 0, 0, 0); __builtin_amdgcn_s_setprio(0); } while (0)
#define PG8_WAIT_V(n) asm volatile("s_waitcnt vmcnt(" #n ")" ::: "memory")
#define PG8_WAIT_L(n) asm volatile("s_waitcnt lgkmcnt(" #n ")" ::: "memory")
#define PG8_BAR __builtin_amdgcn_s_barrier()
#define PG8_SCHED __builtin_amdgcn_sched_barrier(0)
    Unit cur, nxt; int ui = 0;
    if (!S.next(0, cur)) return;
    f32x4 acc[2][2][4][2];
#pragma unroll
    for (int a = 0; a < 2; ++a)
#pragma unroll
        for (int b = 0; b < 2; ++b)
#pragma unroll
            for (int m = 0; m < 4; ++m)
#pragma unroll
                for (int n = 0; n < 2; ++n) acc[a][b][m][n] = (f32x4){0.f, 0.f, 0.f, 0.f};
    bf16x8 At[4][2], B0[2][2], B1[2][2];
    const char* cA = (const char*)g.A + (size_t)cur.pm * tstep + (size_t)cur.k0 * kstep; const char* cB = (const char*)g.Bt + (size_t)cur.pn * tstep + (size_t)cur.k0 * kstep;
    PG8_STAGE(PG8_SB(0, 0), cB, voffB); PG8_STAGE(PG8_SA(0, 0), cA, voffA); PG8_STAGE(PG8_SB(0, 1), cB + hstep, voffB); PG8_STAGE(PG8_SA(0, 1), cA + hstep, voffA);
    if (wr == 1) PG8_BAR;
    PG8_WAIT_V(4); PG8_BAR;
    PG8_STAGE(PG8_SB(1, 0), cB + kstep, voffB); PG8_STAGE(PG8_SA(1, 0), cA + kstep, voffA); PG8_STAGE(PG8_SB(1, 1), cB + hstep + kstep, voffB);
    PG8_WAIT_V(6); PG8_BAR;
    for (;;) {
        const bool has_next = S.next(ui + 1, nxt);
        const char* nA = has_next ? (const char*)g.A + (size_t)nxt.pm * tstep + (size_t)nxt.k0 * kstep : cA; const char* nB = has_next ? (const char*)g.Bt + (size_t)nxt.pn * tstep + (size_t)nxt.k0 * kstep : cB;
        const int nt = cur.nk;
        for (int t = 0; t < nt; t += 2) {
            const bool last = (t == nt - 2);
            const char* a1 = cA + (size_t)(t + 1) * kstep;
            const char* a2 = last ? nA : cA + (size_t)(t + 2) * kstep; const char* b2 = last ? nB : cB + (size_t)(t + 2) * kstep;
            const char* a3 = a2 + kstep; const char* b3 = b2 + kstep;
            PG8_LDB(B0, 0, 0); PG8_SCHED; PG8_LDA(At, 0, 0); PG8_STAGE(PG8_SA(1, 1), a1 + hstep, voffA);
            PG8_WAIT_L(8); PG8_BAR; PG8_WAIT_L(0); PG8_MMA(0, 0, At, B0); PG8_BAR; PG8_SCHED;
            PG8_LDB(B1, 0, 1); PG8_STAGE(PG8_SB(0, 0), b2, voffB);
            PG8_BAR; PG8_WAIT_L(0); PG8_MMA(0, 1, At, B1); PG8_BAR;
            PG8_LDA(At, 0, 1); PG8_STAGE(PG8_SA(0, 0), a2, voffA);
            PG8_BAR; PG8_WAIT_L(0); PG8_MMA(1, 0, At, B0); PG8_BAR; PG8_SCHED;
            PG8_STAGE(PG8_SB(0, 1), b2 + hstep, voffB);
            PG8_WAIT_V(6); PG8_BAR; PG8_MMA(1, 1, At, B1); PG8_BAR;
            PG8_LDB(B0, 1, 0); PG8_SCHED; PG8_LDA(At, 1, 0); PG8_STAGE(PG8_SA(0, 1), a2 + hstep, voffA);
            PG8_WAIT_L(8); PG8_BAR; PG8_WAIT_L(0); PG8_MMA(0, 0, At, B0); PG8_BAR; PG8_SCHED;
            PG8_LDB(B1, 1, 1); PG8_STAGE(PG8_SB(1, 0), b3, voffB);
            PG8_BAR; PG8_WAIT_L(0); PG8_MMA(0, 1, At, B1); PG8_BAR;
            PG8_LDA(At, 1, 1); PG8_STAGE(PG8_SA(1, 0), a3, voffA);
            PG8_BAR; PG8_WAIT_L(0); PG8_MMA(1, 0, At, B0); PG8_BAR; PG8_SCHED;
            PG8_STAGE(PG8_SB(1, 1), b3 + hstep, voffB);
            PG8_WAIT_V(6); PG8_BAR; PG8_MMA(1, 1, At, B1); PG8_BAR;
        }
        E(acc, cur, wr, wc, fr, fq);
        if (!has_next) break;
#pragma unroll
        for (int a = 0; a < 2; ++a)
#pragma unroll
            for (int b = 0; b < 2; ++b)
#pragma unroll
                for (int m = 0; m < 4; ++m)
#pragma unroll
                    for (int n = 0; n < 2; ++n) acc[a][b][m][n] = (f32x4){0.f, 0.f, 0.f, 0.f};
        cur = nxt; cA = nA; cB = nB; ++ui;
    }
    PG8_WAIT_V(0);
    if (wr == 0) PG8_BAR;
    PG8_BAR;
#undef PG8_SA
#undef PG8_SB
#undef PG8_STAGE
#undef PG8_LDA
#undef PG8_LDB
#undef PG8_MMA
#undef PG8_WAIT_V
#undef PG8_WAIT_L
#undef PG8_BAR
#undef PG8_SCHED
}
}
using pg8::Unit;

struct EpiSwiglu {
    static constexpr bool PERM = true;
    bf16_t* H;
    __device__ __forceinline__ void operator()(const f32x4 (&acc)[2][2][4][2], const Unit& u, int wr, int wc, int fr, int fq) const {
        const int row0 = u.pm * 256 + wr * 64 + fr, col0 = u.pn * 128 + wc * 32 + 8 * fq;
#pragma unroll
        for (int ai = 0; ai < 2; ++ai)
#pragma unroll
            for (int m = 0; m < 4; ++m) {
                const f32x4 g0 = acc[ai][0][m][0], g1 = acc[ai][0][m][1], u0 = acc[ai][1][m][0], u1 = acc[ai][1][m][1];
                u32x4 o;
                o.x = pk2(siluf(g0[0]) * u0[0], siluf(g0[1]) * u0[1]); o.y = pk2(siluf(g0[2]) * u0[2], siluf(g0[3]) * u0[3]);
                o.z = pk2(siluf(g1[0]) * u1[0], siluf(g1[1]) * u1[1]); o.w = pk2(siluf(g1[2]) * u1[2], siluf(g1[3]) * u1[3]);
                *(u32x4*)(H + (size_t)(row0 + ai * 128 + m * 16) * DFF + col0) = o;
            }
    }
};
struct EpiResid {
    static constexpr bool PERM = false;
    bf16_t* R; const float* X0; const float* X1; float* P; const bf16_t* XB; float scale;
    __device__ __forceinline__ void operator()(const f32x4 (&acc)[2][2][4][2], const Unit& u, int wr, int wc, int fr, int fq) const {
        const int row0 = u.pm * 256 + wr * 64 + fr, col0 = u.pn * 256 + wc * 32 + 4 * fq;
#pragma unroll
        for (int ai = 0; ai < 2; ++ai)
#pragma unroll
            for (int m = 0; m < 4; ++m) {
                const int row = row0 + ai * 128 + m * 16;
                const float* xr = (XB != nullptr) ? nullptr : (row < NPR ? X0 + (size_t)row * DM : X1 + (size_t)(row - NPR) * DM) + col0;
                bf16_t* rp = R + (size_t)row * DM + col0;
#pragma unroll
                for (int bj = 0; bj < 2; ++bj)
#pragma unroll
                    for (int n = 0; n < 2; ++n) {
                        if (!u.part) {
                            f32x4 xv;
                            if (XB != nullptr) { const u32x2 xb2 = *(const u32x2*)(XB + (size_t)row * DM + col0 + bj * 128 + n * 16); xv = (f32x4){bflo(xb2.x), bfhi(xb2.x), bflo(xb2.y), bfhi(xb2.y)}; }
                            else xv = *(const f32x4*)(xr + bj * 128 + n * 16);
                            const f32x4 rv = xv * ALPHA + acc[ai][bj][m][n] * scale;
                            u32x2 ro; ro.x = pk2(rv[0], rv[1]); ro.y = pk2(rv[2], rv[3]);
                            *(u32x2*)(rp + bj * 128 + n * 16) = ro;
                        } else {
                            *(f32x4*)(P + ((size_t)u.sp * 512 + (row - NPR)) * DM + col0 + bj * 128 + n * 16) = acc[ai][bj][m][n] * scale;
                        }
                    }
            }
    }
};
struct EpiMixIn {
    static constexpr bool PERM = true;
    bf16_t* PB; float* BD;
    __device__ __forceinline__ void operator()(const f32x4 (&acc)[2][2][4][2], const Unit& u, int wr, int wc, int fr, int fq) const {
        const int row0 = u.pm * 256 + wr * 64 + fr;
        if (u.pn < 20) {
            const int col0 = u.pn * 256 + wc * 32 + 8 * fq;
#pragma unroll
            for (int ai = 0; ai < 2; ++ai)
#pragma unroll
                for (int m = 0; m < 4; ++m)
#pragma unroll
                    for (int bj = 0; bj < 2; ++bj) {
                        const f32x4 v0 = acc[ai][bj][m][0], v1 = acc[ai][bj][m][1];
                        u32x4 o; o.x = pk2(v0[0], v0[1]); o.y = pk2(v0[2], v0[3]); o.z = pk2(v1[0], v1[1]); o.w = pk2(v1[2], v1[3]);
                        *(u32x4*)(PB + (size_t)(row0 + ai * 128 + m * 16) * NPB + col0 + bj * 128) = o;
                    }
        } else if (wc == 0 && fq < 2) {
#pragma unroll
            for (int ai = 0; ai < 2; ++ai)
#pragma unroll
                for (int m = 0; m < 4; ++m) {
                    float* bp = BD + (size_t)(row0 + ai * 128 + m * 16) * 16 + 8 * fq;
                    *(f32x4*)(bp) = acc[ai][0][m][0]; *(f32x4*)(bp + 4) = acc[ai][0][m][1];
                }
        }
    }
};
struct EpiGlu {
    static constexpr bool PERM = true;
    bf16_t* YM; const bf16_t* ZB; const float* bias;
    __device__ __forceinline__ void operator()(const f32x4 (&acc)[2][2][4][2], const Unit& u, int wr, int wc, int fr, int fq) const {
        const int row0 = u.pm * 256 + wr * 64 + fr, col0 = u.pn * 256 + wc * 32 + 8 * fq;
#pragma unroll
        for (int bj = 0; bj < 2; ++bj) {
            const f32x4 b0 = *(const f32x4*)(bias + col0 + bj * 128), b1 = *(const f32x4*)(bias + col0 + bj * 128 + 4);
#pragma unroll
            for (int ai = 0; ai < 2; ++ai)
#pragma unroll
                for (int m = 0; m < 4; ++m) {
                    const int row = row0 + ai * 128 + m * 16;
                    const u32x4 zz = *(const u32x4*)(ZB + (size_t)row * 1024 + col0 + bj * 128);
                    const f32x4 v0 = acc[ai][bj][m][0] + b0, v1 = acc[ai][bj][m][1] + b1;
                    u32x4 o;
                    o.x = pk2(bflo(zz.x) * sigmf(v0[0]), bfhi(zz.x) * sigmf(v0[1])); o.y = pk2(bflo(zz.y) * sigmf(v0[2]), bfhi(zz.y) * sigmf(v0[3]));
                    o.z = pk2(bflo(zz.z) * sigmf(v1[0]), bfhi(zz.z) * sigmf(v1[1])); o.w = pk2(bflo(zz.w) * sigmf(v1[2]), bfhi(zz.w) * sigmf(v1[3]));
                    *(u32x4*)(YM + (size_t)row * DM + col0 + bj * 128) = o;
                }
        }
    }
};

__device__ __forceinline__ void transpose_tile(const float* __restrict__ W, int K, int N, bf16_t* __restrict__ WT, int kt, int nt, int mode, LAS float* tile) {
    int tid = threadIdx.x; asm volatile("" : "+v"(tid));
    const int k0 = kt * 64, n0 = nt * 256;
    f32x4 v[8];
#pragma unroll
    for (int i = 0; i < 8; ++i) {
        const int idx = tid + 512 * i, rr = idx >> 6, c4 = (idx & 63) * 4;
        v[i] = (f32x4){0.f, 0.f, 0.f, 0.f};
        if (n0 + c4 < N) v[i] = *(const f32x4*)(W + (size_t)(k0 + rr) * N + n0 + c4);
    }
#pragma unroll
    for (int i = 0; i < 8; ++i) {
        const int idx = tid + 512 * i, rr = idx >> 6, c4 = (idx & 63) * 4;
        tile[rr * 257 + c4 + 0] = v[i][0]; tile[rr * 257 + c4 + 1] = v[i][1]; tile[rr * 257 + c4 + 2] = v[i][2]; tile[rr * 257 + c4 + 3] = v[i][3];
    }
    __syncthreads();
#pragma unroll
    for (int j = 0; j < 4; ++j) {
        const int id = tid + 512 * j, n = id >> 3, kc = id & 7;
        float f[8];
#pragma unroll
        for (int e = 0; e < 8; ++e) f[e] = tile[(kc * 8 + e) * 257 + n];
        const int nn = n0 + n; int drow = nn;
        if (mode == 1) { const int isup = nn >= DFF; const int jj = isup ? nn - DFF : nn; drow = (jj >> 7) * 256 + isup * 128 + (jj & 127); }
        u32x4 o; o.x = pk2(f[0], f[1]); o.y = pk2(f[2], f[3]); o.z = pk2(f[4], f[5]); o.w = pk2(f[6], f[7]);
        *(u32x4*)(WT + (size_t)drow * K + k0 + kc * 8) = o;
    }
    __syncthreads();
}
__device__ __forceinline__ void transpose_matrix(const float* W, int K, int N, bf16_t* WT, int mode, LAS float* tile, int b0 = 0) {
    const int nkt = K / 64, nnt = (N + 255) / 256, tot = nkt * nnt;
    if ((int)blockIdx.x < b0) return;
    for (int t = blockIdx.x - b0; t < tot; t += gridDim.x - b0) transpose_tile(W, K, N, WT, t / nnt, t % nnt, mode, tile);
}

__device__ __forceinline__ void phase_convert0(const Params& p, LAS unsigned char* lds) {
    unsigned char* ws = p.ws;
    LAS float* tile = (LAS float*)lds;
    transpose_matrix(p.in[8], DM, 2 * DFF, (bf16_t*)(ws + OFF_W1T), 1, tile);
    transpose_matrix(p.in[9], DFF, DM, (bf16_t*)(ws + OFF_W1O), 0, tile);
    const size_t gtid = (size_t)blockIdx.x * 512 + threadIdx.x, gsz = (size_t)gridDim.x * 512;
    { bf16_t* xb = (bf16_t*)(ws + OFF_XNB); const size_t n8 = (size_t)NTOK * DM / 8, np8 = (size_t)NPR * DM / 8;
      for (size_t i = gtid; i < n8; i += gsz) {
          const float* s = (i < np8) ? p.in[0] + i * 8 : p.in[1] + (i - np8) * 8;
          const f32x4 a = *(const f32x4*)s, b = *(const f32x4*)(s + 4);
          u32x4 o; o.x = pk2(a[0], a[1]); o.y = pk2(a[2], a[3]); o.z = pk2(b[0], b[1]); o.w = pk2(b[2], b[3]);
          *(u32x4*)(xb + i * 8) = o; } }
    if (gtid < 4096) {
        const int g = (int)(gtid >> 6), pp = (int)(gtid & 63);
        const double dt = exp((double)p.in[13][g]);
        const double lr = (double)p.in[11][g * 64 + pp], li = (double)p.in[12][g * 64 + pp];
        const double mag = exp(lr * dt), abr = mag * cos(li * dt), abi = mag * sin(li * dt);
        const double nr = abr - 1.0, ni = abi, den = lr * lr + li * li;
        const double cr = (nr * lr + ni * li) / den, ci = (ni * lr - nr * li) / den;
        bf16_t* bbt = (bf16_t*)(ws + OFF_BBT) + (size_t)g * 128 * 16;
        for (int h = 0; h < 16; ++h) {
            const double bre = (double)p.in[14][(g * 64 + pp) * 16 + h], bim = (double)p.in[15][(g * 64 + pp) * 16 + h];
            bbt[pp * 16 + h] = f2bf((float)(cr * bre - ci * bim));
            bbt[(64 + pp) * 16 + h] = f2bf((float)(cr * bim + ci * bre));
        }
        float* ab = (float*)(ws + OFF_ABAR); ab[(g * 64 + pp) * 2] = (float)abr; ab[(g * 64 + pp) * 2 + 1] = (float)abi;
        bf16_t* ct = (bf16_t*)(ws + OFF_CT) + (size_t)g * 16 * 128;
        for (int o = 0; o < 16; ++o) {
            ct[o * 128 + pp] = f2bf(p.in[16][(g * 16 + o) * 64 + pp]);
            ct[o * 128 + 64 + pp] = f2bf(-p.in[17][(g * 16 + o) * 64 + pp]);
        }
    }
}
__device__ __forceinline__ void phase_convert_mid(const Params& p, LAS unsigned char* lds, int b0) {
    unsigned char* ws = p.ws;
    LAS float* tile = (LAS float*)lds;
    transpose_matrix(p.in[10], DM, NMIX, (bf16_t*)(ws + OFF_WMI), 0, tile, b0);
    transpose_matrix(p.in[19], 1024, 1024, (bf16_t*)(ws + OFF_GLU), 0, tile, b0);
    transpose_matrix(p.in[25], DM, DM, (bf16_t*)(ws + OFF_WMO), 0, tile, b0);
}
__device__ __forceinline__ void phase_convert1(const Params& p, LAS unsigned char* lds, int b0) {
    LAS float* tile = (LAS float*)lds;
    transpose_matrix(p.in[28], DM, 2 * DFF, (bf16_t*)(p.ws + OFF_W1T), 1, tile, b0);
    transpose_matrix(p.in[29], DFF, DM, (bf16_t*)(p.ws + OFF_W1O), 0, tile, b0);
}

__device__ __forceinline__ void phase_ln(const bf16_t* R, const float* gam, const float* bet, float* outf, bf16_t* outb, const float* P, const float* XS, const bf16_t* XSB) {
    int lane = threadIdx.x; asm volatile("" : "+v"(lane)); lane &= 63;
    const int wave = __builtin_amdgcn_readfirstlane(threadIdx.x >> 6);
    for (int row = blockIdx.x * 8 + wave; row < NTOK; row += gridDim.x * 8) {
        const u32x2* rp = (const u32x2*)(R + (size_t)row * DM) + lane;
        f32x4 v[8]; float s = 0.f;
        if (P != nullptr && row >= NPR) {
            const f32x4* pp = (const f32x4*)(P + (size_t)(row - NPR) * DM) + lane;
#pragma unroll
            for (int j = 0; j < 8; ++j) {
                f32x4 xv;
                if (XSB != nullptr) { const u32x2 xb2 = *((const u32x2*)(XSB + (size_t)(row - NPR) * DM) + lane + 64 * j); xv = (f32x4){bflo(xb2.x), bfhi(xb2.x), bflo(xb2.y), bfhi(xb2.y)}; }
                else xv = ((const f32x4*)(XS + (size_t)(row - NPR) * DM) + lane)[64 * j];
                v[j] = xv * ALPHA + ((pp[64 * j] + pp[64 * j + 512 * 512]) + (pp[64 * j + 2 * 512 * 512] + pp[64 * j + 3 * 512 * 512]));
            }
        } else {
#pragma unroll
            for (int j = 0; j < 8; ++j) { const u32x2 rb = rp[64 * j]; v[j] = (f32x4){bflo(rb.x), bfhi(rb.x), bflo(rb.y), bfhi(rb.y)}; }
        }
#pragma unroll
        for (int j = 0; j < 8; ++j) s += (v[j][0] + v[j][1]) + (v[j][2] + v[j][3]);
        const float mean = wave_sum(s) * (1.f / DM); float s2 = 0.f;
#pragma unroll
        for (int j = 0; j < 8; ++j) { v[j] = v[j] - mean; s2 += (v[j][0] * v[j][0] + v[j][1] * v[j][1]) + (v[j][2] * v[j][2] + v[j][3] * v[j][3]); }
        const float rstd = 1.f / sqrtf(wave_sum(s2) * (1.f / DM) + 1e-5f);
#pragma unroll
        for (int j = 0; j < 8; ++j) {
            const int col = 4 * (lane + 64 * j);
            const f32x4 gg = *(const f32x4*)(gam + col), bb = *(const f32x4*)(bet + col);
            const f32x4 y = v[j] * rstd * gg + bb;
            if (outf) *(f32x4*)(outf + (size_t)row * DM + col) = y;
            if (outb) { u32x2 o; o.x = pk2(y[0], y[1]); o.y = pk2(y[2], y[3]); *(u32x2*)(outb + (size_t)row * DM + col) = o; }
        }
    }
}

__device__ __forceinline__ void phase_conv(const Params& p) {
    unsigned char* ws = p.ws;
    int lane = threadIdx.x; asm volatile("" : "+v"(lane)); lane &= 63;
    const int wave = __builtin_amdgcn_readfirstlane(threadIdx.x >> 6);
    const bf16_t* PB = (const bf16_t*)(ws + OFF_PROJB);
    const float* BD = (const float*)(ws + OFF_BD);
    const float* cw = p.in[21];
    float* G = (float*)(ws + OFF_G); float* BT = (float*)(ws + OFF_BETA);
    bf16_t* QN = (bf16_t*)(ws + OFF_QN); bf16_t* KN = (bf16_t*)(ws + OFF_KN); float* VV = (float*)(ws + OFF_VV);
    bf16_t* KT = (bf16_t*)(ws + OFF_KT);
    float* QKVS = (float*)(ws + OFF_QKVS);
    const int NIT = 8192 + 1024;
    for (int it = blockIdx.x * 8 + wave; it < NIT; it += gridDim.x * 8) {
        if (it < 8192) {
            const int h = it & 7, tg = (it >> 3) & 255, b = it >> 11;
            const int t0 = tg * 8, tok0 = b * 2048 + t0;
            if (lane < 8) {
                const int tok = tok0 + lane;
                const float braw = BD[(size_t)tok * 16 + h], araw = BD[(size_t)tok * 16 + 8 + h];
                const float xx = araw + p.in[23][h];
                const float sp = xx > 20.f ? xx : log1pf(expf(xx));
                G[(size_t)tok * 8 + h] = -expf(p.in[22][h]) * sp;
                BT[(size_t)tok * 8 + h] = 1.f / (1.f + expf(-braw));
            }
            float x0[3][11], x1[3][11], w0[3][4], w1[3][4];
#pragma unroll
            for (int st = 0; st < 3; ++st) {
                const int col = st * 1024 + h * 128 + 2 * lane;
#pragma unroll
                for (int j = 0; j < 11; ++j) {
                    const int t = t0 - 3 + j;
                    unsigned v = 0u;
                    if (t >= 0) v = *(const unsigned*)(PB + (size_t)(b * 2048 + t) * NPB + 1024 + col);
                    x0[st][j] = bflo(v); x1[st][j] = bfhi(v);
                }
#pragma unroll
                for (int j = 0; j < 4; ++j) { w0[st][j] = cw[j * 3072 + col]; w1[st][j] = cw[j * 3072 + col + 1]; }
            }
            float y0[3][8], y1[3][8];
#pragma unroll
            for (int st = 0; st < 3; ++st)
#pragma unroll
                for (int t = 0; t < 8; ++t) {
                    float a0 = 0.f, a1 = 0.f;
#pragma unroll
                    for (int j = 0; j < 4; ++j) { a0 += x0[st][t + j] * w0[st][j]; a1 += x1[st][t + j] * w1[st][j]; }
                    y0[st][t] = siluf(a0); y1[st][t] = siluf(a1);
                }
            float ss[2][8];
#pragma unroll
            for (int st = 0; st < 2; ++st)
#pragma unroll
                for (int t = 0; t < 8; ++t) ss[st][t] = y0[st][t] * y0[st][t] + y1[st][t] * y1[st][t];
#pragma unroll
            for (int o = 1; o < 64; o <<= 1)
#pragma unroll
                for (int st = 0; st < 2; ++st)
#pragma unroll
                    for (int t = 0; t < 8; ++t) ss[st][t] += __shfl_xor(ss[st][t], o);
#pragma unroll
            for (int st = 0; st < 2; ++st)
#pragma unroll
                for (int t = 0; t < 8; ++t) {
                    float sc = 1.f / sqrtf(ss[st][t] + 1e-6f);
                    if (st == 0) sc *= 0.08838834764831845f;
                    y0[st][t] *= sc; y1[st][t] *= sc;
                }
#pragma unroll
            for (int t = 0; t < 8; ++t) {
                *(unsigned*)(QN + (size_t)(tok0 + t) * 1024 + h * 128 + 2 * lane) = pk2(y0[0][t], y1[0][t]);
                *(unsigned*)(KN + (size_t)(tok0 + t) * 1024 + h * 128 + 2 * lane) = pk2(y0[1][t], y1[1][t]);
                float* o = VV + (size_t)(tok0 + t) * 1024 + h * 128 + 2 * lane; o[0] = y0[2][t]; o[1] = y1[2][t];
            }
            {
                const int chunk = t0 >> 6, c0 = t0 & 63;
                bf16_t* base = KT + ((size_t)((b * 8 + h) * 32 + chunk) * 128 + 2 * lane) * 64 + c0;
                u32x4 o0, o1;
                o0.x = pk2(y0[1][0], y0[1][1]); o0.y = pk2(y0[1][2], y0[1][3]); o0.z = pk2(y0[1][4], y0[1][5]); o0.w = pk2(y0[1][6], y0[1][7]);
                o1.x = pk2(y1[1][0], y1[1][1]); o1.y = pk2(y1[1][2], y1[1][3]); o1.z = pk2(y1[1][4], y1[1][5]); o1.w = pk2(y1[1][6], y1[1][7]);
                *(u32x4*)base = o0; *(u32x4*)(base + 64) = o1;
            }
            if (tg == 255) {
#pragma unroll
                for (int st = 0; st < 3; ++st)
#pragma unroll
                    for (int j = 0; j < 3; ++j) {
                        float* o = p.out + O_PCONV + (size_t)(b * 3 + j) * 3072 + st * 1024 + h * 128 + 2 * lane;
                        o[0] = x0[st][8 + j]; o[1] = x1[st][8 + j];
                    }
            }
        } else {
            const int si = it - 8192, h = si & 7, b = si >> 3;
            const int tok0 = NPR + b * 4;
            if (lane < 4) {
                const int tok = tok0 + lane;
                const float braw = BD[(size_t)tok * 16 + h], araw = BD[(size_t)tok * 16 + 8 + h];
                const float xx = araw + p.in[23][h];
                const float sp = xx > 20.f ? xx : log1pf(expf(xx));
                G[(size_t)tok * 8 + h] = -expf(p.in[22][h]) * sp;
                BT[(size_t)tok * 8 + h] = 1.f / (1.f + expf(-braw));
            }
#pragma unroll
            for (int st = 0; st < 3; ++st) {
                const int col = st * 1024 + h * 128 + 2 * lane;
                float x0[7], x1[7];
#pragma unroll
                for (int j = 0; j < 3; ++j) { const float* s = p.in[5] + (size_t)(b * 3 + j) * 3072 + col; x0[j] = s[0]; x1[j] = s[1]; }
#pragma unroll
                for (int j = 0; j < 4; ++j) { const unsigned v = *(const unsigned*)(PB + (size_t)(tok0 + j) * NPB + 1024 + col); x0[3 + j] = bflo(v); x1[3 + j] = bfhi(v); }
                float w0[4], w1[4];
#pragma unroll
                for (int j = 0; j < 4; ++j) { w0[j] = cw[j * 3072 + col]; w1[j] = cw[j * 3072 + col + 1]; }
#pragma unroll
                for (int t = 0; t < 4; ++t) {
                    float a0 = 0.f, a1 = 0.f;
#pragma unroll
                    for (int j = 0; j < 4; ++j) { a0 += x0[t + j] * w0[j]; a1 += x1[t + j] * w1[j]; }
                    float y0 = siluf(a0), y1 = siluf(a1);
                    if (st < 2) {
                        const float ss = wave_sum(y0 * y0 + y1 * y1);
                        float sc = 1.f / sqrtf(ss + 1e-6f);
                        if (st == 0) sc *= 0.08838834764831845f;
                        y0 *= sc; y1 *= sc;
                    }
                    float* o = QKVS + (size_t)(b * 4 + t) * 3072 + col; o[0] = y0; o[1] = y1;
                }
#pragma unroll
                for (int j = 0; j < 3; ++j) {
                    float* o = p.out + O_SCONV + (size_t)(b * 3 + j) * 3072 + col;
                    o[0] = x0[4 + j]; o[1] = x1[4 + j];
                }
            }
        }
    }
}

__device__ __forceinline__ f32x16 mfma32(bf16x8 a, bf16x8 b, f32x16 c) { return __builtin_amdgcn_mfma_f32_32x32x16_bf16(a, b, c, 0, 0, 0); }
__device__ __forceinline__ f32x4 mfma16(bf16x8 a, bf16x8 b, f32x4 c) { return __builtin_amdgcn_mfma_f32_16x16x32_bf16(a, b, c, 0, 0, 0); }
__device__ __forceinline__ bf16x8 mk8(unsigned a, unsigned b, unsigned c, unsigned d) { u32x4 t = {a, b, c, d}; return __builtin_bit_cast(bf16x8, t); }
constexpr int MTP = 36;

template <int C> __device__ __forceinline__ void solve_col(float (&t)[64], const LAS float* MT, int lane) {
    float a0 = 0.f, a1 = 0.f, a2 = 0.f, a3 = 0.f;
    int mb = 0; if (C < 63) asm volatile("" : "+v"(mb) : "v"(t[C + 1]));
#pragma unroll
    for (int jj = (C + 1) / 4; jj < 16; ++jj) {
        const int j4 = jj * 4;
        if (jj == 8 && (C + 1) / 4 < 8) asm volatile("" : "+v"(mb) : "v"(a0), "v"(a1), "v"(a2), "v"(a3));
        const int ti = (j4 >> 5) + (C >> 5);
        const f32x4 m = *(const LAS f32x4*)(MT + mb + ti * 32 * MTP + (C & 31) * MTP + (j4 & 31));
        if (j4 + 0 > C) a0 += t[j4 + 0] * m[0];
        if (j4 + 1 > C) a1 += t[j4 + 1] * m[1];
        if (j4 + 2 > C) a2 += t[j4 + 2] * m[2];
        if (j4 + 3 > C) a3 += t[j4 + 3] * m[3];
    }
    t[C] = ((lane == C) ? 1.f : 0.f) - ((a0 + a1) + (a2 + a3));
    if constexpr (C > 0) solve_col<C - 1>(t, MT, lane);
}

__device__ __forceinline__ void gdn_prep_item(const Params& p, int it, LAS unsigned char* wl, LAS float* gcl_) {
    unsigned char* ws = p.ws;
    int lane = threadIdx.x; asm volatile("" : "+v"(lane)); lane &= 63;
    const int r = lane & 31, hh = lane >> 5;
    const int n = it & 31, bh = it >> 5, h = bh & 7, b = bh >> 3;
    const int tok0 = b * 2048 + n * 64;
    LAS float* MT = (LAS float*)wl;
    LAS float* gcL = gcl_;
    LAS float* btL = gcL + 64;
    const float* G = (const float*)(ws + OFF_G); const float* BT = (const float*)(ws + OFF_BETA);
    float gc = G[(size_t)(tok0 + lane) * 8 + h];
    const float bv = BT[(size_t)(tok0 + lane) * 8 + h];
#pragma unroll
    for (int o = 1; o < 64; o <<= 1) { const float t = __int_as_float(__builtin_amdgcn_ds_bpermute((lane - o) << 2, __float_as_int(gc))); if (lane >= o) gc += t; }
    const float gl = __int_as_float(__builtin_amdgcn_readlane(__float_as_int(gc), 63));
    gcL[lane] = gc; btL[lane] = bv;
    if (lane == 0) ((float*)(ws + OFF_GLAST))[it] = __expf(gl);
    WSYNC();
    const bf16_t* kp = (const bf16_t*)(ws + OFF_KN) + (size_t)tok0 * 1024 + h * 128;
    const bf16_t* qp = (const bf16_t*)(ws + OFF_QN) + (size_t)tok0 * 1024 + h * 128;
    bf16x8 Kf[2][8];
#pragma unroll
    for (int mt = 0; mt < 2; ++mt)
#pragma unroll
        for (int ks = 0; ks < 8; ++ks) Kf[mt][ks] = *(const bf16x8*)(kp + (size_t)(mt * 32 + r) * 1024 + ks * 16 + hh * 8);
    {
        bf16_t* KG = (bf16_t*)(ws + OFF_KG) + (size_t)it * 8192;
#pragma unroll
        for (int mt = 0; mt < 2; ++mt) {
            const float e = -__expf(gcL[mt * 32 + r]);
#pragma unroll
            for (int ks = 0; ks < 8; ++ks) {
                const u32x4 v = __builtin_bit_cast(u32x4, Kf[mt][ks]);
                u32x2 o0, o1; o0.x = pk2(bflo(v.x) * e, bfhi(v.x) * e); o0.y = pk2(bflo(v.y) * e, bfhi(v.y) * e);
                o1.x = pk2(bflo(v.z) * e, bfhi(v.z) * e); o1.y = pk2(bflo(v.w) * e, bfhi(v.w) * e);
                bf16_t* fp = KG + (mt * 8 + ks) * 512 + r * 8 + 4 * hh;
                *(u32x2*)fp = o0; *(u32x2*)(fp + 256) = o1;
            }
        }
    }
    __builtin_amdgcn_sched_barrier(0);
#pragma unroll
    for (int ti = 0; ti < 3; ++ti) {
        __builtin_amdgcn_sched_barrier(0);
        const int mi = (ti >= 1), ni = (ti == 2);
        f32x16 a = {};
#pragma unroll
        for (int ks = 0; ks < 8; ++ks) a = mfma32(Kf[mi][ks], Kf[ni][ks], a);
        const int j = ni * 32 + r; const float gcj = gcL[j];
#pragma unroll
        for (int qq = 0; qq < 4; ++qq) {
            const int i0 = mi * 32 + 8 * qq + 4 * hh;
            const f32x4 gci = *(const LAS f32x4*)(gcL + i0), bti = *(const LAS f32x4*)(btL + i0);
            f32x4 mv;
#pragma unroll
            for (int e = 0; e < 4; ++e) {
                const int i = i0 + e;
                const float dec = __expf(fminf(gci[e] - gcj, 0.f));
                mv[e] = (i > j) ? bti[e] * a[qq * 4 + e] * dec : 0.f;
            }
            *(LAS f32x4*)(MT + ti * 32 * MTP + r * MTP + 8 * qq + 4 * hh) = mv;
        }
    }
    bf16_t* ATT = (bf16_t*)(ws + OFF_ATT) + (size_t)it * 4096;
    bf16_t* QG = (bf16_t*)(ws + OFF_QG) + (size_t)it * 8192;
#pragma unroll
    for (int mi = 0; mi < 2; ++mi) {
        __builtin_amdgcn_sched_barrier(0);
        bf16x8 Qf[8];
#pragma unroll
        for (int ks = 0; ks < 8; ++ks) Qf[ks] = *(const bf16x8*)(qp + (size_t)(mi * 32 + r) * 1024 + ks * 16 + hh * 8);
#pragma unroll
        for (int ni = 0; ni <= mi; ++ni) {
            __builtin_amdgcn_sched_barrier(0);
            f32x16 q = {};
#pragma unroll
            for (int ks = 0; ks < 8; ++ks) q = mfma32(Qf[ks], Kf[ni][ks], q);
            const int j = ni * 32 + r; const float gcj = gcL[j];
#pragma unroll
            for (int qq = 0; qq < 4; ++qq) {
                const int i0 = mi * 32 + 8 * qq + 4 * hh;
                const f32x4 gci = *(const LAS f32x4*)(gcL + i0);
#pragma unroll
                for (int e = 0; e < 4; ++e) {
                    const int i = i0 + e;
                    const float dec = __expf(fminf(gci[e] - gcj, 0.f));
                    ATT[((mi * 2 + ni) * 2 + (r >> 4)) * 512 + (((r >> 2) & 1) * 32 + (i & 31)) * 8 + 4 * ((r >> 3) & 1) + (r & 3)] = f2bf((i >= j) ? q[qq * 4 + e] * dec : 0.f);
                }
            }
        }
        __builtin_amdgcn_sched_barrier(0);
        const float e = __expf(gcL[mi * 32 + r]);
#pragma unroll
        for (int ks = 0; ks < 8; ++ks) {
            const u32x4 v = __builtin_bit_cast(u32x4, Qf[ks]);
            u32x2 o0, o1; o0.x = pk2(bflo(v.x) * e, bfhi(v.x) * e); o0.y = pk2(bflo(v.y) * e, bfhi(v.y) * e);
            o1.x = pk2(bflo(v.z) * e, bfhi(v.z) * e); o1.y = pk2(bflo(v.w) * e, bfhi(v.w) * e);
            bf16_t* fp = QG + (mi * 8 + ks) * 512 + r * 8 + 4 * hh;
            *(u32x2*)fp = o0; *(u32x2*)(fp + 256) = o1;
        }
    }
    WSYNC();
    float t[64];
    solve_col<63>(t, MT, lane);
    WSYNC();
    int lane5 = lane; asm volatile("" : "+v"(lane5) : "v"(t[0]));
    const int r5 = lane5 & 31, h5 = lane5 >> 5;
    {
        bf16_t* TBt = (bf16_t*)(ws + OFF_TBT) + (size_t)it * 4096 + ((lane5 >> 5) * 4) * 512 + (lane5 & 31) * 8;
#pragma unroll
        for (int m2 = 0; m2 < 2; ++m2)
#pragma unroll
            for (int sx = 0; sx < 2; ++sx) {
                const int c0 = m2 * 32 + 16 * sx;
                const f32x4 b0 = *(const LAS f32x4*)(btL + c0), b1 = *(const LAS f32x4*)(btL + c0 + 4), b2 = *(const LAS f32x4*)(btL + c0 + 8), b3 = *(const LAS f32x4*)(btL + c0 + 12);
                u32x4 oa, ob;
                oa.x = pk2(t[c0 + 0] * b0[0], t[c0 + 1] * b0[1]); oa.y = pk2(t[c0 + 2] * b0[2], t[c0 + 3] * b0[3]);
                oa.z = pk2(t[c0 + 8] * b2[0], t[c0 + 9] * b2[1]); oa.w = pk2(t[c0 + 10] * b2[2], t[c0 + 11] * b2[3]);
                ob.x = pk2(t[c0 + 4] * b1[0], t[c0 + 5] * b1[1]); ob.y = pk2(t[c0 + 6] * b1[2], t[c0 + 7] * b1[3]);
                ob.z = pk2(t[c0 + 12] * b3[0], t[c0 + 13] * b3[1]); ob.w = pk2(t[c0 + 14] * b3[2], t[c0 + 15] * b3[3]);
                bf16_t* fp = TBt + (m2 * 2 + sx) * 512;
                *(u32x4*)fp = oa; *(u32x4*)(fp + 256) = ob;
            }
    }
    {
        const bf16_t* KT = (const bf16_t*)(ws + OFF_KT) + (size_t)it * 8192;
        bf16_t* KDT = (bf16_t*)(ws + OFF_KDT) + (size_t)it * 8192;
#pragma unroll
        for (int nt = 0; nt < 4; ++nt) {
            __builtin_amdgcn_sched_barrier(0);
#pragma unroll
            for (int ks = 0; ks < 4; ++ks) {
                const u32x4 v = *(const u32x4*)(KT + (size_t)(nt * 32 + r5) * 64 + ks * 16 + h5 * 8);
                const f32x4 g0 = *(const LAS f32x4*)(gcL + ks * 16 + h5 * 8), g1 = *(const LAS f32x4*)(gcL + ks * 16 + h5 * 8 + 4);
                u32x2 o0, o1;
                o0.x = pk2(bflo(v.x) * __expf(gl - g0[0]), bfhi(v.x) * __expf(gl - g0[1])); o0.y = pk2(bflo(v.y) * __expf(gl - g0[2]), bfhi(v.y) * __expf(gl - g0[3]));
                o1.x = pk2(bflo(v.z) * __expf(gl - g1[0]), bfhi(v.z) * __expf(gl - g1[1])); o1.y = pk2(bflo(v.w) * __expf(gl - g1[2]), bfhi(v.w) * __expf(gl - g1[3]));
                bf16_t* fp = KDT + (nt * 4 + ks) * 512 + r5 * 8 + 4 * h5;
                *(u32x2*)fp = o0; *(u32x2*)(fp + 256) = o1;
            }
        }
    }
    WSYNC();
}

__device__ __forceinline__ void gdn_sample_item(const Params& p, int it, LAS unsigned char* wl) {
    unsigned char* ws = p.ws;
    int lane = threadIdx.x; asm volatile("" : "+v"(lane)); lane &= 63;
    const int c = lane & 31, hh = lane >> 5;
    const int qd = it & 3, bh = it >> 2, h = bh & 7, b = bh >> 3;
    const int dv = qd * 32 + c;
    float s[64];
    { const float* sp = p.in[4] + (size_t)bh * 16384 + (size_t)(hh * 64) * 128 + dv;
#pragma unroll
      for (int i = 0; i < 64; ++i) s[i] = sp[i * 128]; }
    LAS float* kq = (LAS float*)wl;
    const float* QKVS = (const float*)(ws + OFF_QKVS);
    const float* G = (const float*)(ws + OFF_G); const float* BT = (const float*)(ws + OFF_BETA);
    bf16_t* O = (bf16_t*)(ws + OFF_O);
#pragma unroll
    for (int t = 0; t < 4; ++t) {
        const float* row = QKVS + (size_t)(b * 4 + t) * 3072 + h * 128;
        kq[t * 256 + lane] = row[1024 + lane]; kq[t * 256 + 64 + lane] = row[1024 + 64 + lane];
        kq[t * 256 + 128 + lane] = row[lane]; kq[t * 256 + 192 + lane] = row[64 + lane];
    }
    WSYNC();
#pragma unroll 1
    for (int t = 0; t < 4; ++t) {
        const int tok = NPR + b * 4 + t;
        const float al = __expf(G[(size_t)tok * 8 + h]), be = BT[(size_t)tok * 8 + h];
        const float v = QKVS[(size_t)(b * 4 + t) * 3072 + 2048 + h * 128 + dv];
        float d0 = 0.f, d1 = 0.f, d2 = 0.f, d3 = 0.f;
        int kb = t * 256 + hh * 64;
#pragma unroll
        for (int i = 0; i < 64; i += 4) {
            if ((i & 15) == 0) asm volatile("" : "+v"(kb) : "v"(d0), "v"(d1), "v"(d2), "v"(d3));
            const f32x4 kk = *(const LAS f32x4*)(kq + kb + i);
            s[i] *= al; s[i + 1] *= al; s[i + 2] *= al; s[i + 3] *= al;
            d0 += kk[0] * s[i]; d1 += kk[1] * s[i + 1]; d2 += kk[2] * s[i + 2]; d3 += kk[3] * s[i + 3];
        }
        float dd = (d0 + d1) + (d2 + d3);
        dd += __shfl_xor(dd, 32);
        const float rr = be * (v - dd);
        float o0 = 0.f, o1 = 0.f, o2 = 0.f, o3 = 0.f;
        asm volatile("" : "+v"(kb) : "v"(rr));
#pragma unroll
        for (int i = 0; i < 64; i += 4) {
            if ((i & 15) == 0) asm volatile("" : "+v"(kb) : "v"(o0), "v"(o1), "v"(o2), "v"(o3));
            const f32x4 kk = *(const LAS f32x4*)(kq + kb + i);
            const f32x4 qq = *(const LAS f32x4*)(kq + kb + 128 + i);
            s[i] += rr * kk[0]; s[i + 1] += rr * kk[1]; s[i + 2] += rr * kk[2]; s[i + 3] += rr * kk[3];
            o0 += qq[0] * s[i]; o1 += qq[1] * s[i + 1]; o2 += qq[2] * s[i + 2]; o3 += qq[3] * s[i + 3];
        }
        float oo = (o0 + o1) + (o2 + o3);
        oo += __shfl_xor(oo, 32);
        if (hh == 0) O[(size_t)tok * 1024 + h * 128 + dv] = f2bf(oo);
    }
    int dv2 = dv; asm volatile("" : "+v"(dv2));
    float* So = p.out + O_SGDN + (size_t)bh * 16384 + (size_t)(hh * 64) * 128 + dv2;
#pragma unroll
    for (int i = 0; i < 64; ++i) So[i * 128] = s[i];
    WSYNC();
}

__device__ __forceinline__ void s5_unit(const Params& p, int g, int tok_base, int nsub, bool sample, int b0, LAS unsigned char* wl, int hb_off);
__device__ __forceinline__ void phase_gdn_prep(const Params& p, LAS unsigned char* lds) {
    const int wave = __builtin_amdgcn_readfirstlane(threadIdx.x >> 6);
    LAS unsigned char* wl = lds + wave * 16384;
    if (wave < 4) { for (int it = blockIdx.x * 4 + wave; it < 1024; it += gridDim.x * 4) gdn_prep_item(p, it, wl, (LAS float*)(lds + 143360 + wave * 512)); }
    else {
        for (int it = blockIdx.x * 4 + (wave - 4); it < 4096; it += gridDim.x * 4) gdn_sample_item(p, it, wl);
        for (int u = blockIdx.x * 4 + (wave - 4); u < 2048; u += gridDim.x * 4) { const int g = u & 63, bq = u >> 6; s5_unit(p, g, NPR + bq * 16, 1, true, bq * 4, wl, 8192); }
    }
}

__device__ __forceinline__ bf16x8 ldperm(const bf16_t* p8, int hh) {
    const u32x2 lo = *(const u32x2*)(p8 + 4 * hh), hi = *(const u32x2*)(p8 + 8 + 4 * hh);
    return mk8(lo.x, lo.y, hi.x, hi.y);
}
constexpr int GDN_BUF = 61440, GDN_LDS0 = 21504;
__device__ __forceinline__ void gdn_dma_chunk(const unsigned char* ws, int it, LAS unsigned char* buf, int lane) {
    const bf16_t* KG = (const bf16_t*)(ws + OFF_KG) + (size_t)it * 8192 + lane * 8;
    const bf16_t* QG = (const bf16_t*)(ws + OFF_QG) + (size_t)it * 8192 + lane * 8;
    const bf16_t* KDT = (const bf16_t*)(ws + OFF_KDT) + (size_t)it * 8192 + lane * 8;
#pragma unroll
    for (int f = 0; f < 16; ++f) __builtin_amdgcn_global_load_lds((const unsigned*)(KG + f * 512), (LAS unsigned*)(buf + f * 1024), 16, 0, 0);
#pragma unroll
    for (int f = 0; f < 16; ++f) __builtin_amdgcn_global_load_lds((const unsigned*)(QG + f * 512), (LAS unsigned*)(buf + 16384 + f * 1024), 16, 0, 0);
#pragma unroll
    for (int f = 0; f < 16; ++f) __builtin_amdgcn_global_load_lds((const unsigned*)(KDT + f * 512), (LAS unsigned*)(buf + 32768 + f * 1024), 16, 0, 0);
    const bf16_t* TBt = (const bf16_t*)(ws + OFF_TBT) + (size_t)it * 4096 + lane * 8;
    const bf16_t* ATT = (const bf16_t*)(ws + OFF_ATT) + (size_t)it * 4096 + lane * 8;
#pragma unroll
    for (int k = 0; k < 6; ++k) { const int f = (k < 2) ? k : k + 2;
        __builtin_amdgcn_global_load_lds((const unsigned*)(TBt + f * 512), (LAS unsigned*)(buf + 49152 + k * 1024), 16, 0, 0);
        __builtin_amdgcn_global_load_lds((const unsigned*)(ATT + f * 512), (LAS unsigned*)(buf + 55296 + k * 1024), 16, 0, 0); }
}
template <int PAR>
__device__ __forceinline__ void gdn_chunk(const Params& p, LAS unsigned char* gb, int n, int bh, int b, int h, int dv, int hh, int lane, f32x16 (&S)[4]) {
    unsigned char* ws = p.ws;
    asm volatile("s_waitcnt vmcnt(0)" ::: "memory");
    const int it = bh * 32 + n;
    const LAS unsigned char* cb = gb + PAR * GDN_BUF + lane * 16;
    const float* VV = (const float*)(ws + OFF_VV) + (size_t)(b * 2048 + n * 64) * 1024 + h * 128 + dv;
    bf16_t* O = (bf16_t*)(ws + OFF_O);
    const float gl = ((const float*)(ws + OFF_GLAST))[it];
    f32x16 v0, v1;
#pragma unroll
    for (int q = 0; q < 16; ++q) { const int i = 8 * (q >> 2) + 4 * hh + (q & 3); v0[q] = VV[(size_t)i * 1024]; v1[q] = VV[(size_t)(32 + i) * 1024]; }
    float pf8 = 0.f;
    if (n + 1 < 32) pf8 = VV[(size_t)(64 + lane) * 1024];
    if (n + 1 < 32) gdn_dma_chunk(ws, it + 1, gb + (1 - PAR) * GDN_BUF, lane);
    bf16x8 Sb[4][2];
#pragma unroll
    for (int kt = 0; kt < 4; ++kt)
#pragma unroll
        for (int s = 0; s < 2; ++s)
            Sb[kt][s] = mk8(pk2(S[kt][8 * s + 0], S[kt][8 * s + 1]), pk2(S[kt][8 * s + 2], S[kt][8 * s + 3]), pk2(S[kt][8 * s + 4], S[kt][8 * s + 5]), pk2(S[kt][8 * s + 6], S[kt][8 * s + 7]));
    bf16x8 Eb[2][2];
    {
        f32x16 a0 = {}, a1 = {};
#pragma unroll
        for (int kt = 0; kt < 4; ++kt)
#pragma unroll
            for (int s = 0; s < 2; ++s) {
                const u32x4 hv = __builtin_bit_cast(u32x4, Sb[kt][s]);
                const bf16x8 lo = mk8(pk2(S[kt][8 * s + 0] - bflo(hv.x), S[kt][8 * s + 1] - bfhi(hv.x)), pk2(S[kt][8 * s + 2] - bflo(hv.y), S[kt][8 * s + 3] - bfhi(hv.y)),
                                      pk2(S[kt][8 * s + 4] - bflo(hv.z), S[kt][8 * s + 5] - bfhi(hv.z)), pk2(S[kt][8 * s + 6] - bflo(hv.w), S[kt][8 * s + 7] - bfhi(hv.w)));
                const bf16x8 A0 = *(const LAS bf16x8*)(cb + (kt * 2 + s) * 1024);
                const bf16x8 A1 = *(const LAS bf16x8*)(cb + (8 + kt * 2 + s) * 1024);
                a0 = mfma32(A0, Sb[kt][s], a0); a1 = mfma32(A1, Sb[kt][s], a1);
                a0 = mfma32(A0, lo, a0); a1 = mfma32(A1, lo, a1);
            }
        a0 += v0; a1 += v1;
#pragma unroll
        for (int s = 0; s < 2; ++s) {
            Eb[0][s] = mk8(pk2(a0[8 * s + 0], a0[8 * s + 1]), pk2(a0[8 * s + 2], a0[8 * s + 3]), pk2(a0[8 * s + 4], a0[8 * s + 5]), pk2(a0[8 * s + 6], a0[8 * s + 7]));
            Eb[1][s] = mk8(pk2(a1[8 * s + 0], a1[8 * s + 1]), pk2(a1[8 * s + 2], a1[8 * s + 3]), pk2(a1[8 * s + 4], a1[8 * s + 5]), pk2(a1[8 * s + 6], a1[8 * s + 7]));
        }
    }
    bf16x8 Vb[2][2];
#pragma unroll
    for (int mt = 0; mt < 2; ++mt) {
        f32x16 a = {};
#pragma unroll
        for (int m2 = 0; m2 <= mt; ++m2)
#pragma unroll
            for (int s = 0; s < 2; ++s) a = mfma32(*(const LAS bf16x8*)(cb + 49152 + ((mt == 0) ? s : 2 + m2 * 2 + s) * 1024), Eb[m2][s], a);
#pragma unroll
        for (int s = 0; s < 2; ++s)
            Vb[mt][s] = mk8(pk2(a[8 * s + 0], a[8 * s + 1]), pk2(a[8 * s + 2], a[8 * s + 3]), pk2(a[8 * s + 4], a[8 * s + 5]), pk2(a[8 * s + 6], a[8 * s + 7]));
    }
#pragma unroll
    for (int mt = 0; mt < 2; ++mt) {
        f32x16 a = {};
#pragma unroll
        for (int kt = 0; kt < 4; ++kt)
#pragma unroll
            for (int s = 0; s < 2; ++s) a = mfma32(*(const LAS bf16x8*)(cb + 16384 + ((mt * 4 + kt) * 2 + s) * 1024), Sb[kt][s], a);
#pragma unroll
        for (int m2 = 0; m2 <= mt; ++m2)
#pragma unroll
            for (int s = 0; s < 2; ++s) a = mfma32(*(const LAS bf16x8*)(cb + 55296 + ((mt == 0) ? s : 2 + m2 * 2 + s) * 1024), Vb[m2][s], a);
#pragma unroll
        for (int q = 0; q < 16; ++q) { const int i = mt * 32 + 8 * (q >> 2) + 4 * hh + (q & 3);
            O[(size_t)(b * 2048 + n * 64 + i) * 1024 + h * 128 + dv] = f2bf(a[q]); }
    }
#pragma unroll
    for (int kt = 0; kt < 4; ++kt) {
        f32x16 a = S[kt] * gl;
#pragma unroll
        for (int m2 = 0; m2 < 2; ++m2)
#pragma unroll
            for (int s = 0; s < 2; ++s) a = mfma32(*(const LAS bf16x8*)(cb + 32768 + ((kt * 2 + m2) * 2 + s) * 1024), Vb[m2][s], a);
        S[kt] = a;
    }
    asm volatile("" :: "v"(pf8));
}
__device__ __forceinline__ void gdn_scan_unit(const Params& p, int unit, LAS unsigned char* gb) {
    int lane = threadIdx.x; asm volatile("" : "+v"(lane)); lane &= 63;
    const int r = lane & 31, hh = lane >> 5;
    const int sl = unit & 3, bh = unit >> 2, h = bh & 7, b = bh >> 3;
    const int dv = sl * 32 + r;
    f32x16 S[4];
#pragma unroll
    for (int kt = 0; kt < 4; ++kt) S[kt] = (f32x16){};
    gdn_dma_chunk(p.ws, bh * 32, gb, lane);
#pragma unroll 1
    for (int n = 0; n < 32; n += 2) {
        gdn_chunk<0>(p, gb, n, bh, b, h, dv, hh, lane, S);
        gdn_chunk<1>(p, gb, n + 1, bh, b, h, dv, hh, lane, S);
    }
    int lane6 = threadIdx.x; asm volatile("" : "+v"(lane6)); lane6 &= 63;
    float* So = p.out + O_PGDN + (size_t)bh * 16384 + (sl * 32 + (lane6 & 31)) + (size_t)(4 * (lane6 >> 5)) * 128;
#pragma unroll
    for (int kt = 0; kt < 4; ++kt)
#pragma unroll
        for (int q = 0; q < 16; ++q) { const int dk = kt * 32 + 8 * (q >> 2) + (q & 3); So[(size_t)dk * 128] = S[kt][q]; }
}

__device__ __forceinline__ void s5_unit(const Params& p, int g, int tok_base, int nsub, bool sample, int b0, LAS unsigned char* wl, int hb_off) {
    unsigned char* ws = p.ws;
    int lane = threadIdx.x; asm volatile("" : "+v"(lane)); lane &= 63;
    const int l15 = lane & 15, l4 = lane >> 4;
    LAS bf16_t* HB = (LAS bf16_t*)(wl + hb_off);
    const bf16_t* PB = (const bf16_t*)(ws + OFF_PROJB);
    bf16_t* ZB = (bf16_t*)(ws + OFF_ZB);
    const float* AB = (const float*)(ws + OFF_ABAR);
    const float ar = AB[(g * 64 + lane) * 2], ai = AB[(g * 64 + lane) * 2 + 1];
    const bf16_t* bbt = (const bf16_t*)(ws + OFF_BBT) + (size_t)g * 2048;
    const bf16_t* ct = (const bf16_t*)(ws + OFF_CT) + (size_t)g * 2048;
    bf16x8 Bf[8], Cf[4];
    const bf16x8 zero8 = {0, 0, 0, 0, 0, 0, 0, 0};
#pragma unroll
    for (int nt = 0; nt < 8; ++nt) Bf[nt] = (l4 < 2) ? *(const bf16x8*)(bbt + (nt * 16 + l15) * 16 + 8 * l4) : zero8;
#pragma unroll
    for (int s = 0; s < 4; ++s) Cf[s] = *(const bf16x8*)(ct + l15 * 128 + 32 * s + 8 * l4);
    const float dskip = p.in[18][g * 16 + l15];
    float hr = 0.f, hi = 0.f;
    const int last_tok = tok_base + (nsub - 1) * 16;
    {
        const bf16x8 A0 = (l4 < 2) ? *(const bf16x8*)(PB + (size_t)(tok_base + l15) * NPB + g * 16 + 8 * l4) : zero8;
        LAS float* BU = (LAS float*)wl;
#pragma unroll
        for (int nt = 0; nt < 8; ++nt) {
            f32x4 a = {0.f, 0.f, 0.f, 0.f};
            a = mfma16(A0, Bf[nt], a);
#pragma unroll
            for (int q = 0; q < 4; ++q) BU[(4 * l4 + q) * 128 + nt * 16 + l15] = a[q];
        }
    }
    const int tok1 = (nsub > 1) ? tok_base + 16 : tok_base;
    bf16x8 Au = (l4 < 2) ? *(const bf16x8*)(PB + (size_t)(tok1 + l15) * NPB + g * 16 + 8 * l4) : zero8;
    float uu[4];
#pragma unroll
    for (int q = 0; q < 4; ++q) uu[q] = bf2f(PB[(size_t)(tok_base + 4 * l4 + q) * NPB + g * 16 + l15]);
    WSYNC();
#pragma unroll 1
    for (int sc = 0; sc < nsub; ++sc) {
        const int tok0 = tok_base + sc * 16;
        LAS float* BU = (LAS float*)(wl + (sc & 1) * 8192);
        LAS float* BUn = (LAS float*)(wl + ((sc + 1) & 1) * 8192);
        const int tok2 = (tok0 + 32 <= last_tok) ? tok0 + 32 : last_tok;
        const int tokn = (tok0 + 16 <= last_tok) ? tok0 + 16 : last_tok;
        const bf16x8 Au_n = (l4 < 2) ? *(const bf16x8*)(PB + (size_t)(tok2 + l15) * NPB + g * 16 + 8 * l4) : zero8;
        float uu_n[4];
#pragma unroll
        for (int q = 0; q < 4; ++q) uu_n[q] = bf2f(PB[(size_t)(tokn + 4 * l4 + q) * NPB + g * 16 + l15]);
        if (sc + 1 < nsub) {
#pragma unroll
            for (int nt = 0; nt < 8; ++nt) {
                f32x4 a = {0.f, 0.f, 0.f, 0.f};
                a = mfma16(Au, Bf[nt], a);
#pragma unroll
                for (int q = 0; q < 4; ++q) BUn[(4 * l4 + q) * 128 + nt * 16 + l15] = a[q];
            }
        }
#pragma unroll
        for (int t = 0; t < 16; ++t) {
            if (sample && (t & 3) == 0) {
                const int bb = b0 + (t >> 2);
                hr = p.in[2][((size_t)bb * 64 + g) * 64 + lane]; hi = p.in[3][((size_t)bb * 64 + g) * 64 + lane];
            }
            const float br = BU[t * 128 + lane], bi = BU[t * 128 + 64 + lane];
            const float nr = ar * hr - ai * hi + br, ni = ar * hi + ai * hr + bi;
            hr = nr; hi = ni;
            HB[t * 136 + lane] = f2bf(hr); HB[t * 136 + 64 + lane] = f2bf(hi);
            if (sample && (t & 3) == 3) {
                const int bb = b0 + (t >> 2);
                p.out[O_SRE + ((size_t)bb * 64 + g) * 64 + lane] = hr; p.out[O_SIM + ((size_t)bb * 64 + g) * 64 + lane] = hi;
            }
        }
        WSYNC();
        f32x4 y = {0.f, 0.f, 0.f, 0.f};
#pragma unroll
        for (int s = 0; s < 4; ++s) {
            const bf16x8 Ah = *(const LAS bf16x8*)(HB + l15 * 136 + 32 * s + 8 * l4);
            y = mfma16(Ah, Cf[s], y);
        }
#pragma unroll
        for (int q = 0; q < 4; ++q) {
            const int tok = tok0 + 4 * l4 + q;
            ZB[(size_t)tok * 1024 + g * 16 + l15] = f2bf(gelu_tanh(y[q] + dskip * uu[q]));
        }
        WSYNC();
        Au = Au_n;
#pragma unroll
        for (int q = 0; q < 4; ++q) uu[q] = uu_n[q];
    }
    if (!sample) {
        const int b = tok_base >> 11;
        p.out[O_PRE + ((size_t)b * 64 + g) * 64 + lane] = hr; p.out[O_PIM + ((size_t)b * 64 + g) * 64 + lane] = hi;
    }
}

__device__ __forceinline__ void phase_scan(const Params& p, LAS unsigned char* lds) {
    const int wave = __builtin_amdgcn_readfirstlane(threadIdx.x >> 6);
    if (wave == 0) {
        for (int B = blockIdx.x; B < 128; B += gridDim.x) { const int xi = B & 7, idx = B >> 3; gdn_scan_unit(p, ((xi * 4 + (idx >> 2)) << 2) + (idx & 3), lds + GDN_LDS0); }
    }
    else if (wave == 1) { for (int u = blockIdx.x; u < 256; u += gridDim.x) s5_unit(p, u & 63, (u >> 6) * 2048, 128, false, 0, lds, 16384); }
}

__device__ __forceinline__ void phase_onorm(const Params& p) {
    unsigned char* ws = p.ws;
    int lane = threadIdx.x; asm volatile("" : "+v"(lane)); lane &= 63;
    const int wave = __builtin_amdgcn_readfirstlane(threadIdx.x >> 6);
    const bf16_t* O = (const bf16_t*)(ws + OFF_O); const bf16_t* PB = (const bf16_t*)(ws + OFF_PROJB);
    bf16_t* YM = (bf16_t*)(ws + OFF_YMIX);
    const float nw0 = p.in[24][2 * lane], nw1 = p.in[24][2 * lane + 1];
    for (int it4 = blockIdx.x * 8 + wave; it4 < NTOK * 2; it4 += gridDim.x * 8) {
        unsigned ov[4], gv[4];
#pragma unroll
        for (int j = 0; j < 4; ++j) {
            const int it = it4 * 4 + j, h = it & 7, tok = it >> 3;
            ov[j] = *(const unsigned*)(O + (size_t)tok * 1024 + h * 128 + 2 * lane);
            gv[j] = *(const unsigned*)(PB + (size_t)tok * NPB + 4096 + h * 128 + 2 * lane);
        }
        float ss[4];
#pragma unroll
        for (int j = 0; j < 4; ++j) { const float o0 = bflo(ov[j]), o1 = bfhi(ov[j]); ss[j] = o0 * o0 + o1 * o1; }
#pragma unroll
        for (int o = 1; o < 64; o <<= 1) {
#pragma unroll
            for (int j = 0; j < 4; ++j) ss[j] += __shfl_xor(ss[j], o);
        }
#pragma unroll
        for (int j = 0; j < 4; ++j) {
            const int it = it4 * 4 + j, h = it & 7, tok = it >> 3;
            const float o0 = bflo(ov[j]), o1 = bfhi(ov[j]);
            const float rs = 1.f / sqrtf(ss[j] * (1.f / 128.f) + 1e-6f);
            *(unsigned*)(YM + (size_t)tok * DM + 1024 + h * 128 + 2 * lane) = pk2(o0 * rs * nw0 * siluf(bflo(gv[j])), o1 * rs * nw1 * siluf(bfhi(gv[j])));
        }
    }
}

#define XB_TMO      128
#define XB_XCNT(j)  (256  + 64 * (j))
#define XB_XSUB(j)  (1280 + 64 * (j))
#define XB_XGEN(j)  (2304 + 64 * (j))
#define XB_TOP      3328
#define XB_TOPGEN   3392
#define XCD_BAR_WORDS 3456
#define XB_SPIN_CAP (1u << 18)
__device__ __forceinline__ unsigned xb_ld(unsigned* p)              { return __hip_atomic_load(p, __ATOMIC_RELAXED, __HIP_MEMORY_SCOPE_AGENT); }
__device__ __forceinline__ unsigned xb_add(unsigned* p, unsigned v) { return __hip_atomic_fetch_add(p, v, __ATOMIC_RELAXED, __HIP_MEMORY_SCOPE_AGENT); }
__device__ __forceinline__ unsigned xb_xcc_id() { return (unsigned)__builtin_amdgcn_s_getreg((3 << 11) | 20) & 0xFu; }
#define XB_SPIN(cond, bar) do { unsigned _sp = 0; while (cond) { __builtin_amdgcn_s_sleep(1); \
    if ((++_sp & 255u) == 0u) { if (xb_ld(&(bar)[XB_TMO])) break; if (_sp > XB_SPIN_CAP) { atomicAdd(&(bar)[XB_TMO], 1u); break; } } } } while (0)
struct XcdBarrier { unsigned* bar; unsigned x; volatile LAS unsigned* st; };
__device__ __forceinline__ XcdBarrier xcd_barrier_post(unsigned* bar, volatile LAS unsigned* st) {
    XcdBarrier b; b.bar = bar; b.x = xb_xcc_id(); b.st = st;
    if (threadIdx.x == 0) (void)xb_add(&bar[XB_XCNT(b.x)], 1u);
    return b;
}
__device__ __forceinline__ void xcd_barrier_complete(unsigned* bar, unsigned x, unsigned& nloc, unsigned& nx) {
    const unsigned G = gridDim.x * gridDim.y * gridDim.z;
    unsigned sum, cnt, mine, sp = 0u;
    for (;;) {
        sum = 0u; cnt = 0u; mine = 0u;
#pragma unroll
        for (unsigned j = 0; j < 16; ++j) { const unsigned c = xb_ld(&bar[XB_XCNT(j)]); sum += c; cnt += (c > 0u) ? 1u : 0u; mine = (j == x) ? c : mine; }
        if (sum == G) break;
        __builtin_amdgcn_s_sleep(1);
        if ((++sp & 255u) == 0u) { if (xb_ld(&bar[XB_TMO])) break; if (sp > XB_SPIN_CAP) { atomicAdd(&bar[XB_TMO], 1u); break; } }
    }
    nloc = mine > 0u ? mine : 1u; nx = cnt > 0u ? cnt : 1u;
}
__device__ __forceinline__ void xcd_barrier(const XcdBarrier& b) {
    asm volatile("s_waitcnt vmcnt(0)" ::: "memory");
    __syncthreads();
    if (threadIdx.x == 0) {
        unsigned* bar = b.bar;
        __builtin_amdgcn_s_waitcnt(0);
        unsigned nloc = b.st[0], nx = b.st[1];
        if (nloc == 0u) { xcd_barrier_complete(bar, b.x, nloc, nx); b.st[0] = nloc; b.st[1] = nx; }
        const unsigned old = xb_add(&bar[XB_XSUB(b.x)], 1u);
        const unsigned gen = old / nloc;
        if (old + 1u == (gen + 1u) * nloc) {
            __builtin_amdgcn_fence(__ATOMIC_RELEASE, "agent");
            asm volatile("s_waitcnt vmcnt(0)" ::: "memory");
            const unsigned og = xb_add(&bar[XB_TOP], 1u);
            const unsigned tg = og / nx;
            if (og + 1u == (tg + 1u) * nx) xb_add(&bar[XB_TOPGEN], 1u);
            else XB_SPIN(xb_ld(&bar[XB_TOPGEN]) == tg, bar);
            __builtin_amdgcn_fence(__ATOMIC_ACQUIRE, "agent");
            xb_add(&bar[XB_XGEN(b.x)], 1u);
            asm volatile("s_waitcnt vmcnt(0)" ::: "memory");
        } else {
            XB_SPIN(xb_ld(&bar[XB_XGEN(b.x)]) == gen, bar);
            __builtin_amdgcn_fence(__ATOMIC_ACQUIRE, "agent");
            asm volatile("s_waitcnt vmcnt(0)" ::: "memory");
        }
    }
    __syncthreads();
}

__global__ void __launch_bounds__(512, 2) fwd_megakernel(Params p) {
    extern __shared__ __attribute__((aligned(16))) unsigned char shm[];
    LAS unsigned char* lds = (LAS unsigned char*)shm;
    cg::grid_group grid = cg::this_grid();
    unsigned char* ws = p.ws;
    pg8::StaticOrder S;
    volatile LAS unsigned* bst = (volatile LAS unsigned*)(lds + 147456 - 16);
    if (threadIdx.x == 0) { bst[0] = 0u; bst[1] = 0u; }
    __syncthreads();
    const XcdBarrier xb = xcd_barrier_post((unsigned*)(ws + OFF_BAR), bst);
    phase_convert0(p, lds);
    grid.sync();
    if (STOP_AFTER <= 0) return;
    { S.init(NTOK, 2 * DFF, DM, gridDim.x, blockIdx.x, false); pg8::Gemm g{(const bf16_t*)(ws + OFF_XNB), (const bf16_t*)(ws + OFF_W1T), NTOK, 2 * DFF, DM};
      EpiSwiglu E{(bf16_t*)(ws + OFF_H)}; pg8::gemm_phase(lds, g, S, E); }
    xcd_barrier(xb);
    { S.init(NTOK, DM, DFF, gridDim.x, blockIdx.x, true); pg8::Gemm g{(const bf16_t*)(ws + OFF_H), (const bf16_t*)(ws + OFF_W1O), NTOK, DM, DFF};
      EpiResid E{(bf16_t*)(ws + OFF_R), p.in[0], p.in[1], (float*)(ws + OFF_PART), nullptr, 0.5f}; pg8::gemm_phase(lds, g, S, E); }
    __syncthreads();
    phase_convert_mid(p, lds, S.tail_busy());
    xcd_barrier(xb);
    phase_ln((const bf16_t*)(ws + OFF_R), p.in[6], p.in[7], nullptr, (bf16_t*)(ws + OFF_XRB), S.mode == 1 ? (const float*)(ws + OFF_PART) : nullptr, p.in[1], nullptr);
    xcd_barrier(xb);
    if (STOP_AFTER <= 3) return;
    { S.init(NTOK, NMIXP, DM, gridDim.x, blockIdx.x, false); pg8::Gemm g{(const bf16_t*)(ws + OFF_XRB), (const bf16_t*)(ws + OFF_WMI), NTOK, NMIXP, DM};
      EpiMixIn E{(bf16_t*)(ws + OFF_PROJB), (float*)(ws + OFF_BD)}; pg8::gemm_phase(lds, g, S, E); }
    xcd_barrier(xb);
    phase_conv(p);
    xcd_barrier(xb);
    if (STOP_AFTER <= 4) return;
    phase_gdn_prep(p, lds);
    xcd_barrier(xb);
    phase_scan(p, lds);
    xcd_barrier(xb);
    if (STOP_AFTER <= 5) return;
    phase_onorm(p);
    __syncthreads();
    { S.init(NTOK, 1024, 1024, gridDim.x, blockIdx.x, false); pg8::Gemm g{(const bf16_t*)(ws + OFF_ZB), (const bf16_t*)(ws + OFF_GLU), NTOK, 1024, 1024};
      EpiGlu E{(bf16_t*)(ws + OFF_YMIX), (const bf16_t*)(ws + OFF_ZB), p.in[20]}; pg8::gemm_phase(lds, g, S, E); }
    xcd_barrier(xb);
    { S.init(NTOK, DM, DM, gridDim.x, blockIdx.x, true); pg8::Gemm g{(const bf16_t*)(ws + OFF_YMIX), (const bf16_t*)(ws + OFF_WMO), NTOK, DM, DM};
      EpiResid E{(bf16_t*)(ws + OFF_R), nullptr, nullptr, (float*)(ws + OFF_PART), (const bf16_t*)(ws + OFF_XRB), 1.0f}; pg8::gemm_phase(lds, g, S, E); }
    __syncthreads();
    phase_convert1(p, lds, S.tail_busy());
    xcd_barrier(xb);
    phase_ln((const bf16_t*)(ws + OFF_R), p.in[26], p.in[27], nullptr, (bf16_t*)(ws + OFF_XRB), S.mode == 1 ? (const float*)(ws + OFF_PART) : nullptr, nullptr, (const bf16_t*)(ws + OFF_XRB) + (size_t)NPR * DM);
    xcd_barrier(xb);
    { S.init(NTOK, 2 * DFF, DM, gridDim.x, blockIdx.x, false); pg8::Gemm g{(const bf16_t*)(ws + OFF_XRB), (const bf16_t*)(ws + OFF_W1T), NTOK, 2 * DFF, DM};
      EpiSwiglu E{(bf16_t*)(ws + OFF_H)}; pg8::gemm_phase(lds, g, S, E); }
    xcd_barrier(xb);
    { S.init(NTOK, DM, DFF, gridDim.x, blockIdx.x, true); pg8::Gemm g{(const bf16_t*)(ws + OFF_H), (const bf16_t*)(ws + OFF_W1O), NTOK, DM, DFF};
      EpiResid E{(bf16_t*)(ws + OFF_R), nullptr, nullptr, (float*)(ws + OFF_PART), (const bf16_t*)(ws + OFF_XRB), 0.5f}; pg8::gemm_phase(lds, g, S, E); }
    xcd_barrier(xb);
    phase_ln((const bf16_t*)(ws + OFF_R), p.in[30], p.in[31], p.out + O_Y, nullptr, S.mode == 1 ? (const float*)(ws + OFF_PART) : nullptr, nullptr, (const bf16_t*)(ws + OFF_XRB) + (size_t)NPR * DM);
}

extern "C" void kernel_launch(void* const* d_in, const int* in_sizes, int n_in, void* d_out, int out_size, void* d_ws, size_t ws_size, hipStream_t stream) {
    constexpr int LDS_BYTES = 147456;
    static int grid_blocks = 0;
    if (grid_blocks == 0) {
        int dev = 0, cus = 0, per_cu = 0;
        hipGetDevice(&dev);
        hipDeviceGetAttribute(&cus, hipDeviceAttributeMultiprocessorCount, dev);
        hipFuncSetAttribute((const void*)fwd_megakernel, hipFuncAttributeMaxDynamicSharedMemorySize, LDS_BYTES);
        hipOccupancyMaxActiveBlocksPerMultiprocessor(&per_cu, (const void*)fwd_megakernel, 512, LDS_BYTES);
        if (per_cu < 1) { fprintf(stderr, "occupancy query returned %d\n", per_cu); per_cu = 1; }
        grid_blocks = cus * 1;
        if (ws_size < WS_END) fprintf(stderr, "workspace too small: %zu < %zu\n", ws_size, (size_t)WS_END);
    }
    (void)hipMemsetAsync((unsigned char*)d_ws + OFF_BAR, 0, XCD_BAR_WORDS * 4, stream);
    Params p{};
    for (int i = 0; i < 32; ++i) p.in[i] = (const float*)d_in[i];
    p.out = (float*)d_out; p.ws = (unsigned char*)d_ws;
    void* args[] = {&p};
    hipError_t e = hipLaunchCooperativeKernel((const void*)fwd_megakernel, dim3(grid_blocks), dim3(512), args, LDS_BYTES, stream);
    if (e != hipSuccess) fprintf(stderr, "cooperative launch failed: %s (grid %d)\n", hipGetErrorString(e), grid_blocks);
}
```

```cpp
#include <hip/hip_runtime.h>
#include <hip/hip_cooperative_groups.h>
#include <cstdio>
namespace cg = cooperative_groups;

#define LAS __attribute__((address_space(3)))
typedef unsigned short bf16_t;
typedef short bf16x8 __attribute__((ext_vector_type(8)));
typedef float f32x4 __attribute__((ext_vector_type(4)));
typedef float f32x16 __attribute__((ext_vector_type(16)));
typedef unsigned u32x4 __attribute__((ext_vector_type(4)));
typedef unsigned u32x2 __attribute__((ext_vector_type(2)));

#ifndef STOP_AFTER
#define STOP_AFTER 99
#endif

constexpr int NTOK = 8704, NPR = 8192, DM = 2048, DFF = 5632, NMIX = 5136, NMIXP = 5376, NPB = 5120;
constexpr float ALPHA = 1.189207115002721f;

constexpr size_t O_Y = 0, O_PRE = 17825792, O_PIM = 17842176, O_PGDN = 17858560, O_PCONV = 18382848,
                 O_SRE = 18419712, O_SIM = 18944000, O_SGDN = 19468288, O_SCONV = 36245504;

constexpr size_t SZ_W1T = (size_t)11264 * 2048 * 2, SZ_W1O = (size_t)2048 * 5632 * 2;
constexpr size_t OFF_W1T = 0;
constexpr size_t OFF_W1O = OFF_W1T + SZ_W1T;
constexpr size_t OFF_WMI = OFF_W1O + SZ_W1O;
constexpr size_t OFF_GLU = OFF_WMI + (size_t)NMIXP * 2048 * 2;
constexpr size_t OFF_WMO = OFF_GLU + (size_t)1024 * 1024 * 2;
constexpr size_t OFF_XNB = OFF_WMO + (size_t)2048 * 2048 * 2;
constexpr size_t OFF_XN  = OFF_XNB + (size_t)NTOK * 2048 * 2;
constexpr size_t OFF_R   = OFF_XN + (size_t)NTOK * 2048 * 4;
constexpr size_t OFF_H   = OFF_R + (size_t)NTOK * 2048 * 4;
constexpr size_t OFF_KDT = OFF_H + (size_t)NTOK * DFF * 2;
constexpr size_t SZ_CH   = (size_t)1024 * 64 * 128 * 2;
constexpr size_t OFF_TBT = OFF_KDT + SZ_CH;
constexpr size_t OFF_O   = OFF_TBT + (size_t)1024 * 64 * 64 * 2;
constexpr size_t OFF_ZB  = OFF_O + (size_t)NTOK * 1024 * 2;
constexpr size_t OFF_BBT = OFF_ZB + (size_t)NTOK * 1024 * 2;
constexpr size_t OFF_CT  = OFF_BBT + 262144;
constexpr size_t OFF_ABAR = OFF_CT + 262144;
constexpr size_t OFF_GLAST = OFF_ABAR + 32768;
constexpr size_t OFF_BAR = OFF_GLAST + 4096;
constexpr size_t OFF_PART = OFF_BAR + 16384;
constexpr size_t WS_END  = OFF_PART + (size_t)4 * 512 * 2048 * 4;
constexpr size_t OFF_PROJB = OFF_H;
constexpr size_t OFF_XRB = OFF_XN;
constexpr size_t OFF_YMIX = OFF_XN + (size_t)NTOK * 2048 * 2;
constexpr size_t OFF_QN = OFF_R, OFF_KN = OFF_QN + (size_t)NPR * 1024 * 2, OFF_VV = OFF_KN + (size_t)NPR * 1024 * 2;
constexpr size_t OFF_G = OFF_VV + (size_t)NPR * 1024 * 4;
constexpr size_t OFF_BETA = OFF_G + (size_t)NTOK * 8 * 4;
constexpr size_t OFF_BD = OFF_BETA + (size_t)NTOK * 8 * 4;
constexpr size_t OFF_KT = OFF_W1T, OFF_ATT = OFF_KT + SZ_CH, OFF_QG = OFF_ATT + (size_t)1024 * 64 * 64 * 2, OFF_KG = OFF_QG + SZ_CH;
constexpr size_t OFF_QKVS = OFF_KG + SZ_CH;
static_assert(OFF_BD + (size_t)NTOK * 16 * 4 <= OFF_H, "R alias overflow");
static_assert(OFF_QKVS + (size_t)512 * 3072 * 4 <= OFF_WMI, "W1 alias overflow");

struct Params { const float* in[32]; float* out; unsigned char* ws; };

typedef __bf16 bf16v2_t __attribute__((ext_vector_type(2)));
typedef float f32v2_t __attribute__((ext_vector_type(2)));
__device__ __forceinline__ unsigned pk2(float lo, float hi) { f32v2_t v = {lo, hi}; bf16v2_t b = __builtin_convertvector(v, bf16v2_t); return __builtin_bit_cast(unsigned, b); }
__device__ __forceinline__ bf16_t f2bf(float f) { return (bf16_t)(pk2(f, 0.f) & 0xffffu); }
__device__ __forceinline__ float bf2f(bf16_t b) { return __uint_as_float(((unsigned)b) << 16); }
__device__ __forceinline__ float bflo(unsigned u) { return __uint_as_float(u << 16); }
__device__ __forceinline__ float bfhi(unsigned u) { return __uint_as_float(u & 0xffff0000u); }
__device__ __forceinline__ float wave_sum(float v) {
#pragma unroll
    for (int o = 1; o < 64; o <<= 1) v += __shfl_xor(v, o);
    return v;
}
__device__ __forceinline__ float siluf(float x) { return x / (1.f + __expf(-x)); }
__device__ __forceinline__ float sigmf(float x) { return 1.f / (1.f + __expf(-x)); }
__device__ __forceinline__ float gelu_tanh(float y) {
    const float t = 0.7978845608028654f * (y + 0.044715f * y * y * y);
    const float th = 1.f - 2.f / (1.f + __expf(2.f * t));
    return 0.5f * y * (1.f + th);
}
#define WSYNC() asm volatile("s_waitcnt lgkmcnt(0)" ::: "memory")

namespace pg8 {
constexpr int BM = 256, BK = 64, HALF = 128, HTB = HALF * BK * 2, STAGE_BYTES = 8 * HTB, NXCD = 8, WGM = 8;
__host__ __device__ __forceinline__ int lds_byte(int r, int c) { const int st = (r >> 4) * 2 + (c >> 5), rr = r & 15, cc = c & 31, ob = rr * 64 + cc * 2; return st * 1024 + (ob ^ (((ob >> 9) & 1) << 5)); }
__host__ __device__ __forceinline__ void stage_rc(int b, int& R, int& C) { const int st = b / 1024, sb = b % 1024, swz = sb ^ (((sb >> 9) & 1) << 5); R = (st >> 1) * 16 + swz / 64; C = (st & 1) * 32 + (swz % 64) / 2; }
__host__ __device__ __forceinline__ int perm32(int rho) { const int n = rho >> 4, i = rho & 15; return 8 * (i >> 2) + 4 * n + (i & 3); }
struct Unit { int pm, pn, k0, nk, part, sp; };
struct Gemm { const bf16_t* A; const bf16_t* Bt; int M, N, K; };
struct StaticOrder {
    int nM, nN, nwg, G, c, ntK, mode;
    __device__ __forceinline__ void init(int M, int N, int K, int G_, int c_, bool split) {
        nM = M / BM; nN = N / BM; nwg = nM * nN; G = G_; c = c_; ntK = K / BK;
        mode = (split && G == 256 && nM == 34 && nN == 8 && (ntK % 8) == 0) ? 1 : 0;
    }
    __device__ __forceinline__ void map(int L, Unit& u, int nMl) const {
        const int nw = nMl * nN;
        int wgid = L; { const int q = nw / NXCD, r = nw % NXCD, xcd = wgid % NXCD, off = wgid / NXCD; wgid = (xcd < r ? xcd * (q + 1) : r * (q + 1) + (xcd - r) * q) + off; }
        const int nig = WGM * nN, gid = wgid / nig, fm = gid * WGM, gsz = (nMl - fm) < WGM ? (nMl - fm) : WGM;
        u.pm = fm + ((wgid % nig) % gsz); u.pn = (wgid % nig) / gsz;
    }
    __device__ __forceinline__ int tail_busy() const { return mode == 1 ? 64 : (((nwg % G) * 2 <= G) ? (nwg % G) : 0); }
    __device__ __forceinline__ bool next_(int i, Unit& u) const {
        u.pm = 0; u.pn = 0; u.k0 = 0; u.nk = ntK; u.part = 0; u.sp = 0;
        if (mode == 0) { const long L = (long)i * G + c; if (L >= nwg) return false; map((int)L, u, nM); return true; }
        if (i == 0) { map(c, u, 32); return true; }
        if (i == 1 && c < 64) { const int tt = c >> 2; u.pm = 32 + (tt & 1); u.pn = tt >> 1; u.sp = c & 3; u.nk = ntK / 4; u.k0 = u.sp * u.nk; u.part = 1; return true; }
        return false;
    }
    __device__ __forceinline__ bool next(int i, Unit& u) const {
        const bool ok = next_(i, u);
        u.pm = __builtin_amdgcn_readfirstlane(u.pm); u.pn = __builtin_amdgcn_readfirstlane(u.pn); u.k0 = __builtin_amdgcn_readfirstlane(u.k0);
        u.nk = __builtin_amdgcn_readfirstlane(u.nk); u.part = __builtin_amdgcn_readfirstlane(u.part); u.sp = __builtin_amdgcn_readfirstlane(u.sp);
        return __builtin_amdgcn_readfirstlane((int)ok) != 0;
    }
};

template <class Epi>
__device__ __forceinline__ void gemm_phase(LAS unsigned char* lds, const Gemm g, const StaticOrder& S, const Epi& E) {
    int tid = threadIdx.x; asm volatile("" : "+v"(tid));
    const int wid = __builtin_amdgcn_readfirstlane(tid >> 6), lane = tid & 63, wr = wid >> 2, wc = wid & 3, fr = lane & 15, fq = lane >> 4;
    const int K = g.K;
    unsigned voffA[2], voffB[2];
#pragma unroll
    for (int i = 0; i < 2; ++i) { int R, C; stage_rc(tid * 16 + i * 8192, R, C); const int Rb = Epi::PERM ? ((R & ~31) + perm32(R & 31)) : R;
        voffA[i] = (unsigned)(R * K + C) * 2u; voffB[i] = (unsigned)(Rb * K + C) * 2u; }
    const size_t kstep = (size_t)(BK * 2);
    const size_t hstep = (size_t)HALF * K * 2;
    const size_t tstep = 2 * hstep;
    const unsigned ldsw = (unsigned)wid * 1024u;
    const int aoff = lds_byte(wr * 64 + fr, fq * 8), boff = lds_byte(wc * 32 + fr, fq * 8);
#define PG8_SA(b, h) (((b) * 2 + (h)) * HTB)
#define PG8_SB(b, h) ((4 + (b) * 2 + (h)) * HTB)
#define PG8_STAGE(bufoff, gbase, voff) do { _Pragma("unroll") for (int _i = 0; _i < 2; ++_i) \
        __builtin_amdgcn_global_load_lds((const unsigned*)((const char*)(gbase) + (voff)[_i]), (LAS unsigned*)(lds + (bufoff) + ldsw + _i * 8192), 16, 0, 0); } while (0)
#define PG8_LDA(dst, b, h) do { _Pragma("unroll") for (int m = 0; m < 4; ++m) _Pragma("unroll") for (int k = 0; k < 2; ++k) dst[m][k] = *(const LAS bf16x8*)(lds + PG8_SA(b, h) + aoff + m * 2048 + k * 1024); } while (0)
#define PG8_LDB(dst, b, h) do { _Pragma("unroll") for (int n = 0; n < 2; ++n) _Pragma("unroll") for (int k = 0; k < 2; ++k) dst[n][k] = *(const LAS bf16x8*)(lds + PG8_SB(b, h) + boff + n * 2048 + k * 1024); } while (0)
#define PG8_MMA(ai, bj, At, Bt) do { __builtin_amdgcn_s_setprio(1); _Pragma("unroll") for (int m = 0; m < 4; ++m) _Pragma("unroll") for (int n = 0; n < 2; ++n) _Pragma("unroll") for (int k = 0; k < 2; ++k) \
        acc[ai][bj][m][n] = __builtin_amdgcn_mfma_f32_16x16x32_bf16(Bt[n][k], At[m][k], acc[ai][bj][m][n], 0, 0, 0); __builtin_amdgcn_s_setprio(0); } while (0)
#define PG8_WAIT_V(n) asm volatile("s_waitcnt vmcnt(" #n ")" ::: "memory")
#define PG8_WAIT_L(n) asm volatile("s_waitcnt lgkmcnt(" #n ")" ::: "memory")
#define PG8_BAR __builtin_amdgcn_s_barrier()
#define PG8_SCHED __builtin_amdgcn_sched_barrier(0)
    Unit cur, nxt; int ui = 0;
    if (!S.next(0, cur)) return;
    f32x4 acc[2][2][4][2];
#pragma unroll
    for (int a = 0; a < 2; ++a)
#pragma unroll
        for (int b = 0; b < 2; ++b)
#pragma unroll
            for (int m = 0; m < 4; ++m)
#pragma unroll
                for (int n = 0; n < 2; ++n) acc[a][b][m][n] = (f32x4){0.f, 0.f, 0.f, 0.f};
    bf16x8 At[4][2], B0[2][2], B1[2][2];
    const char* cA = (const char*)g.A + (size_t)cur.pm * tstep + (size_t)cur.k0 * kstep; const char* cB = (const char*)g.Bt + (size_t)cur.pn * tstep + (size_t)cur.k0 * kstep;
    PG8_STAGE(PG8_SB(0, 0), cB, voffB); PG8_STAGE(PG8_SA(0, 0), cA, voffA); PG8_STAGE(PG8_SB(0, 1), cB + hstep, voffB); PG8_STAGE(PG8_SA(0, 1), cA + hstep, voffA);
    if (wr == 1) PG8_BAR;
    PG8_WAIT_V(4); PG8_BAR;
    PG8_STAGE(PG8_SB(1, 0), cB + kstep, voffB); PG8_STAGE(PG8_SA(1, 0), cA + kstep, voffA); PG8_STAGE(PG8_SB(1, 1), cB + hstep + kstep, voffB);
    PG8_WAIT_V(6); PG8_BAR;
    for (;;) {
        const bool has_next = S.next(ui + 1, nxt);
        const char* nA = has_next ? (const char*)g.A + (size_t)nxt.pm * tstep + (size_t)nxt.k0 * kstep : cA; const char* nB = has_next ? (const char*)g.Bt + (size_t)nxt.pn * tstep + (size_t)nxt.k0 * kstep : cB;
        const int nt = cur.nk;
        for (int t = 0; t < nt; t += 2) {
            const bool last = (t == nt - 2);
            const char* a1 = cA + (size_t)(t + 1) * kstep;
            const char* a2 = last ? nA : cA + (size_t)(t + 2) * kstep; const char* b2 = last ? nB : cB + (size_t)(t + 2) * kstep;
            const char* a3 = a2 + kstep; const char* b3 = b2 + kstep;
            PG8_LDB(B0, 0, 0); PG8_SCHED; PG8_LDA(At, 0, 0); PG8_STAGE(PG8_SA(1, 1), a1 + hstep, voffA);
            PG8_WAIT_L(8); PG8_BAR; PG8_WAIT_L(0); PG8_MMA(0, 0, At, B0); PG8_BAR; PG8_SCHED;
            PG8_LDB(B1, 0, 1); PG8_STAGE(PG8_SB(0, 0), b2, voffB);
            PG8_BAR; PG8_WAIT_L(0); PG8_MMA(0, 1, At, B1); PG8_BAR;
            PG8_LDA(At, 0, 1); PG8_STAGE(PG8_SA(0, 0), a2, voffA);
            PG8_BAR; PG8_WAIT_L(0); PG8_MMA(1, 0, At, B0); PG8_BAR; PG8_SCHED;
            PG8_STAGE(PG8_SB(0, 1), b2 + hstep, voffB);
            PG8_WAIT_V(6); PG8_BAR; PG8_MMA(1, 1, At, B1); PG8_BAR;
            PG8_LDB(B0, 1, 0); PG8_SCHED; PG8_LDA(At, 1, 0); PG8_STAGE(PG8_SA(0, 1), a2 + hstep, voffA);
            PG8_WAIT_L(8); PG8_BAR; PG8_WAIT_L(0); PG8_MMA(0, 0, At, B0); PG8_BAR; PG8_SCHED;
            PG8_LDB(B1, 1, 1); PG8_STAGE(PG8_SB(1, 0), b3, voffB);
            PG8_BAR; PG8_WAIT_L(0); PG8_MMA(0, 1, At, B1); PG8_BAR;
            PG8_LDA(At, 1, 1); PG8_STAGE(PG8_SA(1, 0), a3, voffA);
            PG8_BAR; PG8_WAIT_L(0); PG8_MMA(1, 0, At, B0); PG8_BAR; PG8_SCHED;
            PG8_STAGE(PG8_SB(1, 1), b3 + hstep, voffB);
            PG8_WAIT_V(6); PG8_BAR; PG8_MMA(1, 1, At, B1); PG8_BAR;
        }
        E(acc, cur, wr, wc, fr, fq);
        if (!has_next) break;
#pragma unroll
        for (int a = 0; a < 2; ++a)
#pragma unroll
            for (int b = 0; b < 2; ++b)
#pragma unroll
                for (int m = 0; m < 4; ++m)
#pragma unroll
                    for (int n = 0; n < 2; ++n) acc[a][b][m][n] = (f32x4){0.f, 0.f, 0.f, 0.f};
        cur = nxt; cA = nA; cB = nB; ++ui;
    }
    PG8_WAIT_V(0);
    if (wr == 0) PG8_BAR;
    PG8_BAR;
#undef PG8_SA
#undef PG8_SB
#undef PG8_STAGE
#undef PG8_LDA
#undef PG8_LDB
#undef PG8_MMA
#undef PG8_WAIT_V
#undef PG8_WAIT_L
#undef PG8_BAR
#undef PG8_SCHED
}
}
using pg8::Unit;

struct EpiSwiglu {
    static constexpr bool PERM = true;
    bf16_t* H;
    __device__ __forceinline__ void operator()(const f32x4 (&acc)[2][2][4][2], const Unit& u, int wr, int wc, int fr, int fq) const {
        const int row0 = u.pm * 256 + wr * 64 + fr, col0 = u.pn * 128 + wc * 32 + 8 * fq;
#pragma unroll
        for (int ai = 0; ai < 2; ++ai)
#pragma unroll
            for (int m = 0; m < 4; ++m) {
                const f32x4 g0 = acc[ai][0][m][0], g1 = acc[ai][0][m][1], u0 = acc[ai][1][m][0], u1 = acc[ai][1][m][1];
                u32x4 o;
                o.x = pk2(siluf(g0[0]) * u0[0], siluf(g0[1]) * u0[1]); o.y = pk2(siluf(g0[2]) * u0[2], siluf(g0[3]) * u0[3]);
                o.z = pk2(siluf(g1[0]) * u1[0], siluf(g1[1]) * u1[1]); o.w = pk2(siluf(g1[2]) * u1[2], siluf(g1[3]) * u1[3]);
                *(u32x4*)(H + (size_t)(row0 + ai * 128 + m * 16) * DFF + col0) = o;
            }
    }
};
struct EpiResid {
    static constexpr bool PERM = false;
    bf16_t* R; const float* X0; const float* X1; float* P; const bf16_t* XB; float scale;
    __device__ __forceinline__ void operator()(const f32x4 (&acc)[2][2][4][2], const Unit& u, int wr, int wc, int fr, int fq) const {
        const int row0 = u.pm * 256 + wr * 64 + fr, col0 = u.pn * 256 + wc * 32 + 4 * fq;
#pragma unroll
        for (int ai = 0; ai < 2; ++ai)
#pragma unroll
            for (int m = 0; m < 4; ++m) {
                const int row = row0 + ai * 128 + m * 16;
                const float* xr = (XB != nullptr) ? nullptr : (row < NPR ? X0 + (size_t)row * DM : X1 + (size_t)(row - NPR) * DM) + col0;
                bf16_t* rp = R + (size_t)row * DM + col0;
#pragma unroll
                for (int bj = 0; bj < 2; ++bj)
#pragma unroll
                    for (int n = 0; n < 2; ++n) {
                        if (!u.part) {
                            f32x4 xv;
                            if (XB != nullptr) { const u32x2 xb2 = *(const u32x2*)(XB + (size_t)row * DM + col0 + bj * 128 + n * 16); xv = (f32x4){bflo(xb2.x), bfhi(xb2.x), bflo(xb2.y), bfhi(xb2.y)}; }
                            else xv = *(const f32x4*)(xr + bj * 128 + n * 16);
                            const f32x4 rv = xv * ALPHA + acc[ai][bj][m][n] * scale;
                            u32x2 ro; ro.x = pk2(rv[0], rv[1]); ro.y = pk2(rv[2], rv[3]);
                            *(u32x2*)(rp + bj * 128 + n * 16) = ro;
                        } else {
                            *(f32x4*)(P + ((size_t)u.sp * 512 + (row - NPR)) * DM + col0 + bj * 128 + n * 16) = acc[ai][bj][m][n] * scale;
                        }
                    }
            }
    }
};
struct EpiMixIn {
    static constexpr bool PERM = true;
    bf16_t* PB; float* BD;
    __device__ __forceinline__ void operator()(const f32x4 (&acc)[2][2][4][2], const Unit& u, int wr, int wc, int fr, int fq) const {
        const int row0 = u.pm * 256 + wr * 64 + fr;
        if (u.pn < 20) {
            const int col0 = u.pn * 256 + wc * 32 + 8 * fq;
#pragma unroll
            for (int ai = 0; ai < 2; ++ai)
#pragma unroll
                for (int m = 0; m < 4; ++m)
#pragma unroll
                    for (int bj = 0; bj < 2; ++bj) {
                        const f32x4 v0 = acc[ai][bj][m][0], v1 = acc[ai][bj][m][1];
                        u32x4 o; o.x = pk2(v0[0], v0[1]); o.y = pk2(v0[2], v0[3]); o.z = pk2(v1[0], v1[1]); o.w = pk2(v1[2], v1[3]);
                        *(u32x4*)(PB + (size_t)(row0 + ai * 128 + m * 16) * NPB + col0 + bj * 128) = o;
                    }
        } else if (wc == 0 && fq < 2) {
#pragma unroll
            for (int ai = 0; ai < 2; ++ai)
#pragma unroll
                for (int m = 0; m < 4; ++m) {
                    float* bp = BD + (size_t)(row0 + ai * 128 + m * 16) * 16 + 8 * fq;
                    *(f32x4*)(bp) = acc[ai][0][m][0]; *(f32x4*)(bp + 4) = acc[ai][0][m][1];
                }
        }
    }
};
struct EpiGlu {
    static constexpr bool PERM = true;
    bf16_t* YM; const bf16_t* ZB; const float* bias;
    __device__ __forceinline__ void operator()(const f32x4 (&acc)[2][2][4][2], const Unit& u, int wr, int wc, int fr, int fq) const {
        const int row0 = u.pm * 256 + wr * 64 + fr, col0 = u.pn * 256 + wc * 32 + 8 * fq;
#pragma unroll
        for (int bj = 0; bj < 2; ++bj) {
            const f32x4 b0 = *(const f32x4*)(bias + col0 + bj * 128), b1 = *(const f32x4*)(bias + col0 + bj * 128 + 4);
#pragma unroll
            for (int ai = 0; ai < 2; ++ai)
#pragma unroll
                for (int m = 0; m < 4; ++m) {
                    const int row = row0 + ai * 128 + m * 16;
                    const u32x4 zz = *(const u32x4*)(ZB + (size_t)row * 1024 + col0 + bj * 128);
                    const f32x4 v0 = acc[ai][bj][m][0] + b0, v1 = acc[ai][bj][m][1] + b1;
                    u32x4 o;
                    o.x = pk2(bflo(zz.x) * sigmf(v0[0]), bfhi(zz.x) * sigmf(v0[1])); o.y = pk2(bflo(zz.y) * sigmf(v0[2]), bfhi(zz.y) * sigmf(v0[3]));
                    o.z = pk2(bflo(zz.z) * sigmf(v1[0]), bfhi(zz.z) * sigmf(v1[1])); o.w = pk2(bflo(zz.w) * sigmf(v1[2]), bfhi(zz.w) * sigmf(v1[3]));
                    *(u32x4*)(YM + (size_t)row * DM + col0 + bj * 128) = o;
                }
        }
    }
};

__device__ __forceinline__ void transpose_tile(const float* __restrict__ W, int K, int N, bf16_t* __restrict__ WT, int kt, int nt, int mode, LAS float* tile) {
    int tid = threadIdx.x; asm volatile("" : "+v"(tid));
    const int k0 = kt * 64, n0 = nt * 256;
    f32x4 v[8];
#pragma unroll
    for (int i = 0; i < 8; ++i) {
        const int idx = tid + 512 * i, rr = idx >> 6, c4 = (idx & 63) * 4;
        v[i] = (f32x4){0.f, 0.f, 0.f, 0.f};
        if (n0 + c4 < N) v[i] = *(const f32x4*)(W + (size_t)(k0 + rr) * N + n0 + c4);
    }
#pragma unroll
    for (int i = 0; i < 8; ++i) {
        const int idx = tid + 512 * i, rr = idx >> 6, c4 = (idx & 63) * 4;
        tile[rr * 257 + c4 + 0] = v[i][0]; tile[rr * 257 + c4 + 1] = v[i][1]; tile[rr * 257 + c4 + 2] = v[i][2]; tile[rr * 257 + c4 + 3] = v[i][3];
    }
    __syncthreads();
#pragma unroll
    for (int j = 0; j < 4; ++j) {
        const int id = tid + 512 * j, n = id >> 3, kc = id & 7;
        float f[8];
#pragma unroll
        for (int e = 0; e < 8; ++e) f[e] = tile[(kc * 8 + e) * 257 + n];
        const int nn = n0 + n; int drow = nn;
        if (mode == 1) { const int isup = nn >= DFF; const int jj = isup ? nn - DFF : nn; drow = (jj >> 7) * 256 + isup * 128 + (jj & 127); }
        u32x4 o; o.x = pk2(f[0], f[1]); o.y = pk2(f[2], f[3]); o.z = pk2(f[4], f[5]); o.w = pk2(f[6], f[7]);
        *(u32x4*)(WT + (size_t)drow * K + k0 + kc * 8) = o;
    }
    __syncthreads();
}
__device__ __forceinline__ void transpose_matrix(const float* W, int K, int N, bf16_t* WT, int mode, LAS float* tile, int b0 = 0) {
    const int nkt = K / 64, nnt = (N + 255) / 256, tot = nkt * nnt;
    if ((int)blockIdx.x < b0) return;
    for (int t = blockIdx.x - b0; t < tot; t += gridDim.x - b0) transpose_tile(W, K, N, WT, t / nnt, t % nnt, mode, tile);
}

__device__ __forceinline__ void phase_convert0(const Params& p, LAS unsigned char* lds) {
    unsigned char* ws = p.ws;
    LAS float* tile = (LAS float*)lds;
    transpose_matrix(p.in[8], DM, 2 * DFF, (bf16_t*)(ws + OFF_W1T), 1, tile);
    transpose_matrix(p.in[9], DFF, DM, (bf16_t*)(ws + OFF_W1O), 0, tile);
    const size_t gtid = (size_t)blockIdx.x * 512 + threadIdx.x, gsz = (size_t)gridDim.x * 512;
    { bf16_t* xb = (bf16_t*)(ws + OFF_XNB); const size_t n8 = (size_t)NTOK * DM / 8, np8 = (size_t)NPR * DM / 8;
      for (size_t i = gtid; i < n8; i += gsz) {
          const float* s = (i < np8) ? p.in[0] + i * 8 : p.in[1] + (i - np8) * 8;
          const f32x4 a = *(const f32x4*)s, b = *(const f32x4*)(s + 4);
          u32x4 o; o.x = pk2(a[0], a[1]); o.y = pk2(a[2], a[3]); o.z = pk2(b[0], b[1]); o.w = pk2(b[2], b[3]);
          *(u32x4*)(xb + i * 8) = o; } }
    if (gtid < 4096) {
        const int g = (int)(gtid >> 6), pp = (int)(gtid & 63);
        const double dt = exp((double)p.in[13][g]);
        const double lr = (double)p.in[11][g * 64 + pp], li = (double)p.in[12][g * 64 + pp];
        const double mag = exp(lr * dt), abr = mag * cos(li * dt), abi = mag * sin(li * dt);
        const double nr = abr - 1.0, ni = abi, den = lr * lr + li * li;
        const double cr = (nr * lr + ni * li) / den, ci = (ni * lr - nr * li) / den;
        bf16_t* bbt = (bf16_t*)(ws + OFF_BBT) + (size_t)g * 128 * 16;
        for (int h = 0; h < 16; ++h) {
            const double bre = (double)p.in[14][(g * 64 + pp) * 16 + h], bim = (double)p.in[15][(g * 64 + pp) * 16 + h];
            bbt[pp * 16 + h] = f2bf((float)(cr * bre - ci * bim));
            bbt[(64 + pp) * 16 + h] = f2bf((float)(cr * bim + ci * bre));
        }
        float* ab = (float*)(ws + OFF_ABAR); ab[(g * 64 + pp) * 2] = (float)abr; ab[(g * 64 + pp) * 2 + 1] = (float)abi;
        bf16_t* ct = (bf16_t*)(ws + OFF_CT) + (size_t)g * 16 * 128;
        for (int o = 0; o < 16; ++o) {
            ct[o * 128 + pp] = f2bf(p.in[16][(g * 16 + o) * 64 + pp]);
            ct[o * 128 + 64 + pp] = f2bf(-p.in[17][(g * 16 + o) * 64 + pp]);
        }
    }
}
__device__ __forceinline__ void phase_convert_mid(const Params& p, LAS unsigned char* lds, int b0) {
    unsigned char* ws = p.ws;
    LAS float* tile = (LAS float*)lds;
    transpose_matrix(p.in[10], DM, NMIX, (bf16_t*)(ws + OFF_WMI), 0, tile, b0);
    transpose_matrix(p.in[19], 1024, 1024, (bf16_t*)(ws + OFF_GLU), 0, tile, b0);
    transpose_matrix(p.in[25], DM, DM, (bf16_t*)(ws + OFF_WMO), 0, tile, b0);
}
__device__ __forceinline__ void phase_convert1(const Params& p, LAS unsigned char* lds, int b0, bool skip_out) {
    LAS float* tile = (LAS float*)lds;
    transpose_matrix(p.in[28], DM, 2 * DFF, (bf16_t*)(p.ws + OFF_W1T), 1, tile, b0);
    if (!skip_out) transpose_matrix(p.in[29], DFF, DM, (bf16_t*)(p.ws + OFF_W1O), 0, tile, b0);
}

__device__ __forceinline__ void phase_ln(const bf16_t* R, const float* gam, const float* bet, float* outf, bf16_t* outb, const float* P, const float* XS, const bf16_t* XSB) {
    int lane = threadIdx.x; asm volatile("" : "+v"(lane)); lane &= 63;
    const int wave = __builtin_amdgcn_readfirstlane(threadIdx.x >> 6);
    for (int row = blockIdx.x * 8 + wave; row < NTOK; row += gridDim.x * 8) {
        const u32x2* rp = (const u32x2*)(R + (size_t)row * DM) + lane;
        f32x4 v[8]; float s = 0.f;
        if (P != nullptr && row >= NPR) {
            const f32x4* pp = (const f32x4*)(P + (size_t)(row - NPR) * DM) + lane;
#pragma unroll
            for (int j = 0; j < 8; ++j) {
                f32x4 xv;
                if (XSB != nullptr) { const u32x2 xb2 = *((const u32x2*)(XSB + (size_t)(row - NPR) * DM) + lane + 64 * j); xv = (f32x4){bflo(xb2.x), bfhi(xb2.x), bflo(xb2.y), bfhi(xb2.y)}; }
                else xv = ((const f32x4*)(XS + (size_t)(row - NPR) * DM) + lane)[64 * j];
                v[j] = xv * ALPHA + ((pp[64 * j] + pp[64 * j + 512 * 512]) + (pp[64 * j + 2 * 512 * 512] + pp[64 * j + 3 * 512 * 512]));
            }
        } else {
#pragma unroll
            for (int j = 0; j < 8; ++j) { const u32x2 rb = rp[64 * j]; v[j] = (f32x4){bflo(rb.x), bfhi(rb.x), bflo(rb.y), bfhi(rb.y)}; }
        }
#pragma unroll
        for (int j = 0; j < 8; ++j) s += (v[j][0] + v[j][1]) + (v[j][2] + v[j][3]);
        const float mean = wave_sum(s) * (1.f / DM); float s2 = 0.f;
#pragma unroll
        for (int j = 0; j < 8; ++j) { v[j] = v[j] - mean; s2 += (v[j][0] * v[j][0] + v[j][1] * v[j][1]) + (v[j][2] * v[j][2] + v[j][3] * v[j][3]); }
        const float rstd = 1.f / sqrtf(wave_sum(s2) * (1.f / DM) + 1e-5f);
#pragma unroll
        for (int j = 0; j < 8; ++j) {
            const int col = 4 * (lane + 64 * j);
            const f32x4 gg = *(const f32x4*)(gam + col), bb = *(const f32x4*)(bet + col);
            const f32x4 y = v[j] * rstd * gg + bb;
            if (outf) *(f32x4*)(outf + (size_t)row * DM + col) = y;
            if (outb) { u32x2 o; o.x = pk2(y[0], y[1]); o.y = pk2(y[2], y[3]); *(u32x2*)(outb + (size_t)row * DM + col) = o; }
        }
    }
}

__device__ __forceinline__ void phase_conv(const Params& p) {
    unsigned char* ws = p.ws;
    int lane = threadIdx.x; asm volatile("" : "+v"(lane)); lane &= 63;
    const int wave = __builtin_amdgcn_readfirstlane(threadIdx.x >> 6);
    const bf16_t* PB = (const bf16_t*)(ws + OFF_PROJB);
    const float* BD = (const float*)(ws + OFF_BD);
    const float* cw = p.in[21];
    float* G = (float*)(ws + OFF_G); float* BT = (float*)(ws + OFF_BETA);
    bf16_t* QN = (bf16_t*)(ws + OFF_QN); bf16_t* KN = (bf16_t*)(ws + OFF_KN); float* VV = (float*)(ws + OFF_VV);
    bf16_t* KT = (bf16_t*)(ws + OFF_KT);
    float* QKVS = (float*)(ws + OFF_QKVS);
    const int NIT = 8192 + 1024;
    for (int it = blockIdx.x * 8 + wave; it < NIT; it += gridDim.x * 8) {
        if (it < 8192) {
            const int h = it & 7, tg = (it >> 3) & 255, b = it >> 11;
            const int t0 = tg * 8, tok0 = b * 2048 + t0;
            if (lane < 8) {
                const int tok = tok0 + lane;
                const float braw = BD[(size_t)tok * 16 + h], araw = BD[(size_t)tok * 16 + 8 + h];
                const float xx = araw + p.in[23][h];
                const float sp = xx > 20.f ? xx : log1pf(expf(xx));
                G[(size_t)tok * 8 + h] = -expf(p.in[22][h]) * sp;
                BT[(size_t)tok * 8 + h] = 1.f / (1.f + expf(-braw));
            }
            float x0[3][11], x1[3][11], w0[3][4], w1[3][4];
#pragma unroll
            for (int st = 0; st < 3; ++st) {
                const int col = st * 1024 + h * 128 + 2 * lane;
#pragma unroll
                for (int j = 0; j < 11; ++j) {
                    const int t = t0 - 3 + j;
                    unsigned v = 0u;
                    if (t >= 0) v = *(const unsigned*)(PB + (size_t)(b * 2048 + t) * NPB + 1024 + col);
                    x0[st][j] = bflo(v); x1[st][j] = bfhi(v);
                }
#pragma unroll
                for (int j = 0; j < 4; ++j) { w0[st][j] = cw[j * 3072 + col]; w1[st][j] = cw[j * 3072 + col + 1]; }
            }
            float y0[3][8], y1[3][8];
#pragma unroll
            for (int st = 0; st < 3; ++st)
#pragma unroll
                for (int t = 0; t < 8; ++t) {
                    float a0 = 0.f, a1 = 0.f;
#pragma unroll
                    for (int j = 0; j < 4; ++j) { a0 += x0[st][t + j] * w0[st][j]; a1 += x1[st][t + j] * w1[st][j]; }
                    y0[st][t] = siluf(a0); y1[st][t] = siluf(a1);
                }
            float ss[2][8];
#pragma unroll
            for (int st = 0; st < 2; ++st)
#pragma unroll
                for (int t = 0; t < 8; ++t) ss[st][t] = y0[st][t] * y0[st][t] + y1[st][t] * y1[st][t];
#pragma unroll
            for (int o = 1; o < 64; o <<= 1)
#pragma unroll
                for (int st = 0; st < 2; ++st)
#pragma unroll
                    for (int t = 0; t < 8; ++t) ss[st][t] += __shfl_xor(ss[st][t], o);
#pragma unroll
            for (int st = 0; st < 2; ++st)
#pragma unroll
                for (int t = 0; t < 8; ++t) {
                    float sc = 1.f / sqrtf(ss[st][t] + 1e-6f);
                    if (st == 0) sc *= 0.08838834764831845f;
                    y0[st][t] *= sc; y1[st][t] *= sc;
                }
#pragma unroll
            for (int t = 0; t < 8; ++t) {
                *(unsigned*)(QN + (size_t)(tok0 + t) * 1024 + h * 128 + 2 * lane) = pk2(y0[0][t], y1[0][t]);
                *(unsigned*)(KN + (size_t)(tok0 + t) * 1024 + h * 128 + 2 * lane) = pk2(y0[1][t], y1[1][t]);
                float* o = VV + (size_t)(tok0 + t) * 1024 + h * 128 + 2 * lane; o[0] = y0[2][t]; o[1] = y1[2][t];
            }
            {
                const int chunk = t0 >> 6, c0 = t0 & 63;
                bf16_t* base = KT + ((size_t)((b * 8 + h) * 32 + chunk) * 128 + 2 * lane) * 64 + c0;
                u32x4 o0, o1;
                o0.x = pk2(y0[1][0], y0[1][1]); o0.y = pk2(y0[1][2], y0[1][3]); o0.z = pk2(y0[1][4], y0[1][5]); o0.w = pk2(y0[1][6], y0[1][7]);
                o1.x = pk2(y1[1][0], y1[1][1]); o1.y = pk2(y1[1][2], y1[1][3]); o1.z = pk2(y1[1][4], y1[1][5]); o1.w = pk2(y1[1][6], y1[1][7]);
                *(u32x4*)base = o0; *(u32x4*)(base + 64) = o1;
            }
            if (tg == 255) {
#pragma unroll
                for (int st = 0; st < 3; ++st)
#pragma unroll
                    for (int j = 0; j < 3; ++j) {
                        float* o = p.out + O_PCONV + (size_t)(b * 3 + j) * 3072 + st * 1024 + h * 128 + 2 * lane;
                        o[0] = x0[st][8 + j]; o[1] = x1[st][8 + j];
                    }
            }
        } else {
            const int si = it - 8192, h = si & 7, b = si >> 3;
            const int tok0 = NPR + b * 4;
            if (lane < 4) {
                const int tok = tok0 + lane;
                const float braw = BD[(size_t)tok * 16 + h], araw = BD[(size_t)tok * 16 + 8 + h];
                const float xx = araw + p.in[23][h];
                const float sp = xx > 20.f ? xx : log1pf(expf(xx));
                G[(size_t)tok * 8 + h] = -expf(p.in[22][h]) * sp;
                BT[(size_t)tok * 8 + h] = 1.f / (1.f + expf(-braw));
            }
#pragma unroll
            for (int st = 0; st < 3; ++st) {
                const int col = st * 1024 + h * 128 + 2 * lane;
                float x0[7], x1[7];
#pragma unroll
                for (int j = 0; j < 3; ++j) { const float* s = p.in[5] + (size_t)(b * 3 + j) * 3072 + col; x0[j] = s[0]; x1[j] = s[1]; }
#pragma unroll
                for (int j = 0; j < 4; ++j) { const unsigned v = *(const unsigned*)(PB + (size_t)(tok0 + j) * NPB + 1024 + col); x0[3 + j] = bflo(v); x1[3 + j] = bfhi(v); }
                float w0[4], w1[4];
#pragma unroll
                for (int j = 0; j < 4; ++j) { w0[j] = cw[j * 3072 + col]; w1[j] = cw[j * 3072 + col + 1]; }
#pragma unroll
                for (int t = 0; t < 4; ++t) {
                    float a0 = 0.f, a1 = 0.f;
#pragma unroll
                    for (int j = 0; j < 4; ++j) { a0 += x0[t + j] * w0[j]; a1 += x1[t + j] * w1[j]; }
                    float y0 = siluf(a0), y1 = siluf(a1);
                    if (st < 2) {
                        const float ss = wave_sum(y0 * y0 + y1 * y1);
                        float sc = 1.f / sqrtf(ss + 1e-6f);
                        if (st == 0) sc *= 0.08838834764831845f;
                        y0 *= sc; y1 *= sc;
                    }
                    float* o = QKVS + (size_t)(b * 4 + t) * 3072 + col; o[0] = y0; o[1] = y1;
                }
#pragma unroll
                for (int j = 0; j < 3; ++j) {
                    float* o = p.out + O_SCONV + (size_t)(b * 3 + j) * 3072 + col;
                    o[0] = x0[4 + j]; o[1] = x1[4 + j];
                }
            }
        }
    }
}

__device__ __forceinline__ f32x16 mfma32(bf16x8 a, bf16x8 b, f32x16 c) { return __builtin_amdgcn_mfma_f32_32x32x16_bf16(a, b, c, 0, 0, 0); }
__device__ __forceinline__ f32x4 mfma16(bf16x8 a, bf16x8 b, f32x4 c) { return __builtin_amdgcn_mfma_f32_16x16x32_bf16(a, b, c, 0, 0, 0); }
__device__ __forceinline__ bf16x8 mk8(unsigned a, unsigned b, unsigned c, unsigned d) { u32x4 t = {a, b, c, d}; return __builtin_bit_cast(bf16x8, t); }
constexpr int MTP = 36;

template <int C> __device__ __forceinline__ void solve_col(float (&t)[64], const LAS float* MT, int lane) {
    float a0 = 0.f, a1 = 0.f, a2 = 0.f, a3 = 0.f;
    int mb = 0; if (C < 63) asm volatile("" : "+v"(mb) : "v"(t[C + 1]));
#pragma unroll
    for (int jj = (C + 1) / 4; jj < 16; ++jj) {
        const int j4 = jj * 4;
        if (jj == 8 && (C + 1) / 4 < 8) asm volatile("" : "+v"(mb) : "v"(a0), "v"(a1), "v"(a2), "v"(a3));
        const int ti = (j4 >> 5) + (C >> 5);
        const f32x4 m = *(const LAS f32x4*)(MT + mb + ti * 32 * MTP + (C & 31) * MTP + (j4 & 31));
        if (j4 + 0 > C) a0 += t[j4 + 0] * m[0];
        if (j4 + 1 > C) a1 += t[j4 + 1] * m[1];
        if (j4 + 2 > C) a2 += t[j4 + 2] * m[2];
        if (j4 + 3 > C) a3 += t[j4 + 3] * m[3];
    }
    t[C] = ((lane == C) ? 1.f : 0.f) - ((a0 + a1) + (a2 + a3));
    if constexpr (C > 0) solve_col<C - 1>(t, MT, lane);
}

__device__ __forceinline__ void gdn_prep_item(const Params& p, int it, LAS unsigned char* wl, LAS float* gcl_) {
    unsigned char* ws = p.ws;
    int lane = threadIdx.x; asm volatile("" : "+v"(lane)); lane &= 63;
    const int r = lane & 31, hh = lane >> 5;
    const int n = it & 31, bh = it >> 5, h = bh & 7, b = bh >> 3;
    const int tok0 = b * 2048 + n * 64;
    LAS float* MT = (LAS float*)wl;
    LAS float* gcL = gcl_;
    LAS float* btL = gcL + 64;
    const float* G = (const float*)(ws + OFF_G); const float* BT = (const float*)(ws + OFF_BETA);
    float gc = G[(size_t)(tok0 + lane) * 8 + h];
    const float bv = BT[(size_t)(tok0 + lane) * 8 + h];
#pragma unroll
    for (int o = 1; o < 64; o <<= 1) { const float t = __int_as_float(__builtin_amdgcn_ds_bpermute((lane - o) << 2, __float_as_int(gc))); if (lane >= o) gc += t; }
    const float gl = __int_as_float(__builtin_amdgcn_readlane(__float_as_int(gc), 63));
    gcL[lane] = gc; btL[lane] = bv;
    if (lane == 0) ((float*)(ws + OFF_GLAST))[it] = __expf(gl);
    WSYNC();
    const bf16_t* kp = (const bf16_t*)(ws + OFF_KN) + (size_t)tok0 * 1024 + h * 128;
    const bf16_t* qp = (const bf16_t*)(ws + OFF_QN) + (size_t)tok0 * 1024 + h * 128;
    bf16x8 Kf[2][8];
#pragma unroll
    for (int mt = 0; mt < 2; ++mt)
#pragma unroll
        for (int ks = 0; ks < 8; ++ks) Kf[mt][ks] = *(const bf16x8*)(kp + (size_t)(mt * 32 + r) * 1024 + ks * 16 + hh * 8);
    {
        bf16_t* KG = (bf16_t*)(ws + OFF_KG) + (size_t)it * 8192;
#pragma unroll
        for (int mt = 0; mt < 2; ++mt) {
            const float e = -__expf(gcL[mt * 32 + r]);
#pragma unroll
            for (int ks = 0; ks < 8; ++ks) {
                const u32x4 v = __builtin_bit_cast(u32x4, Kf[mt][ks]);
                u32x2 o0, o1; o0.x = pk2(bflo(v.x) * e, bfhi(v.x) * e); o0.y = pk2(bflo(v.y) * e, bfhi(v.y) * e);
                o1.x = pk2(bflo(v.z) * e, bfhi(v.z) * e); o1.y = pk2(bflo(v.w) * e, bfhi(v.w) * e);
                bf16_t* fp = KG + (mt * 8 + ks) * 512 + r * 8 + 4 * hh;
                *(u32x2*)fp = o0; *(u32x2*)(fp + 256) = o1;
            }
        }
    }
    __builtin_amdgcn_sched_barrier(0);
#pragma unroll
    for (int ti = 0; ti < 3; ++ti) {
        __builtin_amdgcn_sched_barrier(0);
        const int mi = (ti >= 1), ni = (ti == 2);
        f32x16 a = {};
#pragma unroll
        for (int ks = 0; ks < 8; ++ks) a = mfma32(Kf[mi][ks], Kf[ni][ks], a);
        const int j = ni * 32 + r; const float gcj = gcL[j];
#pragma unroll
        for (int qq = 0; qq < 4; ++qq) {
            const int i0 = mi * 32 + 8 * qq + 4 * hh;
            const f32x4 gci = *(const LAS f32x4*)(gcL + i0), bti = *(const LAS f32x4*)(btL + i0);
            f32x4 mv;
#pragma unroll
            for (int e = 0; e < 4; ++e) {
                const int i = i0 + e;
                const float dec = __expf(fminf(gci[e] - gcj, 0.f));
                mv[e] = (i > j) ? bti[e] * a[qq * 4 + e] * dec : 0.f;
            }
            *(LAS f32x4*)(MT + ti * 32 * MTP + r * MTP + 8 * qq + 4 * hh) = mv;
        }
    }
    bf16_t* ATT = (bf16_t*)(ws + OFF_ATT) + (size_t)it * 4096;
    bf16_t* QG = (bf16_t*)(ws + OFF_QG) + (size_t)it * 8192;
#pragma unroll
    for (int mi = 0; mi < 2; ++mi) {
        __builtin_amdgcn_sched_barrier(0);
        bf16x8 Qf[8];
#pragma unroll
        for (int ks = 0; ks < 8; ++ks) Qf[ks] = *(const bf16x8*)(qp + (size_t)(mi * 32 + r) * 1024 + ks * 16 + hh * 8);
#pragma unroll
        for (int ni = 0; ni <= mi; ++ni) {
            __builtin_amdgcn_sched_barrier(0);
            f32x16 q = {};
#pragma unroll
            for (int ks = 0; ks < 8; ++ks) q = mfma32(Qf[ks], Kf[ni][ks], q);
            const int j = ni * 32 + r; const float gcj = gcL[j];
#pragma unroll
            for (int qq = 0; qq < 4; ++qq) {
                const int i0 = mi * 32 + 8 * qq + 4 * hh;
                const f32x4 gci = *(const LAS f32x4*)(gcL + i0);
#pragma unroll
                for (int e = 0; e < 4; ++e) {
                    const int i = i0 + e;
                    const float dec = __expf(fminf(gci[e] - gcj, 0.f));
                    ATT[((mi * 2 + ni) * 2 + (r >> 4)) * 512 + (((r >> 2) & 1) * 32 + (i & 31)) * 8 + 4 * ((r >> 3) & 1) + (r & 3)] = f2bf((i >= j) ? q[qq * 4 + e] * dec : 0.f);
                }
            }
        }
        __builtin_amdgcn_sched_barrier(0);
        const float e = __expf(gcL[mi * 32 + r]);
#pragma unroll
        for (int ks = 0; ks < 8; ++ks) {
            const u32x4 v = __builtin_bit_cast(u32x4, Qf[ks]);
            u32x2 o0, o1; o0.x = pk2(bflo(v.x) * e, bfhi(v.x) * e); o0.y = pk2(bflo(v.y) * e, bfhi(v.y) * e);
            o1.x = pk2(bflo(v.z) * e, bfhi(v.z) * e); o1.y = pk2(bflo(v.w) * e, bfhi(v.w) * e);
            bf16_t* fp = QG + (mi * 8 + ks) * 512 + r * 8 + 4 * hh;
            *(u32x2*)fp = o0; *(u32x2*)(fp + 256) = o1;
        }
    }
    WSYNC();
    float t[64];
    solve_col<63>(t, MT, lane);
    WSYNC();
    int lane5 = lane; asm volatile("" : "+v"(lane5) : "v"(t[0]));
    const int r5 = lane5 & 31, h5 = lane5 >> 5;
    {
        bf16_t* TBt = (bf16_t*)(ws + OFF_TBT) + (size_t)it * 4096 + ((lane5 >> 5) * 4) * 512 + (lane5 & 31) * 8;
#pragma unroll
        for (int m2 = 0; m2 < 2; ++m2)
#pragma unroll
            for (int sx = 0; sx < 2; ++sx) {
                const int c0 = m2 * 32 + 16 * sx;
                const f32x4 b0 = *(const LAS f32x4*)(btL + c0), b1 = *(const LAS f32x4*)(btL + c0 + 4), b2 = *(const LAS f32x4*)(btL + c0 + 8), b3 = *(const LAS f32x4*)(btL + c0 + 12);
                u32x4 oa, ob;
                oa.x = pk2(t[c0 + 0] * b0[0], t[c0 + 1] * b0[1]); oa.y = pk2(t[c0 + 2] * b0[2], t[c0 + 3] * b0[3]);
                oa.z = pk2(t[c0 + 8] * b2[0], t[c0 + 9] * b2[1]); oa.w = pk2(t[c0 + 10] * b2[2], t[c0 + 11] * b2[3]);
                ob.x = pk2(t[c0 + 4] * b1[0], t[c0 + 5] * b1[1]); ob.y = pk2(t[c0 + 6] * b1[2], t[c0 + 7] * b1[3]);
                ob.z = pk2(t[c0 + 12] * b3[0], t[c0 + 13] * b3[1]); ob.w = pk2(t[c0 + 14] * b3[2], t[c0 + 15] * b3[3]);
                bf16_t* fp = TBt + (m2 * 2 + sx) * 512;
                *(u32x4*)fp = oa; *(u32x4*)(fp + 256) = ob;
            }
    }
    {
        const bf16_t* KT = (const bf16_t*)(ws + OFF_KT) + (size_t)it * 8192;
        bf16_t* KDT = (bf16_t*)(ws + OFF_KDT) + (size_t)it * 8192;
#pragma unroll
        for (int nt = 0; nt < 4; ++nt) {
            __builtin_amdgcn_sched_barrier(0);
#pragma unroll
            for (int ks = 0; ks < 4; ++ks) {
                const u32x4 v = *(const u32x4*)(KT + (size_t)(nt * 32 + r5) * 64 + ks * 16 + h5 * 8);
                const f32x4 g0 = *(const LAS f32x4*)(gcL + ks * 16 + h5 * 8), g1 = *(const LAS f32x4*)(gcL + ks * 16 + h5 * 8 + 4);
                u32x2 o0, o1;
                o0.x = pk2(bflo(v.x) * __expf(gl - g0[0]), bfhi(v.x) * __expf(gl - g0[1])); o0.y = pk2(bflo(v.y) * __expf(gl - g0[2]), bfhi(v.y) * __expf(gl - g0[3]));
                o1.x = pk2(bflo(v.z) * __expf(gl - g1[0]), bfhi(v.z) * __expf(gl - g1[1])); o1.y = pk2(bflo(v.w) * __expf(gl - g1[2]), bfhi(v.w) * __expf(gl - g1[3]));
                bf16_t* fp = KDT + (nt * 4 + ks) * 512 + r5 * 8 + 4 * h5;
                *(u32x2*)fp = o0; *(u32x2*)(fp + 256) = o1;
            }
        }
    }
    WSYNC();
}

__device__ __forceinline__ void gdn_sample_item(const Params& p, int it, LAS unsigned char* wl) {
    unsigned char* ws = p.ws;
    int lane = threadIdx.x; asm volatile("" : "+v"(lane)); lane &= 63;
    const int c = lane & 31, hh = lane >> 5;
    const int qd = it & 3, bh = it >> 2, h = bh & 7, b = bh >> 3;
    const int dv = qd * 32 + c;
    float s[64];
    { const float* sp = p.in[4] + (size_t)bh * 16384 + (size_t)(hh * 64) * 128 + dv;
#pragma unroll
      for (int i = 0; i < 64; ++i) s[i] = sp[i * 128]; }
    LAS float* kq = (LAS float*)wl;
    const float* QKVS = (const float*)(ws + OFF_QKVS);
    const float* G = (const float*)(ws + OFF_G); const float* BT = (const float*)(ws + OFF_BETA);
    bf16_t* O = (bf16_t*)(ws + OFF_O);
#pragma unroll
    for (int t = 0; t < 4; ++t) {
        const float* row = QKVS + (size_t)(b * 4 + t) * 3072 + h * 128;
        kq[t * 256 + lane] = row[1024 + lane]; kq[t * 256 + 64 + lane] = row[1024 + 64 + lane];
        kq[t * 256 + 128 + lane] = row[lane]; kq[t * 256 + 192 + lane] = row[64 + lane];
    }
    WSYNC();
#pragma unroll 1
    for (int t = 0; t < 4; ++t) {
        const int tok = NPR + b * 4 + t;
        const float al = __expf(G[(size_t)tok * 8 + h]), be = BT[(size_t)tok * 8 + h];
        const float v = QKVS[(size_t)(b * 4 + t) * 3072 + 2048 + h * 128 + dv];
        float d0 = 0.f, d1 = 0.f, d2 = 0.f, d3 = 0.f;
        int kb = t * 256 + hh * 64;
#pragma unroll
        for (int i = 0; i < 64; i += 4) {
            if ((i & 15) == 0) asm volatile("" : "+v"(kb) : "v"(d0), "v"(d1), "v"(d2), "v"(d3));
            const f32x4 kk = *(const LAS f32x4*)(kq + kb + i);
            s[i] *= al; s[i + 1] *= al; s[i + 2] *= al; s[i + 3] *= al;
            d0 += kk[0] * s[i]; d1 += kk[1] * s[i + 1]; d2 += kk[2] * s[i + 2]; d3 += kk[3] * s[i + 3];
        }
        float dd = (d0 + d1) + (d2 + d3);
        dd += __shfl_xor(dd, 32);
        const float rr = be * (v - dd);
        float o0 = 0.f, o1 = 0.f, o2 = 0.f, o3 = 0.f;
        asm volatile("" : "+v"(kb) : "v"(rr));
#pragma unroll
        for (int i = 0; i < 64; i += 4) {
            if ((i & 15) == 0) asm volatile("" : "+v"(kb) : "v"(o0), "v"(o1), "v"(o2), "v"(o3));
            const f32x4 kk = *(const LAS f32x4*)(kq + kb + i);
            const f32x4 qq = *(const LAS f32x4*)(kq + kb + 128 + i);
            s[i] += rr * kk[0]; s[i + 1] += rr * kk[1]; s[i + 2] += rr * kk[2]; s[i + 3] += rr * kk[3];
            o0 += qq[0] * s[i]; o1 += qq[1] * s[i + 1]; o2 += qq[2] * s[i + 2]; o3 += qq[3] * s[i + 3];
        }
        float oo = (o0 + o1) + (o2 + o3);
        oo += __shfl_xor(oo, 32);
        if (hh == 0) O[(size_t)tok * 1024 + h * 128 + dv] = f2bf(oo);
    }
    int dv2 = dv; asm volatile("" : "+v"(dv2));
    float* So = p.out + O_SGDN + (size_t)bh * 16384 + (size_t)(hh * 64) * 128 + dv2;
#pragma unroll
    for (int i = 0; i < 64; ++i) So[i * 128] = s[i];
    WSYNC();
}

__device__ __forceinline__ void s5_unit(const Params& p, int g, int tok_base, int nsub, bool sample, int b0, LAS unsigned char* wl, int hb_off);
__device__ __forceinline__ void phase_gdn_prep(const Params& p, LAS unsigned char* lds) {
    const int wave = __builtin_amdgcn_readfirstlane(threadIdx.x >> 6);
    LAS unsigned char* wl = lds + wave * 16384;
    if (wave < 4) { for (int it = blockIdx.x * 4 + wave; it < 1024; it += gridDim.x * 4) gdn_prep_item(p, it, wl, (LAS float*)(lds + 143360 + wave * 512)); }
    else {
        for (int it = blockIdx.x * 4 + (wave - 4); it < 4096; it += gridDim.x * 4) gdn_sample_item(p, it, wl);
        for (int u = blockIdx.x * 4 + (wave - 4); u < 2048; u += gridDim.x * 4) { const int g = u & 63, bq = u >> 6; s5_unit(p, g, NPR + bq * 16, 1, true, bq * 4, wl, 8192); }
    }
}

__device__ __forceinline__ bf16x8 ldperm(const bf16_t* p8, int hh) {
    const u32x2 lo = *(const u32x2*)(p8 + 4 * hh), hi = *(const u32x2*)(p8 + 8 + 4 * hh);
    return mk8(lo.x, lo.y, hi.x, hi.y);
}
constexpr int GDN_BUF = 61440, GDN_LDS0 = 21504;
__device__ __forceinline__ void gdn_dma_chunk(const unsigned char* ws, int it, LAS unsigned char* buf, int lane) {
    const bf16_t* KG = (const bf16_t*)(ws + OFF_KG) + (size_t)it * 8192 + lane * 8;
    const bf16_t* QG = (const bf16_t*)(ws + OFF_QG) + (size_t)it * 8192 + lane * 8;
    const bf16_t* KDT = (const bf16_t*)(ws + OFF_KDT) + (size_t)it * 8192 + lane * 8;
#pragma unroll
    for (int f = 0; f < 16; ++f) __builtin_amdgcn_global_load_lds((const unsigned*)(KG + f * 512), (LAS unsigned*)(buf + f * 1024), 16, 0, 0);
#pragma unroll
    for (int f = 0; f < 16; ++f) __builtin_amdgcn_global_load_lds((const unsigned*)(QG + f * 512), (LAS unsigned*)(buf + 16384 + f * 1024), 16, 0, 0);
#pragma unroll
    for (int f = 0; f < 16; ++f) __builtin_amdgcn_global_load_lds((const unsigned*)(KDT + f * 512), (LAS unsigned*)(buf + 32768 + f * 1024), 16, 0, 0);
    const bf16_t* TBt = (const bf16_t*)(ws + OFF_TBT) + (size_t)it * 4096 + lane * 8;
    const bf16_t* ATT = (const bf16_t*)(ws + OFF_ATT) + (size_t)it * 4096 + lane * 8;
#pragma unroll
    for (int k = 0; k < 6; ++k) { const int f = (k < 2) ? k : k + 2;
        __builtin_amdgcn_global_load_lds((const unsigned*)(TBt + f * 512), (LAS unsigned*)(buf + 49152 + k * 1024), 16, 0, 0);
        __builtin_amdgcn_global_load_lds((const unsigned*)(ATT + f * 512), (LAS unsigned*)(buf + 55296 + k * 1024), 16, 0, 0); }
}
template <int PAR>
__device__ __forceinline__ void gdn_chunk(const Params& p, LAS unsigned char* gb, int n, int bh, int b, int h, int dv, int hh, int lane, f32x16 (&S)[4]) {
    unsigned char* ws = p.ws;
    asm volatile("s_waitcnt vmcnt(0)" ::: "memory");
    const int it = bh * 32 + n;
    const LAS unsigned char* cb = gb + PAR * GDN_BUF + lane * 16;
    const float* VV = (const float*)(ws + OFF_VV) + (size_t)(b * 2048 + n * 64) * 1024 + h * 128 + dv;
    bf16_t* O = (bf16_t*)(ws + OFF_O);
    const float gl = ((const float*)(ws + OFF_GLAST))[it];
    f32x16 v0, v1;
#pragma unroll
    for (int q = 0; q < 16; ++q) { const int i = 8 * (q >> 2) + 4 * hh + (q & 3); v0[q] = VV[(size_t)i * 1024]; v1[q] = VV[(size_t)(32 + i) * 1024]; }
    float pf8 = 0.f;
    if (n + 1 < 32) pf8 = VV[(size_t)(64 + lane) * 1024];
    if (n + 1 < 32) gdn_dma_chunk(ws, it + 1, gb + (1 - PAR) * GDN_BUF, lane);
    bf16x8 Sb[4][2];
#pragma unroll
    for (int kt = 0; kt < 4; ++kt)
#pragma unroll
        for (int s = 0; s < 2; ++s)
            Sb[kt][s] = mk8(pk2(S[kt][8 * s + 0], S[kt][8 * s + 1]), pk2(S[kt][8 * s + 2], S[kt][8 * s + 3]), pk2(S[kt][8 * s + 4], S[kt][8 * s + 5]), pk2(S[kt][8 * s + 6], S[kt][8 * s + 7]));
    bf16x8 Eb[2][2];
    {
        f32x16 a0 = {}, a1 = {};
#pragma unroll
        for (int kt = 0; kt < 4; ++kt)
#pragma unroll
            for (int s = 0; s < 2; ++s) {
                const u32x4 hv = __builtin_bit_cast(u32x4, Sb[kt][s]);
                const bf16x8 lo = mk8(pk2(S[kt][8 * s + 0] - bflo(hv.x), S[kt][8 * s + 1] - bfhi(hv.x)), pk2(S[kt][8 * s + 2] - bflo(hv.y), S[kt][8 * s + 3] - bfhi(hv.y)),
                                      pk2(S[kt][8 * s + 4] - bflo(hv.z), S[kt][8 * s + 5] - bfhi(hv.z)), pk2(S[kt][8 * s + 6] - bflo(hv.w), S[kt][8 * s + 7] - bfhi(hv.w)));
                const bf16x8 A0 = *(const LAS bf16x8*)(cb + (kt * 2 + s) * 1024);
                const bf16x8 A1 = *(const LAS bf16x8*)(cb + (8 + kt * 2 + s) * 1024);
                a0 = mfma32(A0, Sb[kt][s], a0); a1 = mfma32(A1, Sb[kt][s], a1);
                a0 = mfma32(A0, lo, a0); a1 = mfma32(A1, lo, a1);
            }
        a0 += v0; a1 += v1;
#pragma unroll
        for (int s = 0; s < 2; ++s) {
            Eb[0][s] = mk8(pk2(a0[8 * s + 0], a0[8 * s + 1]), pk2(a0[8 * s + 2], a0[8 * s + 3]), pk2(a0[8 * s + 4], a0[8 * s + 5]), pk2(a0[8 * s + 6], a0[8 * s + 7]));
            Eb[1][s] = mk8(pk2(a1[8 * s + 0], a1[8 * s + 1]), pk2(a1[8 * s + 2], a1[8 * s + 3]), pk2(a1[8 * s + 4], a1[8 * s + 5]), pk2(a1[8 * s + 6], a1[8 * s + 7]));
        }
    }
    bf16x8 Vb[2][2];
#pragma unroll
    for (int mt = 0; mt < 2; ++mt) {
        f32x16 a = {};
#pragma unroll
        for (int m2 = 0; m2 <= mt; ++m2)
#pragma unroll
            for (int s = 0; s < 2; ++s) a = mfma32(*(const LAS bf16x8*)(cb + 49152 + ((mt == 0) ? s : 2 + m2 * 2 + s) * 1024), Eb[m2][s], a);
#pragma unroll
        for (int s = 0; s < 2; ++s)
            Vb[mt][s] = mk8(pk2(a[8 * s + 0], a[8 * s + 1]), pk2(a[8 * s + 2], a[8 * s + 3]), pk2(a[8 * s + 4], a[8 * s + 5]), pk2(a[8 * s + 6], a[8 * s + 7]));
    }
#pragma unroll
    for (int mt = 0; mt < 2; ++mt) {
        f32x16 a = {};
#pragma unroll
        for (int kt = 0; kt < 4; ++kt)
#pragma unroll
            for (int s = 0; s < 2; ++s) a = mfma32(*(const LAS bf16x8*)(cb + 16384 + ((mt * 4 + kt) * 2 + s) * 1024), Sb[kt][s], a);
#pragma unroll
        for (int m2 = 0; m2 <= mt; ++m2)
#pragma unroll
            for (int s = 0; s < 2; ++s) a = mfma32(*(const LAS bf16x8*)(cb + 55296 + ((mt == 0) ? s : 2 + m2 * 2 + s) * 1024), Vb[m2][s], a);
#pragma unroll
        for (int q = 0; q < 16; ++q) { const int i = mt * 32 + 8 * (q >> 2) + 4 * hh + (q & 3);
            O[(size_t)(b * 2048 + n * 64 + i) * 1024 + h * 128 + dv] = f2bf(a[q]); }
    }
#pragma unroll
    for (int kt = 0; kt < 4; ++kt) {
        f32x16 a = S[kt] * gl;
#pragma unroll
        for (int m2 = 0; m2 < 2; ++m2)
#pragma unroll
            for (int s = 0; s < 2; ++s) a = mfma32(*(const LAS bf16x8*)(cb + 32768 + ((kt * 2 + m2) * 2 + s) * 1024), Vb[m2][s], a);
        S[kt] = a;
    }
    asm volatile("" :: "v"(pf8));
}
__device__ __forceinline__ void gdn_scan_unit(const Params& p, int unit, LAS unsigned char* gb) {
    int lane = threadIdx.x; asm volatile("" : "+v"(lane)); lane &= 63;
    const int r = lane & 31, hh = lane >> 5;
    const int sl = unit & 3, bh = unit >> 2, h = bh & 7, b = bh >> 3;
    const int dv = sl * 32 + r;
    f32x16 S[4];
#pragma unroll
    for (int kt = 0; kt < 4; ++kt) S[kt] = (f32x16){};
    gdn_dma_chunk(p.ws, bh * 32, gb, lane);
#pragma unroll 1
    for (int n = 0; n < 32; n += 2) {
        gdn_chunk<0>(p, gb, n, bh, b, h, dv, hh, lane, S);
        gdn_chunk<1>(p, gb, n + 1, bh, b, h, dv, hh, lane, S);
    }
    int lane6 = threadIdx.x; asm volatile("" : "+v"(lane6)); lane6 &= 63;
    float* So = p.out + O_PGDN + (size_t)bh * 16384 + (sl * 32 + (lane6 & 31)) + (size_t)(4 * (lane6 >> 5)) * 128;
#pragma unroll
    for (int kt = 0; kt < 4; ++kt)
#pragma unroll
        for (int q = 0; q < 16; ++q) { const int dk = kt * 32 + 8 * (q >> 2) + (q & 3); So[(size_t)dk * 128] = S[kt][q]; }
}

__device__ __forceinline__ void s5_unit(const Params& p, int g, int tok_base, int nsub, bool sample, int b0, LAS unsigned char* wl, int hb_off) {
    unsigned char* ws = p.ws;
    int lane = threadIdx.x; asm volatile("" : "+v"(lane)); lane &= 63;
    const int l15 = lane & 15, l4 = lane >> 4;
    LAS bf16_t* HB = (LAS bf16_t*)(wl + hb_off);
    const bf16_t* PB = (const bf16_t*)(ws + OFF_PROJB);
    bf16_t* ZB = (bf16_t*)(ws + OFF_ZB);
    const float* AB = (const float*)(ws + OFF_ABAR);
    const float ar = AB[(g * 64 + lane) * 2], ai = AB[(g * 64 + lane) * 2 + 1];
    const bf16_t* bbt = (const bf16_t*)(ws + OFF_BBT) + (size_t)g * 2048;
    const bf16_t* ct = (const bf16_t*)(ws + OFF_CT) + (size_t)g * 2048;
    bf16x8 Bf[8], Cf[4];
    const bf16x8 zero8 = {0, 0, 0, 0, 0, 0, 0, 0};
#pragma unroll
    for (int nt = 0; nt < 8; ++nt) Bf[nt] = (l4 < 2) ? *(const bf16x8*)(bbt + (nt * 16 + l15) * 16 + 8 * l4) : zero8;
#pragma unroll
    for (int s = 0; s < 4; ++s) Cf[s] = *(const bf16x8*)(ct + l15 * 128 + 32 * s + 8 * l4);
    const float dskip = p.in[18][g * 16 + l15];
    float hr = 0.f, hi = 0.f;
    const int last_tok = tok_base + (nsub - 1) * 16;
    {
        const bf16x8 A0 = (l4 < 2) ? *(const bf16x8*)(PB + (size_t)(tok_base + l15) * NPB + g * 16 + 8 * l4) : zero8;
        LAS float* BU = (LAS float*)wl;
#pragma unroll
        for (int nt = 0; nt < 8; ++nt) {
            f32x4 a = {0.f, 0.f, 0.f, 0.f};
            a = mfma16(A0, Bf[nt], a);
#pragma unroll
            for (int q = 0; q < 4; ++q) BU[(4 * l4 + q) * 128 + nt * 16 + l15] = a[q];
        }
    }
    const int tok1 = (nsub > 1) ? tok_base + 16 : tok_base;
    bf16x8 Au = (l4 < 2) ? *(const bf16x8*)(PB + (size_t)(tok1 + l15) * NPB + g * 16 + 8 * l4) : zero8;
    float uu[4];
#pragma unroll
    for (int q = 0; q < 4; ++q) uu[q] = bf2f(PB[(size_t)(tok_base + 4 * l4 + q) * NPB + g * 16 + l15]);
    WSYNC();
#pragma unroll 1
    for (int sc = 0; sc < nsub; ++sc) {
        const int tok0 = tok_base + sc * 16;
        LAS float* BU = (LAS float*)(wl + (sc & 1) * 8192);
        LAS float* BUn = (LAS float*)(wl + ((sc + 1) & 1) * 8192);
        const int tok2 = (tok0 + 32 <= last_tok) ? tok0 + 32 : last_tok;
        const int tokn = (tok0 + 16 <= last_tok) ? tok0 + 16 : last_tok;
        const bf16x8 Au_n = (l4 < 2) ? *(const bf16x8*)(PB + (size_t)(tok2 + l15) * NPB + g * 16 + 8 * l4) : zero8;
        float uu_n[4];
#pragma unroll
        for (int q = 0; q < 4; ++q) uu_n[q] = bf2f(PB[(size_t)(tokn + 4 * l4 + q) * NPB + g * 16 + l15]);
        if (sc + 1 < nsub) {
#pragma unroll
            for (int nt = 0; nt < 8; ++nt) {
                f32x4 a = {0.f, 0.f, 0.f, 0.f};
                a = mfma16(Au, Bf[nt], a);
#pragma unroll
                for (int q = 0; q < 4; ++q) BUn[(4 * l4 + q) * 128 + nt * 16 + l15] = a[q];
            }
        }
#pragma unroll
        for (int t = 0; t < 16; ++t) {
            if (sample && (t & 3) == 0) {
                const int bb = b0 + (t >> 2);
                hr = p.in[2][((size_t)bb * 64 + g) * 64 + lane]; hi = p.in[3][((size_t)bb * 64 + g) * 64 + lane];
            }
            const float br = BU[t * 128 + lane], bi = BU[t * 128 + 64 + lane];
            const float nr = ar * hr - ai * hi + br, ni = ar * hi + ai * hr + bi;
            hr = nr; hi = ni;
            HB[t * 136 + lane] = f2bf(hr); HB[t * 136 + 64 + lane] = f2bf(hi);
            if (sample && (t & 3) == 3) {
                const int bb = b0 + (t >> 2);
                p.out[O_SRE + ((size_t)bb * 64 + g) * 64 + lane] = hr; p.out[O_SIM + ((size_t)bb * 64 + g) * 64 + lane] = hi;
            }
        }
        WSYNC();
        f32x4 y = {0.f, 0.f, 0.f, 0.f};
#pragma unroll
        for (int s = 0; s < 4; ++s) {
            const bf16x8 Ah = *(const LAS bf16x8*)(HB + l15 * 136 + 32 * s + 8 * l4);
            y = mfma16(Ah, Cf[s], y);
        }
#pragma unroll
        for (int q = 0; q < 4; ++q) {
            const int tok = tok0 + 4 * l4 + q;
            ZB[(size_t)tok * 1024 + g * 16 + l15] = f2bf(gelu_tanh(y[q] + dskip * uu[q]));
        }
        WSYNC();
        Au = Au_n;
#pragma unroll
        for (int q = 0; q < 4; ++q) uu[q] = uu_n[q];
    }
    if (!sample) {
        const int b = tok_base >> 11;
        p.out[O_PRE + ((size_t)b * 64 + g) * 64 + lane] = hr; p.out[O_PIM + ((size_t)b * 64 + g) * 64 + lane] = hi;
    }
}

__device__ __forceinline__ void phase_scan(const Params& p, LAS unsigned char* lds) {
    const int wave = __builtin_amdgcn_readfirstlane(threadIdx.x >> 6);
    if (wave == 0) {
        for (int B = blockIdx.x; B < 128; B += gridDim.x) { const int xi = B & 7, idx = B >> 3; gdn_scan_unit(p, ((xi * 4 + (idx >> 2)) << 2) + (idx & 3), lds + GDN_LDS0); }
    }
    else if (wave == 1) { for (int u = blockIdx.x; u < 256; u += gridDim.x) s5_unit(p, u & 63, (u >> 6) * 2048, 128, false, 0, lds, 16384); }
}

__device__ __forceinline__ void phase_onorm(const Params& p) {
    unsigned char* ws = p.ws;
    int lane = threadIdx.x; asm volatile("" : "+v"(lane)); lane &= 63;
    const int wave = __builtin_amdgcn_readfirstlane(threadIdx.x >> 6);
    const bf16_t* O = (const bf16_t*)(ws + OFF_O); const bf16_t* PB = (const bf16_t*)(ws + OFF_PROJB);
    bf16_t* YM = (bf16_t*)(ws + OFF_YMIX);
    const float nw0 = p.in[24][2 * lane], nw1 = p.in[24][2 * lane + 1];
    for (int it4 = blockIdx.x * 8 + wave; it4 < NTOK * 2; it4 += gridDim.x * 8) {
        unsigned ov[4], gv[4];
#pragma unroll
        for (int j = 0; j < 4; ++j) {
            const int it = it4 * 4 + j, h = it & 7, tok = it >> 3;
            ov[j] = *(const unsigned*)(O + (size_t)tok * 1024 + h * 128 + 2 * lane);
            gv[j] = *(const unsigned*)(PB + (size_t)tok * NPB + 4096 + h * 128 + 2 * lane);
        }
        float ss[4];
#pragma unroll
        for (int j = 0; j < 4; ++j) { const float o0 = bflo(ov[j]), o1 = bfhi(ov[j]); ss[j] = o0 * o0 + o1 * o1; }
#pragma unroll
        for (int o = 1; o < 64; o <<= 1) {
#pragma unroll
            for (int j = 0; j < 4; ++j) ss[j] += __shfl_xor(ss[j], o);
        }
#pragma unroll
        for (int j = 0; j < 4; ++j) {
            const int it = it4 * 4 + j, h = it & 7, tok = it >> 3;
            const float o0 = bflo(ov[j]), o1 = bfhi(ov[j]);
            const float rs = 1.f / sqrtf(ss[j] * (1.f / 128.f) + 1e-6f);
            *(unsigned*)(YM + (size_t)tok * DM + 1024 + h * 128 + 2 * lane) = pk2(o0 * rs * nw0 * siluf(bflo(gv[j])), o1 * rs * nw1 * siluf(bfhi(gv[j])));
        }
    }
}

#define XB_TMO      128
#define XB_XCNT(j)  (256  + 64 * (j))
#define XB_XSUB(j)  (1280 + 64 * (j))
#define XB_XGEN(j)  (2304 + 64 * (j))
#define XB_TOP      3328
#define XB_TOPGEN   3392
#define XCD_BAR_WORDS 3456
#define XB_SPIN_CAP (1u << 18)
__device__ __forceinline__ unsigned xb_ld(unsigned* p)              { return __hip_atomic_load(p, __ATOMIC_RELAXED, __HIP_MEMORY_SCOPE_AGENT); }
__device__ __forceinline__ unsigned xb_add(unsigned* p, unsigned v) { return __hip_atomic_fetch_add(p, v, __ATOMIC_RELAXED, __HIP_MEMORY_SCOPE_AGENT); }
__device__ __forceinline__ unsigned xb_xcc_id() { return (unsigned)__builtin_amdgcn_s_getreg((3 << 11) | 20) & 0xFu; }
#define XB_SPIN(cond, bar) do { unsigned _sp = 0; while (cond) { __builtin_amdgcn_s_sleep(1); \
    if ((++_sp & 255u) == 0u) { if (xb_ld(&(bar)[XB_TMO])) break; if (_sp > XB_SPIN_CAP) { atomicAdd(&(bar)[XB_TMO], 1u); break; } } } } while (0)
struct XcdBarrier { unsigned* bar; unsigned x; volatile LAS unsigned* st; };
__device__ __forceinline__ XcdBarrier xcd_barrier_post(unsigned* bar, volatile LAS unsigned* st) {
    XcdBarrier b; b.bar = bar; b.x = xb_xcc_id(); b.st = st;
    if (threadIdx.x == 0) (void)xb_add(&bar[XB_XCNT(b.x)], 1u);
    return b;
}
__device__ __forceinline__ void xcd_barrier_complete(unsigned* bar, unsigned x, unsigned& nloc, unsigned& nx) {
    const unsigned G = gridDim.x * gridDim.y * gridDim.z;
    unsigned sum, cnt, mine, sp = 0u;
    for (;;) {
        sum = 0u; cnt = 0u; mine = 0u;
#pragma unroll
        for (unsigned j = 0; j < 16; ++j) { const unsigned c = xb_ld(&bar[XB_XCNT(j)]); sum += c; cnt += (c > 0u) ? 1u : 0u; mine = (j == x) ? c : mine; }
        if (sum == G) break;
        __builtin_amdgcn_s_sleep(1);
        if ((++sp & 255u) == 0u) { if (xb_ld(&bar[XB_TMO])) break; if (sp > XB_SPIN_CAP) { atomicAdd(&bar[XB_TMO], 1u); break; } }
    }
    nloc = mine > 0u ? mine : 1u; nx = cnt > 0u ? cnt : 1u;
}
__device__ __forceinline__ void xcd_barrier(const XcdBarrier& b) {
    asm volatile("s_waitcnt vmcnt(0)" ::: "memory");
    __syncthreads();
    if (threadIdx.x == 0) {
        unsigned* bar = b.bar;
        __builtin_amdgcn_s_waitcnt(0);
        unsigned nloc = b.st[0], nx = b.st[1];
        if (nloc == 0u) { xcd_barrier_complete(bar, b.x, nloc, nx); b.st[0] = nloc; b.st[1] = nx; }
        const unsigned old = xb_add(&bar[XB_XSUB(b.x)], 1u);
        const unsigned gen = old / nloc;
        if (old + 1u == (gen + 1u) * nloc) {
            __builtin_amdgcn_fence(__ATOMIC_RELEASE, "agent");
            asm volatile("s_waitcnt vmcnt(0)" ::: "memory");
            const unsigned og = xb_add(&bar[XB_TOP], 1u);
            const unsigned tg = og / nx;
            if (og + 1u == (tg + 1u) * nx) xb_add(&bar[XB_TOPGEN], 1u);
            else XB_SPIN(xb_ld(&bar[XB_TOPGEN]) == tg, bar);
            __builtin_amdgcn_fence(__ATOMIC_ACQUIRE, "agent");
            xb_add(&bar[XB_XGEN(b.x)], 1u);
            asm volatile("s_waitcnt vmcnt(0)" ::: "memory");
        } else {
            XB_SPIN(xb_ld(&bar[XB_XGEN(b.x)]) == gen, bar);
            __builtin_amdgcn_fence(__ATOMIC_ACQUIRE, "agent");
            asm volatile("s_waitcnt vmcnt(0)" ::: "memory");
        }
    }
    __syncthreads();
}

__global__ void __launch_bounds__(512, 2) fwd_megakernel(Params p) {
    extern __shared__ __attribute__((aligned(16))) unsigned char shm[];
    LAS unsigned char* lds = (LAS unsigned char*)shm;
    cg::grid_group grid = cg::this_grid();
    unsigned char* ws = p.ws;
    pg8::StaticOrder S;
    volatile LAS unsigned* bst = (volatile LAS unsigned*)(lds + 147456 - 16);
    if (threadIdx.x == 0) { bst[0] = 0u; bst[1] = 0u; }
    __syncthreads();
    const XcdBarrier xb = xcd_barrier_post((unsigned*)(ws + OFF_BAR), bst);
    phase_convert0(p, lds);
    grid.sync();
    if (STOP_AFTER <= 0) return;
    { S.init(NTOK, 2 * DFF, DM, gridDim.x, blockIdx.x, false); pg8::Gemm g{(const bf16_t*)(ws + OFF_XNB), (const bf16_t*)(ws + OFF_W1T), NTOK, 2 * DFF, DM};
      EpiSwiglu E{(bf16_t*)(ws + OFF_H)}; pg8::gemm_phase(lds, g, S, E); }
    xcd_barrier(xb);
    { S.init(NTOK, DM, DFF, gridDim.x, blockIdx.x, true); pg8::Gemm g{(const bf16_t*)(ws + OFF_H), (const bf16_t*)(ws + OFF_W1O), NTOK, DM, DFF};
      EpiResid E{(bf16_t*)(ws + OFF_R), p.in[0], p.in[1], (float*)(ws + OFF_PART), (const bf16_t*)(ws + OFF_XNB), 0.5f}; pg8::gemm_phase(lds, g, S, E); }
    __syncthreads();
    phase_convert_mid(p, lds, S.tail_busy());
    xcd_barrier(xb);
    phase_ln((const bf16_t*)(ws + OFF_R), p.in[6], p.in[7], nullptr, (bf16_t*)(ws + OFF_XRB), S.mode == 1 ? (const float*)(ws + OFF_PART) : nullptr, p.in[1], nullptr);
    xcd_barrier(xb);
    if (STOP_AFTER <= 3) return;
    { S.init(NTOK, NMIXP, DM, gridDim.x, blockIdx.x, false); pg8::Gemm g{(const bf16_t*)(ws + OFF_XRB), (const bf16_t*)(ws + OFF_WMI), NTOK, NMIXP, DM};
      EpiMixIn E{(bf16_t*)(ws + OFF_PROJB), (float*)(ws + OFF_BD)}; pg8::gemm_phase(lds, g, S, E); }
    xcd_barrier(xb);
    phase_conv(p);
    xcd_barrier(xb);
    if (STOP_AFTER <= 4) return;
    phase_gdn_prep(p, lds);
    xcd_barrier(xb);
    phase_scan(p, lds);
    xcd_barrier(xb);
    if (STOP_AFTER <= 5) return;
    phase_onorm(p);
    __syncthreads();
    { S.init(NTOK, 1024, 1024, gridDim.x, blockIdx.x, false); pg8::Gemm g{(const bf16_t*)(ws + OFF_ZB), (const bf16_t*)(ws + OFF_GLU), NTOK, 1024, 1024};
      EpiGlu E{(bf16_t*)(ws + OFF_YMIX), (const bf16_t*)(ws + OFF_ZB), p.in[20]}; pg8::gemm_phase(lds, g, S, E);
      __syncthreads();
      if (S.nwg < (int)gridDim.x) transpose_matrix(p.in[29], DFF, DM, (bf16_t*)(ws + OFF_W1O), 0, (LAS float*)lds, S.nwg); }
    xcd_barrier(xb);
    { S.init(NTOK, DM, DM, gridDim.x, blockIdx.x, true); pg8::Gemm g{(const bf16_t*)(ws + OFF_YMIX), (const bf16_t*)(ws + OFF_WMO), NTOK, DM, DM};
      EpiResid E{(bf16_t*)(ws + OFF_R), nullptr, nullptr, (float*)(ws + OFF_PART), (const bf16_t*)(ws + OFF_XRB), 1.0f}; pg8::gemm_phase(lds, g, S, E); }
    __syncthreads();
    phase_convert1(p, lds, S.tail_busy(), gridDim.x > 136);
    xcd_barrier(xb);
    phase_ln((const bf16_t*)(ws + OFF_R), p.in[26], p.in[27], nullptr, (bf16_t*)(ws + OFF_XRB), S.mode == 1 ? (const float*)(ws + OFF_PART) : nullptr, nullptr, (const bf16_t*)(ws + OFF_XRB) + (size_t)NPR * DM);
    xcd_barrier(xb);
    { S.init(NTOK, 2 * DFF, DM, gridDim.x, blockIdx.x, false); pg8::Gemm g{(const bf16_t*)(ws + OFF_XRB), (const bf16_t*)(ws + OFF_W1T), NTOK, 2 * DFF, DM};
      EpiSwiglu E{(bf16_t*)(ws + OFF_H)}; pg8::gemm_phase(lds, g, S, E); }
    xcd_barrier(xb);
    { S.init(NTOK, DM, DFF, gridDim.x, blockIdx.x, true); pg8::Gemm g{(const bf16_t*)(ws + OFF_H), (const bf16_t*)(ws + OFF_W1O), NTOK, DM, DFF};
      EpiResid E{(bf16_t*)(ws + OFF_R), nullptr, nullptr, (float*)(ws + OFF_PART), (const bf16_t*)(ws + OFF_XRB), 0.5f}; pg8::gemm_phase(lds, g, S, E); }
    xcd_barrier(xb);
    phase_ln((const bf16_t*)(ws + OFF_R), p.in[30], p.in[31], p.out + O_Y, nullptr, S.mode == 1 ? (const float*)(ws + OFF_PART) : nullptr, nullptr, (const bf16_t*)(ws + OFF_XRB) + (size_t)NPR * DM);
}

extern "C" void kernel_launch(void* const* d_in, const int* in_sizes, int n_in, void* d_out, int out_size, void* d_ws, size_t ws_size, hipStream_t stream) {
    constexpr int LDS_BYTES = 147456;
    static int grid_blocks = 0;
    if (grid_blocks == 0) {
        int dev = 0, cus = 0, per_cu = 0;
        hipGetDevice(&dev);
        hipDeviceGetAttribute(&cus, hipDeviceAttributeMultiprocessorCount, dev);
        hipFuncSetAttribute((const void*)fwd_megakernel, hipFuncAttributeMaxDynamicSharedMemorySize, LDS_BYTES);
        hipOccupancyMaxActiveBlocksPerMultiprocessor(&per_cu, (const void*)fwd_megakernel, 512, LDS_BYTES);
        if (per_cu < 1) { fprintf(stderr, "occupancy query returned %d\n", per_cu); per_cu = 1; }
        grid_blocks = cus * 1;
        if (ws_size < WS_END) fprintf(stderr, "workspace too small: %zu < %zu\n", ws_size, (size_t)WS_END);
    }
    (void)hipMemsetAsync((unsigned char*)d_ws + OFF_BAR, 0, XCD_BAR_WORDS * 4, stream);
    Params p{};
    for (int i = 0; i < 32; ++i) p.in[i] = (const float*)d_in[i];
    p.out = (float*)d_out; p.ws = (unsigned char*)d_ws;
    void* args[] = {&p};
    hipError_t e = hipLaunchCooperativeKernel((const void*)fwd_megakernel, dim3(grid_blocks), dim3(512), args, LDS_BYTES, stream);
    if (e != hipSuccess) fprintf(stderr, "cooperative launch failed: %s (grid %d)\n", hipGetErrorString(e), grid_blocks);
}
```

```cpp
#include <hip/hip_runtime.h>
#include <hip/hip_cooperative_groups.h>
#include <cstdio>
namespace cg = cooperative_groups;

#define LAS __attribute__((address_space(3)))
typedef unsigned short bf16_t;
typedef short bf16x8 __attribute__((ext_vector_type(8)));
typedef float f32x4 __attribute__((ext_vector_type(4)));
typedef float f32x16 __attribute__((ext_vector_type(16)));
typedef unsigned u32x4 __attribute__((ext_vector_type(4)));
typedef unsigned u32x2 __attribute__((ext_vector_type(2)));

#ifndef STOP_AFTER
#define STOP_AFTER 99
#endif

constexpr int NTOK = 8704, NPR = 8192, DM = 2048, DFF = 5632, NMIX = 5136, NMIXP = 5376, NPB = 5120;
constexpr float ALPHA = 1.189207115002721f;

constexpr size_t O_Y = 0, O_PRE = 17825792, O_PIM = 17842176, O_PGDN = 17858560, O_PCONV = 18382848,
                 O_SRE = 18419712, O_SIM = 18944000, O_SGDN = 19468288, O_SCONV = 36245504;

constexpr size_t SZ_W1T = (size_t)11264 * 2048 * 2, SZ_W1O = (size_t)2048 * 5632 * 2;
constexpr size_t OFF_W1T = 0;
constexpr size_t OFF_W1O = OFF_W1T + SZ_W1T;
constexpr size_t OFF_WMI = OFF_W1O + SZ_W1O;
constexpr size_t OFF_GLU = OFF_WMI + (size_t)NMIXP * 2048 * 2;
constexpr size_t OFF_WMO = OFF_GLU + (size_t)1024 * 1024 * 2;
constexpr size_t OFF_XNB = OFF_WMO + (size_t)2048 * 2048 * 2;
constexpr size_t OFF_XN  = OFF_XNB + (size_t)NTOK * 2048 * 2;
constexpr size_t OFF_R   = OFF_XN + (size_t)NTOK * 2048 * 4;
constexpr size_t OFF_H   = OFF_R + (size_t)NTOK * 2048 * 4;
constexpr size_t OFF_KDT = OFF_H + (size_t)NTOK * DFF * 2;
constexpr size_t SZ_CH   = (size_t)1024 * 64 * 128 * 2;
constexpr size_t OFF_TBT = OFF_KDT + SZ_CH;
constexpr size_t OFF_O   = OFF_TBT + (size_t)1024 * 64 * 64 * 2;
constexpr size_t OFF_ZB  = OFF_O + (size_t)NTOK * 1024 * 2;
constexpr size_t OFF_BBT = OFF_ZB + (size_t)NTOK * 1024 * 2;
constexpr size_t OFF_CT  = OFF_BBT + 262144;
constexpr size_t OFF_ABAR = OFF_CT + 262144;
constexpr size_t OFF_GLAST = OFF_ABAR + 32768;
constexpr size_t OFF_BAR = OFF_GLAST + 4096;
constexpr size_t OFF_PART = OFF_BAR + 16384;
constexpr size_t WS_END  = OFF_PART + (size_t)4 * 512 * 2048 * 4;
constexpr size_t OFF_PROJB = OFF_H;
constexpr size_t OFF_XRB = OFF_XN;
constexpr size_t OFF_YMIX = OFF_XN + (size_t)NTOK * 2048 * 2;
constexpr size_t OFF_QN = OFF_R, OFF_KN = OFF_QN + (size_t)NPR * 1024 * 2, OFF_VV = OFF_KN + (size_t)NPR * 1024 * 2;
constexpr size_t OFF_G = OFF_VV + (size_t)NPR * 1024 * 4;
constexpr size_t OFF_BETA = OFF_G + (size_t)NTOK * 8 * 4;
constexpr size_t OFF_BD = OFF_BETA + (size_t)NTOK * 8 * 4;
constexpr size_t OFF_KT = OFF_W1T, OFF_ATT = OFF_KT + SZ_CH, OFF_QG = OFF_ATT + (size_t)1024 * 64 * 64 * 2, OFF_KG = OFF_QG + SZ_CH;
constexpr size_t OFF_QKVS = OFF_KG + SZ_CH;
static_assert(OFF_BD + (size_t)NTOK * 16 * 4 <= OFF_H, "R alias overflow");
static_assert(OFF_QKVS + (size_t)512 * 3072 * 4 <= OFF_WMI, "W1 alias overflow");

struct Params { const float* in[32]; float* out; unsigned char* ws; };

typedef __bf16 bf16v2_t __attribute__((ext_vector_type(2)));
typedef float f32v2_t __attribute__((ext_vector_type(2)));
__device__ __forceinline__ unsigned pk2(float lo, float hi) { f32v2_t v = {lo, hi}; bf16v2_t b = __builtin_convertvector(v, bf16v2_t); return __builtin_bit_cast(unsigned, b); }
__device__ __forceinline__ bf16_t f2bf(float f) { return (bf16_t)(pk2(f, 0.f) & 0xffffu); }
__device__ __forceinline__ float bf2f(bf16_t b) { return __uint_as_float(((unsigned)b) << 16); }
__device__ __forceinline__ float bflo(unsigned u) { return __uint_as_float(u << 16); }
__device__ __forceinline__ float bfhi(unsigned u) { return __uint_as_float(u & 0xffff0000u); }
__device__ __forceinline__ float wave_sum(float v) {
#pragma unroll
    for (int o = 1; o < 64; o <<= 1) v += __shfl_xor(v, o);
    return v;
}
__device__ __forceinline__ float siluf(float x) { return x / (1.f + __expf(-x)); }
__device__ __forceinline__ float sigmf(float x) { return 1.f / (1.f + __expf(-x)); }
__device__ __forceinline__ float gelu_tanh(float y) {
    const float t = 0.7978845608028654f * (y + 0.044715f * y * y * y);
    const float th = 1.f - 2.f / (1.f + __expf(2.f * t));
    return 0.5f * y * (1.f + th);
}
#define WSYNC() asm volatile("s_waitcnt lgkmcnt(0)" ::: "memory")

namespace pg8 {
constexpr int BM = 256, BK = 64, HALF = 128, HTB = HALF * BK * 2, STAGE_BYTES = 8 * HTB, NXCD = 8, WGM = 8;
__host__ __device__ __forceinline__ int lds_byte(int r, int c) { const int st = (r >> 4) * 2 + (c >> 5), rr = r & 15, cc = c & 31, ob = rr * 64 + cc * 2; return st * 1024 + (ob ^ (((ob >> 9) & 1) << 5)); }
__host__ __device__ __forceinline__ void stage_rc(int b, int& R, int& C) { const int st = b / 1024, sb = b % 1024, swz = sb ^ (((sb >> 9) & 1) << 5); R = (st >> 1) * 16 + swz / 64; C = (st & 1) * 32 + (swz % 64) / 2; }
__host__ __device__ __forceinline__ int perm32(int rho) { const int n = rho >> 4, i = rho & 15; return 8 * (i >> 2) + 4 * n + (i & 3); }
struct Unit { int pm, pn, k0, nk, part, sp; };
struct Gemm { const bf16_t* A; const bf16_t* Bt; int M, N, K; };
struct StaticOrder {
    int nM, nN, nwg, G, c, ntK, mode, nsp;
    __device__ __forceinline__ void init(int M, int N, int K, int G_, int c_, bool split) {
        nM = M / BM; nN = N / BM; nwg = nM * nN; G = G_; c = c_; ntK = K / BK;
        mode = (split && G == 256 && nM == 34 && nN == 8 && (ntK % 8) == 0) ? 1 : 0; nsp = 4;
    }
    __device__ __forceinline__ void map(int L, Unit& u, int nMl) const {
        const int nw = nMl * nN;
        int wgid = L; { const int q = nw / NXCD, r = nw % NXCD, xcd = wgid % NXCD, off = wgid / NXCD; wgid = (xcd < r ? xcd * (q + 1) : r * (q + 1) + (xcd - r) * q) + off; }
        const int nig = WGM * nN, gid = wgid / nig, fm = gid * WGM, gsz = (nMl - fm) < WGM ? (nMl - fm) : WGM;
        u.pm = fm + ((wgid % nig) % gsz); u.pn = (wgid % nig) / gsz;
    }
    __device__ __forceinline__ int tail_busy() const { return mode == 1 ? 16 * nsp : (((nwg % G) * 2 <= G) ? (nwg % G) : 0); }
    __device__ __forceinline__ bool next_(int i, Unit& u) const {
        u.pm = 0; u.pn = 0; u.k0 = 0; u.nk = ntK; u.part = 0; u.sp = 0;
        if (mode == 0) { const long L = (long)i * G + c; if (L >= nwg) return false; map((int)L, u, nM); return true; }
        if (i == 0) { map(c, u, 32); return true; }
        if (i == 1 && c < 16 * nsp) {
            const int lsp = (nsp == 8) ? 3 : 2;
            const int tt = c >> lsp; u.pm = 32 + (tt & 1); u.pn = tt >> 1; u.sp = c & (nsp - 1);
            const int pairs = ntK >> 1, base = pairs >> lsp, rem = pairs & (nsp - 1);
            u.k0 = 2 * (u.sp * base + (u.sp < rem ? u.sp : rem)); u.nk = 2 * (base + (u.sp < rem ? 1 : 0)); u.part = 1; return true; }
        return false;
    }
    __device__ __forceinline__ bool next(int i, Unit& u) const {
        const bool ok = next_(i, u);
        u.pm = __builtin_amdgcn_readfirstlane(u.pm); u.pn = __builtin_amdgcn_readfirstlane(u.pn); u.k0 = __builtin_amdgcn_readfirstlane(u.k0);
        u.nk = __builtin_amdgcn_readfirstlane(u.nk); u.part = __builtin_amdgcn_readfirstlane(u.part); u.sp = __builtin_amdgcn_readfirstlane(u.sp);
        return __builtin_amdgcn_readfirstlane((int)ok) != 0;
    }
};

template <class Epi>
__device__ __forceinline__ void gemm_phase(LAS unsigned char* lds, const Gemm g, const StaticOrder& S, const Epi& E) {
    int tid = threadIdx.x; asm volatile("" : "+v"(tid));
    const int wid = __builtin_amdgcn_readfirstlane(tid >> 6), lane = tid & 63, wr = wid >> 2, wc = wid & 3, fr = lane & 15, fq = lane >> 4;
    const int K = g.K;
    unsigned voffA[2], voffB[2];
#pragma unroll
    for (int i = 0; i < 2; ++i) { int R, C; stage_rc(tid * 16 + i * 8192, R, C); const int Rb = Epi::PERM ? ((R & ~31) + perm32(R & 31)) : R;
        voffA[i] = (unsigned)(R * K + C) * 2u; voffB[i] = (unsigned)(Rb * K + C) * 2u; }
    const size_t kstep = (size_t)(BK * 2);
    const size_t hstep = (size_t)HALF * K * 2;
    const size_t tstep = 2 * hstep;
    const unsigned ldsw = (unsigned)wid * 1024u;
    const int aoff = lds_byte(wr * 64 + fr, fq * 8), boff = lds_byte(wc * 32 + fr, fq * 8);
#define PG8_SA(b, h) (((b) * 2 + (h)) * HTB)
#define PG8_SB(b, h) ((4 + (b) * 2 + (h)) * HTB)
#define PG8_STAGE(bufoff, gbase, voff) do { _Pragma("unroll") for (int _i = 0; _i < 2; ++_i) \
        __builtin_amdgcn_global_load_lds((const unsigned*)((const char*)(gbase) + (voff)[_i]), (LAS unsigned*)(lds + (bufoff) + ldsw + _i * 8192), 16, 0, 0); } while (0)
#define PG8_LDA(dst, b, h) do { _Pragma("unroll") for (int m = 0; m < 4; ++m) _Pragma("unroll") for (int k = 0; k < 2; ++k) dst[m][k] = *(const LAS bf16x8*)(lds + PG8_SA(b, h) + aoff + m * 2048 + k * 1024); } while (0)
#define PG8_LDB(dst, b, h) do { _Pragma("unroll") for (int n = 0; n < 2; ++n) _Pragma("unroll") for (int k = 0; k < 2; ++k) dst[n][k] = *(const LAS bf16x8*)(lds + PG8_SB(b, h) + boff + n * 2048 + k * 1024); } while (0)
#define PG8_MMA(ai, bj, At, Bt) do { __builtin_amdgcn_s_setprio(1); _Pragma("unroll") for (int m = 0; m < 4; ++m) _Pragma("unroll") for (int n = 0; n < 2; ++n) _Pragma("unroll") for (int k = 0; k < 2; ++k) \
        acc[ai][bj][m][n] = __builtin_amdgcn_mfma_f32_16x16x32_bf16(Bt[n][k], At[m][k], acc[ai][bj][m][n], 0, 0, 0); __builtin_amdgcn_s_setprio(0); } while (0)
#define PG8_WAIT_V(n) asm volatile("s_waitcnt vmcnt(" #n ")" ::: "memory")
#define PG8_WAIT_L(n) asm volatile("s_waitcnt lgkmcnt(" #n ")" ::: "memory")
#define PG8_BAR __builtin_amdgcn_s_barrier()
#define PG8_SCHED __builtin_amdgcn_sched_barrier(0)
    Unit cur, nxt; int ui = 0;
    if (!S.next(0, cur)) return;
    f32x4 acc[2][2][4][2];
#pragma unroll
    for (int a = 0; a < 2; ++a)
#pragma unroll
        for (int b = 0; b < 2; ++b)
#pragma unroll
            for (int m = 0; m < 4; ++m)
#pragma unroll
                for (int n = 0; n < 2; ++n) acc[a][b][m][n] = (f32x4){0.f, 0.f, 0.f, 0.f};
    bf16x8 At[4][2], B0[2][2], B1[2][2];
    const char* cA = (const char*)g.A + (size_t)cur.pm * tstep + (size_t)cur.k0 * kstep; const char* cB = (const char*)g.Bt + (size_t)cur.pn * tstep + (size_t)cur.k0 * kstep;
    PG8_STAGE(PG8_SB(0, 0), cB, voffB); PG8_STAGE(PG8_SA(0, 0), cA, voffA); PG8_STAGE(PG8_SB(0, 1), cB + hstep, voffB); PG8_STAGE(PG8_SA(0, 1), cA + hstep, voffA);
    if (wr == 1) PG8_BAR;
    PG8_WAIT_V(4); PG8_BAR;
    PG8_STAGE(PG8_SB(1, 0), cB + kstep, voffB); PG8_STAGE(PG8_SA(1, 0), cA + kstep, voffA); PG8_STAGE(PG8_SB(1, 1), cB + hstep + kstep, voffB);
    PG8_WAIT_V(6); PG8_BAR;
    for (;;) {
        const bool has_next = S.next(ui + 1, nxt);
        const char* nA = has_next ? (const char*)g.A + (size_t)nxt.pm * tstep + (size_t)nxt.k0 * kstep : cA; const char* nB = has_next ? (const char*)g.Bt + (size_t)nxt.pn * tstep + (size_t)nxt.k0 * kstep : cB;
        const int nt = cur.nk;
        for (int t = 0; t < nt; t += 2) {
            const bool last = (t == nt - 2);
            const char* a1 = cA + (size_t)(t + 1) * kstep;
            const char* a2 = last ? nA : cA + (size_t)(t + 2) * kstep; const char* b2 = last ? nB : cB + (size_t)(t + 2) * kstep;
            const char* a3 = a2 + kstep; const char* b3 = b2 + kstep;
            PG8_LDB(B0, 0, 0); PG8_SCHED; PG8_LDA(At, 0, 0); PG8_STAGE(PG8_SA(1, 1), a1 + hstep, voffA);
            PG8_WAIT_L(8); PG8_BAR; PG8_WAIT_L(0); PG8_MMA(0, 0, At, B0); PG8_BAR; PG8_SCHED;
            PG8_LDB(B1, 0, 1); PG8_STAGE(PG8_SB(0, 0), b2, voffB);
            PG8_BAR; PG8_WAIT_L(0); PG8_MMA(0, 1, At, B1); PG8_BAR;
            PG8_LDA(At, 0, 1); PG8_STAGE(PG8_SA(0, 0), a2, voffA);
            PG8_BAR; PG8_WAIT_L(0); PG8_MMA(1, 0, At, B0); PG8_BAR; PG8_SCHED;
            PG8_STAGE(PG8_SB(0, 1), b2 + hstep, voffB);
            PG8_WAIT_V(6); PG8_BAR; PG8_MMA(1, 1, At, B1); PG8_BAR;
            PG8_LDB(B0, 1, 0); PG8_SCHED; PG8_LDA(At, 1, 0); PG8_STAGE(PG8_SA(0, 1), a2 + hstep, voffA);
            PG8_WAIT_L(8); PG8_BAR; PG8_WAIT_L(0); PG8_MMA(0, 0, At, B0); PG8_BAR; PG8_SCHED;
            PG8_LDB(B1, 1, 1); PG8_STAGE(PG8_SB(1, 0), b3, voffB);
            PG8_BAR; PG8_WAIT_L(0); PG8_MMA(0, 1, At, B1); PG8_BAR;
            PG8_LDA(At, 1, 1); PG8_STAGE(PG8_SA(1, 0), a3, voffA);
            PG8_BAR; PG8_WAIT_L(0); PG8_MMA(1, 0, At, B0); PG8_BAR; PG8_SCHED;
            PG8_STAGE(PG8_SB(1, 1), b3 + hstep, voffB);
            PG8_WAIT_V(6); PG8_BAR; PG8_MMA(1, 1, At, B1); PG8_BAR;
        }
        E(acc, cur, wr, wc, fr, fq);
        if (!has_next) break;
#pragma unroll
        for (int a = 0; a < 2; ++a)
#pragma unroll
            for (int b = 0; b < 2; ++b)
#pragma unroll
                for (int m = 0; m < 4; ++m)
#pragma unroll
                    for (int n = 0; n < 2; ++n) acc[a][b][m][n] = (f32x4){0.f, 0.f, 0.f, 0.f};
        cur = nxt; cA = nA; cB = nB; ++ui;
    }
    PG8_WAIT_V(0);
    if (wr == 0) PG8_BAR;
    PG8_BAR;
#undef PG8_SA
#undef PG8_SB
#undef PG8_STAGE
#undef PG8_LDA
#undef PG8_LDB
#undef PG8_MMA
#undef PG8_WAIT_V
#undef PG8_WAIT_L
#undef PG8_BAR
#undef PG8_SCHED
}
}
using pg8::Unit;

struct EpiSwiglu {
    static constexpr bool PERM = true;
    bf16_t* H;
    __device__ __forceinline__ void operator()(const f32x4 (&acc)[2][2][4][2], const Unit& u, int wr, int wc, int fr, int fq) const {
        const int row0 = u.pm * 256 + wr * 64 + fr, col0 = u.pn * 128 + wc * 32 + 8 * fq;
#pragma unroll
        for (int ai = 0; ai < 2; ++ai)
#pragma unroll
            for (int m = 0; m < 4; ++m) {
                const f32x4 g0 = acc[ai][0][m][0], g1 = acc[ai][0][m][1], u0 = acc[ai][1][m][0], u1 = acc[ai][1][m][1];
                u32x4 o;
                o.x = pk2(siluf(g0[0]) * u0[0], siluf(g0[1]) * u0[1]); o.y = pk2(siluf(g0[2]) * u0[2], siluf(g0[3]) * u0[3]);
                o.z = pk2(siluf(g1[0]) * u1[0], siluf(g1[1]) * u1[1]); o.w = pk2(siluf(g1[2]) * u1[2], siluf(g1[3]) * u1[3]);
                *(u32x4*)(H + (size_t)(row0 + ai * 128 + m * 16) * DFF + col0) = o;
            }
    }
};
struct EpiResid {
    static constexpr bool PERM = false;
    bf16_t* R; const float* X0; const float* X1; float* P; float* P2; const bf16_t* XB; float scale;
    __device__ __forceinline__ void operator()(const f32x4 (&acc)[2][2][4][2], const Unit& u, int wr, int wc, int fr, int fq) const {
        float* const Pb = (u.sp < 4 ? P : P2) + (size_t)(u.sp & 3) * 512 * DM;
        const int row0 = u.pm * 256 + wr * 64 + fr, col0 = u.pn * 256 + wc * 32 + 4 * fq;
#pragma unroll
        for (int ai = 0; ai < 2; ++ai)
#pragma unroll
            for (int m = 0; m < 4; ++m) {
                const int row = row0 + ai * 128 + m * 16;
                const float* xr = (XB != nullptr) ? nullptr : (row < NPR ? X0 + (size_t)row * DM : X1 + (size_t)(row - NPR) * DM) + col0;
                bf16_t* rp = R + (size_t)row * DM + col0;
#pragma unroll
                for (int bj = 0; bj < 2; ++bj)
#pragma unroll
                    for (int n = 0; n < 2; ++n) {
                        if (!u.part) {
                            f32x4 xv;
                            if (XB != nullptr) { const u32x2 xb2 = *(const u32x2*)(XB + (size_t)row * DM + col0 + bj * 128 + n * 16); xv = (f32x4){bflo(xb2.x), bfhi(xb2.x), bflo(xb2.y), bfhi(xb2.y)}; }
                            else xv = *(const f32x4*)(xr + bj * 128 + n * 16);
                            const f32x4 rv = xv * ALPHA + acc[ai][bj][m][n] * scale;
                            u32x2 ro; ro.x = pk2(rv[0], rv[1]); ro.y = pk2(rv[2], rv[3]);
                            *(u32x2*)(rp + bj * 128 + n * 16) = ro;
                        } else {
                            *(f32x4*)(Pb + (size_t)(row - NPR) * DM + col0 + bj * 128 + n * 16) = acc[ai][bj][m][n] * scale;
                        }
                    }
            }
    }
};
struct EpiMixIn {
    static constexpr bool PERM = true;
    bf16_t* PB; float* BD;
    __device__ __forceinline__ void operator()(const f32x4 (&acc)[2][2][4][2], const Unit& u, int wr, int wc, int fr, int fq) const {
        const int row0 = u.pm * 256 + wr * 64 + fr;
        if (u.pn < 20) {
            const int col0 = u.pn * 256 + wc * 32 + 8 * fq;
#pragma unroll
            for (int ai = 0; ai < 2; ++ai)
#pragma unroll
                for (int m = 0; m < 4; ++m)
#pragma unroll
                    for (int bj = 0; bj < 2; ++bj) {
                        const f32x4 v0 = acc[ai][bj][m][0], v1 = acc[ai][bj][m][1];
                        u32x4 o; o.x = pk2(v0[0], v0[1]); o.y = pk2(v0[2], v0[3]); o.z = pk2(v1[0], v1[1]); o.w = pk2(v1[2], v1[3]);
                        *(u32x4*)(PB + (size_t)(row0 + ai * 128 + m * 16) * NPB + col0 + bj * 128) = o;
                    }
        } else if (wc == 0 && fq < 2) {
#pragma unroll
            for (int ai = 0; ai < 2; ++ai)
#pragma unroll
                for (int m = 0; m < 4; ++m) {
                    float* bp = BD + (size_t)(row0 + ai * 128 + m * 16) * 16 + 8 * fq;
                    *(f32x4*)(bp) = acc[ai][0][m][0]; *(f32x4*)(bp + 4) = acc[ai][0][m][1];
                }
        }
    }
};
struct EpiGlu {
    static constexpr bool PERM = true;
    bf16_t* YM; const bf16_t* ZB; const float* bias;
    __device__ __forceinline__ void operator()(const f32x4 (&acc)[2][2][4][2], const Unit& u, int wr, int wc, int fr, int fq) const {
        const int row0 = u.pm * 256 + wr * 64 + fr, col0 = u.pn * 256 + wc * 32 + 8 * fq;
#pragma unroll
        for (int bj = 0; bj < 2; ++bj) {
            const f32x4 b0 = *(const f32x4*)(bias + col0 + bj * 128), b1 = *(const f32x4*)(bias + col0 + bj * 128 + 4);
#pragma unroll
            for (int ai = 0; ai < 2; ++ai)
#pragma unroll
                for (int m = 0; m < 4; ++m) {
                    const int row = row0 + ai * 128 + m * 16;
                    const u32x4 zz = *(const u32x4*)(ZB + (size_t)row * 1024 + col0 + bj * 128);
                    const f32x4 v0 = acc[ai][bj][m][0] + b0, v1 = acc[ai][bj][m][1] + b1;
                    u32x4 o;
                    o.x = pk2(bflo(zz.x) * sigmf(v0[0]), bfhi(zz.x) * sigmf(v0[1])); o.y = pk2(bflo(zz.y) * sigmf(v0[2]), bfhi(zz.y) * sigmf(v0[3]));
                    o.z = pk2(bflo(zz.z) * sigmf(v1[0]), bfhi(zz.z) * sigmf(v1[1])); o.w = pk2(bflo(zz.w) * sigmf(v1[2]), bfhi(zz.w) * sigmf(v1[3]));
                    *(u32x4*)(YM + (size_t)row * DM + col0 + bj * 128) = o;
                }
        }
    }
};

__device__ __forceinline__ void transpose_tile(const float* __restrict__ W, int K, int N, bf16_t* __restrict__ WT, int kt, int nt, int mode, LAS float* tile) {
    int tid = threadIdx.x; asm volatile("" : "+v"(tid));
    const int k0 = kt * 64, n0 = nt * 256;
    f32x4 v[8];
#pragma unroll
    for (int i = 0; i < 8; ++i) {
        const int idx = tid + 512 * i, rr = idx >> 6, c4 = (idx & 63) * 4;
        v[i] = (f32x4){0.f, 0.f, 0.f, 0.f};
        if (n0 + c4 < N) v[i] = *(const f32x4*)(W + (size_t)(k0 + rr) * N + n0 + c4);
    }
#pragma unroll
    for (int i = 0; i < 8; ++i) {
        const int idx = tid + 512 * i, rr = idx >> 6, c4 = (idx & 63) * 4;
        tile[rr * 257 + c4 + 0] = v[i][0]; tile[rr * 257 + c4 + 1] = v[i][1]; tile[rr * 257 + c4 + 2] = v[i][2]; tile[rr * 257 + c4 + 3] = v[i][3];
    }
    __syncthreads();
#pragma unroll
    for (int j = 0; j < 4; ++j) {
        const int id = tid + 512 * j, n = id >> 3, kc = id & 7;
        float f[8];
#pragma unroll
        for (int e = 0; e < 8; ++e) f[e] = tile[(kc * 8 + e) * 257 + n];
        const int nn = n0 + n; int drow = nn;
        if (mode == 1) { const int isup = nn >= DFF; const int jj = isup ? nn - DFF : nn; drow = (jj >> 7) * 256 + isup * 128 + (jj & 127); }
        u32x4 o; o.x = pk2(f[0], f[1]); o.y = pk2(f[2], f[3]); o.z = pk2(f[4], f[5]); o.w = pk2(f[6], f[7]);
        *(u32x4*)(WT + (size_t)drow * K + k0 + kc * 8) = o;
    }
    __syncthreads();
}
__device__ __forceinline__ void transpose_matrix(const float* W, int K, int N, bf16_t* WT, int mode, LAS float* tile, int b0 = 0) {
    const int nkt = K / 64, nnt = (N + 255) / 256, tot = nkt * nnt;
    if ((int)blockIdx.x < b0) return;
    for (int t = blockIdx.x - b0; t < tot; t += gridDim.x - b0) transpose_tile(W, K, N, WT, t / nnt, t % nnt, mode, tile);
}

__device__ __forceinline__ void phase_convert0(const Params& p, LAS unsigned char* lds) {
    unsigned char* ws = p.ws;
    LAS float* tile = (LAS float*)lds;
    transpose_matrix(p.in[8], DM, 2 * DFF, (bf16_t*)(ws + OFF_W1T), 1, tile);
    transpose_matrix(p.in[9], DFF, DM, (bf16_t*)(ws + OFF_W1O), 0, tile);
    const size_t gtid = (size_t)blockIdx.x * 512 + threadIdx.x, gsz = (size_t)gridDim.x * 512;
    { bf16_t* xb = (bf16_t*)(ws + OFF_XNB); const size_t n8 = (size_t)NTOK * DM / 8, np8 = (size_t)NPR * DM / 8;
      for (size_t i = gtid; i < n8; i += gsz) {
          const float* s = (i < np8) ? p.in[0] + i * 8 : p.in[1] + (i - np8) * 8;
          const f32x4 a = *(const f32x4*)s, b = *(const f32x4*)(s + 4);
          u32x4 o; o.x = pk2(a[0], a[1]); o.y = pk2(a[2], a[3]); o.z = pk2(b[0], b[1]); o.w = pk2(b[2], b[3]);
          *(u32x4*)(xb + i * 8) = o; } }
    if (gtid < 4096) {
        const int g = (int)(gtid >> 6), pp = (int)(gtid & 63);
        const double dt = exp((double)p.in[13][g]);
        const double lr = (double)p.in[11][g * 64 + pp], li = (double)p.in[12][g * 64 + pp];
        const double mag = exp(lr * dt), abr = mag * cos(li * dt), abi = mag * sin(li * dt);
        const double nr = abr - 1.0, ni = abi, den = lr * lr + li * li;
        const double cr = (nr * lr + ni * li) / den, ci = (ni * lr - nr * li) / den;
        bf16_t* bbt = (bf16_t*)(ws + OFF_BBT) + (size_t)g * 128 * 16;
        for (int h = 0; h < 16; ++h) {
            const double bre = (double)p.in[14][(g * 64 + pp) * 16 + h], bim = (double)p.in[15][(g * 64 + pp) * 16 + h];
            bbt[pp * 16 + h] = f2bf((float)(cr * bre - ci * bim));
            bbt[(64 + pp) * 16 + h] = f2bf((float)(cr * bim + ci * bre));
        }
        float* ab = (float*)(ws + OFF_ABAR); ab[(g * 64 + pp) * 2] = (float)abr; ab[(g * 64 + pp) * 2 + 1] = (float)abi;
        bf16_t* ct = (bf16_t*)(ws + OFF_CT) + (size_t)g * 16 * 128;
        for (int o = 0; o < 16; ++o) {
            ct[o * 128 + pp] = f2bf(p.in[16][(g * 16 + o) * 64 + pp]);
            ct[o * 128 + 64 + pp] = f2bf(-p.in[17][(g * 16 + o) * 64 + pp]);
        }
    }
}
__device__ __forceinline__ void phase_convert_mid(const Params& p, LAS unsigned char* lds, int b0) {
    unsigned char* ws = p.ws;
    LAS float* tile = (LAS float*)lds;
    transpose_matrix(p.in[10], DM, NMIX, (bf16_t*)(ws + OFF_WMI), 0, tile, b0);
    transpose_matrix(p.in[19], 1024, 1024, (bf16_t*)(ws + OFF_GLU), 0, tile, b0);
    transpose_matrix(p.in[25], DM, DM, (bf16_t*)(ws + OFF_WMO), 0, tile, b0);
}
__device__ __forceinline__ void phase_convert1(const Params& p, LAS unsigned char* lds, int b0, bool skip_out) {
    LAS float* tile = (LAS float*)lds;
    transpose_matrix(p.in[28], DM, 2 * DFF, (bf16_t*)(p.ws + OFF_W1T), 1, tile, b0);
    if (!skip_out) transpose_matrix(p.in[29], DFF, DM, (bf16_t*)(p.ws + OFF_W1O), 0, tile, b0);
}

__device__ __forceinline__ void phase_ln(const bf16_t* R, const float* gam, const float* bet, float* outf, bf16_t* outb, const float* P, const float* XS, const bf16_t* XSB, const float* P2 = nullptr) {
    int lane = threadIdx.x; asm volatile("" : "+v"(lane)); lane &= 63;
    const int wave = __builtin_amdgcn_readfirstlane(threadIdx.x >> 6);
    for (int row = blockIdx.x * 8 + wave; row < NTOK; row += gridDim.x * 8) {
        const u32x2* rp = (const u32x2*)(R + (size_t)row * DM) + lane;
        f32x4 v[8]; float s = 0.f;
        if (P != nullptr && row >= NPR) {
#pragma unroll
            for (int j = 0; j < 8; ++j) {
                f32x4 xv;
                if (XSB != nullptr) { const u32x2 xb2 = *((const u32x2*)(XSB + (size_t)(row - NPR) * DM) + lane + 64 * j); xv = (f32x4){bflo(xb2.x), bfhi(xb2.x), bflo(xb2.y), bfhi(xb2.y)}; }
                else xv = ((const f32x4*)(XS + (size_t)(row - NPR) * DM) + lane)[64 * j];
                v[j] = xv * ALPHA;
            }
            const int nslab = (P2 != nullptr) ? 8 : 4;
#pragma unroll 1
            for (int k = 0; k < nslab; ++k) {
                const f32x4* pk = (const f32x4*)((k < 4 ? P : P2) + ((size_t)(k & 3) * 512 + (row - NPR)) * DM) + lane;
#pragma unroll
                for (int j = 0; j < 8; ++j) v[j] += pk[64 * j];
            }
        } else {
#pragma unroll
            for (int j = 0; j < 8; ++j) { const u32x2 rb = rp[64 * j]; v[j] = (f32x4){bflo(rb.x), bfhi(rb.x), bflo(rb.y), bfhi(rb.y)}; }
        }
#pragma unroll
        for (int j = 0; j < 8; ++j) s += (v[j][0] + v[j][1]) + (v[j][2] + v[j][3]);
        const float mean = wave_sum(s) * (1.f / DM); float s2 = 0.f;
#pragma unroll
        for (int j = 0; j < 8; ++j) { v[j] = v[j] - mean; s2 += (v[j][0] * v[j][0] + v[j][1] * v[j][1]) + (v[j][2] * v[j][2] + v[j][3] * v[j][3]); }
        const float rstd = 1.f / sqrtf(wave_sum(s2) * (1.f / DM) + 1e-5f);
#pragma unroll
        for (int j = 0; j < 8; ++j) {
            const int col = 4 * (lane + 64 * j);
            const f32x4 gg = *(const f32x4*)(gam + col), bb = *(const f32x4*)(bet + col);
            const f32x4 y = v[j] * rstd * gg + bb;
            if (outf) *(f32x4*)(outf + (size_t)row * DM + col) = y;
            if (outb) { u32x2 o; o.x = pk2(y[0], y[1]); o.y = pk2(y[2], y[3]); *(u32x2*)(outb + (size_t)row * DM + col) = o; }
        }
    }
}

__device__ __forceinline__ void phase_conv(const Params& p) {
    unsigned char* ws = p.ws;
    int lane = threadIdx.x; asm volatile("" : "+v"(lane)); lane &= 63;
    const int wave = __builtin_amdgcn_readfirstlane(threadIdx.x >> 6);
    const bf16_t* PB = (const bf16_t*)(ws + OFF_PROJB);
    const float* BD = (const float*)(ws + OFF_BD);
    const float* cw = p.in[21];
    float* G = (float*)(ws + OFF_G); float* BT = (float*)(ws + OFF_BETA);
    bf16_t* QN = (bf16_t*)(ws + OFF_QN); bf16_t* KN = (bf16_t*)(ws + OFF_KN); float* VV = (float*)(ws + OFF_VV);
    bf16_t* KT = (bf16_t*)(ws + OFF_KT);
    float* QKVS = (float*)(ws + OFF_QKVS);
    const int NIT = 8192 + 1024;
    for (int it = blockIdx.x * 8 + wave; it < NIT; it += gridDim.x * 8) {
        if (it < 8192) {
            const int h = it & 7, tg = (it >> 3) & 255, b = it >> 11;
            const int t0 = tg * 8, tok0 = b * 2048 + t0;
            if (lane < 8) {
                const int tok = tok0 + lane;
                const float braw = BD[(size_t)tok * 16 + h], araw = BD[(size_t)tok * 16 + 8 + h];
                const float xx = araw + p.in[23][h];
                const float sp = xx > 20.f ? xx : log1pf(expf(xx));
                G[(size_t)tok * 8 + h] = -expf(p.in[22][h]) * sp;
                BT[(size_t)tok * 8 + h] = 1.f / (1.f + expf(-braw));
            }
            float x0[3][11], x1[3][11], w0[3][4], w1[3][4];
#pragma unroll
            for (int st = 0; st < 3; ++st) {
                const int col = st * 1024 + h * 128 + 2 * lane;
#pragma unroll
                for (int j = 0; j < 11; ++j) {
                    const int t = t0 - 3 + j;
                    unsigned v = 0u;
                    if (t >= 0) v = *(const unsigned*)(PB + (size_t)(b * 2048 + t) * NPB + 1024 + col);
                    x0[st][j] = bflo(v); x1[st][j] = bfhi(v);
                }
#pragma unroll
                for (int j = 0; j < 4; ++j) { w0[st][j] = cw[j * 3072 + col]; w1[st][j] = cw[j * 3072 + col + 1]; }
            }
            float y0[3][8], y1[3][8];
#pragma unroll
            for (int st = 0; st < 3; ++st)
#pragma unroll
                for (int t = 0; t < 8; ++t) {
                    float a0 = 0.f, a1 = 0.f;
#pragma unroll
                    for (int j = 0; j < 4; ++j) { a0 += x0[st][t + j] * w0[st][j]; a1 += x1[st][t + j] * w1[st][j]; }
                    y0[st][t] = siluf(a0); y1[st][t] = siluf(a1);
                }
            float ss[2][8];
#pragma unroll
            for (int st = 0; st < 2; ++st)
#pragma unroll
                for (int t = 0; t < 8; ++t) ss[st][t] = y0[st][t] * y0[st][t] + y1[st][t] * y1[st][t];
#pragma unroll
            for (int o = 1; o < 64; o <<= 1)
#pragma unroll
                for (int st = 0; st < 2; ++st)
#pragma unroll
                    for (int t = 0; t < 8; ++t) ss[st][t] += __shfl_xor(ss[st][t], o);
#pragma unroll
            for (int st = 0; st < 2; ++st)
#pragma unroll
                for (int t = 0; t < 8; ++t) {
                    float sc = 1.f / sqrtf(ss[st][t] + 1e-6f);
                    if (st == 0) sc *= 0.08838834764831845f;
                    y0[st][t] *= sc; y1[st][t] *= sc;
                }
#pragma unroll
            for (int t = 0; t < 8; ++t) {
                *(unsigned*)(QN + (size_t)(tok0 + t) * 1024 + h * 128 + 2 * lane) = pk2(y0[0][t], y1[0][t]);
                *(unsigned*)(KN + (size_t)(tok0 + t) * 1024 + h * 128 + 2 * lane) = pk2(y0[1][t], y1[1][t]);
                float* o = VV + (size_t)(tok0 + t) * 1024 + h * 128 + 2 * lane; o[0] = y0[2][t]; o[1] = y1[2][t];
            }
            {
                const int chunk = t0 >> 6, c0 = t0 & 63;
                bf16_t* base = KT + ((size_t)((b * 8 + h) * 32 + chunk) * 128 + 2 * lane) * 64 + c0;
                u32x4 o0, o1;
                o0.x = pk2(y0[1][0], y0[1][1]); o0.y = pk2(y0[1][2], y0[1][3]); o0.z = pk2(y0[1][4], y0[1][5]); o0.w = pk2(y0[1][6], y0[1][7]);
                o1.x = pk2(y1[1][0], y1[1][1]); o1.y = pk2(y1[1][2], y1[1][3]); o1.z = pk2(y1[1][4], y1[1][5]); o1.w = pk2(y1[1][6], y1[1][7]);
                *(u32x4*)base = o0; *(u32x4*)(base + 64) = o1;
            }
            if (tg == 255) {
#pragma unroll
                for (int st = 0; st < 3; ++st)
#pragma unroll
                    for (int j = 0; j < 3; ++j) {
                        float* o = p.out + O_PCONV + (size_t)(b * 3 + j) * 3072 + st * 1024 + h * 128 + 2 * lane;
                        o[0] = x0[st][8 + j]; o[1] = x1[st][8 + j];
                    }
            }
        } else {
            const int si = it - 8192, h = si & 7, b = si >> 3;
            const int tok0 = NPR + b * 4;
            if (lane < 4) {
                const int tok = tok0 + lane;
                const float braw = BD[(size_t)tok * 16 + h], araw = BD[(size_t)tok * 16 + 8 + h];
                const float xx = araw + p.in[23][h];
                const float sp = xx > 20.f ? xx : log1pf(expf(xx));
                G[(size_t)tok * 8 + h] = -expf(p.in[22][h]) * sp;
                BT[(size_t)tok * 8 + h] = 1.f / (1.f + expf(-braw));
            }
#pragma unroll
            for (int st = 0; st < 3; ++st) {
                const int col = st * 1024 + h * 128 + 2 * lane;
                float x0[7], x1[7];
#pragma unroll
                for (int j = 0; j < 3; ++j) { const float* s = p.in[5] + (size_t)(b * 3 + j) * 3072 + col; x0[j] = s[0]; x1[j] = s[1]; }
#pragma unroll
                for (int j = 0; j < 4; ++j) { const unsigned v = *(const unsigned*)(PB + (size_t)(tok0 + j) * NPB + 1024 + col); x0[3 + j] = bflo(v); x1[3 + j] = bfhi(v); }
                float w0[4], w1[4];
#pragma unroll
                for (int j = 0; j < 4; ++j) { w0[j] = cw[j * 3072 + col]; w1[j] = cw[j * 3072 + col + 1]; }
#pragma unroll
                for (int t = 0; t < 4; ++t) {
                    float a0 = 0.f, a1 = 0.f;
#pragma unroll
                    for (int j = 0; j < 4; ++j) { a0 += x0[t + j] * w0[j]; a1 += x1[t + j] * w1[j]; }
                    float y0 = siluf(a0), y1 = siluf(a1);
                    if (st < 2) {
                        const float ss = wave_sum(y0 * y0 + y1 * y1);
                        float sc = 1.f / sqrtf(ss + 1e-6f);
                        if (st == 0) sc *= 0.08838834764831845f;
                        y0 *= sc; y1 *= sc;
                    }
                    float* o = QKVS + (size_t)(b * 4 + t) * 3072 + col; o[0] = y0; o[1] = y1;
                }
#pragma unroll
                for (int j = 0; j < 3; ++j) {
                    float* o = p.out + O_SCONV + (size_t)(b * 3 + j) * 3072 + col;
                    o[0] = x0[4 + j]; o[1] = x1[4 + j];
                }
            }
        }
    }
}

__device__ __forceinline__ f32x16 mfma32(bf16x8 a, bf16x8 b, f32x16 c) { return __builtin_amdgcn_mfma_f32_32x32x16_bf16(a, b, c, 0, 0, 0); }
__device__ __forceinline__ f32x4 mfma16(bf16x8 a, bf16x8 b, f32x4 c) { return __builtin_amdgcn_mfma_f32_16x16x32_bf16(a, b, c, 0, 0, 0); }
__device__ __forceinline__ bf16x8 mk8(unsigned a, unsigned b, unsigned c, unsigned d) { u32x4 t = {a, b, c, d}; return __builtin_bit_cast(bf16x8, t); }
constexpr int MTP = 36;

template <int C> __device__ __forceinline__ void solve_col(float (&t)[64], const LAS float* MT, int lane) {
    float a0 = 0.f, a1 = 0.f, a2 = 0.f, a3 = 0.f;
    int mb = 0; if (C < 63) asm volatile("" : "+v"(mb) : "v"(t[C + 1]));
#pragma unroll
    for (int jj = (C + 1) / 4; jj < 16; ++jj) {
        const int j4 = jj * 4;
        if (jj == 8 && (C + 1) / 4 < 8) asm volatile("" : "+v"(mb) : "v"(a0), "v"(a1), "v"(a2), "v"(a3));
        const int ti = (j4 >> 5) + (C >> 5);
        const f32x4 m = *(const LAS f32x4*)(MT + mb + ti * 32 * MTP + (C & 31) * MTP + (j4 & 31));
        if (j4 + 0 > C) a0 += t[j4 + 0] * m[0];
        if (j4 + 1 > C) a1 += t[j4 + 1] * m[1];
        if (j4 + 2 > C) a2 += t[j4 + 2] * m[2];
        if (j4 + 3 > C) a3 += t[j4 + 3] * m[3];
    }
    t[C] = ((lane == C) ? 1.f : 0.f) - ((a0 + a1) + (a2 + a3));
    if constexpr (C > 0) solve_col<C - 1>(t, MT, lane);
}

__device__ __forceinline__ void gdn_prep_item(const Params& p, int it, LAS unsigned char* wl, LAS float* gcl_) {
    unsigned char* ws = p.ws;
    int lane = threadIdx.x; asm volatile("" : "+v"(lane)); lane &= 63;
    const int r = lane & 31, hh = lane >> 5;
    const int n = it & 31, bh = it >> 5, h = bh & 7, b = bh >> 3;
    const int tok0 = b * 2048 + n * 64;
    LAS float* MT = (LAS float*)wl;
    LAS float* gcL = gcl_;
    LAS float* btL = gcL + 64;
    const float* G = (const float*)(ws + OFF_G); const float* BT = (const float*)(ws + OFF_BETA);
    float gc = G[(size_t)(tok0 + lane) * 8 + h];
    const float bv = BT[(size_t)(tok0 + lane) * 8 + h];
#pragma unroll
    for (int o = 1; o < 64; o <<= 1) { const float t = __int_as_float(__builtin_amdgcn_ds_bpermute((lane - o) << 2, __float_as_int(gc))); if (lane >= o) gc += t; }
    const float gl = __int_as_float(__builtin_amdgcn_readlane(__float_as_int(gc), 63));
    gcL[lane] = gc; btL[lane] = bv;
    if (lane == 0) ((float*)(ws + OFF_GLAST))[it] = __expf(gl);
    WSYNC();
    const bf16_t* kp = (const bf16_t*)(ws + OFF_KN) + (size_t)tok0 * 1024 + h * 128;
    const bf16_t* qp = (const bf16_t*)(ws + OFF_QN) + (size_t)tok0 * 1024 + h * 128;
    bf16x8 Kf[2][8];
#pragma unroll
    for (int mt = 0; mt < 2; ++mt)
#pragma unroll
        for (int ks = 0; ks < 8; ++ks) Kf[mt][ks] = *(const bf16x8*)(kp + (size_t)(mt * 32 + r) * 1024 + ks * 16 + hh * 8);
    {
        bf16_t* KG = (bf16_t*)(ws + OFF_KG) + (size_t)it * 8192;
#pragma unroll
        for (int mt = 0; mt < 2; ++mt) {
            const float e = -__expf(gcL[mt * 32 + r]);
#pragma unroll
            for (int ks = 0; ks < 8; ++ks) {
                const u32x4 v = __builtin_bit_cast(u32x4, Kf[mt][ks]);
                u32x2 o0, o1; o0.x = pk2(bflo(v.x) * e, bfhi(v.x) * e); o0.y = pk2(bflo(v.y) * e, bfhi(v.y) * e);
                o1.x = pk2(bflo(v.z) * e, bfhi(v.z) * e); o1.y = pk2(bflo(v.w) * e, bfhi(v.w) * e);
                bf16_t* fp = KG + (mt * 8 + ks) * 512 + r * 8 + 4 * hh;
                *(u32x2*)fp = o0; *(u32x2*)(fp + 256) = o1;
            }
        }
    }
    __builtin_amdgcn_sched_barrier(0);
#pragma unroll
    for (int ti = 0; ti < 3; ++ti) {
        __builtin_amdgcn_sched_barrier(0);
        const int mi = (ti >= 1), ni = (ti == 2);
        f32x16 a = {};
#pragma unroll
        for (int ks = 0; ks < 8; ++ks) a = mfma32(Kf[mi][ks], Kf[ni][ks], a);
        const int j = ni * 32 + r; const float gcj = gcL[j];
#pragma unroll
        for (int qq = 0; qq < 4; ++qq) {
            const int i0 = mi * 32 + 8 * qq + 4 * hh;
            const f32x4 gci = *(const LAS f32x4*)(gcL + i0), bti = *(const LAS f32x4*)(btL + i0);
            f32x4 mv;
#pragma unroll
            for (int e = 0; e < 4; ++e) {
                const int i = i0 + e;
                const float dec = __expf(fminf(gci[e] - gcj, 0.f));
                mv[e] = (i > j) ? bti[e] * a[qq * 4 + e] * dec : 0.f;
            }
            *(LAS f32x4*)(MT + ti * 32 * MTP + r * MTP + 8 * qq + 4 * hh) = mv;
        }
    }
    bf16_t* ATT = (bf16_t*)(ws + OFF_ATT) + (size_t)it * 4096;
    bf16_t* QG = (bf16_t*)(ws + OFF_QG) + (size_t)it * 8192;
#pragma unroll
    for (int mi = 0; mi < 2; ++mi) {
        __builtin_amdgcn_sched_barrier(0);
        bf16x8 Qf[8];
#pragma unroll
        for (int ks = 0; ks < 8; ++ks) Qf[ks] = *(const bf16x8*)(qp + (size_t)(mi * 32 + r) * 1024 + ks * 16 + hh * 8);
#pragma unroll
        for (int ni = 0; ni <= mi; ++ni) {
            __builtin_amdgcn_sched_barrier(0);
            f32x16 q = {};
#pragma unroll
            for (int ks = 0; ks < 8; ++ks) q = mfma32(Qf[ks], Kf[ni][ks], q);
            const int j = ni * 32 + r; const float gcj = gcL[j];
#pragma unroll
            for (int qq = 0; qq < 4; ++qq) {
                const int i0 = mi * 32 + 8 * qq + 4 * hh;
                const f32x4 gci = *(const LAS f32x4*)(gcL + i0);
#pragma unroll
                for (int e = 0; e < 4; ++e) {
                    const int i = i0 + e;
                    const float dec = __expf(fminf(gci[e] - gcj, 0.f));
                    ATT[((mi * 2 + ni) * 2 + (r >> 4)) * 512 + (((r >> 2) & 1) * 32 + (i & 31)) * 8 + 4 * ((r >> 3) & 1) + (r & 3)] = f2bf((i >= j) ? q[qq * 4 + e] * dec : 0.f);
                }
            }
        }
        __builtin_amdgcn_sched_barrier(0);
        const float e = __expf(gcL[mi * 32 + r]);
#pragma unroll
        for (int ks = 0; ks < 8; ++ks) {
            const u32x4 v = __builtin_bit_cast(u32x4, Qf[ks]);
            u32x2 o0, o1; o0.x = pk2(bflo(v.x) * e, bfhi(v.x) * e); o0.y = pk2(bflo(v.y) * e, bfhi(v.y) * e);
            o1.x = pk2(bflo(v.z) * e, bfhi(v.z) * e); o1.y = pk2(bflo(v.w) * e, bfhi(v.w) * e);
            bf16_t* fp = QG + (mi * 8 + ks) * 512 + r * 8 + 4 * hh;
            *(u32x2*)fp = o0; *(u32x2*)(fp + 256) = o1;
        }
    }
    WSYNC();
    float t[64];
    solve_col<63>(t, MT, lane);
    WSYNC();
    int lane5 = lane; asm volatile("" : "+v"(lane5) : "v"(t[0]));
    const int r5 = lane5 & 31, h5 = lane5 >> 5;
    {
        bf16_t* TBt = (bf16_t*)(ws + OFF_TBT) + (size_t)it * 4096 + ((lane5 >> 5) * 4) * 512 + (lane5 & 31) * 8;
#pragma unroll
        for (int m2 = 0; m2 < 2; ++m2)
#pragma unroll
            for (int sx = 0; sx < 2; ++sx) {
                const int c0 = m2 * 32 + 16 * sx;
                const f32x4 b0 = *(const LAS f32x4*)(btL + c0), b1 = *(const LAS f32x4*)(btL + c0 + 4), b2 = *(const LAS f32x4*)(btL + c0 + 8), b3 = *(const LAS f32x4*)(btL + c0 + 12);
                u32x4 oa, ob;
                oa.x = pk2(t[c0 + 0] * b0[0], t[c0 + 1] * b0[1]); oa.y = pk2(t[c0 + 2] * b0[2], t[c0 + 3] * b0[3]);
                oa.z = pk2(t[c0 + 8] * b2[0], t[c0 + 9] * b2[1]); oa.w = pk2(t[c0 + 10] * b2[2], t[c0 + 11] * b2[3]);
                ob.x = pk2(t[c0 + 4] * b1[0], t[c0 + 5] * b1[1]); ob.y = pk2(t[c0 + 6] * b1[2], t[c0 + 7] * b1[3]);
                ob.z = pk2(t[c0 + 12] * b3[0], t[c0 + 13] * b3[1]); ob.w = pk2(t[c0 + 14] * b3[2], t[c0 + 15] * b3[3]);
                bf16_t* fp = TBt + (m2 * 2 + sx) * 512;
                *(u32x4*)fp = oa; *(u32x4*)(fp + 256) = ob;
            }
    }
    {
        const bf16_t* KT = (const bf16_t*)(ws + OFF_KT) + (size_t)it * 8192;
        bf16_t* KDT = (bf16_t*)(ws + OFF_KDT) + (size_t)it * 8192;
#pragma unroll
        for (int nt = 0; nt < 4; ++nt) {
            __builtin_amdgcn_sched_barrier(0);
#pragma unroll
            for (int ks = 0; ks < 4; ++ks) {
                const u32x4 v = *(const u32x4*)(KT + (size_t)(nt * 32 + r5) * 64 + ks * 16 + h5 * 8);
                const f32x4 g0 = *(const LAS f32x4*)(gcL + ks * 16 + h5 * 8), g1 = *(const LAS f32x4*)(gcL + ks * 16 + h5 * 8 + 4);
                u32x2 o0, o1;
                o0.x = pk2(bflo(v.x) * __expf(gl - g0[0]), bfhi(v.x) * __expf(gl - g0[1])); o0.y = pk2(bflo(v.y) * __expf(gl - g0[2]), bfhi(v.y) * __expf(gl - g0[3]));
                o1.x = pk2(bflo(v.z) * __expf(gl - g1[0]), bfhi(v.z) * __expf(gl - g1[1])); o1.y = pk2(bflo(v.w) * __expf(gl - g1[2]), bfhi(v.w) * __expf(gl - g1[3]));
                bf16_t* fp = KDT + (nt * 4 + ks) * 512 + r5 * 8 + 4 * h5;
                *(u32x2*)fp = o0; *(u32x2*)(fp + 256) = o1;
            }
        }
    }
    WSYNC();
}

__device__ __forceinline__ void gdn_sample_item(const Params& p, int it, LAS unsigned char* wl) {
    unsigned char* ws = p.ws;
    int lane = threadIdx.x; asm volatile("" : "+v"(lane)); lane &= 63;
    const int c = lane & 31, hh = lane >> 5;
    const int qd = it & 3, bh = it >> 2, h = bh & 7, b = bh >> 3;
    const int dv = qd * 32 + c;
    float s[64];
    { const float* sp = p.in[4] + (size_t)bh * 16384 + (size_t)(hh * 64) * 128 + dv;
#pragma unroll
      for (int i = 0; i < 64; ++i) s[i] = sp[i * 128]; }
    LAS float* kq = (LAS float*)wl;
    const float* QKVS = (const float*)(ws + OFF_QKVS);
    const float* G = (const float*)(ws + OFF_G); const float* BT = (const float*)(ws + OFF_BETA);
    bf16_t* O = (bf16_t*)(ws + OFF_O);
#pragma unroll
    for (int t = 0; t < 4; ++t) {
        const float* row = QKVS + (size_t)(b * 4 + t) * 3072 + h * 128;
        kq[t * 256 + lane] = row[1024 + lane]; kq[t * 256 + 64 + lane] = row[1024 + 64 + lane];
        kq[t * 256 + 128 + lane] = row[lane]; kq[t * 256 + 192 + lane] = row[64 + lane];
    }
    WSYNC();
#pragma unroll 1
    for (int t = 0; t < 4; ++t) {
        const int tok = NPR + b * 4 + t;
        const float al = __expf(G[(size_t)tok * 8 + h]), be = BT[(size_t)tok * 8 + h];
        const float v = QKVS[(size_t)(b * 4 + t) * 3072 + 2048 + h * 128 + dv];
        float d0 = 0.f, d1 = 0.f, d2 = 0.f, d3 = 0.f;
        int kb = t * 256 + hh * 64;
#pragma unroll
        for (int i = 0; i < 64; i += 4) {
            if ((i & 15) == 0) asm volatile("" : "+v"(kb) : "v"(d0), "v"(d1), "v"(d2), "v"(d3));
            const f32x4 kk = *(const LAS f32x4*)(kq + kb + i);
            s[i] *= al; s[i + 1] *= al; s[i + 2] *= al; s[i + 3] *= al;
            d0 += kk[0] * s[i]; d1 += kk[1] * s[i + 1]; d2 += kk[2] * s[i + 2]; d3 += kk[3] * s[i + 3];
        }
        float dd = (d0 + d1) + (d2 + d3);
        dd += __shfl_xor(dd, 32);
        const float rr = be * (v - dd);
        float o0 = 0.f, o1 = 0.f, o2 = 0.f, o3 = 0.f;
        asm volatile("" : "+v"(kb) : "v"(rr));
#pragma unroll
        for (int i = 0; i < 64; i += 4) {
            if ((i & 15) == 0) asm volatile("" : "+v"(kb) : "v"(o0), "v"(o1), "v"(o2), "v"(o3));
            const f32x4 kk = *(const LAS f32x4*)(kq + kb + i);
            const f32x4 qq = *(const LAS f32x4*)(kq + kb + 128 + i);
            s[i] += rr * kk[0]; s[i + 1] += rr * kk[1]; s[i + 2] += rr * kk[2]; s[i + 3] += rr * kk[3];
            o0 += qq[0] * s[i]; o1 += qq[1] * s[i + 1]; o2 += qq[2] * s[i + 2]; o3 += qq[3] * s[i + 3];
        }
        float oo = (o0 + o1) + (o2 + o3);
        oo += __shfl_xor(oo, 32);
        if (hh == 0) O[(size_t)tok * 1024 + h * 128 + dv] = f2bf(oo);
    }
    int dv2 = dv; asm volatile("" : "+v"(dv2));
    float* So = p.out + O_SGDN + (size_t)bh * 16384 + (size_t)(hh * 64) * 128 + dv2;
#pragma unroll
    for (int i = 0; i < 64; ++i) So[i * 128] = s[i];
    WSYNC();
}

__device__ __forceinline__ void s5_unit(const Params& p, int g, int tok_base, int nsub, bool sample, int b0, LAS unsigned char* wl, int hb_off);
__device__ __forceinline__ void phase_gdn_prep(const Params& p, LAS unsigned char* lds) {
    const int wave = __builtin_amdgcn_readfirstlane(threadIdx.x >> 6);
    LAS unsigned char* wl = lds + wave * 16384;
    if (wave < 4) { for (int it = blockIdx.x * 4 + wave; it < 1024; it += gridDim.x * 4) gdn_prep_item(p, it, wl, (LAS float*)(lds + 143360 + wave * 512)); }
    else {
        for (int it = blockIdx.x * 4 + (wave - 4); it < 4096; it += gridDim.x * 4) gdn_sample_item(p, it, wl);
        for (int u = blockIdx.x * 4 + (wave - 4); u < 2048; u += gridDim.x * 4) { const int g = u & 63, bq = u >> 6; s5_unit(p, g, NPR + bq * 16, 1, true, bq * 4, wl, 8192); }
    }
}

__device__ __forceinline__ bf16x8 ldperm(const bf16_t* p8, int hh) {
    const u32x2 lo = *(const u32x2*)(p8 + 4 * hh), hi = *(const u32x2*)(p8 + 8 + 4 * hh);
    return mk8(lo.x, lo.y, hi.x, hi.y);
}
constexpr int GDN_BUF = 61440, GDN_LDS0 = 21504;
__device__ __forceinline__ void gdn_dma_chunk(const unsigned char* ws, int it, LAS unsigned char* buf, int lane) {
    const bf16_t* KG = (const bf16_t*)(ws + OFF_KG) + (size_t)it * 8192 + lane * 8;
    const bf16_t* QG = (const bf16_t*)(ws + OFF_QG) + (size_t)it * 8192 + lane * 8;
    const bf16_t* KDT = (const bf16_t*)(ws + OFF_KDT) + (size_t)it * 8192 + lane * 8;
#pragma unroll
    for (int f = 0; f < 16; ++f) __builtin_amdgcn_global_load_lds((const unsigned*)(KG + f * 512), (LAS unsigned*)(buf + f * 1024), 16, 0, 0);
#pragma unroll
    for (int f = 0; f < 16; ++f) __builtin_amdgcn_global_load_lds((const unsigned*)(QG + f * 512), (LAS unsigned*)(buf + 16384 + f * 1024), 16, 0, 0);
#pragma unroll
    for (int f = 0; f < 16; ++f) __builtin_amdgcn_global_load_lds((const unsigned*)(KDT + f * 512), (LAS unsigned*)(buf + 32768 + f * 1024), 16, 0, 0);
    const bf16_t* TBt = (const bf16_t*)(ws + OFF_TBT) + (size_t)it * 4096 + lane * 8;
    const bf16_t* ATT = (const bf16_t*)(ws + OFF_ATT) + (size_t)it * 4096 + lane * 8;
#pragma unroll
    for (int k = 0; k < 6; ++k) { const int f = (k < 2) ? k : k + 2;
        __builtin_amdgcn_global_load_lds((const unsigned*)(TBt + f * 512), (LAS unsigned*)(buf + 49152 + k * 1024), 16, 0, 0);
        __builtin_amdgcn_global_load_lds((const unsigned*)(ATT + f * 512), (LAS unsigned*)(buf + 55296 + k * 1024), 16, 0, 0); }
}
template <int PAR>
__device__ __forceinline__ void gdn_chunk(const Params& p, LAS unsigned char* gb, int n, int bh, int b, int h, int dv, int hh, int lane, f32x16 (&S)[4]) {
    unsigned char* ws = p.ws;
    asm volatile("s_waitcnt vmcnt(0)" ::: "memory");
    const int it = bh * 32 + n;
    const LAS unsigned char* cb = gb + PAR * GDN_BUF + lane * 16;
    const float* VV = (const float*)(ws + OFF_VV) + (size_t)(b * 2048 + n * 64) * 1024 + h * 128 + dv;
    bf16_t* O = (bf16_t*)(ws + OFF_O);
    const float gl = ((const float*)(ws + OFF_GLAST))[it];
    f32x16 v0, v1;
#pragma unroll
    for (int q = 0; q < 16; ++q) { const int i = 8 * (q >> 2) + 4 * hh + (q & 3); v0[q] = VV[(size_t)i * 1024]; v1[q] = VV[(size_t)(32 + i) * 1024]; }
    float pf8 = 0.f;
    if (n + 1 < 32) pf8 = VV[(size_t)(64 + lane) * 1024];
    if (n + 1 < 32) gdn_dma_chunk(ws, it + 1, gb + (1 - PAR) * GDN_BUF, lane);
    bf16x8 Sb[4][2];
#pragma unroll
    for (int kt = 0; kt < 4; ++kt)
#pragma unroll
        for (int s = 0; s < 2; ++s)
            Sb[kt][s] = mk8(pk2(S[kt][8 * s + 0], S[kt][8 * s + 1]), pk2(S[kt][8 * s + 2], S[kt][8 * s + 3]), pk2(S[kt][8 * s + 4], S[kt][8 * s + 5]), pk2(S[kt][8 * s + 6], S[kt][8 * s + 7]));
    bf16x8 Eb[2][2];
    {
        f32x16 a0 = {}, a1 = {};
#pragma unroll
        for (int kt = 0; kt < 4; ++kt)
#pragma unroll
            for (int s = 0; s < 2; ++s) {
                const u32x4 hv = __builtin_bit_cast(u32x4, Sb[kt][s]);
                const bf16x8 lo = mk8(pk2(S[kt][8 * s + 0] - bflo(hv.x), S[kt][8 * s + 1] - bfhi(hv.x)), pk2(S[kt][8 * s + 2] - bflo(hv.y), S[kt][8 * s + 3] - bfhi(hv.y)),
                                      pk2(S[kt][8 * s + 4] - bflo(hv.z), S[kt][8 * s + 5] - bfhi(hv.z)), pk2(S[kt][8 * s + 6] - bflo(hv.w), S[kt][8 * s + 7] - bfhi(hv.w)));
                const bf16x8 A0 = *(const LAS bf16x8*)(cb + (kt * 2 + s) * 1024);
                const bf16x8 A1 = *(const LAS bf16x8*)(cb + (8 + kt * 2 + s) * 1024);
                a0 = mfma32(A0, Sb[kt][s], a0); a1 = mfma32(A1, Sb[kt][s], a1);
                a0 = mfma32(A0, lo, a0); a1 = mfma32(A1, lo, a1);
            }
        a0 += v0; a1 += v1;
#pragma unroll
        for (int s = 0; s < 2; ++s) {
            Eb[0][s] = mk8(pk2(a0[8 * s + 0], a0[8 * s + 1]), pk2(a0[8 * s + 2], a0[8 * s + 3]), pk2(a0[8 * s + 4], a0[8 * s + 5]), pk2(a0[8 * s + 6], a0[8 * s + 7]));
            Eb[1][s] = mk8(pk2(a1[8 * s + 0], a1[8 * s + 1]), pk2(a1[8 * s + 2], a1[8 * s + 3]), pk2(a1[8 * s + 4], a1[8 * s + 5]), pk2(a1[8 * s + 6], a1[8 * s + 7]));
        }
    }
    bf16x8 Vb[2][2];
#pragma unroll
    for (int mt = 0; mt < 2; ++mt) {
        f32x16 a = {};
#pragma unroll
        for (int m2 = 0; m2 <= mt; ++m2)
#pragma unroll
            for (int s = 0; s < 2; ++s) a = mfma32(*(const LAS bf16x8*)(cb + 49152 + ((mt == 0) ? s : 2 + m2 * 2 + s) * 1024), Eb[m2][s], a);
#pragma unroll
        for (int s = 0; s < 2; ++s)
            Vb[mt][s] = mk8(pk2(a[8 * s + 0], a[8 * s + 1]), pk2(a[8 * s + 2], a[8 * s + 3]), pk2(a[8 * s + 4], a[8 * s + 5]), pk2(a[8 * s + 6], a[8 * s + 7]));
    }
#pragma unroll
    for (int mt = 0; mt < 2; ++mt) {
        f32x16 a = {};
#pragma unroll
        for (int kt = 0; kt < 4; ++kt)
#pragma unroll
            for (int s = 0; s < 2; ++s) a = mfma32(*(const LAS bf16x8*)(cb + 16384 + ((mt * 4 + kt) * 2 + s) * 1024), Sb[kt][s], a);
#pragma unroll
        for (int m2 = 0; m2 <= mt; ++m2)
#pragma unroll
            for (int s = 0; s < 2; ++s) a = mfma32(*(const LAS bf16x8*)(cb + 55296 + ((mt == 0) ? s : 2 + m2 * 2 + s) * 1024), Vb[m2][s], a);
#pragma unroll
        for (int q = 0; q < 16; ++q) { const int i = mt * 32 + 8 * (q >> 2) + 4 * hh + (q & 3);
            O[(size_t)(b * 2048 + n * 64 + i) * 1024 + h * 128 + dv] = f2bf(a[q]); }
    }
#pragma unroll
    for (int kt = 0; kt < 4; ++kt) {
        f32x16 a = S[kt] * gl;
#pragma unroll
        for (int m2 = 0; m2 < 2; ++m2)
#pragma unroll
            for (int s = 0; s < 2; ++s) a = mfma32(*(const LAS bf16x8*)(cb + 32768 + ((kt * 2 + m2) * 2 + s) * 1024), Vb[m2][s], a);
        S[kt] = a;
    }
    asm volatile("" :: "v"(pf8));
}
__device__ __forceinline__ void gdn_scan_unit(const Params& p, int unit, LAS unsigned char* gb) {
    int lane = threadIdx.x; asm volatile("" : "+v"(lane)); lane &= 63;
    const int r = lane & 31, hh = lane >> 5;
    const int sl = unit & 3, bh = unit >> 2, h = bh & 7, b = bh >> 3;
    const int dv = sl * 32 + r;
    f32x16 S[4];
#pragma unroll
    for (int kt = 0; kt < 4; ++kt) S[kt] = (f32x16){};
    gdn_dma_chunk(p.ws, bh * 32, gb, lane);
#pragma unroll 1
    for (int n = 0; n < 32; n += 2) {
        gdn_chunk<0>(p, gb, n, bh, b, h, dv, hh, lane, S);
        gdn_chunk<1>(p, gb, n + 1, bh, b, h, dv, hh, lane, S);
    }
    int lane6 = threadIdx.x; asm volatile("" : "+v"(lane6)); lane6 &= 63;
    float* So = p.out + O_PGDN + (size_t)bh * 16384 + (sl * 32 + (lane6 & 31)) + (size_t)(4 * (lane6 >> 5)) * 128;
#pragma unroll
    for (int kt = 0; kt < 4; ++kt)
#pragma unroll
        for (int q = 0; q < 16; ++q) { const int dk = kt * 32 + 8 * (q >> 2) + (q & 3); So[(size_t)dk * 128] = S[kt][q]; }
}

__device__ __forceinline__ void s5_unit(const Params& p, int g, int tok_base, int nsub, bool sample, int b0, LAS unsigned char* wl, int hb_off) {
    unsigned char* ws = p.ws;
    int lane = threadIdx.x; asm volatile("" : "+v"(lane)); lane &= 63;
    const int l15 = lane & 15, l4 = lane >> 4;
    LAS bf16_t* HB = (LAS bf16_t*)(wl + hb_off);
    const bf16_t* PB = (const bf16_t*)(ws + OFF_PROJB);
    bf16_t* ZB = (bf16_t*)(ws + OFF_ZB);
    const float* AB = (const float*)(ws + OFF_ABAR);
    const float ar = AB[(g * 64 + lane) * 2], ai = AB[(g * 64 + lane) * 2 + 1];
    const bf16_t* bbt = (const bf16_t*)(ws + OFF_BBT) + (size_t)g * 2048;
    const bf16_t* ct = (const bf16_t*)(ws + OFF_CT) + (size_t)g * 2048;
    bf16x8 Bf[8], Cf[4];
    const bf16x8 zero8 = {0, 0, 0, 0, 0, 0, 0, 0};
#pragma unroll
    for (int nt = 0; nt < 8; ++nt) Bf[nt] = (l4 < 2) ? *(const bf16x8*)(bbt + (nt * 16 + l15) * 16 + 8 * l4) : zero8;
#pragma unroll
    for (int s = 0; s < 4; ++s) Cf[s] = *(const bf16x8*)(ct + l15 * 128 + 32 * s + 8 * l4);
    const float dskip = p.in[18][g * 16 + l15];
    float hr = 0.f, hi = 0.f;
    const int last_tok = tok_base + (nsub - 1) * 16;
    {
        const bf16x8 A0 = (l4 < 2) ? *(const bf16x8*)(PB + (size_t)(tok_base + l15) * NPB + g * 16 + 8 * l4) : zero8;
        LAS float* BU = (LAS float*)wl;
#pragma unroll
        for (int nt = 0; nt < 8; ++nt) {
            f32x4 a = {0.f, 0.f, 0.f, 0.f};
            a = mfma16(A0, Bf[nt], a);
#pragma unroll
            for (int q = 0; q < 4; ++q) BU[(4 * l4 + q) * 128 + nt * 16 + l15] = a[q];
        }
    }
    const int tok1 = (nsub > 1) ? tok_base + 16 : tok_base;
    bf16x8 Au = (l4 < 2) ? *(const bf16x8*)(PB + (size_t)(tok1 + l15) * NPB + g * 16 + 8 * l4) : zero8;
    float uu[4];
#pragma unroll
    for (int q = 0; q < 4; ++q) uu[q] = bf2f(PB[(size_t)(tok_base + 4 * l4 + q) * NPB + g * 16 + l15]);
    WSYNC();
#pragma unroll 1
    for (int sc = 0; sc < nsub; ++sc) {
        const int tok0 = tok_base + sc * 16;
        LAS float* BU = (LAS float*)(wl + (sc & 1) * 8192);
        LAS float* BUn = (LAS float*)(wl + ((sc + 1) & 1) * 8192);
        const int tok2 = (tok0 + 32 <= last_tok) ? tok0 + 32 : last_tok;
        const int tokn = (tok0 + 16 <= last_tok) ? tok0 + 16 : last_tok;
        const bf16x8 Au_n = (l4 < 2) ? *(const bf16x8*)(PB + (size_t)(tok2 + l15) * NPB + g * 16 + 8 * l4) : zero8;
        float uu_n[4];
#pragma unroll
        for (int q = 0; q < 4; ++q) uu_n[q] = bf2f(PB[(size_t)(tokn + 4 * l4 + q) * NPB + g * 16 + l15]);
        if (sc + 1 < nsub) {
#pragma unroll
            for (int nt = 0; nt < 8; ++nt) {
                f32x4 a = {0.f, 0.f, 0.f, 0.f};
                a = mfma16(Au, Bf[nt], a);
#pragma unroll
                for (int q = 0; q < 4; ++q) BUn[(4 * l4 + q) * 128 + nt * 16 + l15] = a[q];
            }
        }
#pragma unroll
        for (int t = 0; t < 16; ++t) {
            if (sample && (t & 3) == 0) {
                const int bb = b0 + (t >> 2);
                hr = p.in[2][((size_t)bb * 64 + g) * 64 + lane]; hi = p.in[3][((size_t)bb * 64 + g) * 64 + lane];
            }
            const float br = BU[t * 128 + lane], bi = BU[t * 128 + 64 + lane];
            const float nr = ar * hr - ai * hi + br, ni = ar * hi + ai * hr + bi;
            hr = nr; hi = ni;
            HB[t * 136 + lane] = f2bf(hr); HB[t * 136 + 64 + lane] = f2bf(hi);
            if (sample && (t & 3) == 3) {
                const int bb = b0 + (t >> 2);
                p.out[O_SRE + ((size_t)bb * 64 + g) * 64 + lane] = hr; p.out[O_SIM + ((size_t)bb * 64 + g) * 64 + lane] = hi;
            }
        }
        WSYNC();
        f32x4 y = {0.f, 0.f, 0.f, 0.f};
#pragma unroll
        for (int s = 0; s < 4; ++s) {
            const bf16x8 Ah = *(const LAS bf16x8*)(HB + l15 * 136 + 32 * s + 8 * l4);
            y = mfma16(Ah, Cf[s], y);
        }
#pragma unroll
        for (int q = 0; q < 4; ++q) {
            const int tok = tok0 + 4 * l4 + q;
            ZB[(size_t)tok * 1024 + g * 16 + l15] = f2bf(gelu_tanh(y[q] + dskip * uu[q]));
        }
        WSYNC();
        Au = Au_n;
#pragma unroll
        for (int q = 0; q < 4; ++q) uu[q] = uu_n[q];
    }
    if (!sample) {
        const int b = tok_base >> 11;
        p.out[O_PRE + ((size_t)b * 64 + g) * 64 + lane] = hr; p.out[O_PIM + ((size_t)b * 64 + g) * 64 + lane] = hi;
    }
}

__device__ __forceinline__ void phase_scan(const Params& p, LAS unsigned char* lds) {
    const int wave = __builtin_amdgcn_readfirstlane(threadIdx.x >> 6);
    if (wave == 0) {
        for (int B = blockIdx.x; B < 128; B += gridDim.x) { const int xi = B & 7, idx = B >> 3; gdn_scan_unit(p, ((xi * 4 + (idx >> 2)) << 2) + (idx & 3), lds + GDN_LDS0); }
    }
    else if (wave == 1) { for (int u = blockIdx.x; u < 256; u += gridDim.x) s5_unit(p, u & 63, (u >> 6) * 2048, 128, false, 0, lds, 16384); }
}

__device__ __forceinline__ void phase_onorm(const Params& p) {
    unsigned char* ws = p.ws;
    int lane = threadIdx.x; asm volatile("" : "+v"(lane)); lane &= 63;
    const int wave = __builtin_amdgcn_readfirstlane(threadIdx.x >> 6);
    const bf16_t* O = (const bf16_t*)(ws + OFF_O); const bf16_t* PB = (const bf16_t*)(ws + OFF_PROJB);
    bf16_t* YM = (bf16_t*)(ws + OFF_YMIX);
    const float nw0 = p.in[24][2 * lane], nw1 = p.in[24][2 * lane + 1];
    for (int it4 = blockIdx.x * 8 + wave; it4 < NTOK * 2; it4 += gridDim.x * 8) {
        unsigned ov[4], gv[4];
#pragma unroll
        for (int j = 0; j < 4; ++j) {
            const int it = it4 * 4 + j, h = it & 7, tok = it >> 3;
            ov[j] = *(const unsigned*)(O + (size_t)tok * 1024 + h * 128 + 2 * lane);
            gv[j] = *(const unsigned*)(PB + (size_t)tok * NPB + 4096 + h * 128 + 2 * lane);
        }
        float ss[4];
#pragma unroll
        for (int j = 0; j < 4; ++j) { const float o0 = bflo(ov[j]), o1 = bfhi(ov[j]); ss[j] = o0 * o0 + o1 * o1; }
#pragma unroll
        for (int o = 1; o < 64; o <<= 1) {
#pragma unroll
            for (int j = 0; j < 4; ++j) ss[j] += __shfl_xor(ss[j], o);
        }
#pragma unroll
        for (int j = 0; j < 4; ++j) {
            const int it = it4 * 4 + j, h = it & 7, tok = it >> 3;
            const float o0 = bflo(ov[j]), o1 = bfhi(ov[j]);
            const float rs = 1.f / sqrtf(ss[j] * (1.f / 128.f) + 1e-6f);
            *(unsigned*)(YM + (size_t)tok * DM + 1024 + h * 128 + 2 * lane) = pk2(o0 * rs * nw0 * siluf(bflo(gv[j])), o1 * rs * nw1 * siluf(bfhi(gv[j])));
        }
    }
}

#define XB_TMO      128
#define XB_XCNT(j)  (256  + 64 * (j))
#define XB_XSUB(j)  (1280 + 64 * (j))
#define XB_XGEN(j)  (2304 + 64 * (j))
#define XB_TOP      3328
#define XB_TOPGEN   3392
#define XCD_BAR_WORDS 3456
#define XB_SPIN_CAP (1u << 18)
__device__ __forceinline__ unsigned xb_ld(unsigned* p)              { return __hip_atomic_load(p, __ATOMIC_RELAXED, __HIP_MEMORY_SCOPE_AGENT); }
__device__ __forceinline__ unsigned xb_add(unsigned* p, unsigned v) { return __hip_atomic_fetch_add(p, v, __ATOMIC_RELAXED, __HIP_MEMORY_SCOPE_AGENT); }
__device__ __forceinline__ unsigned xb_xcc_id() { return (unsigned)__builtin_amdgcn_s_getreg((3 << 11) | 20) & 0xFu; }
#define XB_SPIN(cond, bar) do { unsigned _sp = 0; while (cond) { __builtin_amdgcn_s_sleep(1); \
    if ((++_sp & 255u) == 0u) { if (xb_ld(&(bar)[XB_TMO])) break; if (_sp > XB_SPIN_CAP) { atomicAdd(&(bar)[XB_TMO], 1u); break; } } } } while (0)
struct XcdBarrier { unsigned* bar; unsigned x; volatile LAS unsigned* st; };
__device__ __forceinline__ XcdBarrier xcd_barrier_post(unsigned* bar, volatile LAS unsigned* st) {
    XcdBarrier b; b.bar = bar; b.x = xb_xcc_id(); b.st = st;
    if (threadIdx.x == 0) (void)xb_add(&bar[XB_XCNT(b.x)], 1u);
    return b;
}
__device__ __forceinline__ void xcd_barrier_complete(unsigned* bar, unsigned x, unsigned& nloc, unsigned& nx) {
    const unsigned G = gridDim.x * gridDim.y * gridDim.z;
    unsigned sum, cnt, mine, sp = 0u;
    for (;;) {
        sum = 0u; cnt = 0u; mine = 0u;
#pragma unroll
        for (unsigned j = 0; j < 16; ++j) { const unsigned c = xb_ld(&bar[XB_XCNT(j)]); sum += c; cnt += (c > 0u) ? 1u : 0u; mine = (j == x) ? c : mine; }
        if (sum == G) break;
        __builtin_amdgcn_s_sleep(1);
        if ((++sp & 255u) == 0u) { if (xb_ld(&bar[XB_TMO])) break; if (sp > XB_SPIN_CAP) { atomicAdd(&bar[XB_TMO], 1u); break; } }
    }
    nloc = mine > 0u ? mine : 1u; nx = cnt > 0u ? cnt : 1u;
}
__device__ __forceinline__ void xcd_barrier(const XcdBarrier& b) {
    asm volatile("s_waitcnt vmcnt(0)" ::: "memory");
    __syncthreads();
    if (threadIdx.x == 0) {
        unsigned* bar = b.bar;
        __builtin_amdgcn_s_waitcnt(0);
        unsigned nloc = b.st[0], nx = b.st[1];
        if (nloc == 0u) { xcd_barrier_complete(bar, b.x, nloc, nx); b.st[0] = nloc; b.st[1] = nx; }
        const unsigned old = xb_add(&bar[XB_XSUB(b.x)], 1u);
        const unsigned gen = old / nloc;
        if (old + 1u == (gen + 1u) * nloc) {
            __builtin_amdgcn_fence(__ATOMIC_RELEASE, "agent");
            asm volatile("s_waitcnt vmcnt(0)" ::: "memory");
            const unsigned og = xb_add(&bar[XB_TOP], 1u);
            const unsigned tg = og / nx;
            if (og + 1u == (tg + 1u) * nx) xb_add(&bar[XB_TOPGEN], 1u);
            else XB_SPIN(xb_ld(&bar[XB_TOPGEN]) == tg, bar);
            __builtin_amdgcn_fence(__ATOMIC_ACQUIRE, "agent");
            xb_add(&bar[XB_XGEN(b.x)], 1u);
            asm volatile("s_waitcnt vmcnt(0)" ::: "memory");
        } else {
            XB_SPIN(xb_ld(&bar[XB_XGEN(b.x)]) == gen, bar);
            __builtin_amdgcn_fence(__ATOMIC_ACQUIRE, "agent");
            asm volatile("s_waitcnt vmcnt(0)" ::: "memory");
        }
    }
    __syncthreads();
}

__global__ void __launch_bounds__(512, 2) fwd_megakernel(Params p) {
    extern __shared__ __attribute__((aligned(16))) unsigned char shm[];
    LAS unsigned char* lds = (LAS unsigned char*)shm;
    cg::grid_group grid = cg::this_grid();
    unsigned char* ws = p.ws;
    pg8::StaticOrder S;
    volatile LAS unsigned* bst = (volatile LAS unsigned*)(lds + 147456 - 16);
    if (threadIdx.x == 0) { bst[0] = 0u; bst[1] = 0u; }
    __syncthreads();
    const XcdBarrier xb = xcd_barrier_post((unsigned*)(ws + OFF_BAR), bst);
    phase_convert0(p, lds);
    grid.sync();
    if (STOP_AFTER <= 0) return;
    { S.init(NTOK, 2 * DFF, DM, gridDim.x, blockIdx.x, false); pg8::Gemm g{(const bf16_t*)(ws + OFF_XNB), (const bf16_t*)(ws + OFF_W1T), NTOK, 2 * DFF, DM};
      EpiSwiglu E{(bf16_t*)(ws + OFF_H)}; pg8::gemm_phase(lds, g, S, E); }
    xcd_barrier(xb);
    { S.init(NTOK, DM, DFF, gridDim.x, blockIdx.x, true); pg8::Gemm g{(const bf16_t*)(ws + OFF_H), (const bf16_t*)(ws + OFF_W1O), NTOK, DM, DFF};
      EpiResid E{(bf16_t*)(ws + OFF_R), p.in[0], p.in[1], (float*)(ws + OFF_PART), nullptr, (const bf16_t*)(ws + OFF_XNB), 0.5f}; pg8::gemm_phase(lds, g, S, E); }
    __syncthreads();
    phase_convert_mid(p, lds, S.tail_busy());
    xcd_barrier(xb);
    phase_ln((const bf16_t*)(ws + OFF_R), p.in[6], p.in[7], nullptr, (bf16_t*)(ws + OFF_XRB), S.mode == 1 ? (const float*)(ws + OFF_PART) : nullptr, p.in[1], nullptr);
    xcd_barrier(xb);
    if (STOP_AFTER <= 3) return;
    { S.init(NTOK, NMIXP, DM, gridDim.x, blockIdx.x, false); pg8::Gemm g{(const bf16_t*)(ws + OFF_XRB), (const bf16_t*)(ws + OFF_WMI), NTOK, NMIXP, DM};
      EpiMixIn E{(bf16_t*)(ws + OFF_PROJB), (float*)(ws + OFF_BD)}; pg8::gemm_phase(lds, g, S, E); }
    xcd_barrier(xb);
    phase_conv(p);
    xcd_barrier(xb);
    if (STOP_AFTER <= 4) return;
    phase_gdn_prep(p, lds);
    xcd_barrier(xb);
    phase_scan(p, lds);
    xcd_barrier(xb);
    if (STOP_AFTER <= 5) return;
    phase_onorm(p);
    __syncthreads();
    { S.init(NTOK, 1024, 1024, gridDim.x, blockIdx.x, false); pg8::Gemm g{(const bf16_t*)(ws + OFF_ZB), (const bf16_t*)(ws + OFF_GLU), NTOK, 1024, 1024};
      EpiGlu E{(bf16_t*)(ws + OFF_YMIX), (const bf16_t*)(ws + OFF_ZB), p.in[20]}; pg8::gemm_phase(lds, g, S, E);
      __syncthreads();
      if (S.nwg < (int)gridDim.x) transpose_matrix(p.in[29], DFF, DM, (bf16_t*)(ws + OFF_W1O), 0, (LAS float*)lds, S.nwg); }
    xcd_barrier(xb);
    { S.init(NTOK, DM, DM, gridDim.x, blockIdx.x, true); pg8::Gemm g{(const bf16_t*)(ws + OFF_YMIX), (const bf16_t*)(ws + OFF_WMO), NTOK, DM, DM};
      EpiResid E{(bf16_t*)(ws + OFF_R), nullptr, nullptr, (float*)(ws + OFF_PART), nullptr, (const bf16_t*)(ws + OFF_XRB), 1.0f}; pg8::gemm_phase(lds, g, S, E); }
    __syncthreads();
    phase_convert1(p, lds, S.tail_busy(), gridDim.x > 136);
    xcd_barrier(xb);
    phase_ln((const bf16_t*)(ws + OFF_R), p.in[26], p.in[27], nullptr, (bf16_t*)(ws + OFF_XRB), S.mode == 1 ? (const float*)(ws + OFF_PART) : nullptr, nullptr, (const bf16_t*)(ws + OFF_XRB) + (size_t)NPR * DM);
    xcd_barrier(xb);
    { S.init(NTOK, 2 * DFF, DM, gridDim.x, blockIdx.x, false); pg8::Gemm g{(const bf16_t*)(ws + OFF_XRB), (const bf16_t*)(ws + OFF_W1T), NTOK, 2 * DFF, DM};
      EpiSwiglu E{(bf16_t*)(ws + OFF_H)}; pg8::gemm_phase(lds, g, S, E); }
    xcd_barrier(xb);
    { S.init(NTOK, DM, DFF, gridDim.x, blockIdx.x, true); if (S.mode == 1) S.nsp = 8; pg8::Gemm g{(const bf16_t*)(ws + OFF_H), (const bf16_t*)(ws + OFF_W1O), NTOK, DM, DFF};
      EpiResid E{(bf16_t*)(ws + OFF_R), nullptr, nullptr, (float*)(ws + OFF_PART), (float*)(ws + OFF_XNB), (const bf16_t*)(ws + OFF_XRB), 0.5f}; pg8::gemm_phase(lds, g, S, E); }
    xcd_barrier(xb);
    phase_ln((const bf16_t*)(ws + OFF_R), p.in[30], p.in[31], p.out + O_Y, nullptr, S.mode == 1 ? (const float*)(ws + OFF_PART) : nullptr, nullptr, (const bf16_t*)(ws + OFF_XRB) + (size_t)NPR * DM, (S.mode == 1 && S.nsp == 8) ? (const float*)(ws + OFF_XNB) : nullptr);
}

extern "C" void kernel_launch(void* const* d_in, const int* in_sizes, int n_in, void* d_out, int out_size, void* d_ws, size_t ws_size, hipStream_t stream) {
    constexpr int LDS_BYTES = 147456;
    static int grid_blocks = 0;
    if (grid_blocks == 0) {
        int dev = 0, cus = 0, per_cu = 0;
        hipGetDevice(&dev);
        hipDeviceGetAttribute(&cus, hipDeviceAttributeMultiprocessorCount, dev);
        hipFuncSetAttribute((const void*)fwd_megakernel, hipFuncAttributeMaxDynamicSharedMemorySize, LDS_BYTES);
        hipOccupancyMaxActiveBlocksPerMultiprocessor(&per_cu, (const void*)fwd_megakernel, 512, LDS_BYTES);
        if (per_cu < 1) { fprintf(stderr, "occupancy query returned %d\n", per_cu); per_cu = 1; }
        grid_blocks = cus * 1;
        if (ws_size < WS_END) fprintf(stderr, "workspace too small: %zu < %zu\n", ws_size, (size_t)WS_END);
    }
    (void)hipMemsetAsync((unsigned char*)d_ws + OFF_BAR, 0, XCD_BAR_WORDS * 4, stream);
    Params p{};
    for (int i = 0; i < 32; ++i) p.in[i] = (const float*)d_in[i];
    p.out = (float*)d_out; p.ws = (unsigned char*)d_ws;
    void* args[] = {&p};
    hipError_t e = hipLaunchCooperativeKernel((const void*)fwd_megakernel, dim3(grid_blocks), dim3(512), args, LDS_BYTES, stream);
    if (e != hipSuccess) fprintf(stderr, "cooperative launch failed: %s (grid %d)\n", hipGetErrorString(e), grid_blocks);
}
```

```cpp
#include <hip/hip_runtime.h>
#include <hip/hip_cooperative_groups.h>
#include <cstdio>
namespace cg = cooperative_groups;

#define LAS __attribute__((address_space(3)))
typedef unsigned short bf16_t;
typedef short bf16x8 __attribute__((ext_vector_type(8)));
typedef float f32x4 __attribute__((ext_vector_type(4)));
typedef float f32x16 __attribute__((ext_vector_type(16)));
typedef unsigned u32x4 __attribute__((ext_vector_type(4)));
typedef unsigned u32x2 __attribute__((ext_vector_type(2)));

#ifndef STOP_AFTER
#define STOP_AFTER 99
#endif

constexpr int NTOK = 8704, NPR = 8192, DM = 2048, DFF = 5632, NMIX = 5136, NMIXP = 5376, NPB = 5120;
constexpr float ALPHA = 1.189207115002721f;

constexpr size_t O_Y = 0, O_PRE = 17825792, O_PIM = 17842176, O_PGDN = 17858560, O_PCONV = 18382848,
                 O_SRE = 18419712, O_SIM = 18944000, O_SGDN = 19468288, O_SCONV = 36245504;

constexpr size_t SZ_W1T = (size_t)11264 * 2048 * 2, SZ_W1O = (size_t)2048 * 5632 * 2;
constexpr size_t OFF_W1T = 0;
constexpr size_t OFF_W1O = OFF_W1T + SZ_W1T;
constexpr size_t OFF_WMI = OFF_W1O + SZ_W1O;
constexpr size_t OFF_GLU = OFF_WMI + (size_t)NMIXP * 2048 * 2;
constexpr size_t OFF_WMO = OFF_GLU + (size_t)1024 * 1024 * 2;
constexpr size_t OFF_XNB = OFF_WMO + (size_t)2048 * 2048 * 2;
constexpr size_t OFF_XN  = OFF_XNB + (size_t)NTOK * 2048 * 2;
constexpr size_t OFF_R   = OFF_XN + (size_t)NTOK * 2048 * 4;
constexpr size_t OFF_H   = OFF_R + (size_t)NTOK * 2048 * 4;
constexpr size_t OFF_KDT = OFF_H + (size_t)NTOK * DFF * 2;
constexpr size_t SZ_CH   = (size_t)1024 * 64 * 128 * 2;
constexpr size_t OFF_TBT = OFF_KDT + SZ_CH;
constexpr size_t OFF_O   = OFF_TBT + (size_t)1024 * 64 * 64 * 2;
constexpr size_t OFF_ZB  = OFF_O + (size_t)NTOK * 1024 * 2;
constexpr size_t OFF_BBT = OFF_ZB + (size_t)NTOK * 1024 * 2;
constexpr size_t OFF_CT  = OFF_BBT + 262144;
constexpr size_t OFF_ABAR = OFF_CT + 262144;
constexpr size_t OFF_GLAST = OFF_ABAR + 32768;
constexpr size_t OFF_BAR = OFF_GLAST + 4096;
constexpr size_t OFF_PART = OFF_BAR + 16384;
constexpr size_t WS_END  = OFF_PART + (size_t)4 * 512 * 2048 * 4;
constexpr size_t OFF_PROJB = OFF_H;
constexpr size_t OFF_XRB = OFF_XN;
constexpr size_t OFF_YMIX = OFF_XN + (size_t)NTOK * 2048 * 2;
constexpr size_t OFF_QN = OFF_R, OFF_KN = OFF_QN + (size_t)NPR * 1024 * 2, OFF_VV = OFF_KN + (size_t)NPR * 1024 * 2;
constexpr size_t OFF_G = OFF_VV + (size_t)NPR * 1024 * 4;
constexpr size_t OFF_BETA = OFF_G + (size_t)NTOK * 8 * 4;
constexpr size_t OFF_BD = OFF_BETA + (size_t)NTOK * 8 * 4;
constexpr size_t OFF_KT = OFF_W1T, OFF_ATT = OFF_KT + SZ_CH, OFF_QG = OFF_ATT + (size_t)1024 * 64 * 64 * 2, OFF_KG = OFF_QG + SZ_CH;
constexpr size_t OFF_QKVS = OFF_KG + SZ_CH;
static_assert(OFF_BD + (size_t)NTOK * 16 * 4 <= OFF_H, "R alias overflow");
static_assert(OFF_QKVS + (size_t)512 * 3072 * 4 <= OFF_WMI, "W1 alias overflow");

struct Params { const float* in[32]; float* out; unsigned char* ws; };

typedef __bf16 bf16v2_t __attribute__((ext_vector_type(2)));
typedef float f32v2_t __attribute__((ext_vector_type(2)));
__device__ __forceinline__ unsigned pk2(float lo, float hi) { f32v2_t v = {lo, hi}; bf16v2_t b = __builtin_convertvector(v, bf16v2_t); return __builtin_bit_cast(unsigned, b); }
__device__ __forceinline__ bf16_t f2bf(float f) { return (bf16_t)(pk2(f, 0.f) & 0xffffu); }
__device__ __forceinline__ float bf2f(bf16_t b) { return __uint_as_float(((unsigned)b) << 16); }
__device__ __forceinline__ float bflo(unsigned u) { return __uint_as_float(u << 16); }
__device__ __forceinline__ float bfhi(unsigned u) { return __uint_as_float(u & 0xffff0000u); }
__device__ __forceinline__ float wave_sum(float v) {
#pragma unroll
    for (int o = 1; o < 64; o <<= 1) v += __shfl_xor(v, o);
    return v;
}
__device__ __forceinline__ float siluf(float x) { return x / (1.f + __expf(-x)); }
__device__ __forceinline__ float sigmf(float x) { return 1.f / (1.f + __expf(-x)); }
__device__ __forceinline__ float gelu_tanh(float y) {
    const float t = 0.7978845608028654f * (y + 0.044715f * y * y * y);
    const float th = 1.f - 2.f / (1.f + __expf(2.f * t));
    return 0.5f * y * (1.f + th);
}
#define WSYNC() asm volatile("s_waitcnt lgkmcnt(0)" ::: "memory")

namespace pg8 {
constexpr int BM = 256, BK = 64, HALF = 128, HTB = HALF * BK * 2, STAGE_BYTES = 8 * HTB, NXCD = 8, WGM = 8;
__host__ __device__ __forceinline__ int lds_byte(int r, int c) { const int st = (r >> 4) * 2 + (c >> 5), rr = r & 15, cc = c & 31, ob = rr * 64 + cc * 2; return st * 1024 + (ob ^ (((ob >> 9) & 1) << 5)); }
__host__ __device__ __forceinline__ void stage_rc(int b, int& R, int& C) { const int st = b / 1024, sb = b % 1024, swz = sb ^ (((sb >> 9) & 1) << 5); R = (st >> 1) * 16 + swz / 64; C = (st & 1) * 32 + (swz % 64) / 2; }
__host__ __device__ __forceinline__ int perm32(int rho) { const int n = rho >> 4, i = rho & 15; return 8 * (i >> 2) + 4 * n + (i & 3); }
struct Unit { int pm, pn, k0, nk, part, sp; };
struct Gemm { const bf16_t* A; const bf16_t* Bt; int M, N, K; };
struct StaticOrder {
    int nM, nN, nwg, G, c, ntK, mode, nsp;
    __device__ __forceinline__ void init(int M, int N, int K, int G_, int c_, bool split) {
        nM = M / BM; nN = N / BM; nwg = nM * nN; G = G_; c = c_; ntK = K / BK;
        mode = (split && G == 256 && nM == 34 && nN == 8 && (ntK % 8) == 0) ? 1 : 0; nsp = 4;
    }
    __device__ __forceinline__ void map(int L, Unit& u, int nMl) const {
        const int nw = nMl * nN;
        int wgid = L; { const int q = nw / NXCD, r = nw % NXCD, xcd = wgid % NXCD, off = wgid / NXCD; wgid = (xcd < r ? xcd * (q + 1) : r * (q + 1) + (xcd - r) * q) + off; }
        const int nig = WGM * nN, gid = wgid / nig, fm = gid * WGM, gsz = (nMl - fm) < WGM ? (nMl - fm) : WGM;
        u.pm = fm + ((wgid % nig) % gsz); u.pn = (wgid % nig) / gsz;
    }
    __device__ __forceinline__ int tail_busy() const { return mode == 1 ? 16 * nsp : (((nwg % G) * 2 <= G) ? (nwg % G) : 0); }
    __device__ __forceinline__ bool next_(int i, Unit& u) const {
        u.pm = 0; u.pn = 0; u.k0 = 0; u.nk = ntK; u.part = 0; u.sp = 0;
        if (mode == 0) { const long L = (long)i * G + c; if (L >= nwg) return false; map((int)L, u, nM); return true; }
        if (i == 0) { map(c, u, 32); return true; }
        if (i == 1 && c < 16 * nsp) {
            const int lsp = (nsp == 8) ? 3 : 2;
            const int tt = c >> lsp; u.pm = 32 + (tt & 1); u.pn = tt >> 1; u.sp = c & (nsp - 1);
            const int pairs = ntK >> 1, base = pairs >> lsp, rem = pairs & (nsp - 1);
            u.k0 = 2 * (u.sp * base + (u.sp < rem ? u.sp : rem)); u.nk = 2 * (base + (u.sp < rem ? 1 : 0)); u.part = 1; return true; }
        return false;
    }
    __device__ __forceinline__ bool next(int i, Unit& u) const {
        const bool ok = next_(i, u);
        u.pm = __builtin_amdgcn_readfirstlane(u.pm); u.pn = __builtin_amdgcn_readfirstlane(u.pn); u.k0 = __builtin_amdgcn_readfirstlane(u.k0);
        u.nk = __builtin_amdgcn_readfirstlane(u.nk); u.part = __builtin_amdgcn_readfirstlane(u.part); u.sp = __builtin_amdgcn_readfirstlane(u.sp);
        return __builtin_amdgcn_readfirstlane((int)ok) != 0;
    }
};

template <class Epi>
__device__ __forceinline__ void gemm_phase(LAS unsigned char* lds, const Gemm g, const StaticOrder& S, const Epi& E) {
    int tid = threadIdx.x; asm volatile("" : "+v"(tid));
    const int wid = __builtin_amdgcn_readfirstlane(tid >> 6), lane = tid & 63, wr = wid >> 2, wc = wid & 3, fr = lane & 15, fq = lane >> 4;
    const int K = g.K;
    unsigned voffA[2], voffB[2];
#pragma unroll
    for (int i = 0; i < 2; ++i) { int R, C; stage_rc(tid * 16 + i * 8192, R, C); const int Rb = Epi::PERM ? ((R & ~31) + perm32(R & 31)) : R;
        voffA[i] = (unsigned)(R * K + C) * 2u; voffB[i] = (unsigned)(Rb * K + C) * 2u; }
    const size_t kstep = (size_t)(BK * 2);
    const size_t hstep = (size_t)HALF * K * 2;
    const size_t tstep = 2 * hstep;
    const unsigned ldsw = (unsigned)wid * 1024u;
    const int aoff = lds_byte(wr * 64 + fr, fq * 8), boff = lds_byte(wc * 32 + fr, fq * 8);
#define PG8_SA(b, h) (((b) * 2 + (h)) * HTB)
#define PG8_SB(b, h) ((4 + (b) * 2 + (h)) * HTB)
#define PG8_STAGE(bufoff, gbase, voff) do { _Pragma("unroll") for (int _i = 0; _i < 2; ++_i) \
        __builtin_amdgcn_global_load_lds((const unsigned*)((const char*)(gbase) + (voff)[_i]), (LAS unsigned*)(lds + (bufoff) + ldsw + _i * 8192), 16, 0, 0); } while (0)
#define PG8_LDA(dst, b, h) do { _Pragma("unroll") for (int m = 0; m < 4; ++m) _Pragma("unroll") for (int k = 0; k < 2; ++k) dst[m][k] = *(const LAS bf16x8*)(lds + PG8_SA(b, h) + aoff + m * 2048 + k * 1024); } while (0)
#define PG8_LDB(dst, b, h) do { _Pragma("unroll") for (int n = 0; n < 2; ++n) _Pragma("unroll") for (int k = 0; k < 2; ++k) dst[n][k] = *(const LAS bf16x8*)(lds + PG8_SB(b, h) + boff + n * 2048 + k * 1024); } while (0)
#define PG8_MMA(ai, bj, At, Bt) do { __builtin_amdgcn_s_setprio(1); _Pragma("unroll") for (int m = 0; m < 4; ++m) _Pragma("unroll") for (int n = 0; n < 2; ++n) _Pragma("unroll") for (int k = 0; k < 2; ++k) \
        acc[ai][bj][m][n] = __builtin_amdgcn_mfma_f32_16x16x32_bf16(Bt[n][k], At[m][k], acc[ai][bj][m][n], 0, 0, 0); __builtin_amdgcn_s_setprio(0); } while (0)
#define PG8_WAIT_V(n) asm volatile("s_waitcnt vmcnt(" #n ")" ::: "memory")
#define PG8_WAIT_L(n) asm volatile("s_waitcnt lgkmcnt(" #n ")" ::: "memory")
#define PG8_BAR __builtin_amdgcn_s_barrier()
#define PG8_SCHED __builtin_amdgcn_sched_barrier(0)
    Unit cur, nxt; int ui = 0;
    if (!S.next(0, cur)) return;
    f32x4 acc[2][2][4][2];
#pragma unroll
    for (int a = 0; a < 2; ++a)
#pragma unroll
        for (int b = 0; b < 2; ++b)
#pragma unroll
            for (int m = 0; m < 4; ++m)
#pragma unroll
                for (int n = 0; n < 2; ++n) acc[a][b][m][n] = (f32x4){0.f, 0.f, 0.f, 0.f};
    bf16x8 At[4][2], B0[2][2], B1[2][2];
    const char* cA = (const char*)g.A + (size_t)cur.pm * tstep + (size_t)cur.k0 * kstep; const char* cB = (const char*)g.Bt + (size_t)cur.pn * tstep + (size_t)cur.k0 * kstep;
    PG8_STAGE(PG8_SB(0, 0), cB, voffB); PG8_STAGE(PG8_SA(0, 0), cA, voffA); PG8_STAGE(PG8_SB(0, 1), cB + hstep, voffB); PG8_STAGE(PG8_SA(0, 1), cA + hstep, voffA);
    if (wr == 1) PG8_BAR;
    PG8_WAIT_V(4); PG8_BAR;
    PG8_STAGE(PG8_SB(1, 0), cB + kstep, voffB); PG8_STAGE(PG8_SA(1, 0), cA + kstep, voffA); PG8_STAGE(PG8_SB(1, 1), cB + hstep + kstep, voffB);
    PG8_WAIT_V(6); PG8_BAR;
    for (;;) {
        const bool has_next = S.next(ui + 1, nxt);
        const char* nA = has_next ? (const char*)g.A + (size_t)nxt.pm * tstep + (size_t)nxt.k0 * kstep : cA; const char* nB = has_next ? (const char*)g.Bt + (size_t)nxt.pn * tstep + (size_t)nxt.k0 * kstep : cB;
        const int nt = cur.nk;
        for (int t = 0; t < nt; t += 2) {
            const bool last = (t == nt - 2);
            const char* a1 = cA + (size_t)(t + 1) * kstep;
            const char* a2 = last ? nA : cA + (size_t)(t + 2) * kstep; const char* b2 = last ? nB : cB + (size_t)(t + 2) * kstep;
            const char* a3 = a2 + kstep; const char* b3 = b2 + kstep;
            PG8_LDB(B0, 0, 0); PG8_SCHED; PG8_LDA(At, 0, 0); PG8_STAGE(PG8_SA(1, 1), a1 + hstep, voffA);
            PG8_WAIT_L(8); PG8_BAR; PG8_WAIT_L(0); PG8_MMA(0, 0, At, B0); PG8_BAR; PG8_SCHED;
            PG8_LDB(B1, 0, 1); PG8_STAGE(PG8_SB(0, 0), b2, voffB);
            PG8_BAR; PG8_WAIT_L(0); PG8_MMA(0, 1, At, B1); PG8_BAR;
            PG8_LDA(At, 0, 1); PG8_STAGE(PG8_SA(0, 0), a2, voffA);
            PG8_BAR; PG8_WAIT_L(0); PG8_MMA(1, 0, At, B0); PG8_BAR; PG8_SCHED;
            PG8_STAGE(PG8_SB(0, 1), b2 + hstep, voffB);
            PG8_WAIT_V(6); PG8_BAR; PG8_MMA(1, 1, At, B1); PG8_BAR;
            PG8_LDB(B0, 1, 0); PG8_SCHED; PG8_LDA(At, 1, 0); PG8_STAGE(PG8_SA(0, 1), a2 + hstep, voffA);
            PG8_WAIT_L(8); PG8_BAR; PG8_WAIT_L(0); PG8_MMA(0, 0, At, B0); PG8_BAR; PG8_SCHED;
            PG8_LDB(B1, 1, 1); PG8_STAGE(PG8_SB(1, 0), b3, voffB);
            PG8_BAR; PG8_WAIT_L(0); PG8_MMA(0, 1, At, B1); PG8_BAR;
            PG8_LDA(At, 1, 1); PG8_STAGE(PG8_SA(1, 0), a3, voffA);
            PG8_BAR; PG8_WAIT_L(0); PG8_MMA(1, 0, At, B0); PG8_BAR; PG8_SCHED;
            PG8_STAGE(PG8_SB(1, 1), b3 + hstep, voffB);
            PG8_WAIT_V(6); PG8_BAR; PG8_MMA(1, 1, At, B1); PG8_BAR;
        }
        E(acc, cur, wr, wc, fr, fq);
        if (!has_next) break;
#pragma unroll
        for (int a = 0; a < 2; ++a)
#pragma unroll
            for (int b = 0; b < 2; ++b)
#pragma unroll
                for (int m = 0; m < 4; ++m)
#pragma unroll
                    for (int n = 0; n < 2; ++n) acc[a][b][m][n] = (f32x4){0.f, 0.f, 0.f, 0.f};
        cur = nxt; cA = nA; cB = nB; ++ui;
    }
    PG8_WAIT_V(0);
    if (wr == 0) PG8_BAR;
    PG8_BAR;
#undef PG8_SA
#undef PG8_SB
#undef PG8_STAGE
#undef PG8_LDA
#undef PG8_LDB
#undef PG8_MMA
#undef PG8_WAIT_V
#undef PG8_WAIT_L
#undef PG8_BAR
#undef PG8_SCHED
}
}
using pg8::Unit;

struct EpiSwiglu {
    static constexpr bool PERM = true;
    bf16_t* H;
    __device__ __forceinline__ void operator()(const f32x4 (&acc)[2][2][4][2], const Unit& u, int wr, int wc, int fr, int fq) const {
        const int row0 = u.pm * 256 + wr * 64 + fr, col0 = u.pn * 128 + wc * 32 + 8 * fq;
#pragma unroll
        for (int ai = 0; ai < 2; ++ai)
#pragma unroll
            for (int m = 0; m < 4; ++m) {
                const f32x4 g0 = acc[ai][0][m][0], g1 = acc[ai][0][m][1], u0 = acc[ai][1][m][0], u1 = acc[ai][1][m][1];
                u32x4 o;
                o.x = pk2(siluf(g0[0]) * u0[0], siluf(g0[1]) * u0[1]); o.y = pk2(siluf(g0[2]) * u0[2], siluf(g0[3]) * u0[3]);
                o.z = pk2(siluf(g1[0]) * u1[0], siluf(g1[1]) * u1[1]); o.w = pk2(siluf(g1[2]) * u1[2], siluf(g1[3]) * u1[3]);
                *(u32x4*)(H + (size_t)(row0 + ai * 128 + m * 16) * DFF + col0) = o;
            }
    }
};
struct EpiResid {
    static constexpr bool PERM = false;
    bf16_t* R; const float* X0; const float* X1; float* P; float* P2; const bf16_t* XB; float scale;
    __device__ __forceinline__ void operator()(const f32x4 (&acc)[2][2][4][2], const Unit& u, int wr, int wc, int fr, int fq) const {
        float* const Pb = (u.sp < 4 ? P : P2) + (size_t)(u.sp & 3) * 512 * DM;
        const int row0 = u.pm * 256 + wr * 64 + fr, col0 = u.pn * 256 + wc * 32 + 4 * fq;
#pragma unroll
        for (int ai = 0; ai < 2; ++ai)
#pragma unroll
            for (int m = 0; m < 4; ++m) {
                const int row = row0 + ai * 128 + m * 16;
                const float* xr = (XB != nullptr) ? nullptr : (row < NPR ? X0 + (size_t)row * DM : X1 + (size_t)(row - NPR) * DM) + col0;
                bf16_t* rp = R + (size_t)row * DM + col0;
#pragma unroll
                for (int bj = 0; bj < 2; ++bj)
#pragma unroll
                    for (int n = 0; n < 2; ++n) {
                        if (!u.part) {
                            f32x4 xv;
                            if (XB != nullptr) { const u32x2 xb2 = *(const u32x2*)(XB + (size_t)row * DM + col0 + bj * 128 + n * 16); xv = (f32x4){bflo(xb2.x), bfhi(xb2.x), bflo(xb2.y), bfhi(xb2.y)}; }
                            else xv = *(const f32x4*)(xr + bj * 128 + n * 16);
                            const f32x4 rv = xv * ALPHA + acc[ai][bj][m][n] * scale;
                            u32x2 ro; ro.x = pk2(rv[0], rv[1]); ro.y = pk2(rv[2], rv[3]);
                            *(u32x2*)(rp + bj * 128 + n * 16) = ro;
                        } else {
                            *(f32x4*)(Pb + (size_t)(row - NPR) * DM + col0 + bj * 128 + n * 16) = acc[ai][bj][m][n] * scale;
                        }
                    }
            }
    }
};
struct EpiMixIn {
    static constexpr bool PERM = true;
    bf16_t* PB; float* BD;
    __device__ __forceinline__ void operator()(const f32x4 (&acc)[2][2][4][2], const Unit& u, int wr, int wc, int fr, int fq) const {
        const int row0 = u.pm * 256 + wr * 64 + fr;
        if (u.pn < 20) {
            const int col0 = u.pn * 256 + wc * 32 + 8 * fq;
#pragma unroll
            for (int ai = 0; ai < 2; ++ai)
#pragma unroll
                for (int m = 0; m < 4; ++m)
#pragma unroll
                    for (int bj = 0; bj < 2; ++bj) {
                        const f32x4 v0 = acc[ai][bj][m][0], v1 = acc[ai][bj][m][1];
                        u32x4 o; o.x = pk2(v0[0], v0[1]); o.y = pk2(v0[2], v0[3]); o.z = pk2(v1[0], v1[1]); o.w = pk2(v1[2], v1[3]);
                        *(u32x4*)(PB + (size_t)(row0 + ai * 128 + m * 16) * NPB + col0 + bj * 128) = o;
                    }
        } else if (wc == 0 && fq < 2) {
#pragma unroll
            for (int ai = 0; ai < 2; ++ai)
#pragma unroll
                for (int m = 0; m < 4; ++m) {
                    float* bp = BD + (size_t)(row0 + ai * 128 + m * 16) * 16 + 8 * fq;
                    *(f32x4*)(bp) = acc[ai][0][m][0]; *(f32x4*)(bp + 4) = acc[ai][0][m][1];
                }
        }
    }
};
struct EpiGlu {
    static constexpr bool PERM = true;
    bf16_t* YM; const bf16_t* ZB; const float* bias;
    __device__ __forceinline__ void operator()(const f32x4 (&acc)[2][2][4][2], const Unit& u, int wr, int wc, int fr, int fq) const {
        const int row0 = u.pm * 256 + wr * 64 + fr, col0 = u.pn * 256 + wc * 32 + 8 * fq;
#pragma unroll
        for (int bj = 0; bj < 2; ++bj) {
            const f32x4 b0 = *(const f32x4*)(bias + col0 + bj * 128), b1 = *(const f32x4*)(bias + col0 + bj * 128 + 4);
#pragma unroll
            for (int ai = 0; ai < 2; ++ai)
#pragma unroll
                for (int m = 0; m < 4; ++m) {
                    const int row = row0 + ai * 128 + m * 16;
                    const u32x4 zz = *(const u32x4*)(ZB + (size_t)row * 1024 + col0 + bj * 128);
                    const f32x4 v0 = acc[ai][bj][m][0] + b0, v1 = acc[ai][bj][m][1] + b1;
                    u32x4 o;
                    o.x = pk2(bflo(zz.x) * sigmf(v0[0]), bfhi(zz.x) * sigmf(v0[1])); o.y = pk2(bflo(zz.y) * sigmf(v0[2]), bfhi(zz.y) * sigmf(v0[3]));
                    o.z = pk2(bflo(zz.z) * sigmf(v1[0]), bfhi(zz.z) * sigmf(v1[1])); o.w = pk2(bflo(zz.w) * sigmf(v1[2]), bfhi(zz.w) * sigmf(v1[3]));
                    *(u32x4*)(YM + (size_t)row * DM + col0 + bj * 128) = o;
                }
        }
    }
};

__device__ __forceinline__ void transpose_tile(const float* __restrict__ W, int K, int N, bf16_t* __restrict__ WT, int kt, int nt, int mode, LAS float* tile) {
    int tid = threadIdx.x; asm volatile("" : "+v"(tid));
    const int k0 = kt * 64, n0 = nt * 256;
    f32x4 v[8];
#pragma unroll
    for (int i = 0; i < 8; ++i) {
        const int idx = tid + 512 * i, rr = idx >> 6, c4 = (idx & 63) * 4;
        v[i] = (f32x4){0.f, 0.f, 0.f, 0.f};
        if (n0 + c4 < N) v[i] = *(const f32x4*)(W + (size_t)(k0 + rr) * N + n0 + c4);
    }
#pragma unroll
    for (int i = 0; i < 8; ++i) {
        const int idx = tid + 512 * i, rr = idx >> 6, c4 = (idx & 63) * 4;
        tile[rr * 257 + c4 + 0] = v[i][0]; tile[rr * 257 + c4 + 1] = v[i][1]; tile[rr * 257 + c4 + 2] = v[i][2]; tile[rr * 257 + c4 + 3] = v[i][3];
    }
    __syncthreads();
#pragma unroll
    for (int j = 0; j < 4; ++j) {
        const int id = tid + 512 * j, n = id >> 3, kc = id & 7;
        float f[8];
#pragma unroll
        for (int e = 0; e < 8; ++e) f[e] = tile[(kc * 8 + e) * 257 + n];
        const int nn = n0 + n; int drow = nn;
        if (mode == 1) { const int isup = nn >= DFF; const int jj = isup ? nn - DFF : nn; drow = (jj >> 7) * 256 + isup * 128 + (jj & 127); }
        u32x4 o; o.x = pk2(f[0], f[1]); o.y = pk2(f[2], f[3]); o.z = pk2(f[4], f[5]); o.w = pk2(f[6], f[7]);
        *(u32x4*)(WT + (size_t)drow * K + k0 + kc * 8) = o;
    }
    __syncthreads();
}
__device__ __forceinline__ void transpose_matrix(const float* W, int K, int N, bf16_t* WT, int mode, LAS float* tile, int b0 = 0) {
    const int nkt = K / 64, nnt = (N + 255) / 256, tot = nkt * nnt;
    if ((int)blockIdx.x < b0) return;
    for (int t = blockIdx.x - b0; t < tot; t += gridDim.x - b0) transpose_tile(W, K, N, WT, t / nnt, t % nnt, mode, tile);
}

__device__ __forceinline__ void phase_convert0(const Params& p, LAS unsigned char* lds) {
    unsigned char* ws = p.ws;
    LAS float* tile = (LAS float*)lds;
    transpose_matrix(p.in[8], DM, 2 * DFF, (bf16_t*)(ws + OFF_W1T), 1, tile);
    transpose_matrix(p.in[9], DFF, DM, (bf16_t*)(ws + OFF_W1O), 0, tile);
    const size_t gtid = (size_t)blockIdx.x * 512 + threadIdx.x, gsz = (size_t)gridDim.x * 512;
    { bf16_t* xb = (bf16_t*)(ws + OFF_XNB); const size_t n8 = (size_t)NTOK * DM / 8, np8 = (size_t)NPR * DM / 8;
      for (size_t i = gtid; i < n8; i += gsz) {
          const float* s = (i < np8) ? p.in[0] + i * 8 : p.in[1] + (i - np8) * 8;
          const f32x4 a = *(const f32x4*)s, b = *(const f32x4*)(s + 4);
          u32x4 o; o.x = pk2(a[0], a[1]); o.y = pk2(a[2], a[3]); o.z = pk2(b[0], b[1]); o.w = pk2(b[2], b[3]);
          *(u32x4*)(xb + i * 8) = o; } }
    if (gtid < 4096) {
        const int g = (int)(gtid >> 6), pp = (int)(gtid & 63);
        const double dt = exp((double)p.in[13][g]);
        const double lr = (double)p.in[11][g * 64 + pp], li = (double)p.in[12][g * 64 + pp];
        const double mag = exp(lr * dt), abr = mag * cos(li * dt), abi = mag * sin(li * dt);
        const double nr = abr - 1.0, ni = abi, den = lr * lr + li * li;
        const double cr = (nr * lr + ni * li) / den, ci = (ni * lr - nr * li) / den;
        bf16_t* bbt = (bf16_t*)(ws + OFF_BBT) + (size_t)g * 128 * 16;
        for (int h = 0; h < 16; ++h) {
            const double bre = (double)p.in[14][(g * 64 + pp) * 16 + h], bim = (double)p.in[15][(g * 64 + pp) * 16 + h];
            bbt[pp * 16 + h] = f2bf((float)(cr * bre - ci * bim));
            bbt[(64 + pp) * 16 + h] = f2bf((float)(cr * bim + ci * bre));
        }
        float* ab = (float*)(ws + OFF_ABAR); ab[(g * 64 + pp) * 2] = (float)abr; ab[(g * 64 + pp) * 2 + 1] = (float)abi;
        bf16_t* ct = (bf16_t*)(ws + OFF_CT) + (size_t)g * 16 * 128;
        for (int o = 0; o < 16; ++o) {
            ct[o * 128 + pp] = f2bf(p.in[16][(g * 16 + o) * 64 + pp]);
            ct[o * 128 + 64 + pp] = f2bf(-p.in[17][(g * 16 + o) * 64 + pp]);
        }
    }
}
__device__ __forceinline__ void phase_convert_mid(const Params& p, LAS unsigned char* lds, int b0) {
    unsigned char* ws = p.ws;
    LAS float* tile = (LAS float*)lds;
    transpose_matrix(p.in[10], DM, NMIX, (bf16_t*)(ws + OFF_WMI), 0, tile, b0);
    transpose_matrix(p.in[19], 1024, 1024, (bf16_t*)(ws + OFF_GLU), 0, tile, b0);
    transpose_matrix(p.in[25], DM, DM, (bf16_t*)(ws + OFF_WMO), 0, tile, b0);
}
__device__ __forceinline__ void phase_convert1(const Params& p, LAS unsigned char* lds, int b0, bool skip_out) {
    LAS float* tile = (LAS float*)lds;
    transpose_matrix(p.in[28], DM, 2 * DFF, (bf16_t*)(p.ws + OFF_W1T), 1, tile, b0);
    if (!skip_out) transpose_matrix(p.in[29], DFF, DM, (bf16_t*)(p.ws + OFF_W1O), 0, tile, b0);
}

__device__ __forceinline__ void phase_ln(const bf16_t* R, const float* gam, const float* bet, float* outf, bf16_t* outb, const float* P, const float* XS, const bf16_t* XSB, const float* P2 = nullptr) {
    int lane = threadIdx.x; asm volatile("" : "+v"(lane)); lane &= 63;
    const int wave = __builtin_amdgcn_readfirstlane(threadIdx.x >> 6);
    for (int row = blockIdx.x * 8 + wave; row < NTOK; row += gridDim.x * 8) {
        const u32x2* rp = (const u32x2*)(R + (size_t)row * DM) + lane;
        f32x4 v[8]; float s = 0.f;
        if (P != nullptr && row >= NPR) {
#pragma unroll
            for (int j = 0; j < 8; ++j) {
                f32x4 xv;
                if (XSB != nullptr) { const u32x2 xb2 = *((const u32x2*)(XSB + (size_t)(row - NPR) * DM) + lane + 64 * j); xv = (f32x4){bflo(xb2.x), bfhi(xb2.x), bflo(xb2.y), bfhi(xb2.y)}; }
                else xv = ((const f32x4*)(XS + (size_t)(row - NPR) * DM) + lane)[64 * j];
                v[j] = xv * ALPHA;
            }
            const int nslab = (P2 != nullptr) ? 8 : 4;
#pragma unroll 1
            for (int k = 0; k < nslab; ++k) {
                const f32x4* pk = (const f32x4*)((k < 4 ? P : P2) + ((size_t)(k & 3) * 512 + (row - NPR)) * DM) + lane;
#pragma unroll
                for (int j = 0; j < 8; ++j) v[j] += pk[64 * j];
            }
        } else {
#pragma unroll
            for (int j = 0; j < 8; ++j) { const u32x2 rb = rp[64 * j]; v[j] = (f32x4){bflo(rb.x), bfhi(rb.x), bflo(rb.y), bfhi(rb.y)}; }
        }
#pragma unroll
        for (int j = 0; j < 8; ++j) s += (v[j][0] + v[j][1]) + (v[j][2] + v[j][3]);
        const float mean = wave_sum(s) * (1.f / DM); float s2 = 0.f;
#pragma unroll
        for (int j = 0; j < 8; ++j) { v[j] = v[j] - mean; s2 += (v[j][0] * v[j][0] + v[j][1] * v[j][1]) + (v[j][2] * v[j][2] + v[j][3] * v[j][3]); }
        const float rstd = 1.f / sqrtf(wave_sum(s2) * (1.f / DM) + 1e-5f);
#pragma unroll
        for (int j = 0; j < 8; ++j) {
            const int col = 4 * (lane + 64 * j);
            const f32x4 gg = *(const f32x4*)(gam + col), bb = *(const f32x4*)(bet + col);
            const f32x4 y = v[j] * rstd * gg + bb;
            if (outf) *(f32x4*)(outf + (size_t)row * DM + col) = y;
            if (outb) { u32x2 o; o.x = pk2(y[0], y[1]); o.y = pk2(y[2], y[3]); *(u32x2*)(outb + (size_t)row * DM + col) = o; }
        }
    }
}

constexpr int S5_SPLIT = 24;
__device__ __forceinline__ void s5_unit(const Params& p, int g, int tok_base, int nsub, bool sample, int b0, LAS unsigned char* wl, int hb_off, float& hr_io, float& hi_io, bool store_final);
__device__ __forceinline__ void phase_conv(const Params& p, LAS unsigned char* lds, float& s5r, float& s5i, bool split5) {
    unsigned char* ws = p.ws;
    int lane = threadIdx.x; asm volatile("" : "+v"(lane)); lane &= 63;
    const int wave = __builtin_amdgcn_readfirstlane(threadIdx.x >> 6);
    const bf16_t* PB = (const bf16_t*)(ws + OFF_PROJB);
    const float* BD = (const float*)(ws + OFF_BD);
    const float* cw = p.in[21];
    float* G = (float*)(ws + OFF_G); float* BT = (float*)(ws + OFF_BETA);
    bf16_t* QN = (bf16_t*)(ws + OFF_QN); bf16_t* KN = (bf16_t*)(ws + OFF_KN); float* VV = (float*)(ws + OFF_VV);
    bf16_t* KT = (bf16_t*)(ws + OFF_KT);
    float* QKVS = (float*)(ws + OFF_QKVS);
    const int NIT = 8192 + 1024;
    const int ncw = split5 ? 7 : 8;
    if (wave >= ncw) {
        const int u = blockIdx.x;
        if (u < 256) s5_unit(p, u & 63, (u >> 6) * 2048, S5_SPLIT, false, 0, lds, 16384, s5r, s5i, false);
        return;
    }
    for (int it = blockIdx.x * ncw + wave; it < NIT; it += gridDim.x * ncw) {
        if (it < 8192) {
            const int h = it & 7, tg = (it >> 3) & 255, b = it >> 11;
            const int t0 = tg * 8, tok0 = b * 2048 + t0;
            if (lane < 8) {
                const int tok = tok0 + lane;
                const float braw = BD[(size_t)tok * 16 + h], araw = BD[(size_t)tok * 16 + 8 + h];
                const float xx = araw + p.in[23][h];
                const float sp = xx > 20.f ? xx : log1pf(expf(xx));
                G[(size_t)tok * 8 + h] = -expf(p.in[22][h]) * sp;
                BT[(size_t)tok * 8 + h] = 1.f / (1.f + expf(-braw));
            }
            float x0[3][11], x1[3][11], w0[3][4], w1[3][4];
#pragma unroll
            for (int st = 0; st < 3; ++st) {
                const int col = st * 1024 + h * 128 + 2 * lane;
#pragma unroll
                for (int j = 0; j < 11; ++j) {
                    const int t = t0 - 3 + j;
                    unsigned v = 0u;
                    if (t >= 0) v = *(const unsigned*)(PB + (size_t)(b * 2048 + t) * NPB + 1024 + col);
                    x0[st][j] = bflo(v); x1[st][j] = bfhi(v);
                }
#pragma unroll
                for (int j = 0; j < 4; ++j) { w0[st][j] = cw[j * 3072 + col]; w1[st][j] = cw[j * 3072 + col + 1]; }
            }
            float y0[3][8], y1[3][8];
#pragma unroll
            for (int st = 0; st < 3; ++st)
#pragma unroll
                for (int t = 0; t < 8; ++t) {
                    float a0 = 0.f, a1 = 0.f;
#pragma unroll
                    for (int j = 0; j < 4; ++j) { a0 += x0[st][t + j] * w0[st][j]; a1 += x1[st][t + j] * w1[st][j]; }
                    y0[st][t] = siluf(a0); y1[st][t] = siluf(a1);
                }
            float ss[2][8];
#pragma unroll
            for (int st = 0; st < 2; ++st)
#pragma unroll
                for (int t = 0; t < 8; ++t) ss[st][t] = y0[st][t] * y0[st][t] + y1[st][t] * y1[st][t];
#pragma unroll
            for (int o = 1; o < 64; o <<= 1)
#pragma unroll
                for (int st = 0; st < 2; ++st)
#pragma unroll
                    for (int t = 0; t < 8; ++t) ss[st][t] += __shfl_xor(ss[st][t], o);
#pragma unroll
            for (int st = 0; st < 2; ++st)
#pragma unroll
                for (int t = 0; t < 8; ++t) {
                    float sc = 1.f / sqrtf(ss[st][t] + 1e-6f);
                    if (st == 0) sc *= 0.08838834764831845f;
                    y0[st][t] *= sc; y1[st][t] *= sc;
                }
#pragma unroll
            for (int t = 0; t < 8; ++t) {
                *(unsigned*)(QN + (size_t)(tok0 + t) * 1024 + h * 128 + 2 * lane) = pk2(y0[0][t], y1[0][t]);
                *(unsigned*)(KN + (size_t)(tok0 + t) * 1024 + h * 128 + 2 * lane) = pk2(y0[1][t], y1[1][t]);
                float* o = VV + (size_t)(tok0 + t) * 1024 + h * 128 + 2 * lane; o[0] = y0[2][t]; o[1] = y1[2][t];
            }
            {
                const int chunk = t0 >> 6, c0 = t0 & 63;
                bf16_t* base = KT + ((size_t)((b * 8 + h) * 32 + chunk) * 128 + 2 * lane) * 64 + c0;
                u32x4 o0, o1;
                o0.x = pk2(y0[1][0], y0[1][1]); o0.y = pk2(y0[1][2], y0[1][3]); o0.z = pk2(y0[1][4], y0[1][5]); o0.w = pk2(y0[1][6], y0[1][7]);
                o1.x = pk2(y1[1][0], y1[1][1]); o1.y = pk2(y1[1][2], y1[1][3]); o1.z = pk2(y1[1][4], y1[1][5]); o1.w = pk2(y1[1][6], y1[1][7]);
                *(u32x4*)base = o0; *(u32x4*)(base + 64) = o1;
            }
            if (tg == 255) {
#pragma unroll
                for (int st = 0; st < 3; ++st)
#pragma unroll
                    for (int j = 0; j < 3; ++j) {
                        float* o = p.out + O_PCONV + (size_t)(b * 3 + j) * 3072 + st * 1024 + h * 128 + 2 * lane;
                        o[0] = x0[st][8 + j]; o[1] = x1[st][8 + j];
                    }
            }
        } else {
            const int si = it - 8192, h = si & 7, b = si >> 3;
            const int tok0 = NPR + b * 4;
            if (lane < 4) {
                const int tok = tok0 + lane;
                const float braw = BD[(size_t)tok * 16 + h], araw = BD[(size_t)tok * 16 + 8 + h];
                const float xx = araw + p.in[23][h];
                const float sp = xx > 20.f ? xx : log1pf(expf(xx));
                G[(size_t)tok * 8 + h] = -expf(p.in[22][h]) * sp;
                BT[(size_t)tok * 8 + h] = 1.f / (1.f + expf(-braw));
            }
#pragma unroll
            for (int st = 0; st < 3; ++st) {
                const int col = st * 1024 + h * 128 + 2 * lane;
                float x0[7], x1[7];
#pragma unroll
                for (int j = 0; j < 3; ++j) { const float* s = p.in[5] + (size_t)(b * 3 + j) * 3072 + col; x0[j] = s[0]; x1[j] = s[1]; }
#pragma unroll
                for (int j = 0; j < 4; ++j) { const unsigned v = *(const unsigned*)(PB + (size_t)(tok0 + j) * NPB + 1024 + col); x0[3 + j] = bflo(v); x1[3 + j] = bfhi(v); }
                float w0[4], w1[4];
#pragma unroll
                for (int j = 0; j < 4; ++j) { w0[j] = cw[j * 3072 + col]; w1[j] = cw[j * 3072 + col + 1]; }
#pragma unroll
                for (int t = 0; t < 4; ++t) {
                    float a0 = 0.f, a1 = 0.f;
#pragma unroll
                    for (int j = 0; j < 4; ++j) { a0 += x0[t + j] * w0[j]; a1 += x1[t + j] * w1[j]; }
                    float y0 = siluf(a0), y1 = siluf(a1);
                    if (st < 2) {
                        const float ss = wave_sum(y0 * y0 + y1 * y1);
                        float sc = 1.f / sqrtf(ss + 1e-6f);
                        if (st == 0) sc *= 0.08838834764831845f;
                        y0 *= sc; y1 *= sc;
                    }
                    float* o = QKVS + (size_t)(b * 4 + t) * 3072 + col; o[0] = y0; o[1] = y1;
                }
#pragma unroll
                for (int j = 0; j < 3; ++j) {
                    float* o = p.out + O_SCONV + (size_t)(b * 3 + j) * 3072 + col;
                    o[0] = x0[4 + j]; o[1] = x1[4 + j];
                }
            }
        }
    }
}

__device__ __forceinline__ f32x16 mfma32(bf16x8 a, bf16x8 b, f32x16 c) { return __builtin_amdgcn_mfma_f32_32x32x16_bf16(a, b, c, 0, 0, 0); }
__device__ __forceinline__ f32x4 mfma16(bf16x8 a, bf16x8 b, f32x4 c) { return __builtin_amdgcn_mfma_f32_16x16x32_bf16(a, b, c, 0, 0, 0); }
__device__ __forceinline__ bf16x8 mk8(unsigned a, unsigned b, unsigned c, unsigned d) { u32x4 t = {a, b, c, d}; return __builtin_bit_cast(bf16x8, t); }
constexpr int MTP = 36;

template <int C> __device__ __forceinline__ void solve_col(float (&t)[64], const LAS float* MT, int lane) {
    float a0 = 0.f, a1 = 0.f, a2 = 0.f, a3 = 0.f;
    int mb = 0; if (C < 63) asm volatile("" : "+v"(mb) : "v"(t[C + 1]));
#pragma unroll
    for (int jj = (C + 1) / 4; jj < 16; ++jj) {
        const int j4 = jj * 4;
        if (jj == 8 && (C + 1) / 4 < 8) asm volatile("" : "+v"(mb) : "v"(a0), "v"(a1), "v"(a2), "v"(a3));
        const int ti = (j4 >> 5) + (C >> 5);
        const f32x4 m = *(const LAS f32x4*)(MT + mb + ti * 32 * MTP + (C & 31) * MTP + (j4 & 31));
        if (j4 + 0 > C) a0 += t[j4 + 0] * m[0];
        if (j4 + 1 > C) a1 += t[j4 + 1] * m[1];
        if (j4 + 2 > C) a2 += t[j4 + 2] * m[2];
        if (j4 + 3 > C) a3 += t[j4 + 3] * m[3];
    }
    t[C] = ((lane == C) ? 1.f : 0.f) - ((a0 + a1) + (a2 + a3));
    if constexpr (C > 0) solve_col<C - 1>(t, MT, lane);
}

__device__ __forceinline__ void gdn_prep_item(const Params& p, int it, LAS unsigned char* wl, LAS float* gcl_) {
    unsigned char* ws = p.ws;
    int lane = threadIdx.x; asm volatile("" : "+v"(lane)); lane &= 63;
    const int r = lane & 31, hh = lane >> 5;
    const int n = it & 31, bh = it >> 5, h = bh & 7, b = bh >> 3;
    const int tok0 = b * 2048 + n * 64;
    LAS float* MT = (LAS float*)wl;
    LAS float* gcL = gcl_;
    LAS float* btL = gcL + 64;
    const float* G = (const float*)(ws + OFF_G); const float* BT = (const float*)(ws + OFF_BETA);
    float gc = G[(size_t)(tok0 + lane) * 8 + h];
    const float bv = BT[(size_t)(tok0 + lane) * 8 + h];
#pragma unroll
    for (int o = 1; o < 64; o <<= 1) { const float t = __int_as_float(__builtin_amdgcn_ds_bpermute((lane - o) << 2, __float_as_int(gc))); if (lane >= o) gc += t; }
    const float gl = __int_as_float(__builtin_amdgcn_readlane(__float_as_int(gc), 63));
    gcL[lane] = gc; btL[lane] = bv;
    if (lane == 0) ((float*)(ws + OFF_GLAST))[it] = __expf(gl);
    WSYNC();
    const bf16_t* kp = (const bf16_t*)(ws + OFF_KN) + (size_t)tok0 * 1024 + h * 128;
    const bf16_t* qp = (const bf16_t*)(ws + OFF_QN) + (size_t)tok0 * 1024 + h * 128;
    bf16x8 Kf[2][8];
#pragma unroll
    for (int mt = 0; mt < 2; ++mt)
#pragma unroll
        for (int ks = 0; ks < 8; ++ks) Kf[mt][ks] = *(const bf16x8*)(kp + (size_t)(mt * 32 + r) * 1024 + ks * 16 + hh * 8);
    {
        bf16_t* KG = (bf16_t*)(ws + OFF_KG) + (size_t)it * 8192;
#pragma unroll
        for (int mt = 0; mt < 2; ++mt) {
            const float e = -__expf(gcL[mt * 32 + r]);
#pragma unroll
            for (int ks = 0; ks < 8; ++ks) {
                const u32x4 v = __builtin_bit_cast(u32x4, Kf[mt][ks]);
                u32x2 o0, o1; o0.x = pk2(bflo(v.x) * e, bfhi(v.x) * e); o0.y = pk2(bflo(v.y) * e, bfhi(v.y) * e);
                o1.x = pk2(bflo(v.z) * e, bfhi(v.z) * e); o1.y = pk2(bflo(v.w) * e, bfhi(v.w) * e);
                bf16_t* fp = KG + (mt * 8 + ks) * 512 + r * 8 + 4 * hh;
                *(u32x2*)fp = o0; *(u32x2*)(fp + 256) = o1;
            }
        }
    }
    __builtin_amdgcn_sched_barrier(0);
#pragma unroll
    for (int ti = 0; ti < 3; ++ti) {
        __builtin_amdgcn_sched_barrier(0);
        const int mi = (ti >= 1), ni = (ti == 2);
        f32x16 a = {};
#pragma unroll
        for (int ks = 0; ks < 8; ++ks) a = mfma32(Kf[mi][ks], Kf[ni][ks], a);
        const int j = ni * 32 + r; const float gcj = gcL[j];
#pragma unroll
        for (int qq = 0; qq < 4; ++qq) {
            const int i0 = mi * 32 + 8 * qq + 4 * hh;
            const f32x4 gci = *(const LAS f32x4*)(gcL + i0), bti = *(const LAS f32x4*)(btL + i0);
            f32x4 mv;
#pragma unroll
            for (int e = 0; e < 4; ++e) {
                const int i = i0 + e;
                const float dec = __expf(fminf(gci[e] - gcj, 0.f));
                mv[e] = (i > j) ? bti[e] * a[qq * 4 + e] * dec : 0.f;
            }
            *(LAS f32x4*)(MT + ti * 32 * MTP + r * MTP + 8 * qq + 4 * hh) = mv;
        }
    }
    bf16_t* ATT = (bf16_t*)(ws + OFF_ATT) + (size_t)it * 4096;
    bf16_t* QG = (bf16_t*)(ws + OFF_QG) + (size_t)it * 8192;
#pragma unroll
    for (int mi = 0; mi < 2; ++mi) {
        __builtin_amdgcn_sched_barrier(0);
        bf16x8 Qf[8];
#pragma unroll
        for (int ks = 0; ks < 8; ++ks) Qf[ks] = *(const bf16x8*)(qp + (size_t)(mi * 32 + r) * 1024 + ks * 16 + hh * 8);
#pragma unroll
        for (int ni = 0; ni <= mi; ++ni) {
            __builtin_amdgcn_sched_barrier(0);
            f32x16 q = {};
#pragma unroll
            for (int ks = 0; ks < 8; ++ks) q = mfma32(Qf[ks], Kf[ni][ks], q);
            const int j = ni * 32 + r; const float gcj = gcL[j];
#pragma unroll
            for (int qq = 0; qq < 4; ++qq) {
                const int i0 = mi * 32 + 8 * qq + 4 * hh;
                const f32x4 gci = *(const LAS f32x4*)(gcL + i0);
#pragma unroll
                for (int e = 0; e < 4; ++e) {
                    const int i = i0 + e;
                    const float dec = __expf(fminf(gci[e] - gcj, 0.f));
                    ATT[((mi * 2 + ni) * 2 + (r >> 4)) * 512 + (((r >> 2) & 1) * 32 + (i & 31)) * 8 + 4 * ((r >> 3) & 1) + (r & 3)] = f2bf((i >= j) ? q[qq * 4 + e] * dec : 0.f);
                }
            }
        }
        __builtin_amdgcn_sched_barrier(0);
        const float e = __expf(gcL[mi * 32 + r]);
#pragma unroll
        for (int ks = 0; ks < 8; ++ks) {
            const u32x4 v = __builtin_bit_cast(u32x4, Qf[ks]);
            u32x2 o0, o1; o0.x = pk2(bflo(v.x) * e, bfhi(v.x) * e); o0.y = pk2(bflo(v.y) * e, bfhi(v.y) * e);
            o1.x = pk2(bflo(v.z) * e, bfhi(v.z) * e); o1.y = pk2(bflo(v.w) * e, bfhi(v.w) * e);
            bf16_t* fp = QG + (mi * 8 + ks) * 512 + r * 8 + 4 * hh;
            *(u32x2*)fp = o0; *(u32x2*)(fp + 256) = o1;
        }
    }
    WSYNC();
    float t[64];
    solve_col<63>(t, MT, lane);
    WSYNC();
    int lane5 = lane; asm volatile("" : "+v"(lane5) : "v"(t[0]));
    const int r5 = lane5 & 31, h5 = lane5 >> 5;
    {
        bf16_t* TBt = (bf16_t*)(ws + OFF_TBT) + (size_t)it * 4096 + ((lane5 >> 5) * 4) * 512 + (lane5 & 31) * 8;
#pragma unroll
        for (int m2 = 0; m2 < 2; ++m2)
#pragma unroll
            for (int sx = 0; sx < 2; ++sx) {
                const int c0 = m2 * 32 + 16 * sx;
                const f32x4 b0 = *(const LAS f32x4*)(btL + c0), b1 = *(const LAS f32x4*)(btL + c0 + 4), b2 = *(const LAS f32x4*)(btL + c0 + 8), b3 = *(const LAS f32x4*)(btL + c0 + 12);
                u32x4 oa, ob;
                oa.x = pk2(t[c0 + 0] * b0[0], t[c0 + 1] * b0[1]); oa.y = pk2(t[c0 + 2] * b0[2], t[c0 + 3] * b0[3]);
                oa.z = pk2(t[c0 + 8] * b2[0], t[c0 + 9] * b2[1]); oa.w = pk2(t[c0 + 10] * b2[2], t[c0 + 11] * b2[3]);
                ob.x = pk2(t[c0 + 4] * b1[0], t[c0 + 5] * b1[1]); ob.y = pk2(t[c0 + 6] * b1[2], t[c0 + 7] * b1[3]);
                ob.z = pk2(t[c0 + 12] * b3[0], t[c0 + 13] * b3[1]); ob.w = pk2(t[c0 + 14] * b3[2], t[c0 + 15] * b3[3]);
                bf16_t* fp = TBt + (m2 * 2 + sx) * 512;
                *(u32x4*)fp = oa; *(u32x4*)(fp + 256) = ob;
            }
    }
    {
        const bf16_t* KT = (const bf16_t*)(ws + OFF_KT) + (size_t)it * 8192;
        bf16_t* KDT = (bf16_t*)(ws + OFF_KDT) + (size_t)it * 8192;
#pragma unroll
        for (int nt = 0; nt < 4; ++nt) {
            __builtin_amdgcn_sched_barrier(0);
#pragma unroll
            for (int ks = 0; ks < 4; ++ks) {
                const u32x4 v = *(const u32x4*)(KT + (size_t)(nt * 32 + r5) * 64 + ks * 16 + h5 * 8);
                const f32x4 g0 = *(const LAS f32x4*)(gcL + ks * 16 + h5 * 8), g1 = *(const LAS f32x4*)(gcL + ks * 16 + h5 * 8 + 4);
                u32x2 o0, o1;
                o0.x = pk2(bflo(v.x) * __expf(gl - g0[0]), bfhi(v.x) * __expf(gl - g0[1])); o0.y = pk2(bflo(v.y) * __expf(gl - g0[2]), bfhi(v.y) * __expf(gl - g0[3]));
                o1.x = pk2(bflo(v.z) * __expf(gl - g1[0]), bfhi(v.z) * __expf(gl - g1[1])); o1.y = pk2(bflo(v.w) * __expf(gl - g1[2]), bfhi(v.w) * __expf(gl - g1[3]));
                bf16_t* fp = KDT + (nt * 4 + ks) * 512 + r5 * 8 + 4 * h5;
                *(u32x2*)fp = o0; *(u32x2*)(fp + 256) = o1;
            }
        }
    }
    WSYNC();
}

__device__ __forceinline__ void gdn_sample_item(const Params& p, int it, LAS unsigned char* wl) {
    unsigned char* ws = p.ws;
    int lane = threadIdx.x; asm volatile("" : "+v"(lane)); lane &= 63;
    const int c = lane & 31, hh = lane >> 5;
    const int qd = it & 3, bh = it >> 2, h = bh & 7, b = bh >> 3;
    const int dv = qd * 32 + c;
    float s[64];
    { const float* sp = p.in[4] + (size_t)bh * 16384 + (size_t)(hh * 64) * 128 + dv;
#pragma unroll
      for (int i = 0; i < 64; ++i) s[i] = sp[i * 128]; }
    LAS float* kq = (LAS float*)wl;
    const float* QKVS = (const float*)(ws + OFF_QKVS);
    const float* G = (const float*)(ws + OFF_G); const float* BT = (const float*)(ws + OFF_BETA);
    bf16_t* O = (bf16_t*)(ws + OFF_O);
#pragma unroll
    for (int t = 0; t < 4; ++t) {
        const float* row = QKVS + (size_t)(b * 4 + t) * 3072 + h * 128;
        kq[t * 256 + lane] = row[1024 + lane]; kq[t * 256 + 64 + lane] = row[1024 + 64 + lane];
        kq[t * 256 + 128 + lane] = row[lane]; kq[t * 256 + 192 + lane] = row[64 + lane];
    }
    WSYNC();
#pragma unroll 1
    for (int t = 0; t < 4; ++t) {
        const int tok = NPR + b * 4 + t;
        const float al = __expf(G[(size_t)tok * 8 + h]), be = BT[(size_t)tok * 8 + h];
        const float v = QKVS[(size_t)(b * 4 + t) * 3072 + 2048 + h * 128 + dv];
        float d0 = 0.f, d1 = 0.f, d2 = 0.f, d3 = 0.f;
        int kb = t * 256 + hh * 64;
#pragma unroll
        for (int i = 0; i < 64; i += 4) {
            if ((i & 15) == 0) asm volatile("" : "+v"(kb) : "v"(d0), "v"(d1), "v"(d2), "v"(d3));
            const f32x4 kk = *(const LAS f32x4*)(kq + kb + i);
            s[i] *= al; s[i + 1] *= al; s[i + 2] *= al; s[i + 3] *= al;
            d0 += kk[0] * s[i]; d1 += kk[1] * s[i + 1]; d2 += kk[2] * s[i + 2]; d3 += kk[3] * s[i + 3];
        }
        float dd = (d0 + d1) + (d2 + d3);
        dd += __shfl_xor(dd, 32);
        const float rr = be * (v - dd);
        float o0 = 0.f, o1 = 0.f, o2 = 0.f, o3 = 0.f;
        asm volatile("" : "+v"(kb) : "v"(rr));
#pragma unroll
        for (int i = 0; i < 64; i += 4) {
            if ((i & 15) == 0) asm volatile("" : "+v"(kb) : "v"(o0), "v"(o1), "v"(o2), "v"(o3));
            const f32x4 kk = *(const LAS f32x4*)(kq + kb + i);
            const f32x4 qq = *(const LAS f32x4*)(kq + kb + 128 + i);
            s[i] += rr * kk[0]; s[i + 1] += rr * kk[1]; s[i + 2] += rr * kk[2]; s[i + 3] += rr * kk[3];
            o0 += qq[0] * s[i]; o1 += qq[1] * s[i + 1]; o2 += qq[2] * s[i + 2]; o3 += qq[3] * s[i + 3];
        }
        float oo = (o0 + o1) + (o2 + o3);
        oo += __shfl_xor(oo, 32);
        if (hh == 0) O[(size_t)tok * 1024 + h * 128 + dv] = f2bf(oo);
    }
    int dv2 = dv; asm volatile("" : "+v"(dv2));
    float* So = p.out + O_SGDN + (size_t)bh * 16384 + (size_t)(hh * 64) * 128 + dv2;
#pragma unroll
    for (int i = 0; i < 64; ++i) So[i * 128] = s[i];
    WSYNC();
}

__device__ __forceinline__ void phase_gdn_prep(const Params& p, LAS unsigned char* lds) {
    const int wave = __builtin_amdgcn_readfirstlane(threadIdx.x >> 6);
    LAS unsigned char* wl = lds + wave * 16384;
    if (wave < 4) { for (int it = blockIdx.x * 4 + wave; it < 1024; it += gridDim.x * 4) gdn_prep_item(p, it, wl, (LAS float*)(lds + 143360 + wave * 512)); }
    else {
        for (int it = blockIdx.x * 4 + (wave - 4); it < 4096; it += gridDim.x * 4) gdn_sample_item(p, it, wl);
        for (int u = blockIdx.x * 4 + (wave - 4); u < 2048; u += gridDim.x * 4) { const int g = u & 63, bq = u >> 6; float zr = 0.f, zi = 0.f; s5_unit(p, g, NPR + bq * 16, 1, true, bq * 4, wl, 8192, zr, zi, false); }
    }
}

__device__ __forceinline__ bf16x8 ldperm(const bf16_t* p8, int hh) {
    const u32x2 lo = *(const u32x2*)(p8 + 4 * hh), hi = *(const u32x2*)(p8 + 8 + 4 * hh);
    return mk8(lo.x, lo.y, hi.x, hi.y);
}
constexpr int GDN_BUF = 61440, GDN_LDS0 = 21504;
__device__ __forceinline__ void gdn_dma_chunk(const unsigned char* ws, int it, LAS unsigned char* buf, int lane) {
    const bf16_t* KG = (const bf16_t*)(ws + OFF_KG) + (size_t)it * 8192 + lane * 8;
    const bf16_t* QG = (const bf16_t*)(ws + OFF_QG) + (size_t)it * 8192 + lane * 8;
    const bf16_t* KDT = (const bf16_t*)(ws + OFF_KDT) + (size_t)it * 8192 + lane * 8;
#pragma unroll
    for (int f = 0; f < 16; ++f) __builtin_amdgcn_global_load_lds((const unsigned*)(KG + f * 512), (LAS unsigned*)(buf + f * 1024), 16, 0, 0);
#pragma unroll
    for (int f = 0; f < 16; ++f) __builtin_amdgcn_global_load_lds((const unsigned*)(QG + f * 512), (LAS unsigned*)(buf + 16384 + f * 1024), 16, 0, 0);
#pragma unroll
    for (int f = 0; f < 16; ++f) __builtin_amdgcn_global_load_lds((const unsigned*)(KDT + f * 512), (LAS unsigned*)(buf + 32768 + f * 1024), 16, 0, 0);
    const bf16_t* TBt = (const bf16_t*)(ws + OFF_TBT) + (size_t)it * 4096 + lane * 8;
    const bf16_t* ATT = (const bf16_t*)(ws + OFF_ATT) + (size_t)it * 4096 + lane * 8;
#pragma unroll
    for (int k = 0; k < 6; ++k) { const int f = (k < 2) ? k : k + 2;
        __builtin_amdgcn_global_load_lds((const unsigned*)(TBt + f * 512), (LAS unsigned*)(buf + 49152 + k * 1024), 16, 0, 0);
        __builtin_amdgcn_global_load_lds((const unsigned*)(ATT + f * 512), (LAS unsigned*)(buf + 55296 + k * 1024), 16, 0, 0); }
}
template <int PAR>
__device__ __forceinline__ void gdn_chunk(const Params& p, LAS unsigned char* gb, int n, int bh, int b, int h, int dv, int hh, int lane, f32x16 (&S)[4]) {
    unsigned char* ws = p.ws;
    asm volatile("s_waitcnt vmcnt(0)" ::: "memory");
    const int it = bh * 32 + n;
    const LAS unsigned char* cb = gb + PAR * GDN_BUF + lane * 16;
    const float* VV = (const float*)(ws + OFF_VV) + (size_t)(b * 2048 + n * 64) * 1024 + h * 128 + dv;
    bf16_t* O = (bf16_t*)(ws + OFF_O);
    const float gl = ((const float*)(ws + OFF_GLAST))[it];
    f32x16 v0, v1;
#pragma unroll
    for (int q = 0; q < 16; ++q) { const int i = 8 * (q >> 2) + 4 * hh + (q & 3); v0[q] = VV[(size_t)i * 1024]; v1[q] = VV[(size_t)(32 + i) * 1024]; }
    float pf8 = 0.f;
    if (n + 1 < 32) pf8 = VV[(size_t)(64 + lane) * 1024];
    if (n + 1 < 32) gdn_dma_chunk(ws, it + 1, gb + (1 - PAR) * GDN_BUF, lane);
    bf16x8 Sb[4][2];
#pragma unroll
    for (int kt = 0; kt < 4; ++kt)
#pragma unroll
        for (int s = 0; s < 2; ++s)
            Sb[kt][s] = mk8(pk2(S[kt][8 * s + 0], S[kt][8 * s + 1]), pk2(S[kt][8 * s + 2], S[kt][8 * s + 3]), pk2(S[kt][8 * s + 4], S[kt][8 * s + 5]), pk2(S[kt][8 * s + 6], S[kt][8 * s + 7]));
    bf16x8 Eb[2][2];
    {
        f32x16 a0 = {}, a1 = {};
#pragma unroll
        for (int kt = 0; kt < 4; ++kt)
#pragma unroll
            for (int s = 0; s < 2; ++s) {
                const u32x4 hv = __builtin_bit_cast(u32x4, Sb[kt][s]);
                const bf16x8 lo = mk8(pk2(S[kt][8 * s + 0] - bflo(hv.x), S[kt][8 * s + 1] - bfhi(hv.x)), pk2(S[kt][8 * s + 2] - bflo(hv.y), S[kt][8 * s + 3] - bfhi(hv.y)),
                                      pk2(S[kt][8 * s + 4] - bflo(hv.z), S[kt][8 * s + 5] - bfhi(hv.z)), pk2(S[kt][8 * s + 6] - bflo(hv.w), S[kt][8 * s + 7] - bfhi(hv.w)));
                const bf16x8 A0 = *(const LAS bf16x8*)(cb + (kt * 2 + s) * 1024);
                const bf16x8 A1 = *(const LAS bf16x8*)(cb + (8 + kt * 2 + s) * 1024);
                a0 = mfma32(A0, Sb[kt][s], a0); a1 = mfma32(A1, Sb[kt][s], a1);
                a0 = mfma32(A0, lo, a0); a1 = mfma32(A1, lo, a1);
            }
        a0 += v0; a1 += v1;
#pragma unroll
        for (int s = 0; s < 2; ++s) {
            Eb[0][s] = mk8(pk2(a0[8 * s + 0], a0[8 * s + 1]), pk2(a0[8 * s + 2], a0[8 * s + 3]), pk2(a0[8 * s + 4], a0[8 * s + 5]), pk2(a0[8 * s + 6], a0[8 * s + 7]));
            Eb[1][s] = mk8(pk2(a1[8 * s + 0], a1[8 * s + 1]), pk2(a1[8 * s + 2], a1[8 * s + 3]), pk2(a1[8 * s + 4], a1[8 * s + 5]), pk2(a1[8 * s + 6], a1[8 * s + 7]));
        }
    }
    bf16x8 Vb[2][2];
#pragma unroll
    for (int mt = 0; mt < 2; ++mt) {
        f32x16 a = {};
#pragma unroll
        for (int m2 = 0; m2 <= mt; ++m2)
#pragma unroll
            for (int s = 0; s < 2; ++s) a = mfma32(*(const LAS bf16x8*)(cb + 49152 + ((mt == 0) ? s : 2 + m2 * 2 + s) * 1024), Eb[m2][s], a);
#pragma unroll
        for (int s = 0; s < 2; ++s)
            Vb[mt][s] = mk8(pk2(a[8 * s + 0], a[8 * s + 1]), pk2(a[8 * s + 2], a[8 * s + 3]), pk2(a[8 * s + 4], a[8 * s + 5]), pk2(a[8 * s + 6], a[8 * s + 7]));
    }
#pragma unroll
    for (int mt = 0; mt < 2; ++mt) {
        f32x16 a = {};
#pragma unroll
        for (int kt = 0; kt < 4; ++kt)
#pragma unroll
            for (int s = 0; s < 2; ++s) a = mfma32(*(const LAS bf16x8*)(cb + 16384 + ((mt * 4 + kt) * 2 + s) * 1024), Sb[kt][s], a);
#pragma unroll
        for (int m2 = 0; m2 <= mt; ++m2)
#pragma unroll
            for (int s = 0; s < 2; ++s) a = mfma32(*(const LAS bf16x8*)(cb + 55296 + ((mt == 0) ? s : 2 + m2 * 2 + s) * 1024), Vb[m2][s], a);
#pragma unroll
        for (int q = 0; q < 16; ++q) { const int i = mt * 32 + 8 * (q >> 2) + 4 * hh + (q & 3);
            O[(size_t)(b * 2048 + n * 64 + i) * 1024 + h * 128 + dv] = f2bf(a[q]); }
    }
#pragma unroll
    for (int kt = 0; kt < 4; ++kt) {
        f32x16 a = S[kt] * gl;
#pragma unroll
        for (int m2 = 0; m2 < 2; ++m2)
#pragma unroll
            for (int s = 0; s < 2; ++s) a = mfma32(*(const LAS bf16x8*)(cb + 32768 + ((kt * 2 + m2) * 2 + s) * 1024), Vb[m2][s], a);
        S[kt] = a;
    }
    asm volatile("" :: "v"(pf8));
}
__device__ __forceinline__ void gdn_scan_unit(const Params& p, int unit, LAS unsigned char* gb) {
    int lane = threadIdx.x; asm volatile("" : "+v"(lane)); lane &= 63;
    const int r = lane & 31, hh = lane >> 5;
    const int sl = unit & 3, bh = unit >> 2, h = bh & 7, b = bh >> 3;
    const int dv = sl * 32 + r;
    f32x16 S[4];
#pragma unroll
    for (int kt = 0; kt < 4; ++kt) S[kt] = (f32x16){};
    gdn_dma_chunk(p.ws, bh * 32, gb, lane);
#pragma unroll 1
    for (int n = 0; n < 32; n += 2) {
        gdn_chunk<0>(p, gb, n, bh, b, h, dv, hh, lane, S);
        gdn_chunk<1>(p, gb, n + 1, bh, b, h, dv, hh, lane, S);
    }
    int lane6 = threadIdx.x; asm volatile("" : "+v"(lane6)); lane6 &= 63;
    float* So = p.out + O_PGDN + (size_t)bh * 16384 + (sl * 32 + (lane6 & 31)) + (size_t)(4 * (lane6 >> 5)) * 128;
#pragma unroll
    for (int kt = 0; kt < 4; ++kt)
#pragma unroll
        for (int q = 0; q < 16; ++q) { const int dk = kt * 32 + 8 * (q >> 2) + (q & 3); So[(size_t)dk * 128] = S[kt][q]; }
}

__device__ __forceinline__ void s5_unit(const Params& p, int g, int tok_base, int nsub, bool sample, int b0, LAS unsigned char* wl, int hb_off, float& hr_io, float& hi_io, bool store_final) {
    unsigned char* ws = p.ws;
    int lane = threadIdx.x; asm volatile("" : "+v"(lane)); lane &= 63;
    const int l15 = lane & 15, l4 = lane >> 4;
    LAS bf16_t* HB = (LAS bf16_t*)(wl + hb_off);
    const bf16_t* PB = (const bf16_t*)(ws + OFF_PROJB);
    bf16_t* ZB = (bf16_t*)(ws + OFF_ZB);
    const float* AB = (const float*)(ws + OFF_ABAR);
    const float ar = AB[(g * 64 + lane) * 2], ai = AB[(g * 64 + lane) * 2 + 1];
    const bf16_t* bbt = (const bf16_t*)(ws + OFF_BBT) + (size_t)g * 2048;
    const bf16_t* ct = (const bf16_t*)(ws + OFF_CT) + (size_t)g * 2048;
    bf16x8 Bf[8], Cf[4];
    const bf16x8 zero8 = {0, 0, 0, 0, 0, 0, 0, 0};
#pragma unroll
    for (int nt = 0; nt < 8; ++nt) Bf[nt] = (l4 < 2) ? *(const bf16x8*)(bbt + (nt * 16 + l15) * 16 + 8 * l4) : zero8;
#pragma unroll
    for (int s = 0; s < 4; ++s) Cf[s] = *(const bf16x8*)(ct + l15 * 128 + 32 * s + 8 * l4);
    const float dskip = p.in[18][g * 16 + l15];
    float hr = hr_io, hi = hi_io;
    const int last_tok = tok_base + (nsub - 1) * 16;
    {
        const bf16x8 A0 = (l4 < 2) ? *(const bf16x8*)(PB + (size_t)(tok_base + l15) * NPB + g * 16 + 8 * l4) : zero8;
        LAS float* BU = (LAS float*)wl;
#pragma unroll
        for (int nt = 0; nt < 8; ++nt) {
            f32x4 a = {0.f, 0.f, 0.f, 0.f};
            a = mfma16(A0, Bf[nt], a);
#pragma unroll
            for (int q = 0; q < 4; ++q) BU[(4 * l4 + q) * 128 + nt * 16 + l15] = a[q];
        }
    }
    const int tok1 = (nsub > 1) ? tok_base + 16 : tok_base;
    bf16x8 Au = (l4 < 2) ? *(const bf16x8*)(PB + (size_t)(tok1 + l15) * NPB + g * 16 + 8 * l4) : zero8;
    float uu[4];
#pragma unroll
    for (int q = 0; q < 4; ++q) uu[q] = bf2f(PB[(size_t)(tok_base + 4 * l4 + q) * NPB + g * 16 + l15]);
    WSYNC();
#pragma unroll 1
    for (int sc = 0; sc < nsub; ++sc) {
        const int tok0 = tok_base + sc * 16;
        LAS float* BU = (LAS float*)(wl + (sc & 1) * 8192);
        LAS float* BUn = (LAS float*)(wl + ((sc + 1) & 1) * 8192);
        const int tok2 = (tok0 + 32 <= last_tok) ? tok0 + 32 : last_tok;
        const int tokn = (tok0 + 16 <= last_tok) ? tok0 + 16 : last_tok;
        const bf16x8 Au_n = (l4 < 2) ? *(const bf16x8*)(PB + (size_t)(tok2 + l15) * NPB + g * 16 + 8 * l4) : zero8;
        float uu_n[4];
#pragma unroll
        for (int q = 0; q < 4; ++q) uu_n[q] = bf2f(PB[(size_t)(tokn + 4 * l4 + q) * NPB + g * 16 + l15]);
        if (sc + 1 < nsub) {
#pragma unroll
            for (int nt = 0; nt < 8; ++nt) {
                f32x4 a = {0.f, 0.f, 0.f, 0.f};
                a = mfma16(Au, Bf[nt], a);
#pragma unroll
                for (int q = 0; q < 4; ++q) BUn[(4 * l4 + q) * 128 + nt * 16 + l15] = a[q];
            }
        }
#pragma unroll
        for (int t = 0; t < 16; ++t) {
            if (sample && (t & 3) == 0) {
                const int bb = b0 + (t >> 2);
                hr = p.in[2][((size_t)bb * 64 + g) * 64 + lane]; hi = p.in[3][((size_t)bb * 64 + g) * 64 + lane];
            }
            const float br = BU[t * 128 + lane], bi = BU[t * 128 + 64 + lane];
            const float nr = ar * hr - ai * hi + br, ni = ar * hi + ai * hr + bi;
            hr = nr; hi = ni;
            HB[t * 136 + lane] = f2bf(hr); HB[t * 136 + 64 + lane] = f2bf(hi);
            if (sample && (t & 3) == 3) {
                const int bb = b0 + (t >> 2);
                p.out[O_SRE + ((size_t)bb * 64 + g) * 64 + lane] = hr; p.out[O_SIM + ((size_t)bb * 64 + g) * 64 + lane] = hi;
            }
        }
        WSYNC();
        f32x4 y = {0.f, 0.f, 0.f, 0.f};
#pragma unroll
        for (int s = 0; s < 4; ++s) {
            const bf16x8 Ah = *(const LAS bf16x8*)(HB + l15 * 136 + 32 * s + 8 * l4);
            y = mfma16(Ah, Cf[s], y);
        }
#pragma unroll
        for (int q = 0; q < 4; ++q) {
            const int tok = tok0 + 4 * l4 + q;
            ZB[(size_t)tok * 1024 + g * 16 + l15] = f2bf(gelu_tanh(y[q] + dskip * uu[q]));
        }
        WSYNC();
        Au = Au_n;
#pragma unroll
        for (int q = 0; q < 4; ++q) uu[q] = uu_n[q];
    }
    hr_io = hr; hi_io = hi;
    if (!sample && store_final) {
        const int b = tok_base >> 11;
        p.out[O_PRE + ((size_t)b * 64 + g) * 64 + lane] = hr; p.out[O_PIM + ((size_t)b * 64 + g) * 64 + lane] = hi;
    }
}

__device__ __forceinline__ void phase_scan(const Params& p, LAS unsigned char* lds, float& s5r, float& s5i, bool split5) {
    const int wave = __builtin_amdgcn_readfirstlane(threadIdx.x >> 6);
    if (wave == 0) {
        for (int B = blockIdx.x; B < 128; B += gridDim.x) { const int xi = B & 7, idx = B >> 3; gdn_scan_unit(p, ((xi * 4 + (idx >> 2)) << 2) + (idx & 3), lds + GDN_LDS0); }
    }
    else if (wave == 7) {
        if (split5) { const int u = blockIdx.x; if (u < 256) s5_unit(p, u & 63, (u >> 6) * 2048 + S5_SPLIT * 16, 128 - S5_SPLIT, false, 0, lds, 16384, s5r, s5i, true); }
        else { for (int u = blockIdx.x; u < 256; u += gridDim.x) { float zr = 0.f, zi = 0.f; s5_unit(p, u & 63, (u >> 6) * 2048, 128, false, 0, lds, 16384, zr, zi, true); } }
    }
}

__device__ __forceinline__ void phase_onorm(const Params& p) {
    unsigned char* ws = p.ws;
    int lane = threadIdx.x; asm volatile("" : "+v"(lane)); lane &= 63;
    const int wave = __builtin_amdgcn_readfirstlane(threadIdx.x >> 6);
    const bf16_t* O = (const bf16_t*)(ws + OFF_O); const bf16_t* PB = (const bf16_t*)(ws + OFF_PROJB);
    bf16_t* YM = (bf16_t*)(ws + OFF_YMIX);
    const float nw0 = p.in[24][2 * lane], nw1 = p.in[24][2 * lane + 1];
    for (int it4 = blockIdx.x * 8 + wave; it4 < NTOK * 2; it4 += gridDim.x * 8) {
        unsigned ov[4], gv[4];
#pragma unroll
        for (int j = 0; j < 4; ++j) {
            const int it = it4 * 4 + j, h = it & 7, tok = it >> 3;
            ov[j] = *(const unsigned*)(O + (size_t)tok * 1024 + h * 128 + 2 * lane);
            gv[j] = *(const unsigned*)(PB + (size_t)tok * NPB + 4096 + h * 128 + 2 * lane);
        }
        float ss[4];
#pragma unroll
        for (int j = 0; j < 4; ++j) { const float o0 = bflo(ov[j]), o1 = bfhi(ov[j]); ss[j] = o0 * o0 + o1 * o1; }
#pragma unroll
        for (int o = 1; o < 64; o <<= 1) {
#pragma unroll
            for (int j = 0; j < 4; ++j) ss[j] += __shfl_xor(ss[j], o);
        }
#pragma unroll
        for (int j = 0; j < 4; ++j) {
            const int it = it4 * 4 + j, h = it & 7, tok = it >> 3;
            const float o0 = bflo(ov[j]), o1 = bfhi(ov[j]);
            const float rs = 1.f / sqrtf(ss[j] * (1.f / 128.f) + 1e-6f);
            *(unsigned*)(YM + (size_t)tok * DM + 1024 + h * 128 + 2 * lane) = pk2(o0 * rs * nw0 * siluf(bflo(gv[j])), o1 * rs * nw1 * siluf(bfhi(gv[j])));
        }
    }
}

#define XB_TMO      128
#define XB_XCNT(j)  (256  + 64 * (j))
#define XB_XSUB(j)  (1280 + 64 * (j))
#define XB_XGEN(j)  (2304 + 64 * (j))
#define XB_TOP      3328
#define XB_TOPGEN   3392
#define XCD_BAR_WORDS 3456
#define XB_SPIN_CAP (1u << 18)
__device__ __forceinline__ unsigned xb_ld(unsigned* p)              { return __hip_atomic_load(p, __ATOMIC_RELAXED, __HIP_MEMORY_SCOPE_AGENT); }
__device__ __forceinline__ unsigned xb_add(unsigned* p, unsigned v) { return __hip_atomic_fetch_add(p, v, __ATOMIC_RELAXED, __HIP_MEMORY_SCOPE_AGENT); }
__device__ __forceinline__ unsigned xb_xcc_id() { return (unsigned)__builtin_amdgcn_s_getreg((3 << 11) | 20) & 0xFu; }
#define XB_SPIN(cond, bar) do { unsigned _sp = 0; while (cond) { __builtin_amdgcn_s_sleep(1); \
    if ((++_sp & 255u) == 0u) { if (xb_ld(&(bar)[XB_TMO])) break; if (_sp > XB_SPIN_CAP) { atomicAdd(&(bar)[XB_TMO], 1u); break; } } } } while (0)
struct XcdBarrier { unsigned* bar; unsigned x; volatile LAS unsigned* st; };
__device__ __forceinline__ XcdBarrier xcd_barrier_post(unsigned* bar, volatile LAS unsigned* st) {
    XcdBarrier b; b.bar = bar; b.x = xb_xcc_id(); b.st = st;
    if (threadIdx.x == 0) (void)xb_add(&bar[XB_XCNT(b.x)], 1u);
    return b;
}
__device__ __forceinline__ void xcd_barrier_complete(unsigned* bar, unsigned x, unsigned& nloc, unsigned& nx) {
    const unsigned G = gridDim.x * gridDim.y * gridDim.z;
    unsigned sum, cnt, mine, sp = 0u;
    for (;;) {
        sum = 0u; cnt = 0u; mine = 0u;
#pragma unroll
        for (unsigned j = 0; j < 16; ++j) { const unsigned c = xb_ld(&bar[XB_XCNT(j)]); sum += c; cnt += (c > 0u) ? 1u : 0u; mine = (j == x) ? c : mine; }
        if (sum == G) break;
        __builtin_amdgcn_s_sleep(1);
        if ((++sp & 255u) == 0u) { if (xb_ld(&bar[XB_TMO])) break; if (sp > XB_SPIN_CAP) { atomicAdd(&bar[XB_TMO], 1u); break; } }
    }
    nloc = mine > 0u ? mine : 1u; nx = cnt > 0u ? cnt : 1u;
}
__device__ __forceinline__ void xcd_barrier(const XcdBarrier& b) {
    asm volatile("s_waitcnt vmcnt(0)" ::: "memory");
    __syncthreads();
    if (threadIdx.x == 0) {
        unsigned* bar = b.bar;
        __builtin_amdgcn_s_waitcnt(0);
        unsigned nloc = b.st[0], nx = b.st[1];
        if (nloc == 0u) { xcd_barrier_complete(bar, b.x, nloc, nx); b.st[0] = nloc; b.st[1] = nx; }
        const unsigned old = xb_add(&bar[XB_XSUB(b.x)], 1u);
        const unsigned gen = old / nloc;
        if (old + 1u == (gen + 1u) * nloc) {
            __builtin_amdgcn_fence(__ATOMIC_RELEASE, "agent");
            asm volatile("s_waitcnt vmcnt(0)" ::: "memory");
            const unsigned og = xb_add(&bar[XB_TOP], 1u);
            const unsigned tg = og / nx;
            if (og + 1u == (tg + 1u) * nx) xb_add(&bar[XB_TOPGEN], 1u);
            else XB_SPIN(xb_ld(&bar[XB_TOPGEN]) == tg, bar);
            __builtin_amdgcn_fence(__ATOMIC_ACQUIRE, "agent");
            xb_add(&bar[XB_XGEN(b.x)], 1u);
            asm volatile("s_waitcnt vmcnt(0)" ::: "memory");
        } else {
            XB_SPIN(xb_ld(&bar[XB_XGEN(b.x)]) == gen, bar);
            __builtin_amdgcn_fence(__ATOMIC_ACQUIRE, "agent");
            asm volatile("s_waitcnt vmcnt(0)" ::: "memory");
        }
    }
    __syncthreads();
}

__global__ void __launch_bounds__(512, 2) fwd_megakernel(Params p) {
    extern __shared__ __attribute__((aligned(16))) unsigned char shm[];
    LAS unsigned char* lds = (LAS unsigned char*)shm;
    cg::grid_group grid = cg::this_grid();
    unsigned char* ws = p.ws;
    pg8::StaticOrder S;
    volatile LAS unsigned* bst = (volatile LAS unsigned*)(lds + 147456 - 16);
    if (threadIdx.x == 0) { bst[0] = 0u; bst[1] = 0u; }
    __syncthreads();
    const XcdBarrier xb = xcd_barrier_post((unsigned*)(ws + OFF_BAR), bst);
    phase_convert0(p, lds);
    grid.sync();
    if (STOP_AFTER <= 0) return;
    { S.init(NTOK, 2 * DFF, DM, gridDim.x, blockIdx.x, false); pg8::Gemm g{(const bf16_t*)(ws + OFF_XNB), (const bf16_t*)(ws + OFF_W1T), NTOK, 2 * DFF, DM};
      EpiSwiglu E{(bf16_t*)(ws + OFF_H)}; pg8::gemm_phase(lds, g, S, E); }
    xcd_barrier(xb);
    { S.init(NTOK, DM, DFF, gridDim.x, blockIdx.x, true); pg8::Gemm g{(const bf16_t*)(ws + OFF_H), (const bf16_t*)(ws + OFF_W1O), NTOK, DM, DFF};
      EpiResid E{(bf16_t*)(ws + OFF_R), p.in[0], p.in[1], (float*)(ws + OFF_PART), nullptr, (const bf16_t*)(ws + OFF_XNB), 0.5f}; pg8::gemm_phase(lds, g, S, E); }
    __syncthreads();
    phase_convert_mid(p, lds, S.tail_busy());
    xcd_barrier(xb);
    phase_ln((const bf16_t*)(ws + OFF_R), p.in[6], p.in[7], nullptr, (bf16_t*)(ws + OFF_XRB), S.mode == 1 ? (const float*)(ws + OFF_PART) : nullptr, p.in[1], nullptr);
    xcd_barrier(xb);
    if (STOP_AFTER <= 3) return;
    { S.init(NTOK, NMIXP, DM, gridDim.x, blockIdx.x, false); pg8::Gemm g{(const bf16_t*)(ws + OFF_XRB), (const bf16_t*)(ws + OFF_WMI), NTOK, NMIXP, DM};
      EpiMixIn E{(bf16_t*)(ws + OFF_PROJB), (float*)(ws + OFF_BD)}; pg8::gemm_phase(lds, g, S, E); }
    xcd_barrier(xb);
    float s5r = 0.f, s5i = 0.f;
    const bool split5 = gridDim.x >= 256;
    phase_conv(p, lds, s5r, s5i, split5);
    xcd_barrier(xb);
    if (STOP_AFTER <= 4) return;
    phase_gdn_prep(p, lds);
    xcd_barrier(xb);
    phase_scan(p, lds, s5r, s5i, split5);
    xcd_barrier(xb);
    if (STOP_AFTER <= 5) return;
    phase_onorm(p);
    __syncthreads();
    { S.init(NTOK, 1024, 1024, gridDim.x, blockIdx.x, false); pg8::Gemm g{(const bf16_t*)(ws + OFF_ZB), (const bf16_t*)(ws + OFF_GLU), NTOK, 1024, 1024};
      EpiGlu E{(bf16_t*)(ws + OFF_YMIX), (const bf16_t*)(ws + OFF_ZB), p.in[20]}; pg8::gemm_phase(lds, g, S, E);
      __syncthreads();
      if (S.nwg < (int)gridDim.x) transpose_matrix(p.in[29], DFF, DM, (bf16_t*)(ws + OFF_W1O), 0, (LAS float*)lds, S.nwg); }
    xcd_barrier(xb);
    { S.init(NTOK, DM, DM, gridDim.x, blockIdx.x, true); pg8::Gemm g{(const bf16_t*)(ws + OFF_YMIX), (const bf16_t*)(ws + OFF_WMO), NTOK, DM, DM};
      EpiResid E{(bf16_t*)(ws + OFF_R), nullptr, nullptr, (float*)(ws + OFF_PART), nullptr, (const bf16_t*)(ws + OFF_XRB), 1.0f}; pg8::gemm_phase(lds, g, S, E); }
    __syncthreads();
    phase_convert1(p, lds, S.tail_busy(), gridDim.x > 136);
    xcd_barrier(xb);
    phase_ln((const bf16_t*)(ws + OFF_R), p.in[26], p.in[27], nullptr, (bf16_t*)(ws + OFF_XRB), S.mode == 1 ? (const float*)(ws + OFF_PART) : nullptr, nullptr, (const bf16_t*)(ws + OFF_XRB) + (size_t)NPR * DM);
    xcd_barrier(xb);
    { S.init(NTOK, 2 * DFF, DM, gridDim.x, blockIdx.x, false); pg8::Gemm g{(const bf16_t*)(ws + OFF_XRB), (const bf16_t*)(ws + OFF_W1T), NTOK, 2 * DFF, DM};
      EpiSwiglu E{(bf16_t*)(ws + OFF_H)}; pg8::gemm_phase(lds, g, S, E); }
    xcd_barrier(xb);
    { S.init(NTOK, DM, DFF, gridDim.x, blockIdx.x, true); if (S.mode == 1) S.nsp = 8; pg8::Gemm g{(const bf16_t*)(ws + OFF_H), (const bf16_t*)(ws + OFF_W1O), NTOK, DM, DFF};
      EpiResid E{(bf16_t*)(ws + OFF_R), nullptr, nullptr, (float*)(ws + OFF_PART), (float*)(ws + OFF_XNB), (const bf16_t*)(ws + OFF_XRB), 0.5f}; pg8::gemm_phase(lds, g, S, E); }
    xcd_barrier(xb);
    phase_ln((const bf16_t*)(ws + OFF_R), p.in[30], p.in[31], p.out + O_Y, nullptr, S.mode == 1 ? (const float*)(ws + OFF_PART) : nullptr, nullptr, (const bf16_t*)(ws + OFF_XRB) + (size_t)NPR * DM, (S.mode == 1 && S.nsp == 8) ? (const float*)(ws + OFF_XNB) : nullptr);
}

extern "C" void kernel_launch(void* const* d_in, const int* in_sizes, int n_in, void* d_out, int out_size, void* d_ws, size_t ws_size, hipStream_t stream) {
    constexpr int LDS_BYTES = 147456;
    static int grid_blocks = 0;
    if (grid_blocks == 0) {
        int dev = 0, cus = 0, per_cu = 0;
        hipGetDevice(&dev);
        hipDeviceGetAttribute(&cus, hipDeviceAttributeMultiprocessorCount, dev);
        hipFuncSetAttribute((const void*)fwd_megakernel, hipFuncAttributeMaxDynamicSharedMemorySize, LDS_BYTES);
        hipOccupancyMaxActiveBlocksPerMultiprocessor(&per_cu, (const void*)fwd_megakernel, 512, LDS_BYTES);
        if (per_cu < 1) { fprintf(stderr, "occupancy query returned %d\n", per_cu); per_cu = 1; }
        grid_blocks = cus * 1;
        if (ws_size < WS_END) fprintf(stderr, "workspace too small: %zu < %zu\n", ws_size, (size_t)WS_END);
    }
    (void)hipMemsetAsync((unsigned char*)d_ws + OFF_BAR, 0, XCD_BAR_WORDS * 4, stream);
    Params p{};
    for (int i = 0; i < 32; ++i) p.in[i] = (const float*)d_in[i];
    p.out = (float*)d_out; p.ws = (unsigned char*)d_ws;
    void* args[] = {&p};
    hipError_t e = hipLaunchCooperativeKernel((const void*)fwd_megakernel, dim3(grid_blocks), dim3(512), args, LDS_BYTES, stream);
    if (e != hipSuccess) fprintf(stderr, "cooperative launch failed: %s (grid %d)\n", hipGetErrorString(e), grid_blocks);
}
```

```cpp
#include <hip/hip_runtime.h>
#include <hip/hip_cooperative_groups.h>
#include <cstdio>
namespace cg = cooperative_groups;

#define LAS __attribute__((address_space(3)))
typedef unsigned short bf16_t;
typedef short bf16x8 __attribute__((ext_vector_type(8)));
typedef float f32x4 __attribute__((ext_vector_type(4)));
typedef float f32x16 __attribute__((ext_vector_type(16)));
typedef unsigned u32x4 __attribute__((ext_vector_type(4)));
typedef unsigned u32x2 __attribute__((ext_vector_type(2)));

#ifndef STOP_AFTER
#define STOP_AFTER 99
#endif

constexpr int NTOK = 8704, NPR = 8192, DM = 2048, DFF = 5632, NMIX = 5136, NMIXP = 5376, NPB = 5120;
constexpr float ALPHA = 1.189207115002721f;

constexpr size_t O_Y = 0, O_PRE = 17825792, O_PIM = 17842176, O_PGDN = 17858560, O_PCONV = 18382848,
                 O_SRE = 18419712, O_SIM = 18944000, O_SGDN = 19468288, O_SCONV = 36245504;

constexpr size_t SZ_W1T = (size_t)11264 * 2048 * 2, SZ_W1O = (size_t)2048 * 5632 * 2;
constexpr size_t OFF_W1T = 0;
constexpr size_t OFF_W1O = OFF_W1T + SZ_W1T;
constexpr size_t OFF_WMI = OFF_W1O + SZ_W1O;
constexpr size_t OFF_GLU = OFF_WMI + (size_t)NMIXP * 2048 * 2;
constexpr size_t OFF_WMO = OFF_GLU + (size_t)1024 * 1024 * 2;
constexpr size_t OFF_XNB = OFF_WMO + (size_t)2048 * 2048 * 2;
constexpr size_t OFF_XN  = OFF_XNB + (size_t)NTOK * 2048 * 2;
constexpr size_t OFF_R   = OFF_XN + (size_t)NTOK * 2048 * 4;
constexpr size_t OFF_H   = OFF_R + (size_t)NTOK * 2048 * 4;
constexpr size_t OFF_KDT = OFF_H + (size_t)NTOK * DFF * 2;
constexpr size_t SZ_CH   = (size_t)1024 * 64 * 128 * 2;
constexpr size_t OFF_TBT = OFF_KDT + SZ_CH;
constexpr size_t OFF_O   = OFF_TBT + (size_t)1024 * 64 * 64 * 2;
constexpr size_t OFF_ZB  = OFF_O + (size_t)NTOK * 1024 * 2;
constexpr size_t OFF_BBT = OFF_ZB + (size_t)NTOK * 1024 * 2;
constexpr size_t OFF_CT  = OFF_BBT + 262144;
constexpr size_t OFF_ABAR = OFF_CT + 262144;
constexpr size_t OFF_GLAST = OFF_ABAR + 32768;
constexpr size_t OFF_BAR = OFF_GLAST + 4096;
constexpr size_t OFF_PART = OFF_BAR + 16384;
constexpr size_t WS_END  = OFF_PART + (size_t)4 * 512 * 2048 * 4;
constexpr size_t OFF_PROJB = OFF_H;
constexpr size_t OFF_XRB = OFF_XN;
constexpr size_t OFF_YMIX = OFF_XN + (size_t)NTOK * 2048 * 2;
constexpr size_t OFF_QN = OFF_R, OFF_KN = OFF_QN + (size_t)NPR * 1024 * 2, OFF_VV = OFF_KN + (size_t)NPR * 1024 * 2;
constexpr size_t OFF_G = OFF_VV + (size_t)NPR * 1024 * 4;
constexpr size_t OFF_BETA = OFF_G + (size_t)NTOK * 8 * 4;
constexpr size_t OFF_BD = OFF_BETA + (size_t)NTOK * 8 * 4;
constexpr size_t OFF_KT = OFF_W1T, OFF_ATT = OFF_KT + SZ_CH, OFF_QG = OFF_ATT + (size_t)1024 * 64 * 64 * 2, OFF_KG = OFF_QG + SZ_CH;
constexpr size_t OFF_QKVS = OFF_KG + SZ_CH;
static_assert(OFF_BD + (size_t)NTOK * 16 * 4 <= OFF_H, "R alias overflow");
static_assert(OFF_QKVS + (size_t)512 * 3072 * 4 <= OFF_WMI, "W1 alias overflow");

struct Params { const float* in[32]; float* out; unsigned char* ws; };

typedef __bf16 bf16v2_t __attribute__((ext_vector_type(2)));
typedef float f32v2_t __attribute__((ext_vector_type(2)));
__device__ __forceinline__ unsigned pk2(float lo, float hi) { f32v2_t v = {lo, hi}; bf16v2_t b = __builtin_convertvector(v, bf16v2_t); return __builtin_bit_cast(unsigned, b); }
__device__ __forceinline__ bf16_t f2bf(float f) { return (bf16_t)(pk2(f, 0.f) & 0xffffu); }
__device__ __forceinline__ float bf2f(bf16_t b) { return __uint_as_float(((unsigned)b) << 16); }
__device__ __forceinline__ float bflo(unsigned u) { return __uint_as_float(u << 16); }
__device__ __forceinline__ float bfhi(unsigned u) { return __uint_as_float(u & 0xffff0000u); }
__device__ __forceinline__ float wave_sum(float v) {
#pragma unroll
    for (int o = 1; o < 64; o <<= 1) v += __shfl_xor(v, o);
    return v;
}
__device__ __forceinline__ float siluf(float x) { return x / (1.f + __expf(-x)); }
__device__ __forceinline__ float sigmf(float x) { return 1.f / (1.f + __expf(-x)); }
__device__ __forceinline__ float gelu_tanh(float y) {
    const float t = 0.7978845608028654f * (y + 0.044715f * y * y * y);
    const float th = 1.f - 2.f / (1.f + __expf(2.f * t));
    return 0.5f * y * (1.f + th);
}
#define WSYNC() asm volatile("s_waitcnt lgkmcnt(0)" ::: "memory")

namespace pg8 {
constexpr int BM = 256, BK = 64, HALF = 128, HTB = HALF * BK * 2, STAGE_BYTES = 8 * HTB, NXCD = 8, WGM = 8;
__host__ __device__ __forceinline__ int lds_byte(int r, int c) { const int st = (r >> 4) * 2 + (c >> 5), rr = r & 15, cc = c & 31, ob = rr * 64 + cc * 2; return st * 1024 + (ob ^ (((ob >> 9) & 1) << 5)); }
__host__ __device__ __forceinline__ void stage_rc(int b, int& R, int& C) { const int st = b / 1024, sb = b % 1024, swz = sb ^ (((sb >> 9) & 1) << 5); R = (st >> 1) * 16 + swz / 64; C = (st & 1) * 32 + (swz % 64) / 2; }
__host__ __device__ __forceinline__ int perm32(int rho) { const int n = rho >> 4, i = rho & 15; return 8 * (i >> 2) + 4 * n + (i & 3); }
struct Unit { int pm, pn, k0, nk, part, sp; };
struct Gemm { const bf16_t* A; const bf16_t* Bt; int M, N, K; };
struct StaticOrder {
    int nM, nN, nwg, G, c, ntK, mode, nsp;
    __device__ __forceinline__ void init(int M, int N, int K, int G_, int c_, bool split) {
        nM = M / BM; nN = N / BM; nwg = nM * nN; G = G_; c = c_; ntK = K / BK;
        mode = (split && G == 256 && nM == 34 && nN == 8 && (ntK % 8) == 0) ? 1 : 0; nsp = 4;
    }
    __device__ __forceinline__ void map(int L, Unit& u, int nMl) const {
        const int nw = nMl * nN;
        int wgid = L; { const int q = nw / NXCD, r = nw % NXCD, xcd = wgid % NXCD, off = wgid / NXCD; wgid = (xcd < r ? xcd * (q + 1) : r * (q + 1) + (xcd - r) * q) + off; }
        const int nig = WGM * nN, gid = wgid / nig, fm = gid * WGM, gsz = (nMl - fm) < WGM ? (nMl - fm) : WGM;
        u.pm = fm + ((wgid % nig) % gsz); u.pn = (wgid % nig) / gsz;
    }
    __device__ __forceinline__ int tail_busy() const { return mode == 1 ? 16 * nsp : (((nwg % G) * 2 <= G) ? (nwg % G) : 0); }
    __device__ __forceinline__ bool next_(int i, Unit& u) const {
        u.pm = 0; u.pn = 0; u.k0 = 0; u.nk = ntK; u.part = 0; u.sp = 0;
        if (mode == 0) { const long L = (long)i * G + c; if (L >= nwg) return false; map((int)L, u, nM); return true; }
        if (i == 0) { map(c, u, 32); return true; }
        if (i == 1 && c < 16 * nsp) {
            const int lsp = (nsp == 8) ? 3 : 2;
            const int tt = c >> lsp; u.pm = 32 + (tt & 1); u.pn = tt >> 1; u.sp = c & (nsp - 1);
            const int pairs = ntK >> 1, base = pairs >> lsp, rem = pairs & (nsp - 1);
            u.k0 = 2 * (u.sp * base + (u.sp < rem ? u.sp : rem)); u.nk = 2 * (base + (u.sp < rem ? 1 : 0)); u.part = 1; return true; }
        return false;
    }
    __device__ __forceinline__ bool next(int i, Unit& u) const {
        const bool ok = next_(i, u);
        u.pm = __builtin_amdgcn_readfirstlane(u.pm); u.pn = __builtin_amdgcn_readfirstlane(u.pn); u.k0 = __builtin_amdgcn_readfirstlane(u.k0);
        u.nk = __builtin_amdgcn_readfirstlane(u.nk); u.part = __builtin_amdgcn_readfirstlane(u.part); u.sp = __builtin_amdgcn_readfirstlane(u.sp);
        return __builtin_amdgcn_readfirstlane((int)ok) != 0;
    }
};

template <class Epi>
__device__ __forceinline__ void gemm_phase(LAS unsigned char* lds, const Gemm g, const StaticOrder& S, const Epi& E) {
    int tid = threadIdx.x; asm volatile("" : "+v"(tid));
    const int wid = __builtin_amdgcn_readfirstlane(tid >> 6), lane = tid & 63, wr = wid >> 2, wc = wid & 3, fr = lane & 15, fq = lane >> 4;
    const int K = g.K;
    unsigned voffA[2], voffB[2];
#pragma unroll
    for (int i = 0; i < 2; ++i) { int R, C; stage_rc(tid * 16 + i * 8192, R, C); const int Rb = Epi::PERM ? ((R & ~31) + perm32(R & 31)) : R;
        voffA[i] = (unsigned)(R * K + C) * 2u; voffB[i] = (unsigned)(Rb * K + C) * 2u; }
    const size_t kstep = (size_t)(BK * 2);
    const size_t hstep = (size_t)HALF * K * 2;
    const size_t tstep = 2 * hstep;
    const unsigned ldsw = (unsigned)wid * 1024u;
    const int aoff = lds_byte(wr * 64 + fr, fq * 8), boff = lds_byte(wc * 32 + fr, fq * 8);
#define PG8_SA(b, h) (((b) * 2 + (h)) * HTB)
#define PG8_SB(b, h) ((4 + (b) * 2 + (h)) * HTB)
#define PG8_STAGE(bufoff, gbase, voff) do { _Pragma("unroll") for (int _i = 0; _i < 2; ++_i) \
        __builtin_amdgcn_global_load_lds((const unsigned*)((const char*)(gbase) + (voff)[_i]), (LAS unsigned*)(lds + (bufoff) + ldsw + _i * 8192), 16, 0, 0); } while (0)
#define PG8_LDA(dst, b, h) do { _Pragma("unroll") for (int m = 0; m < 4; ++m) _Pragma("unroll") for (int k = 0; k < 2; ++k) dst[m][k] = *(const LAS bf16x8*)(lds + PG8_SA(b, h) + aoff + m * 2048 + k * 1024); } while (0)
#define PG8_LDB(dst, b, h) do { _Pragma("unroll") for (int n = 0; n < 2; ++n) _Pragma("unroll") for (int k = 0; k < 2; ++k) dst[n][k] = *(const LAS bf16x8*)(lds + PG8_SB(b, h) + boff + n * 2048 + k * 1024); } while (0)
#define PG8_MMA(ai, bj, At, Bt) do { __builtin_amdgcn_s_setprio(1); _Pragma("unroll") for (int m = 0; m < 4; ++m) _Pragma("unroll") for (int n = 0; n < 2; ++n) _Pragma("unroll") for (int k = 0; k < 2; ++k) \
        acc[ai][bj][m][n] = __builtin_amdgcn_mfma_f32_16x16x32_bf16(Bt[n][k], At[m][k], acc[ai][bj][m][n], 0, 0, 0); __builtin_amdgcn_s_setprio(0); } while (0)
#define PG8_WAIT_V(n) asm volatile("s_waitcnt vmcnt(" #n ")" ::: "memory")
#define PG8_WAIT_L(n) asm volatile("s_waitcnt lgkmcnt(" #n ")" ::: "memory")
#define PG8_BAR __builtin_amdgcn_s_barrier()
#define PG8_SCHED __builtin_amdgcn_sched_barrier(0)
    Unit cur, nxt; int ui = 0;
    if (!S.next(0, cur)) return;
    f32x4 acc[2][2][4][2];
#pragma unroll
    for (int a = 0; a < 2; ++a)
#pragma unroll
        for (int b = 0; b < 2; ++b)
#pragma unroll
            for (int m = 0; m < 4; ++m)
#pragma unroll
                for (int n = 0; n < 2; ++n) acc[a][b][m][n] = (f32x4){0.f, 0.f, 0.f, 0.f};
    bf16x8 At[4][2], B0[2][2], B1[2][2];
    const char* cA = (const char*)g.A + (size_t)cur.pm * tstep + (size_t)cur.k0 * kstep; const char* cB = (const char*)g.Bt + (size_t)cur.pn * tstep + (size_t)cur.k0 * kstep;
    PG8_STAGE(PG8_SB(0, 0), cB, voffB); PG8_STAGE(PG8_SA(0, 0), cA, voffA); PG8_STAGE(PG8_SB(0, 1), cB + hstep, voffB); PG8_STAGE(PG8_SA(0, 1), cA + hstep, voffA);
    if (wr == 1) PG8_BAR;
    PG8_WAIT_V(4); PG8_BAR;
    PG8_STAGE(PG8_SB(1, 0), cB + kstep, voffB); PG8_STAGE(PG8_SA(1, 0), cA + kstep, voffA); PG8_STAGE(PG8_SB(1, 1), cB + hstep + kstep, voffB);
    PG8_WAIT_V(6); PG8_BAR;
    for (;;) {
        const bool has_next = S.next(ui + 1, nxt);
        const char* nA = has_next ? (const char*)g.A + (size_t)nxt.pm * tstep + (size_t)nxt.k0 * kstep : cA; const char* nB = has_next ? (const char*)g.Bt + (size_t)nxt.pn * tstep + (size_t)nxt.k0 * kstep : cB;
        const int nt = cur.nk;
        for (int t = 0; t < nt; t += 2) {
            const bool last = (t == nt - 2);
            const char* a1 = cA + (size_t)(t + 1) * kstep;
            const char* a2 = last ? nA : cA + (size_t)(t + 2) * kstep; const char* b2 = last ? nB : cB + (size_t)(t + 2) * kstep;
            const char* a3 = a2 + kstep; const char* b3 = b2 + kstep;
            PG8_LDB(B0, 0, 0); PG8_SCHED; PG8_LDA(At, 0, 0); PG8_STAGE(PG8_SA(1, 1), a1 + hstep, voffA);
            PG8_WAIT_L(8); PG8_BAR; PG8_WAIT_L(0); PG8_MMA(0, 0, At, B0); PG8_BAR; PG8_SCHED;
            PG8_LDB(B1, 0, 1); PG8_STAGE(PG8_SB(0, 0), b2, voffB);
            PG8_BAR; PG8_WAIT_L(0); PG8_MMA(0, 1, At, B1); PG8_BAR;
            PG8_LDA(At, 0, 1); PG8_STAGE(PG8_SA(0, 0), a2, voffA);
            PG8_BAR; PG8_WAIT_L(0); PG8_MMA(1, 0, At, B0); PG8_BAR; PG8_SCHED;
            PG8_STAGE(PG8_SB(0, 1), b2 + hstep, voffB);
            PG8_WAIT_V(6); PG8_BAR; PG8_MMA(1, 1, At, B1); PG8_BAR;
            PG8_LDB(B0, 1, 0); PG8_SCHED; PG8_LDA(At, 1, 0); PG8_STAGE(PG8_SA(0, 1), a2 + hstep, voffA);
            PG8_WAIT_L(8); PG8_BAR; PG8_WAIT_L(0); PG8_MMA(0, 0, At, B0); PG8_BAR; PG8_SCHED;
            PG8_LDB(B1, 1, 1); PG8_STAGE(PG8_SB(1, 0), b3, voffB);
            PG8_BAR; PG8_WAIT_L(0); PG8_MMA(0, 1, At, B1); PG8_BAR;
            PG8_LDA(At, 1, 1); PG8_STAGE(PG8_SA(1, 0), a3, voffA);
            PG8_BAR; PG8_WAIT_L(0); PG8_MMA(1, 0, At, B0); PG8_BAR; PG8_SCHED;
            PG8_STAGE(PG8_SB(1, 1), b3 + hstep, voffB);
            PG8_WAIT_V(6); PG8_BAR; PG8_MMA(1, 1, At, B1); PG8_BAR;
        }
        E(acc, cur, wr, wc, fr, fq);
        if (!has_next) break;
#pragma unroll
        for (int a = 0; a < 2; ++a)
#pragma unroll
            for (int b = 0; b < 2; ++b)
#pragma unroll
                for (int m = 0; m < 4; ++m)
#pragma unroll
                    for (int n = 0; n < 2; ++n) acc[a][b][m][n] = (f32x4){0.f, 0.f, 0.f, 0.f};
        cur = nxt; cA = nA; cB = nB; ++ui;
    }
    PG8_WAIT_V(0);
    if (wr == 0) PG8_BAR;
    PG8_BAR;
#undef PG8_SA
#undef PG8_SB
#undef PG8_STAGE
#undef PG8_LDA
#undef PG8_LDB
#undef PG8_MMA
#undef PG8_WAIT_V
#undef PG8_WAIT_L
#undef PG8_BAR
#undef PG8_SCHED
}
}
using pg8::Unit;

struct EpiSwiglu {
    static constexpr bool PERM = true;
    bf16_t* H;
    __device__ __forceinline__ void operator()(const f32x4 (&acc)[2][2][4][2], const Unit& u, int wr, int wc, int fr, int fq) const {
        const int row0 = u.pm * 256 + wr * 64 + fr, col0 = u.pn * 128 + wc * 32 + 8 * fq;
#pragma unroll
        for (int ai = 0; ai < 2; ++ai)
#pragma unroll
            for (int m = 0; m < 4; ++m) {
                const f32x4 g0 = acc[ai][0][m][0], g1 = acc[ai][0][m][1], u0 = acc[ai][1][m][0], u1 = acc[ai][1][m][1];
                u32x4 o;
                o.x = pk2(siluf(g0[0]) * u0[0], siluf(g0[1]) * u0[1]); o.y = pk2(siluf(g0[2]) * u0[2], siluf(g0[3]) * u0[3]);
                o.z = pk2(siluf(g1[0]) * u1[0], siluf(g1[1]) * u1[1]); o.w = pk2(siluf(g1[2]) * u1[2], siluf(g1[3]) * u1[3]);
                *(u32x4*)(H + (size_t)(row0 + ai * 128 + m * 16) * DFF + col0) = o;
            }
    }
};
struct EpiResid {
    static constexpr bool PERM = false;
    bf16_t* R; const float* X0; const float* X1; float* P; float* P2; const bf16_t* XB; float scale;
    __device__ __forceinline__ void operator()(const f32x4 (&acc)[2][2][4][2], const Unit& u, int wr, int wc, int fr, int fq) const {
        float* const Pb = (u.sp < 4 ? P : P2) + (size_t)(u.sp & 3) * 512 * DM;
        const int row0 = u.pm * 256 + wr * 64 + fr, col0 = u.pn * 256 + wc * 32 + 4 * fq;
#pragma unroll
        for (int ai = 0; ai < 2; ++ai)
#pragma unroll
            for (int m = 0; m < 4; ++m) {
                const int row = row0 + ai * 128 + m * 16;
                const float* xr = (XB != nullptr) ? nullptr : (row < NPR ? X0 + (size_t)row * DM : X1 + (size_t)(row - NPR) * DM) + col0;
                bf16_t* rp = R + (size_t)row * DM + col0;
#pragma unroll
                for (int bj = 0; bj < 2; ++bj)
#pragma unroll
                    for (int n = 0; n < 2; ++n) {
                        if (!u.part) {
                            f32x4 xv;
                            if (XB != nullptr) { const u32x2 xb2 = *(const u32x2*)(XB + (size_t)row * DM + col0 + bj * 128 + n * 16); xv = (f32x4){bflo(xb2.x), bfhi(xb2.x), bflo(xb2.y), bfhi(xb2.y)}; }
                            else xv = *(const f32x4*)(xr + bj * 128 + n * 16);
                            const f32x4 rv = xv * ALPHA + acc[ai][bj][m][n] * scale;
                            u32x2 ro; ro.x = pk2(rv[0], rv[1]); ro.y = pk2(rv[2], rv[3]);
                            *(u32x2*)(rp + bj * 128 + n * 16) = ro;
                        } else {
                            *(f32x4*)(Pb + (size_t)(row - NPR) * DM + col0 + bj * 128 + n * 16) = acc[ai][bj][m][n] * scale;
                        }
                    }
            }
    }
};
struct EpiMixIn {
    static constexpr bool PERM = true;
    bf16_t* PB; float* BD;
    __device__ __forceinline__ void operator()(const f32x4 (&acc)[2][2][4][2], const Unit& u, int wr, int wc, int fr, int fq) const {
        const int row0 = u.pm * 256 + wr * 64 + fr;
        if (u.pn < 20) {
            const int col0 = u.pn * 256 + wc * 32 + 8 * fq;
#pragma unroll
            for (int ai = 0; ai < 2; ++ai)
#pragma unroll
                for (int m = 0; m < 4; ++m)
#pragma unroll
                    for (int bj = 0; bj < 2; ++bj) {
                        const f32x4 v0 = acc[ai][bj][m][0], v1 = acc[ai][bj][m][1];
                        u32x4 o; o.x = pk2(v0[0], v0[1]); o.y = pk2(v0[2], v0[3]); o.z = pk2(v1[0], v1[1]); o.w = pk2(v1[2], v1[3]);
                        *(u32x4*)(PB + (size_t)(row0 + ai * 128 + m * 16) * NPB + col0 + bj * 128) = o;
                    }
        } else if (wc == 0 && fq < 2) {
#pragma unroll
            for (int ai = 0; ai < 2; ++ai)
#pragma unroll
                for (int m = 0; m < 4; ++m) {
                    float* bp = BD + (size_t)(row0 + ai * 128 + m * 16) * 16 + 8 * fq;
                    *(f32x4*)(bp) = acc[ai][0][m][0]; *(f32x4*)(bp + 4) = acc[ai][0][m][1];
                }
        }
    }
};
struct EpiGlu {
    static constexpr bool PERM = true;
    bf16_t* YM; const bf16_t* ZB; const float* bias;
    __device__ __forceinline__ void operator()(const f32x4 (&acc)[2][2][4][2], const Unit& u, int wr, int wc, int fr, int fq) const {
        const int row0 = u.pm * 256 + wr * 64 + fr, col0 = u.pn * 256 + wc * 32 + 8 * fq;
#pragma unroll
        for (int bj = 0; bj < 2; ++bj) {
            const f32x4 b0 = *(const f32x4*)(bias + col0 + bj * 128), b1 = *(const f32x4*)(bias + col0 + bj * 128 + 4);
#pragma unroll
            for (int ai = 0; ai < 2; ++ai)
#pragma unroll
                for (int m = 0; m < 4; ++m) {
                    const int row = row0 + ai * 128 + m * 16;
                    const u32x4 zz = *(const u32x4*)(ZB + (size_t)row * 1024 + col0 + bj * 128);
                    const f32x4 v0 = acc[ai][bj][m][0] + b0, v1 = acc[ai][bj][m][1] + b1;
                    u32x4 o;
                    o.x = pk2(bflo(zz.x) * sigmf(v0[0]), bfhi(zz.x) * sigmf(v0[1])); o.y = pk2(bflo(zz.y) * sigmf(v0[2]), bfhi(zz.y) * sigmf(v0[3]));
                    o.z = pk2(bflo(zz.z) * sigmf(v1[0]), bfhi(zz.z) * sigmf(v1[1])); o.w = pk2(bflo(zz.w) * sigmf(v1[2]), bfhi(zz.w) * sigmf(v1[3]));
                    *(u32x4*)(YM + (size_t)row * DM + col0 + bj * 128) = o;
                }
        }
    }
};

__device__ __forceinline__ void transpose_tile(const float* __restrict__ W, int K, int N, bf16_t* __restrict__ WT, int kt, int nt, int mode, LAS float* tile) {
    int tid = threadIdx.x; asm volatile("" : "+v"(tid));
    const int k0 = kt * 64, n0 = nt * 256;
    f32x4 v[8];
#pragma unroll
    for (int i = 0; i < 8; ++i) {
        const int idx = tid + 512 * i, rr = idx >> 6, c4 = (idx & 63) * 4;
        v[i] = (f32x4){0.f, 0.f, 0.f, 0.f};
        if (n0 + c4 < N) v[i] = *(const f32x4*)(W + (size_t)(k0 + rr) * N + n0 + c4);
    }
#pragma unroll
    for (int i = 0; i < 8; ++i) {
        const int idx = tid + 512 * i, rr = idx >> 6, c4 = (idx & 63) * 4;
        tile[rr * 257 + c4 + 0] = v[i][0]; tile[rr * 257 + c4 + 1] = v[i][1]; tile[rr * 257 + c4 + 2] = v[i][2]; tile[rr * 257 + c4 + 3] = v[i][3];
    }
    __syncthreads();
#pragma unroll
    for (int j = 0; j < 4; ++j) {
        const int id = tid + 512 * j, n = id >> 3, kc = id & 7;
        float f[8];
#pragma unroll
        for (int e = 0; e < 8; ++e) f[e] = tile[(kc * 8 + e) * 257 + n];
        const int nn = n0 + n; int drow = nn;
        if (mode == 1) { const int isup = nn >= DFF; const int jj = isup ? nn - DFF : nn; drow = (jj >> 7) * 256 + isup * 128 + (jj & 127); }
        u32x4 o; o.x = pk2(f[0], f[1]); o.y = pk2(f[2], f[3]); o.z = pk2(f[4], f[5]); o.w = pk2(f[6], f[7]);
        *(u32x4*)(WT + (size_t)drow * K + k0 + kc * 8) = o;
    }
    __syncthreads();
}
__device__ __forceinline__ void transpose_matrix(const float* W, int K, int N, bf16_t* WT, int mode, LAS float* tile, int b0 = 0) {
    const int nkt = K / 64, nnt = (N + 255) / 256, tot = nkt * nnt;
    if ((int)blockIdx.x < b0) return;
    for (int t = blockIdx.x - b0; t < tot; t += gridDim.x - b0) transpose_tile(W, K, N, WT, t / nnt, t % nnt, mode, tile);
}

__device__ __forceinline__ void phase_convert0(const Params& p, LAS unsigned char* lds) {
    unsigned char* ws = p.ws;
    LAS float* tile = (LAS float*)lds;
    transpose_matrix(p.in[8], DM, 2 * DFF, (bf16_t*)(ws + OFF_W1T), 1, tile);
    transpose_matrix(p.in[9], DFF, DM, (bf16_t*)(ws + OFF_W1O), 0, tile);
    const size_t gtid = (size_t)blockIdx.x * 512 + threadIdx.x, gsz = (size_t)gridDim.x * 512;
    { bf16_t* xb = (bf16_t*)(ws + OFF_XNB); const size_t n8 = (size_t)NTOK * DM / 8, np8 = (size_t)NPR * DM / 8;
      for (size_t i = gtid; i < n8; i += gsz) {
          const float* s = (i < np8) ? p.in[0] + i * 8 : p.in[1] + (i - np8) * 8;
          const f32x4 a = *(const f32x4*)s, b = *(const f32x4*)(s + 4);
          u32x4 o; o.x = pk2(a[0], a[1]); o.y = pk2(a[2], a[3]); o.z = pk2(b[0], b[1]); o.w = pk2(b[2], b[3]);
          *(u32x4*)(xb + i * 8) = o; } }
    if (gtid < 4096) {
        const int g = (int)(gtid >> 6), pp = (int)(gtid & 63);
        const double dt = exp((double)p.in[13][g]);
        const double lr = (double)p.in[11][g * 64 + pp], li = (double)p.in[12][g * 64 + pp];
        const double mag = exp(lr * dt), abr = mag * cos(li * dt), abi = mag * sin(li * dt);
        const double nr = abr - 1.0, ni = abi, den = lr * lr + li * li;
        const double cr = (nr * lr + ni * li) / den, ci = (ni * lr - nr * li) / den;
        bf16_t* bbt = (bf16_t*)(ws + OFF_BBT) + (size_t)g * 128 * 16;
        for (int h = 0; h < 16; ++h) {
            const double bre = (double)p.in[14][(g * 64 + pp) * 16 + h], bim = (double)p.in[15][(g * 64 + pp) * 16 + h];
            bbt[pp * 16 + h] = f2bf((float)(cr * bre - ci * bim));
            bbt[(64 + pp) * 16 + h] = f2bf((float)(cr * bim + ci * bre));
        }
        float* ab = (float*)(ws + OFF_ABAR); ab[(g * 64 + pp) * 2] = (float)abr; ab[(g * 64 + pp) * 2 + 1] = (float)abi;
        bf16_t* ct = (bf16_t*)(ws + OFF_CT) + (size_t)g * 16 * 128;
        for (int o = 0; o < 16; ++o) {
            ct[o * 128 + pp] = f2bf(p.in[16][(g * 16 + o) * 64 + pp]);
            ct[o * 128 + 64 + pp] = f2bf(-p.in[17][(g * 16 + o) * 64 + pp]);
        }
    }
}
__device__ __forceinline__ void phase_convert_mid(const Params& p, LAS unsigned char* lds, int b0) {
    unsigned char* ws = p.ws;
    LAS float* tile = (LAS float*)lds;
    transpose_matrix(p.in[10], DM, NMIX, (bf16_t*)(ws + OFF_WMI), 0, tile, b0);
    transpose_matrix(p.in[19], 1024, 1024, (bf16_t*)(ws + OFF_GLU), 0, tile, b0);
    transpose_matrix(p.in[25], DM, DM, (bf16_t*)(ws + OFF_WMO), 0, tile, b0);
}
__device__ __forceinline__ void phase_convert1(const Params& p, LAS unsigned char* lds, int b0, bool skip_out) {
    LAS float* tile = (LAS float*)lds;
    transpose_matrix(p.in[28], DM, 2 * DFF, (bf16_t*)(p.ws + OFF_W1T), 1, tile, b0);
    if (!skip_out) transpose_matrix(p.in[29], DFF, DM, (bf16_t*)(p.ws + OFF_W1O), 0, tile, b0);
}

__device__ __forceinline__ void phase_ln(const bf16_t* R, const float* gam, const float* bet, float* outf, bf16_t* outb, const float* P, const float* XS, const bf16_t* XSB, const float* P2 = nullptr) {
    int lane = threadIdx.x; asm volatile("" : "+v"(lane)); lane &= 63;
    const int wave = __builtin_amdgcn_readfirstlane(threadIdx.x >> 6);
    for (int row = blockIdx.x * 8 + wave; row < NTOK; row += gridDim.x * 8) {
        const u32x2* rp = (const u32x2*)(R + (size_t)row * DM) + lane;
        f32x4 v[8]; float s = 0.f;
        if (P != nullptr && row >= NPR) {
#pragma unroll
            for (int j = 0; j < 8; ++j) {
                f32x4 xv;
                if (XSB != nullptr) { const u32x2 xb2 = *((const u32x2*)(XSB + (size_t)(row - NPR) * DM) + lane + 64 * j); xv = (f32x4){bflo(xb2.x), bfhi(xb2.x), bflo(xb2.y), bfhi(xb2.y)}; }
                else xv = ((const f32x4*)(XS + (size_t)(row - NPR) * DM) + lane)[64 * j];
                v[j] = xv * ALPHA;
            }
            const int nslab = (P2 != nullptr) ? 8 : 4;
#pragma unroll 1
            for (int k = 0; k < nslab; ++k) {
                const f32x4* pk = (const f32x4*)((k < 4 ? P : P2) + ((size_t)(k & 3) * 512 + (row - NPR)) * DM) + lane;
#pragma unroll
                for (int j = 0; j < 8; ++j) v[j] += pk[64 * j];
            }
        } else {
#pragma unroll
            for (int j = 0; j < 8; ++j) { const u32x2 rb = rp[64 * j]; v[j] = (f32x4){bflo(rb.x), bfhi(rb.x), bflo(rb.y), bfhi(rb.y)}; }
        }
#pragma unroll
        for (int j = 0; j < 8; ++j) s += (v[j][0] + v[j][1]) + (v[j][2] + v[j][3]);
        const float mean = wave_sum(s) * (1.f / DM); float s2 = 0.f;
#pragma unroll
        for (int j = 0; j < 8; ++j) { v[j] = v[j] - mean; s2 += (v[j][0] * v[j][0] + v[j][1] * v[j][1]) + (v[j][2] * v[j][2] + v[j][3] * v[j][3]); }
        const float rstd = 1.f / sqrtf(wave_sum(s2) * (1.f / DM) + 1e-5f);
#pragma unroll
        for (int j = 0; j < 8; ++j) {
            const int col = 4 * (lane + 64 * j);
            const f32x4 gg = *(const f32x4*)(gam + col), bb = *(const f32x4*)(bet + col);
            const f32x4 y = v[j] * rstd * gg + bb;
            if (outf) *(f32x4*)(outf + (size_t)row * DM + col) = y;
            if (outb) { u32x2 o; o.x = pk2(y[0], y[1]); o.y = pk2(y[2], y[3]); *(u32x2*)(outb + (size_t)row * DM + col) = o; }
        }
    }
}

constexpr int S5_SPLIT = 36;
__device__ __forceinline__ void s5_unit(const Params& p, int g, int tok_base, int nsub, bool sample, int b0, LAS unsigned char* wl, int hb_off, float& hr_io, float& hi_io, bool store_final);
__device__ __forceinline__ void phase_conv(const Params& p, LAS unsigned char* lds, float& s5r, float& s5i, bool split5) {
    unsigned char* ws = p.ws;
    int lane = threadIdx.x; asm volatile("" : "+v"(lane)); lane &= 63;
    const int wave = __builtin_amdgcn_readfirstlane(threadIdx.x >> 6);
    const bf16_t* PB = (const bf16_t*)(ws + OFF_PROJB);
    const float* BD = (const float*)(ws + OFF_BD);
    const float* cw = p.in[21];
    float* G = (float*)(ws + OFF_G); float* BT = (float*)(ws + OFF_BETA);
    bf16_t* QN = (bf16_t*)(ws + OFF_QN); bf16_t* KN = (bf16_t*)(ws + OFF_KN); float* VV = (float*)(ws + OFF_VV);
    bf16_t* KT = (bf16_t*)(ws + OFF_KT);
    float* QKVS = (float*)(ws + OFF_QKVS);
    const int NIT = 8192 + 1024;
    const int ncw = split5 ? 7 : 8;
    if (wave >= ncw) {
        const int u = blockIdx.x;
        if (u < 256) s5_unit(p, u & 63, (u >> 6) * 2048, S5_SPLIT, false, 0, lds, 16384, s5r, s5i, false);
        return;
    }
    for (int it = blockIdx.x * ncw + wave; it < NIT; it += gridDim.x * ncw) {
        if (it < 8192) {
            const int h = it & 7, tg = (it >> 3) & 255, b = it >> 11;
            const int t0 = tg * 8, tok0 = b * 2048 + t0;
            if (lane < 8) {
                const int tok = tok0 + lane;
                const float braw = BD[(size_t)tok * 16 + h], araw = BD[(size_t)tok * 16 + 8 + h];
                const float xx = araw + p.in[23][h];
                const float sp = xx > 20.f ? xx : log1pf(expf(xx));
                G[(size_t)tok * 8 + h] = -expf(p.in[22][h]) * sp;
                BT[(size_t)tok * 8 + h] = 1.f / (1.f + expf(-braw));
            }
            float x0[3][11], x1[3][11], w0[3][4], w1[3][4];
#pragma unroll
            for (int st = 0; st < 3; ++st) {
                const int col = st * 1024 + h * 128 + 2 * lane;
#pragma unroll
                for (int j = 0; j < 11; ++j) {
                    const int t = t0 - 3 + j;
                    unsigned v = 0u;
                    if (t >= 0) v = *(const unsigned*)(PB + (size_t)(b * 2048 + t) * NPB + 1024 + col);
                    x0[st][j] = bflo(v); x1[st][j] = bfhi(v);
                }
#pragma unroll
                for (int j = 0; j < 4; ++j) { w0[st][j] = cw[j * 3072 + col]; w1[st][j] = cw[j * 3072 + col + 1]; }
            }
            float y0[3][8], y1[3][8];
#pragma unroll
            for (int st = 0; st < 3; ++st)
#pragma unroll
                for (int t = 0; t < 8; ++t) {
                    float a0 = 0.f, a1 = 0.f;
#pragma unroll
                    for (int j = 0; j < 4; ++j) { a0 += x0[st][t + j] * w0[st][j]; a1 += x1[st][t + j] * w1[st][j]; }
                    y0[st][t] = siluf(a0); y1[st][t] = siluf(a1);
                }
            float ss[2][8];
#pragma unroll
            for (int st = 0; st < 2; ++st)
#pragma unroll
                for (int t = 0; t < 8; ++t) ss[st][t] = y0[st][t] * y0[st][t] + y1[st][t] * y1[st][t];
#pragma unroll
            for (int o = 1; o < 64; o <<= 1)
#pragma unroll
                for (int st = 0; st < 2; ++st)
#pragma unroll
                    for (int t = 0; t < 8; ++t) ss[st][t] += __shfl_xor(ss[st][t], o);
#pragma unroll
            for (int st = 0; st < 2; ++st)
#pragma unroll
                for (int t = 0; t < 8; ++t) {
                    float sc = 1.f / sqrtf(ss[st][t] + 1e-6f);
                    if (st == 0) sc *= 0.08838834764831845f;
                    y0[st][t] *= sc; y1[st][t] *= sc;
                }
#pragma unroll
            for (int t = 0; t < 8; ++t) {
                *(unsigned*)(QN + (size_t)(tok0 + t) * 1024 + h * 128 + 2 * lane) = pk2(y0[0][t], y1[0][t]);
                *(unsigned*)(KN + (size_t)(tok0 + t) * 1024 + h * 128 + 2 * lane) = pk2(y0[1][t], y1[1][t]);
                float* o = VV + (size_t)(tok0 + t) * 1024 + h * 128 + 2 * lane; o[0] = y0[2][t]; o[1] = y1[2][t];
            }
            {
                const int chunk = t0 >> 6, c0 = t0 & 63;
                bf16_t* base = KT + ((size_t)((b * 8 + h) * 32 + chunk) * 128 + 2 * lane) * 64 + c0;
                u32x4 o0, o1;
                o0.x = pk2(y0[1][0], y0[1][1]); o0.y = pk2(y0[1][2], y0[1][3]); o0.z = pk2(y0[1][4], y0[1][5]); o0.w = pk2(y0[1][6], y0[1][7]);
                o1.x = pk2(y1[1][0], y1[1][1]); o1.y = pk2(y1[1][2], y1[1][3]); o1.z = pk2(y1[1][4], y1[1][5]); o1.w = pk2(y1[1][6], y1[1][7]);
                *(u32x4*)base = o0; *(u32x4*)(base + 64) = o1;
            }
            if (tg == 255) {
#pragma unroll
                for (int st = 0; st < 3; ++st)
#pragma unroll
                    for (int j = 0; j < 3; ++j) {
                        float* o = p.out + O_PCONV + (size_t)(b * 3 + j) * 3072 + st * 1024 + h * 128 + 2 * lane;
                        o[0] = x0[st][8 + j]; o[1] = x1[st][8 + j];
                    }
            }
        } else {
            const int si = it - 8192, h = si & 7, b = si >> 3;
            const int tok0 = NPR + b * 4;
            if (lane < 4) {
                const int tok = tok0 + lane;
                const float braw = BD[(size_t)tok * 16 + h], araw = BD[(size_t)tok * 16 + 8 + h];
                const float xx = araw + p.in[23][h];
                const float sp = xx > 20.f ? xx : log1pf(expf(xx));
                G[(size_t)tok * 8 + h] = -expf(p.in[22][h]) * sp;
                BT[(size_t)tok * 8 + h] = 1.f / (1.f + expf(-braw));
            }
#pragma unroll
            for (int st = 0; st < 3; ++st) {
                const int col = st * 1024 + h * 128 + 2 * lane;
                float x0[7], x1[7];
#pragma unroll
                for (int j = 0; j < 3; ++j) { const float* s = p.in[5] + (size_t)(b * 3 + j) * 3072 + col; x0[j] = s[0]; x1[j] = s[1]; }
#pragma unroll
                for (int j = 0; j < 4; ++j) { const unsigned v = *(const unsigned*)(PB + (size_t)(tok0 + j) * NPB + 1024 + col); x0[3 + j] = bflo(v); x1[3 + j] = bfhi(v); }
                float w0[4], w1[4];
#pragma unroll
                for (int j = 0; j < 4; ++j) { w0[j] = cw[j * 3072 + col]; w1[j] = cw[j * 3072 + col + 1]; }
#pragma unroll
                for (int t = 0; t < 4; ++t) {
                    float a0 = 0.f, a1 = 0.f;
#pragma unroll
                    for (int j = 0; j < 4; ++j) { a0 += x0[t + j] * w0[j]; a1 += x1[t + j] * w1[j]; }
                    float y0 = siluf(a0), y1 = siluf(a1);
                    if (st < 2) {
                        const float ss = wave_sum(y0 * y0 + y1 * y1);
                        float sc = 1.f / sqrtf(ss + 1e-6f);
                        if (st == 0) sc *= 0.08838834764831845f;
                        y0 *= sc; y1 *= sc;
                    }
                    float* o = QKVS + (size_t)(b * 4 + t) * 3072 + col; o[0] = y0; o[1] = y1;
                }
#pragma unroll
                for (int j = 0; j < 3; ++j) {
                    float* o = p.out + O_SCONV + (size_t)(b * 3 + j) * 3072 + col;
                    o[0] = x0[4 + j]; o[1] = x1[4 + j];
                }
            }
        }
    }
}

__device__ __forceinline__ f32x16 mfma32(bf16x8 a, bf16x8 b, f32x16 c) { return __builtin_amdgcn_mfma_f32_32x32x16_bf16(a, b, c, 0, 0, 0); }
__device__ __forceinline__ f32x4 mfma16(bf16x8 a, bf16x8 b, f32x4 c) { return __builtin_amdgcn_mfma_f32_16x16x32_bf16(a, b, c, 0, 0, 0); }
__device__ __forceinline__ bf16x8 mk8(unsigned a, unsigned b, unsigned c, unsigned d) { u32x4 t = {a, b, c, d}; return __builtin_bit_cast(bf16x8, t); }
constexpr int MTP = 36;

template <int C> __device__ __forceinline__ void solve_col(float (&t)[64], const LAS float* MT, int lane) {
    float a0 = 0.f, a1 = 0.f, a2 = 0.f, a3 = 0.f;
    int mb = 0; if (C < 63) asm volatile("" : "+v"(mb) : "v"(t[C + 1]));
#pragma unroll
    for (int jj = (C + 1) / 4; jj < 16; ++jj) {
        const int j4 = jj * 4;
        if (jj == 8 && (C + 1) / 4 < 8) asm volatile("" : "+v"(mb) : "v"(a0), "v"(a1), "v"(a2), "v"(a3));
        const int ti = (j4 >> 5) + (C >> 5);
        const f32x4 m = *(const LAS f32x4*)(MT + mb + ti * 32 * MTP + (C & 31) * MTP + (j4 & 31));
        if (j4 + 0 > C) a0 += t[j4 + 0] * m[0];
        if (j4 + 1 > C) a1 += t[j4 + 1] * m[1];
        if (j4 + 2 > C) a2 += t[j4 + 2] * m[2];
        if (j4 + 3 > C) a3 += t[j4 + 3] * m[3];
    }
    t[C] = ((lane == C) ? 1.f : 0.f) - ((a0 + a1) + (a2 + a3));
    if constexpr (C > 0) solve_col<C - 1>(t, MT, lane);
}

__device__ __forceinline__ void gdn_prep_item(const Params& p, int it, LAS unsigned char* wl, LAS float* gcl_) {
    unsigned char* ws = p.ws;
    int lane = threadIdx.x; asm volatile("" : "+v"(lane)); lane &= 63;
    const int r = lane & 31, hh = lane >> 5;
    const int n = it & 31, bh = it >> 5, h = bh & 7, b = bh >> 3;
    const int tok0 = b * 2048 + n * 64;
    LAS float* MT = (LAS float*)wl;
    LAS float* gcL = gcl_;
    LAS float* btL = gcL + 64;
    const float* G = (const float*)(ws + OFF_G); const float* BT = (const float*)(ws + OFF_BETA);
    float gc = G[(size_t)(tok0 + lane) * 8 + h];
    const float bv = BT[(size_t)(tok0 + lane) * 8 + h];
#pragma unroll
    for (int o = 1; o < 64; o <<= 1) { const float t = __int_as_float(__builtin_amdgcn_ds_bpermute((lane - o) << 2, __float_as_int(gc))); if (lane >= o) gc += t; }
    const float gl = __int_as_float(__builtin_amdgcn_readlane(__float_as_int(gc), 63));
    gcL[lane] = gc; btL[lane] = bv;
    if (lane == 0) ((float*)(ws + OFF_GLAST))[it] = __expf(gl);
    WSYNC();
    const bf16_t* kp = (const bf16_t*)(ws + OFF_KN) + (size_t)tok0 * 1024 + h * 128;
    const bf16_t* qp = (const bf16_t*)(ws + OFF_QN) + (size_t)tok0 * 1024 + h * 128;
    bf16x8 Kf[2][8];
#pragma unroll
    for (int mt = 0; mt < 2; ++mt)
#pragma unroll
        for (int ks = 0; ks < 8; ++ks) Kf[mt][ks] = *(const bf16x8*)(kp + (size_t)(mt * 32 + r) * 1024 + ks * 16 + hh * 8);
    {
        bf16_t* KG = (bf16_t*)(ws + OFF_KG) + (size_t)it * 8192;
#pragma unroll
        for (int mt = 0; mt < 2; ++mt) {
            const float e = -__expf(gcL[mt * 32 + r]);
#pragma unroll
            for (int ks = 0; ks < 8; ++ks) {
                const u32x4 v = __builtin_bit_cast(u32x4, Kf[mt][ks]);
                u32x2 o0, o1; o0.x = pk2(bflo(v.x) * e, bfhi(v.x) * e); o0.y = pk2(bflo(v.y) * e, bfhi(v.y) * e);
                o1.x = pk2(bflo(v.z) * e, bfhi(v.z) * e); o1.y = pk2(bflo(v.w) * e, bfhi(v.w) * e);
                bf16_t* fp = KG + (mt * 8 + ks) * 512 + r * 8 + 4 * hh;
                *(u32x2*)fp = o0; *(u32x2*)(fp + 256) = o1;
            }
        }
    }
    __builtin_amdgcn_sched_barrier(0);
#pragma unroll
    for (int ti = 0; ti < 3; ++ti) {
        __builtin_amdgcn_sched_barrier(0);
        const int mi = (ti >= 1), ni = (ti == 2);
        f32x16 a = {};
#pragma unroll
        for (int ks = 0; ks < 8; ++ks) a = mfma32(Kf[mi][ks], Kf[ni][ks], a);
        const int j = ni * 32 + r; const float gcj = gcL[j];
#pragma unroll
        for (int qq = 0; qq < 4; ++qq) {
            const int i0 = mi * 32 + 8 * qq + 4 * hh;
            const f32x4 gci = *(const LAS f32x4*)(gcL + i0), bti = *(const LAS f32x4*)(btL + i0);
            f32x4 mv;
#pragma unroll
            for (int e = 0; e < 4; ++e) {
                const int i = i0 + e;
                const float dec = __expf(fminf(gci[e] - gcj, 0.f));
                mv[e] = (i > j) ? bti[e] * a[qq * 4 + e] * dec : 0.f;
            }
            *(LAS f32x4*)(MT + ti * 32 * MTP + r * MTP + 8 * qq + 4 * hh) = mv;
        }
    }
    bf16_t* ATT = (bf16_t*)(ws + OFF_ATT) + (size_t)it * 4096;
    bf16_t* QG = (bf16_t*)(ws + OFF_QG) + (size_t)it * 8192;
#pragma unroll
    for (int mi = 0; mi < 2; ++mi) {
        __builtin_amdgcn_sched_barrier(0);
        bf16x8 Qf[8];
#pragma unroll
        for (int ks = 0; ks < 8; ++ks) Qf[ks] = *(const bf16x8*)(qp + (size_t)(mi * 32 + r) * 1024 + ks * 16 + hh * 8);
#pragma unroll
        for (int ni = 0; ni <= mi; ++ni) {
            __builtin_amdgcn_sched_barrier(0);
            f32x16 q = {};
#pragma unroll
            for (int ks = 0; ks < 8; ++ks) q = mfma32(Qf[ks], Kf[ni][ks], q);
            const int j = ni * 32 + r; const float gcj = gcL[j];
#pragma unroll
            for (int qq = 0; qq < 4; ++qq) {
                const int i0 = mi * 32 + 8 * qq + 4 * hh;
                const f32x4 gci = *(const LAS f32x4*)(gcL + i0);
#pragma unroll
                for (int e = 0; e < 4; ++e) {
                    const int i = i0 + e;
                    const float dec = __expf(fminf(gci[e] - gcj, 0.f));
                    ATT[((mi * 2 + ni) * 2 + (r >> 4)) * 512 + (((r >> 2) & 1) * 32 + (i & 31)) * 8 + 4 * ((r >> 3) & 1) + (r & 3)] = f2bf((i >= j) ? q[qq * 4 + e] * dec : 0.f);
                }
            }
        }
        __builtin_amdgcn_sched_barrier(0);
        const float e = __expf(gcL[mi * 32 + r]);
#pragma unroll
        for (int ks = 0; ks < 8; ++ks) {
            const u32x4 v = __builtin_bit_cast(u32x4, Qf[ks]);
            u32x2 o0, o1; o0.x = pk2(bflo(v.x) * e, bfhi(v.x) * e); o0.y = pk2(bflo(v.y) * e, bfhi(v.y) * e);
            o1.x = pk2(bflo(v.z) * e, bfhi(v.z) * e); o1.y = pk2(bflo(v.w) * e, bfhi(v.w) * e);
            bf16_t* fp = QG + (mi * 8 + ks) * 512 + r * 8 + 4 * hh;
            *(u32x2*)fp = o0; *(u32x2*)(fp + 256) = o1;
        }
    }
    WSYNC();
    float t[64];
    solve_col<63>(t, MT, lane);
    WSYNC();
    int lane5 = lane; asm volatile("" : "+v"(lane5) : "v"(t[0]));
    const int r5 = lane5 & 31, h5 = lane5 >> 5;
    {
        bf16_t* TBt = (bf16_t*)(ws + OFF_TBT) + (size_t)it * 4096 + ((lane5 >> 5) * 4) * 512 + (lane5 & 31) * 8;
#pragma unroll
        for (int m2 = 0; m2 < 2; ++m2)
#pragma unroll
            for (int sx = 0; sx < 2; ++sx) {
                const int c0 = m2 * 32 + 16 * sx;
                const f32x4 b0 = *(const LAS f32x4*)(btL + c0), b1 = *(const LAS f32x4*)(btL + c0 + 4), b2 = *(const LAS f32x4*)(btL + c0 + 8), b3 = *(const LAS f32x4*)(btL + c0 + 12);
                u32x4 oa, ob;
                oa.x = pk2(t[c0 + 0] * b0[0], t[c0 + 1] * b0[1]); oa.y = pk2(t[c0 + 2] * b0[2], t[c0 + 3] * b0[3]);
                oa.z = pk2(t[c0 + 8] * b2[0], t[c0 + 9] * b2[1]); oa.w = pk2(t[c0 + 10] * b2[2], t[c0 + 11] * b2[3]);
                ob.x = pk2(t[c0 + 4] * b1[0], t[c0 + 5] * b1[1]); ob.y = pk2(t[c0 + 6] * b1[2], t[c0 + 7] * b1[3]);
                ob.z = pk2(t[c0 + 12] * b3[0], t[c0 + 13] * b3[1]); ob.w = pk2(t[c0 + 14] * b3[2], t[c0 + 15] * b3[3]);
                bf16_t* fp = TBt + (m2 * 2 + sx) * 512;
                *(u32x4*)fp = oa; *(u32x4*)(fp + 256) = ob;
            }
    }
    {
        const bf16_t* KT = (const bf16_t*)(ws + OFF_KT) + (size_t)it * 8192;
        bf16_t* KDT = (bf16_t*)(ws + OFF_KDT) + (size_t)it * 8192;
#pragma unroll
        for (int nt = 0; nt < 4; ++nt) {
            __builtin_amdgcn_sched_barrier(0);
#pragma unroll
            for (int ks = 0; ks < 4; ++ks) {
                const u32x4 v = *(const u32x4*)(KT + (size_t)(nt * 32 + r5) * 64 + ks * 16 + h5 * 8);
                const f32x4 g0 = *(const LAS f32x4*)(gcL + ks * 16 + h5 * 8), g1 = *(const LAS f32x4*)(gcL + ks * 16 + h5 * 8 + 4);
                u32x2 o0, o1;
                o0.x = pk2(bflo(v.x) * __expf(gl - g0[0]), bfhi(v.x) * __expf(gl - g0[1])); o0.y = pk2(bflo(v.y) * __expf(gl - g0[2]), bfhi(v.y) * __expf(gl - g0[3]));
                o1.x = pk2(bflo(v.z) * __expf(gl - g1[0]), bfhi(v.z) * __expf(gl - g1[1])); o1.y = pk2(bflo(v.w) * __expf(gl - g1[2]), bfhi(v.w) * __expf(gl - g1[3]));
                bf16_t* fp = KDT + (nt * 4 + ks) * 512 + r5 * 8 + 4 * h5;
                *(u32x2*)fp = o0; *(u32x2*)(fp + 256) = o1;
            }
        }
    }
    WSYNC();
}

__device__ __forceinline__ void gdn_sample_item(const Params& p, int it, LAS unsigned char* wl) {
    unsigned char* ws = p.ws;
    int lane = threadIdx.x; asm volatile("" : "+v"(lane)); lane &= 63;
    const int c = lane & 31, hh = lane >> 5;
    const int qd = it & 3, bh = it >> 2, h = bh & 7, b = bh >> 3;
    const int dv = qd * 32 + c;
    float s[64];
    { const float* sp = p.in[4] + (size_t)bh * 16384 + (size_t)(hh * 64) * 128 + dv;
#pragma unroll
      for (int i = 0; i < 64; ++i) s[i] = sp[i * 128]; }
    LAS float* kq = (LAS float*)wl;
    const float* QKVS = (const float*)(ws + OFF_QKVS);
    const float* G = (const float*)(ws + OFF_G); const float* BT = (const float*)(ws + OFF_BETA);
    bf16_t* O = (bf16_t*)(ws + OFF_O);
#pragma unroll
    for (int t = 0; t < 4; ++t) {
        const float* row = QKVS + (size_t)(b * 4 + t) * 3072 + h * 128;
        kq[t * 256 + lane] = row[1024 + lane]; kq[t * 256 + 64 + lane] = row[1024 + 64 + lane];
        kq[t * 256 + 128 + lane] = row[lane]; kq[t * 256 + 192 + lane] = row[64 + lane];
    }
    WSYNC();
#pragma unroll 1
    for (int t = 0; t < 4; ++t) {
        const int tok = NPR + b * 4 + t;
        const float al = __expf(G[(size_t)tok * 8 + h]), be = BT[(size_t)tok * 8 + h];
        const float v = QKVS[(size_t)(b * 4 + t) * 3072 + 2048 + h * 128 + dv];
        float d0 = 0.f, d1 = 0.f, d2 = 0.f, d3 = 0.f;
        int kb = t * 256 + hh * 64;
#pragma unroll
        for (int i = 0; i < 64; i += 4) {
            if ((i & 15) == 0) asm volatile("" : "+v"(kb) : "v"(d0), "v"(d1), "v"(d2), "v"(d3));
            const f32x4 kk = *(const LAS f32x4*)(kq + kb + i);
            s[i] *= al; s[i + 1] *= al; s[i + 2] *= al; s[i + 3] *= al;
            d0 += kk[0] * s[i]; d1 += kk[1] * s[i + 1]; d2 += kk[2] * s[i + 2]; d3 += kk[3] * s[i + 3];
        }
        float dd = (d0 + d1) + (d2 + d3);
        dd += __shfl_xor(dd, 32);
        const float rr = be * (v - dd);
        float o0 = 0.f, o1 = 0.f, o2 = 0.f, o3 = 0.f;
        asm volatile("" : "+v"(kb) : "v"(rr));
#pragma unroll
        for (int i = 0; i < 64; i += 4) {
            if ((i & 15) == 0) asm volatile("" : "+v"(kb) : "v"(o0), "v"(o1), "v"(o2), "v"(o3));
            const f32x4 kk = *(const LAS f32x4*)(kq + kb + i);
            const f32x4 qq = *(const LAS f32x4*)(kq + kb + 128 + i);
            s[i] += rr * kk[0]; s[i + 1] += rr * kk[1]; s[i + 2] += rr * kk[2]; s[i + 3] += rr * kk[3];
            o0 += qq[0] * s[i]; o1 += qq[1] * s[i + 1]; o2 += qq[2] * s[i + 2]; o3 += qq[3] * s[i + 3];
        }
        float oo = (o0 + o1) + (o2 + o3);
        oo += __shfl_xor(oo, 32);
        if (hh == 0) O[(size_t)tok * 1024 + h * 128 + dv] = f2bf(oo);
    }
    int dv2 = dv; asm volatile("" : "+v"(dv2));
    float* So = p.out + O_SGDN + (size_t)bh * 16384 + (size_t)(hh * 64) * 128 + dv2;
#pragma unroll
    for (int i = 0; i < 64; ++i) So[i * 128] = s[i];
    WSYNC();
}

__device__ __forceinline__ void phase_gdn_prep(const Params& p, LAS unsigned char* lds) {
    const int wave = __builtin_amdgcn_readfirstlane(threadIdx.x >> 6);
    LAS unsigned char* wl = lds + wave * 16384;
    if (wave < 4) { for (int it = blockIdx.x * 4 + wave; it < 1024; it += gridDim.x * 4) gdn_prep_item(p, it, wl, (LAS float*)(lds + 143360 + wave * 512)); }
    else {
        for (int it = blockIdx.x * 4 + (wave - 4); it < 4096; it += gridDim.x * 4) gdn_sample_item(p, it, wl);
        for (int u = blockIdx.x * 4 + (wave - 4); u < 2048; u += gridDim.x * 4) { const int g = u & 63, bq = u >> 6; float zr = 0.f, zi = 0.f; s5_unit(p, g, NPR + bq * 16, 1, true, bq * 4, wl, 8192, zr, zi, false); }
    }
}

__device__ __forceinline__ bf16x8 ldperm(const bf16_t* p8, int hh) {
    const u32x2 lo = *(const u32x2*)(p8 + 4 * hh), hi = *(const u32x2*)(p8 + 8 + 4 * hh);
    return mk8(lo.x, lo.y, hi.x, hi.y);
}
constexpr int GDN_BUF = 61440, GDN_LDS0 = 21504;
__device__ __forceinline__ void gdn_dma_chunk(const unsigned char* ws, int it, LAS unsigned char* buf, int lane) {
    const bf16_t* KG = (const bf16_t*)(ws + OFF_KG) + (size_t)it * 8192 + lane * 8;
    const bf16_t* QG = (const bf16_t*)(ws + OFF_QG) + (size_t)it * 8192 + lane * 8;
    const bf16_t* KDT = (const bf16_t*)(ws + OFF_KDT) + (size_t)it * 8192 + lane * 8;
#pragma unroll
    for (int f = 0; f < 16; ++f) __builtin_amdgcn_global_load_lds((const unsigned*)(KG + f * 512), (LAS unsigned*)(buf + f * 1024), 16, 0, 0);
#pragma unroll
    for (int f = 0; f < 16; ++f) __builtin_amdgcn_global_load_lds((const unsigned*)(QG + f * 512), (LAS unsigned*)(buf + 16384 + f * 1024), 16, 0, 0);
#pragma unroll
    for (int f = 0; f < 16; ++f) __builtin_amdgcn_global_load_lds((const unsigned*)(KDT + f * 512), (LAS unsigned*)(buf + 32768 + f * 1024), 16, 0, 0);
    const bf16_t* TBt = (const bf16_t*)(ws + OFF_TBT) + (size_t)it * 4096 + lane * 8;
    const bf16_t* ATT = (const bf16_t*)(ws + OFF_ATT) + (size_t)it * 4096 + lane * 8;
#pragma unroll
    for (int k = 0; k < 6; ++k) { const int f = (k < 2) ? k : k + 2;
        __builtin_amdgcn_global_load_lds((const unsigned*)(TBt + f * 512), (LAS unsigned*)(buf + 49152 + k * 1024), 16, 0, 0);
        __builtin_amdgcn_global_load_lds((const unsigned*)(ATT + f * 512), (LAS unsigned*)(buf + 55296 + k * 1024), 16, 0, 0); }
}
__device__ __forceinline__ void gdn_store_o(bf16_t* O, const unsigned (&Opk)[16], int b, int nn, int h, int dv, int hh) {
#pragma unroll
    for (int k = 0; k < 16; ++k) {
        const int mt = k >> 3, q = 2 * (k & 7), i = mt * 32 + 8 * (q >> 2) + 4 * hh + (q & 3);
        bf16_t* o = O + (size_t)(b * 2048 + nn * 64 + i) * 1024 + h * 128 + dv;
        o[0] = (bf16_t)(Opk[k] & 0xffffu); o[1024] = (bf16_t)(Opk[k] >> 16);
    }
}
template <int PAR>
__device__ __forceinline__ void gdn_chunk(const Params& p, LAS unsigned char* gb, int n, int bh, int b, int h, int dv, int hh, int lane, f32x16 (&S)[4], unsigned (&Opk)[16]) {
    unsigned char* ws = p.ws;
    asm volatile("s_waitcnt vmcnt(0)" ::: "memory");
    const int it = bh * 32 + n;
    if (n > 0) gdn_store_o((bf16_t*)(ws + OFF_O), Opk, b, n - 1, h, dv, hh);
    const LAS unsigned char* cb = gb + PAR * GDN_BUF + lane * 16;
    const float* VV = (const float*)(ws + OFF_VV) + (size_t)(b * 2048 + n * 64) * 1024 + h * 128 + dv;
    const float gl = ((const float*)(ws + OFF_GLAST))[it];
    f32x16 v0, v1;
#pragma unroll
    for (int q = 0; q < 16; ++q) { const int i = 8 * (q >> 2) + 4 * hh + (q & 3); v0[q] = VV[(size_t)i * 1024]; v1[q] = VV[(size_t)(32 + i) * 1024]; }
    float pf8 = 0.f;
    if (n + 1 < 32) pf8 = VV[(size_t)(64 + lane) * 1024];
    if (n + 1 < 32) gdn_dma_chunk(ws, it + 1, gb + (1 - PAR) * GDN_BUF, lane);
    bf16x8 Sb[4][2];
#pragma unroll
    for (int kt = 0; kt < 4; ++kt)
#pragma unroll
        for (int s = 0; s < 2; ++s)
            Sb[kt][s] = mk8(pk2(S[kt][8 * s + 0], S[kt][8 * s + 1]), pk2(S[kt][8 * s + 2], S[kt][8 * s + 3]), pk2(S[kt][8 * s + 4], S[kt][8 * s + 5]), pk2(S[kt][8 * s + 6], S[kt][8 * s + 7]));
    bf16x8 Eb[2][2];
    {
        f32x16 a0 = {}, a1 = {};
#pragma unroll
        for (int kt = 0; kt < 4; ++kt)
#pragma unroll
            for (int s = 0; s < 2; ++s) {
                const u32x4 hv = __builtin_bit_cast(u32x4, Sb[kt][s]);
                const bf16x8 lo = mk8(pk2(S[kt][8 * s + 0] - bflo(hv.x), S[kt][8 * s + 1] - bfhi(hv.x)), pk2(S[kt][8 * s + 2] - bflo(hv.y), S[kt][8 * s + 3] - bfhi(hv.y)),
                                      pk2(S[kt][8 * s + 4] - bflo(hv.z), S[kt][8 * s + 5] - bfhi(hv.z)), pk2(S[kt][8 * s + 6] - bflo(hv.w), S[kt][8 * s + 7] - bfhi(hv.w)));
                const bf16x8 A0 = *(const LAS bf16x8*)(cb + (kt * 2 + s) * 1024);
                const bf16x8 A1 = *(const LAS bf16x8*)(cb + (8 + kt * 2 + s) * 1024);
                a0 = mfma32(A0, Sb[kt][s], a0); a1 = mfma32(A1, Sb[kt][s], a1);
                a0 = mfma32(A0, lo, a0); a1 = mfma32(A1, lo, a1);
            }
        a0 += v0; a1 += v1;
#pragma unroll
        for (int s = 0; s < 2; ++s) {
            Eb[0][s] = mk8(pk2(a0[8 * s + 0], a0[8 * s + 1]), pk2(a0[8 * s + 2], a0[8 * s + 3]), pk2(a0[8 * s + 4], a0[8 * s + 5]), pk2(a0[8 * s + 6], a0[8 * s + 7]));
            Eb[1][s] = mk8(pk2(a1[8 * s + 0], a1[8 * s + 1]), pk2(a1[8 * s + 2], a1[8 * s + 3]), pk2(a1[8 * s + 4], a1[8 * s + 5]), pk2(a1[8 * s + 6], a1[8 * s + 7]));
        }
    }
    bf16x8 Vb[2][2];
#pragma unroll
    for (int mt = 0; mt < 2; ++mt) {
        f32x16 a = {};
#pragma unroll
        for (int m2 = 0; m2 <= mt; ++m2)
#pragma unroll
            for (int s = 0; s < 2; ++s) a = mfma32(*(const LAS bf16x8*)(cb + 49152 + ((mt == 0) ? s : 2 + m2 * 2 + s) * 1024), Eb[m2][s], a);
#pragma unroll
        for (int s = 0; s < 2; ++s)
            Vb[mt][s] = mk8(pk2(a[8 * s + 0], a[8 * s + 1]), pk2(a[8 * s + 2], a[8 * s + 3]), pk2(a[8 * s + 4], a[8 * s + 5]), pk2(a[8 * s + 6], a[8 * s + 7]));
    }
#pragma unroll
    for (int mt = 0; mt < 2; ++mt) {
        f32x16 a = {};
#pragma unroll
        for (int kt = 0; kt < 4; ++kt)
#pragma unroll
            for (int s = 0; s < 2; ++s) a = mfma32(*(const LAS bf16x8*)(cb + 16384 + ((mt * 4 + kt) * 2 + s) * 1024), Sb[kt][s], a);
#pragma unroll
        for (int m2 = 0; m2 <= mt; ++m2)
#pragma unroll
            for (int s = 0; s < 2; ++s) a = mfma32(*(const LAS bf16x8*)(cb + 55296 + ((mt == 0) ? s : 2 + m2 * 2 + s) * 1024), Vb[m2][s], a);
#pragma unroll
        for (int k = 0; k < 8; ++k) Opk[mt * 8 + k] = pk2(a[2 * k], a[2 * k + 1]);
    }
#pragma unroll
    for (int kt = 0; kt < 4; ++kt) {
        f32x16 a = S[kt] * gl;
#pragma unroll
        for (int m2 = 0; m2 < 2; ++m2)
#pragma unroll
            for (int s = 0; s < 2; ++s) a = mfma32(*(const LAS bf16x8*)(cb + 32768 + ((kt * 2 + m2) * 2 + s) * 1024), Vb[m2][s], a);
        S[kt] = a;
    }
    asm volatile("" :: "v"(pf8));
}
__device__ __forceinline__ void gdn_scan_unit(const Params& p, int unit, LAS unsigned char* gb) {
    int lane = threadIdx.x; asm volatile("" : "+v"(lane)); lane &= 63;
    const int r = lane & 31, hh = lane >> 5;
    const int sl = unit & 3, bh = unit >> 2, h = bh & 7, b = bh >> 3;
    const int dv = sl * 32 + r;
    f32x16 S[4];
#pragma unroll
    for (int kt = 0; kt < 4; ++kt) S[kt] = (f32x16){};
    gdn_dma_chunk(p.ws, bh * 32, gb, lane);
    unsigned Opk[16];
#pragma unroll
    for (int k = 0; k < 16; ++k) Opk[k] = 0u;
#pragma unroll 1
    for (int n = 0; n < 32; n += 2) {
        gdn_chunk<0>(p, gb, n, bh, b, h, dv, hh, lane, S, Opk);
        gdn_chunk<1>(p, gb, n + 1, bh, b, h, dv, hh, lane, S, Opk);
    }
    gdn_store_o((bf16_t*)(p.ws + OFF_O), Opk, b, 31, h, dv, hh);
    int lane6 = threadIdx.x; asm volatile("" : "+v"(lane6)); lane6 &= 63;
    float* So = p.out + O_PGDN + (size_t)bh * 16384 + (sl * 32 + (lane6 & 31)) + (size_t)(4 * (lane6 >> 5)) * 128;
#pragma unroll
    for (int kt = 0; kt < 4; ++kt)
#pragma unroll
        for (int q = 0; q < 16; ++q) { const int dk = kt * 32 + 8 * (q >> 2) + (q & 3); So[(size_t)dk * 128] = S[kt][q]; }
}

__device__ __forceinline__ void s5_unit(const Params& p, int g, int tok_base, int nsub, bool sample, int b0, LAS unsigned char* wl, int hb_off, float& hr_io, float& hi_io, bool store_final) {
    unsigned char* ws = p.ws;
    int lane = threadIdx.x; asm volatile("" : "+v"(lane)); lane &= 63;
    const int l15 = lane & 15, l4 = lane >> 4;
    LAS bf16_t* HB = (LAS bf16_t*)(wl + hb_off);
    const bf16_t* PB = (const bf16_t*)(ws + OFF_PROJB);
    bf16_t* ZB = (bf16_t*)(ws + OFF_ZB);
    const float* AB = (const float*)(ws + OFF_ABAR);
    const float ar = AB[(g * 64 + lane) * 2], ai = AB[(g * 64 + lane) * 2 + 1];
    const bf16_t* bbt = (const bf16_t*)(ws + OFF_BBT) + (size_t)g * 2048;
    const bf16_t* ct = (const bf16_t*)(ws + OFF_CT) + (size_t)g * 2048;
    bf16x8 Bf[8], Cf[4];
    const bf16x8 zero8 = {0, 0, 0, 0, 0, 0, 0, 0};
#pragma unroll
    for (int nt = 0; nt < 8; ++nt) Bf[nt] = (l4 < 2) ? *(const bf16x8*)(bbt + (nt * 16 + l15) * 16 + 8 * l4) : zero8;
#pragma unroll
    for (int s = 0; s < 4; ++s) Cf[s] = *(const bf16x8*)(ct + l15 * 128 + 32 * s + 8 * l4);
    const float dskip = p.in[18][g * 16 + l15];
    float hr = hr_io, hi = hi_io;
    const int last_tok = tok_base + (nsub - 1) * 16;
    {
        const bf16x8 A0 = (l4 < 2) ? *(const bf16x8*)(PB + (size_t)(tok_base + l15) * NPB + g * 16 + 8 * l4) : zero8;
        LAS float* BU = (LAS float*)wl;
#pragma unroll
        for (int nt = 0; nt < 8; ++nt) {
            f32x4 a = {0.f, 0.f, 0.f, 0.f};
            a = mfma16(A0, Bf[nt], a);
#pragma unroll
            for (int q = 0; q < 4; ++q) BU[(4 * l4 + q) * 128 + nt * 16 + l15] = a[q];
        }
    }
    const int tok1 = (nsub > 1) ? tok_base + 16 : tok_base;
    bf16x8 Au = (l4 < 2) ? *(const bf16x8*)(PB + (size_t)(tok1 + l15) * NPB + g * 16 + 8 * l4) : zero8;
    float uu[4];
#pragma unroll
    for (int q = 0; q < 4; ++q) uu[q] = bf2f(PB[(size_t)(tok_base + 4 * l4 + q) * NPB + g * 16 + l15]);
    WSYNC();
#pragma unroll 1
    for (int sc = 0; sc < nsub; ++sc) {
        const int tok0 = tok_base + sc * 16;
        LAS float* BU = (LAS float*)(wl + (sc & 1) * 8192);
        LAS float* BUn = (LAS float*)(wl + ((sc + 1) & 1) * 8192);
        const int tok2 = (tok0 + 32 <= last_tok) ? tok0 + 32 : last_tok;
        const int tokn = (tok0 + 16 <= last_tok) ? tok0 + 16 : last_tok;
        const bf16x8 Au_n = (l4 < 2) ? *(const bf16x8*)(PB + (size_t)(tok2 + l15) * NPB + g * 16 + 8 * l4) : zero8;
        float uu_n[4];
#pragma unroll
        for (int q = 0; q < 4; ++q) uu_n[q] = bf2f(PB[(size_t)(tokn + 4 * l4 + q) * NPB + g * 16 + l15]);
        if (sc + 1 < nsub) {
#pragma unroll
            for (int nt = 0; nt < 8; ++nt) {
                f32x4 a = {0.f, 0.f, 0.f, 0.f};
                a = mfma16(Au, Bf[nt], a);
#pragma unroll
                for (int q = 0; q < 4; ++q) BUn[(4 * l4 + q) * 128 + nt * 16 + l15] = a[q];
            }
        }
#pragma unroll
        for (int t = 0; t < 16; ++t) {
            if (sample && (t & 3) == 0) {
                const int bb = b0 + (t >> 2);
                hr = p.in[2][((size_t)bb * 64 + g) * 64 + lane]; hi = p.in[3][((size_t)bb * 64 + g) * 64 + lane];
            }
            const float br = BU[t * 128 + lane], bi = BU[t * 128 + 64 + lane];
            const float nr = ar * hr - ai * hi + br, ni = ar * hi + ai * hr + bi;
            hr = nr; hi = ni;
            HB[t * 136 + lane] = f2bf(hr); HB[t * 136 + 64 + lane] = f2bf(hi);
            if (sample && (t & 3) == 3) {
                const int bb = b0 + (t >> 2);
                p.out[O_SRE + ((size_t)bb * 64 + g) * 64 + lane] = hr; p.out[O_SIM + ((size_t)bb * 64 + g) * 64 + lane] = hi;
            }
        }
        WSYNC();
        f32x4 y = {0.f, 0.f, 0.f, 0.f};
#pragma unroll
        for (int s = 0; s < 4; ++s) {
            const bf16x8 Ah = *(const LAS bf16x8*)(HB + l15 * 136 + 32 * s + 8 * l4);
            y = mfma16(Ah, Cf[s], y);
        }
#pragma unroll
        for (int q = 0; q < 4; ++q) {
            const int tok = tok0 + 4 * l4 + q;
            ZB[(size_t)tok * 1024 + g * 16 + l15] = f2bf(gelu_tanh(y[q] + dskip * uu[q]));
        }
        WSYNC();
        Au = Au_n;
#pragma unroll
        for (int q = 0; q < 4; ++q) uu[q] = uu_n[q];
    }
    hr_io = hr; hi_io = hi;
    if (!sample && store_final) {
        const int b = tok_base >> 11;
        p.out[O_PRE + ((size_t)b * 64 + g) * 64 + lane] = hr; p.out[O_PIM + ((size_t)b * 64 + g) * 64 + lane] = hi;
    }
}

__device__ __forceinline__ void phase_scan(const Params& p, LAS unsigned char* lds, float& s5r, float& s5i, bool split5) {
    const int wave = __builtin_amdgcn_readfirstlane(threadIdx.x >> 6);
    if (wave == 0) {
        for (int B = blockIdx.x; B < 128; B += gridDim.x) { const int xi = B & 7, idx = B >> 3; gdn_scan_unit(p, ((xi * 4 + (idx >> 2)) << 2) + (idx & 3), lds + GDN_LDS0); }
    }
    else if (wave == 7) {
        if (split5) { const int u = blockIdx.x; if (u < 256) s5_unit(p, u & 63, (u >> 6) * 2048 + S5_SPLIT * 16, 128 - S5_SPLIT, false, 0, lds, 16384, s5r, s5i, true); }
        else { for (int u = blockIdx.x; u < 256; u += gridDim.x) { float zr = 0.f, zi = 0.f; s5_unit(p, u & 63, (u >> 6) * 2048, 128, false, 0, lds, 16384, zr, zi, true); } }
    }
}

__device__ __forceinline__ void phase_onorm(const Params& p) {
    unsigned char* ws = p.ws;
    int lane = threadIdx.x; asm volatile("" : "+v"(lane)); lane &= 63;
    const int wave = __builtin_amdgcn_readfirstlane(threadIdx.x >> 6);
    const bf16_t* O = (const bf16_t*)(ws + OFF_O); const bf16_t* PB = (const bf16_t*)(ws + OFF_PROJB);
    bf16_t* YM = (bf16_t*)(ws + OFF_YMIX);
    const float nw0 = p.in[24][2 * lane], nw1 = p.in[24][2 * lane + 1];
    for (int it4 = blockIdx.x * 8 + wave; it4 < NTOK * 2; it4 += gridDim.x * 8) {
        unsigned ov[4], gv[4];
#pragma unroll
        for (int j = 0; j < 4; ++j) {
            const int it = it4 * 4 + j, h = it & 7, tok = it >> 3;
            ov[j] = *(const unsigned*)(O + (size_t)tok * 1024 + h * 128 + 2 * lane);
            gv[j] = *(const unsigned*)(PB + (size_t)tok * NPB + 4096 + h * 128 + 2 * lane);
        }
        float ss[4];
#pragma unroll
        for (int j = 0; j < 4; ++j) { const float o0 = bflo(ov[j]), o1 = bfhi(ov[j]); ss[j] = o0 * o0 + o1 * o1; }
#pragma unroll
        for (int o = 1; o < 64; o <<= 1) {
#pragma unroll
            for (int j = 0; j < 4; ++j) ss[j] += __shfl_xor(ss[j], o);
        }
#pragma unroll
        for (int j = 0; j < 4; ++j) {
            const int it = it4 * 4 + j, h = it & 7, tok = it >> 3;
            const float o0 = bflo(ov[j]), o1 = bfhi(ov[j]);
            const float rs = 1.f / sqrtf(ss[j] * (1.f / 128.f) + 1e-6f);
            *(unsigned*)(YM + (size_t)tok * DM + 1024 + h * 128 + 2 * lane) = pk2(o0 * rs * nw0 * siluf(bflo(gv[j])), o1 * rs * nw1 * siluf(bfhi(gv[j])));
        }
    }
}

#define XB_TMO      128
#define XB_XCNT(j)  (256  + 64 * (j))
#define XB_XSUB(j)  (1280 + 64 * (j))
#define XB_XGEN(j)  (2304 + 64 * (j))
#define XB_TOP      3328
#define XB_TOPGEN   3392
#define XCD_BAR_WORDS 3456
#define XB_SPIN_CAP (1u << 18)
__device__ __forceinline__ unsigned xb_ld(unsigned* p)              { return __hip_atomic_load(p, __ATOMIC_RELAXED, __HIP_MEMORY_SCOPE_AGENT); }
__device__ __forceinline__ unsigned xb_add(unsigned* p, unsigned v) { return __hip_atomic_fetch_add(p, v, __ATOMIC_RELAXED, __HIP_MEMORY_SCOPE_AGENT); }
__device__ __forceinline__ unsigned xb_xcc_id() { return (unsigned)__builtin_amdgcn_s_getreg((3 << 11) | 20) & 0xFu; }
#define XB_SPIN(cond, bar) do { unsigned _sp = 0; while (cond) { __builtin_amdgcn_s_sleep(1); \
    if ((++_sp & 255u) == 0u) { if (xb_ld(&(bar)[XB_TMO])) break; if (_sp > XB_SPIN_CAP) { atomicAdd(&(bar)[XB_TMO], 1u); break; } } } } while (0)
struct XcdBarrier { unsigned* bar; unsigned x; volatile LAS unsigned* st; };
__device__ __forceinline__ XcdBarrier xcd_barrier_post(unsigned* bar, volatile LAS unsigned* st) {
    XcdBarrier b; b.bar = bar; b.x = xb_xcc_id(); b.st = st;
    if (threadIdx.x == 0) (void)xb_add(&bar[XB_XCNT(b.x)], 1u);
    return b;
}
__device__ __forceinline__ void xcd_barrier_complete(unsigned* bar, unsigned x, unsigned& nloc, unsigned& nx) {
    const unsigned G = gridDim.x * gridDim.y * gridDim.z;
    unsigned sum, cnt, mine, sp = 0u;
    for (;;) {
        sum = 0u; cnt = 0u; mine = 0u;
#pragma unroll
        for (unsigned j = 0; j < 16; ++j) { const unsigned c = xb_ld(&bar[XB_XCNT(j)]); sum += c; cnt += (c > 0u) ? 1u : 0u; mine = (j == x) ? c : mine; }
        if (sum == G) break;
        __builtin_amdgcn_s_sleep(1);
        if ((++sp & 255u) == 0u) { if (xb_ld(&bar[XB_TMO])) break; if (sp > XB_SPIN_CAP) { atomicAdd(&bar[XB_TMO], 1u); break; } }
    }
    nloc = mine > 0u ? mine : 1u; nx = cnt > 0u ? cnt : 1u;
}
__device__ __forceinline__ void xcd_barrier(const XcdBarrier& b) {
    asm volatile("s_waitcnt vmcnt(0)" ::: "memory");
    __syncthreads();
    if (threadIdx.x == 0) {
        unsigned* bar = b.bar;
        __builtin_amdgcn_s_waitcnt(0);
        unsigned nloc = b.st[0], nx = b.st[1];
        if (nloc == 0u) { xcd_barrier_complete(bar, b.x, nloc, nx); b.st[0] = nloc; b.st[1] = nx; }
        const unsigned old = xb_add(&bar[XB_XSUB(b.x)], 1u);
        const unsigned gen = old / nloc;
        if (old + 1u == (gen + 1u) * nloc) {
            __builtin_amdgcn_fence(__ATOMIC_RELEASE, "agent");
            asm volatile("s_waitcnt vmcnt(0)" ::: "memory");
            const unsigned og = xb_add(&bar[XB_TOP], 1u);
            const unsigned tg = og / nx;
            if (og + 1u == (tg + 1u) * nx) xb_add(&bar[XB_TOPGEN], 1u);
            else XB_SPIN(xb_ld(&bar[XB_TOPGEN]) == tg, bar);
            __builtin_amdgcn_fence(__ATOMIC_ACQUIRE, "agent");
            xb_add(&bar[XB_XGEN(b.x)], 1u);
            asm volatile("s_waitcnt vmcnt(0)" ::: "memory");
        } else {
            XB_SPIN(xb_ld(&bar[XB_XGEN(b.x)]) == gen, bar);
            __builtin_amdgcn_fence(__ATOMIC_ACQUIRE, "agent");
            asm volatile("s_waitcnt vmcnt(0)" ::: "memory");
        }
    }
    __syncthreads();
}

__global__ void __launch_bounds__(512, 2) fwd_megakernel(Params p) {
    extern __shared__ __attribute__((aligned(16))) unsigned char shm[];
    LAS unsigned char* lds = (LAS unsigned char*)shm;
    cg::grid_group grid = cg::this_grid();
    unsigned char* ws = p.ws;
    pg8::StaticOrder S;
    volatile LAS unsigned* bst = (volatile LAS unsigned*)(lds + 147456 - 16);
    if (threadIdx.x == 0) { bst[0] = 0u; bst[1] = 0u; }
    __syncthreads();
    const XcdBarrier xb = xcd_barrier_post((unsigned*)(ws + OFF_BAR), bst);
    phase_convert0(p, lds);
    grid.sync();
    if (STOP_AFTER <= 0) return;
    { S.init(NTOK, 2 * DFF, DM, gridDim.x, blockIdx.x, false); pg8::Gemm g{(const bf16_t*)(ws + OFF_XNB), (const bf16_t*)(ws + OFF_W1T), NTOK, 2 * DFF, DM};
      EpiSwiglu E{(bf16_t*)(ws + OFF_H)}; pg8::gemm_phase(lds, g, S, E); }
    xcd_barrier(xb);
    { S.init(NTOK, DM, DFF, gridDim.x, blockIdx.x, true); pg8::Gemm g{(const bf16_t*)(ws + OFF_H), (const bf16_t*)(ws + OFF_W1O), NTOK, DM, DFF};
      EpiResid E{(bf16_t*)(ws + OFF_R), p.in[0], p.in[1], (float*)(ws + OFF_PART), nullptr, (const bf16_t*)(ws + OFF_XNB), 0.5f}; pg8::gemm_phase(lds, g, S, E); }
    __syncthreads();
    phase_convert_mid(p, lds, S.tail_busy());
    xcd_barrier(xb);
    phase_ln((const bf16_t*)(ws + OFF_R), p.in[6], p.in[7], nullptr, (bf16_t*)(ws + OFF_XRB), S.mode == 1 ? (const float*)(ws + OFF_PART) : nullptr, p.in[1], nullptr);
    xcd_barrier(xb);
    if (STOP_AFTER <= 3) return;
    { S.init(NTOK, NMIXP, DM, gridDim.x, blockIdx.x, false); pg8::Gemm g{(const bf16_t*)(ws + OFF_XRB), (const bf16_t*)(ws + OFF_WMI), NTOK, NMIXP, DM};
      EpiMixIn E{(bf16_t*)(ws + OFF_PROJB), (float*)(ws + OFF_BD)}; pg8::gemm_phase(lds, g, S, E); }
    xcd_barrier(xb);
    float s5r = 0.f, s5i = 0.f;
    const bool split5 = gridDim.x >= 256;
    phase_conv(p, lds, s5r, s5i, split5);
    xcd_barrier(xb);
    if (STOP_AFTER <= 4) return;
    phase_gdn_prep(p, lds);
    xcd_barrier(xb);
    phase_scan(p, lds, s5r, s5i, split5);
    xcd_barrier(xb);
    if (STOP_AFTER <= 5) return;
    phase_onorm(p);
    __syncthreads();
    { S.init(NTOK, 1024, 1024, gridDim.x, blockIdx.x, false); pg8::Gemm g{(const bf16_t*)(ws + OFF_ZB), (const bf16_t*)(ws + OFF_GLU), NTOK, 1024, 1024};
      EpiGlu E{(bf16_t*)(ws + OFF_YMIX), (const bf16_t*)(ws + OFF_ZB), p.in[20]}; pg8::gemm_phase(lds, g, S, E);
      __syncthreads();
      if (S.nwg < (int)gridDim.x) transpose_matrix(p.in[29], DFF, DM, (bf16_t*)(ws + OFF_W1O), 0, (LAS float*)lds, S.nwg); }
    xcd_barrier(xb);
    { S.init(NTOK, DM, DM, gridDim.x, blockIdx.x, true); pg8::Gemm g{(const bf16_t*)(ws + OFF_YMIX), (const bf16_t*)(ws + OFF_WMO), NTOK, DM, DM};
      EpiResid E{(bf16_t*)(ws + OFF_R), nullptr, nullptr, (float*)(ws + OFF_PART), nullptr, (const bf16_t*)(ws + OFF_XRB), 1.0f}; pg8::gemm_phase(lds, g, S, E); }
    __syncthreads();
    phase_convert1(p, lds, S.tail_busy(), gridDim.x > 136);
    xcd_barrier(xb);
    phase_ln((const bf16_t*)(ws + OFF_R), p.in[26], p.in[27], nullptr, (bf16_t*)(ws + OFF_XRB), S.mode == 1 ? (const float*)(ws + OFF_PART) : nullptr, nullptr, (const bf16_t*)(ws + OFF_XRB) + (size_t)NPR * DM);
    xcd_barrier(xb);
    { S.init(NTOK, 2 * DFF, DM, gridDim.x, blockIdx.x, false); pg8::Gemm g{(const bf16_t*)(ws + OFF_XRB), (const bf16_t*)(ws + OFF_W1T), NTOK, 2 * DFF, DM};
      EpiSwiglu E{(bf16_t*)(ws + OFF_H)}; pg8::gemm_phase(lds, g, S, E); }
    xcd_barrier(xb);
    { S.init(NTOK, DM, DFF, gridDim.x, blockIdx.x, true); if (S.mode == 1) S.nsp = 8; pg8::Gemm g{(const bf16_t*)(ws + OFF_H), (const bf16_t*)(ws + OFF_W1O), NTOK, DM, DFF};
      EpiResid E{(bf16_t*)(ws + OFF_R), nullptr, nullptr, (float*)(ws + OFF_PART), (float*)(ws + OFF_XNB), (const bf16_t*)(ws + OFF_XRB), 0.5f}; pg8::gemm_phase(lds, g, S, E); }
    xcd_barrier(xb);
    phase_ln((const bf16_t*)(ws + OFF_R), p.in[30], p.in[31], p.out + O_Y, nullptr, S.mode == 1 ? (const float*)(ws + OFF_PART) : nullptr, nullptr, (const bf16_t*)(ws + OFF_XRB) + (size_t)NPR * DM, (S.mode == 1 && S.nsp == 8) ? (const float*)(ws + OFF_XNB) : nullptr);
}

extern "C" void kernel_launch(void* const* d_in, const int* in_sizes, int n_in, void* d_out, int out_size, void* d_ws, size_t ws_size, hipStream_t stream) {
    constexpr int LDS_BYTES = 147456;
    static int grid_blocks = 0;
    if (grid_blocks == 0) {
        int dev = 0, cus = 0, per_cu = 0;
        hipGetDevice(&dev);
        hipDeviceGetAttribute(&cus, hipDeviceAttributeMultiprocessorCount, dev);
        hipFuncSetAttribute((const void*)fwd_megakernel, hipFuncAttributeMaxDynamicSharedMemorySize, LDS_BYTES);
        hipOccupancyMaxActiveBlocksPerMultiprocessor(&per_cu, (const void*)fwd_megakernel, 512, LDS_BYTES);
        if (per_cu < 1) { fprintf(stderr, "occupancy query returned %d\n", per_cu); per_cu = 1; }
        grid_blocks = cus * 1;
        if (ws_size < WS_END) fprintf(stderr, "workspace too small: %zu < %zu\n", ws_size, (size_t)WS_END);
    }
    (void)hipMemsetAsync((unsigned char*)d_ws + OFF_BAR, 0, XCD_BAR_WORDS * 4, stream);
    Params p{};
    for (int i = 0; i < 32; ++i) p.in[i] = (const float*)d_in[i];
    p.out = (float*)d_out; p.ws = (unsigned char*)d_ws;
    void* args[] = {&p};
    hipError_t e = hipLaunchCooperativeKernel((const void*)fwd_megakernel, dim3(grid_blocks), dim3(512), args, LDS_BYTES, stream);
    if (e != hipSuccess) fprintf(stderr, "cooperative launch failed: %s (grid %d)\n", hipGetErrorString(e), grid_blocks);
}
```

```cpp
#include <hip/hip_runtime.h>
#include <hip/hip_cooperative_groups.h>
#include <cstdio>
namespace cg = cooperative_groups;

#define LAS __attribute__((address_space(3)))
typedef unsigned short bf16_t;
typedef short bf16x8 __attribute__((ext_vector_type(8)));
typedef float f32x4 __attribute__((ext_vector_type(4)));
typedef float f32x16 __attribute__((ext_vector_type(16)));
typedef unsigned u32x4 __attribute__((ext_vector_type(4)));
typedef unsigned u32x2 __attribute__((ext_vector_type(2)));

#ifndef STOP_AFTER
#define STOP_AFTER 99
#endif

constexpr int NTOK = 8704, NPR = 8192, DM = 2048, DFF = 5632, NMIX = 5136, NMIXP = 5376, NPB = 5120;
constexpr float ALPHA = 1.189207115002721f;

constexpr size_t O_Y = 0, O_PRE = 17825792, O_PIM = 17842176, O_PGDN = 17858560, O_PCONV = 18382848,
                 O_SRE = 18419712, O_SIM = 18944000, O_SGDN = 19468288, O_SCONV = 36245504;

constexpr size_t SZ_W1T = (size_t)11264 * 2048 * 2, SZ_W1O = (size_t)2048 * 5632 * 2;
constexpr size_t OFF_W1T = 0;
constexpr size_t OFF_W1O = OFF_W1T + SZ_W1T;
constexpr size_t OFF_WMI = OFF_W1O + SZ_W1O;
constexpr size_t OFF_GLU = OFF_WMI + (size_t)NMIXP * 2048 * 2;
constexpr size_t OFF_WMO = OFF_GLU + (size_t)1024 * 1024 * 2;
constexpr size_t OFF_XNB = OFF_WMO + (size_t)2048 * 2048 * 2;
constexpr size_t OFF_XN  = OFF_XNB + (size_t)NTOK * 2048 * 2;
constexpr size_t OFF_R   = OFF_XN + (size_t)NTOK * 2048 * 4;
constexpr size_t OFF_H   = OFF_R + (size_t)NTOK * 2048 * 4;
constexpr size_t OFF_KDT = OFF_H + (size_t)NTOK * DFF * 2;
constexpr size_t SZ_CH   = (size_t)1024 * 64 * 128 * 2;
constexpr size_t OFF_TBT = OFF_KDT + SZ_CH;
constexpr size_t OFF_O   = OFF_TBT + (size_t)1024 * 64 * 64 * 2;
constexpr size_t OFF_ZB  = OFF_O + (size_t)NTOK * 1024 * 2;
constexpr size_t OFF_BBT = OFF_ZB + (size_t)NTOK * 1024 * 2;
constexpr size_t OFF_CT  = OFF_BBT + 262144;
constexpr size_t OFF_ABAR = OFF_CT + 262144;
constexpr size_t OFF_GLAST = OFF_ABAR + 32768;
constexpr size_t OFF_BAR = OFF_GLAST + 4096;
constexpr size_t OFF_PART = OFF_BAR + 16384;
constexpr size_t WS_END  = OFF_PART + (size_t)4 * 512 * 2048 * 4;
constexpr size_t OFF_PROJB = OFF_H;
constexpr size_t OFF_XRB = OFF_XN;
constexpr size_t OFF_YMIX = OFF_XN + (size_t)NTOK * 2048 * 2;
constexpr size_t OFF_QN = OFF_R, OFF_KN = OFF_QN + (size_t)NPR * 1024 * 2, OFF_VV = OFF_KN + (size_t)NPR * 1024 * 2;
constexpr size_t OFF_G = OFF_VV + (size_t)NPR * 1024 * 4;
constexpr size_t OFF_BETA = OFF_G + (size_t)NTOK * 8 * 4;
constexpr size_t OFF_BD = OFF_BETA + (size_t)NTOK * 8 * 4;
constexpr size_t OFF_KT = OFF_W1T, OFF_ATT = OFF_KT + SZ_CH, OFF_QG = OFF_ATT + (size_t)1024 * 64 * 64 * 2, OFF_KG = OFF_QG + SZ_CH;
constexpr size_t OFF_QKVS = OFF_KG + SZ_CH;
static_assert(OFF_BD + (size_t)NTOK * 16 * 4 <= OFF_H, "R alias overflow");
static_assert(OFF_QKVS + (size_t)512 * 3072 * 4 <= OFF_WMI, "W1 alias overflow");

struct Params { const float* in[32]; float* out; unsigned char* ws; };

typedef __bf16 bf16v2_t __attribute__((ext_vector_type(2)));
typedef float f32v2_t __attribute__((ext_vector_type(2)));
__device__ __forceinline__ unsigned pk2(float lo, float hi) { f32v2_t v = {lo, hi}; bf16v2_t b = __builtin_convertvector(v, bf16v2_t); return __builtin_bit_cast(unsigned, b); }
__device__ __forceinline__ bf16_t f2bf(float f) { return (bf16_t)(pk2(f, 0.f) & 0xffffu); }
__device__ __forceinline__ float bf2f(bf16_t b) { return __uint_as_float(((unsigned)b) << 16); }
__device__ __forceinline__ float bflo(unsigned u) { return __uint_as_float(u << 16); }
__device__ __forceinline__ float bfhi(unsigned u) { return __uint_as_float(u & 0xffff0000u); }
__device__ __forceinline__ float wave_sum(float v) {
#pragma unroll
    for (int o = 1; o < 64; o <<= 1) v += __shfl_xor(v, o);
    return v;
}
__device__ __forceinline__ float siluf(float x) { return x / (1.f + __expf(-x)); }
__device__ __forceinline__ float sigmf(float x) { return 1.f / (1.f + __expf(-x)); }
__device__ __forceinline__ float gelu_tanh(float y) {
    const float t = 0.7978845608028654f * (y + 0.044715f * y * y * y);
    const float th = 1.f - 2.f / (1.f + __expf(2.f * t));
    return 0.5f * y * (1.f + th);
}
#define WSYNC() asm volatile("s_waitcnt lgkmcnt(0)" ::: "memory")

namespace pg8 {
constexpr int BM = 256, BK = 64, HALF = 128, HTB = HALF * BK * 2, STAGE_BYTES = 8 * HTB, NXCD = 8, WGM = 8;
__host__ __device__ __forceinline__ int lds_byte(int r, int c) { const int st = (r >> 4) * 2 + (c >> 5), rr = r & 15, cc = c & 31, ob = rr * 64 + cc * 2; return st * 1024 + (ob ^ (((ob >> 9) & 1) << 5)); }
__host__ __device__ __forceinline__ void stage_rc(int b, int& R, int& C) { const int st = b / 1024, sb = b % 1024, swz = sb ^ (((sb >> 9) & 1) << 5); R = (st >> 1) * 16 + swz / 64; C = (st & 1) * 32 + (swz % 64) / 2; }
__host__ __device__ __forceinline__ int perm32(int rho) { const int n = rho >> 4, i = rho & 15; return 8 * (i >> 2) + 4 * n + (i & 3); }
struct Unit { int pm, pn, k0, nk, part, sp; };
struct Gemm { const bf16_t* A; const bf16_t* Bt; int M, N, K; };
struct StaticOrder {
    int nM, nN, nwg, G, c, ntK, mode, nsp;
    __device__ __forceinline__ void init(int M, int N, int K, int G_, int c_, bool split) {
        nM = M / BM; nN = N / BM; nwg = nM * nN; G = G_; c = c_; ntK = K / BK;
        mode = (split && G == 256 && nM == 34 && nN == 8 && (ntK % 8) == 0) ? 1 : 0; nsp = 4;
    }
    __device__ __forceinline__ void map(int L, Unit& u, int nMl) const {
        const int nw = nMl * nN;
        int wgid = L; { const int q = nw / NXCD, r = nw % NXCD, xcd = wgid % NXCD, off = wgid / NXCD; wgid = (xcd < r ? xcd * (q + 1) : r * (q + 1) + (xcd - r) * q) + off; }
        const int nig = WGM * nN, gid = wgid / nig, fm = gid * WGM, gsz = (nMl - fm) < WGM ? (nMl - fm) : WGM;
        u.pm = fm + ((wgid % nig) % gsz); u.pn = (wgid % nig) / gsz;
    }
    __device__ __forceinline__ int tail_busy() const { return mode == 1 ? 16 * nsp : (((nwg % G) * 2 <= G) ? (nwg % G) : 0); }
    __device__ __forceinline__ bool next_(int i, Unit& u) const {
        u.pm = 0; u.pn = 0; u.k0 = 0; u.nk = ntK; u.part = 0; u.sp = 0;
        if (mode == 0) { const long L = (long)i * G + c; if (L >= nwg) return false; map((int)L, u, nM); return true; }
        if (i == 0) { map(c, u, 32); return true; }
        if (i == 1 && c < 16 * nsp) {
            const int lsp = (nsp == 8) ? 3 : 2;
            const int tt = c >> lsp; u.pm = 32 + (tt & 1); u.pn = tt >> 1; u.sp = c & (nsp - 1);
            const int pairs = ntK >> 1, base = pairs >> lsp, rem = pairs & (nsp - 1);
            u.k0 = 2 * (u.sp * base + (u.sp < rem ? u.sp : rem)); u.nk = 2 * (base + (u.sp < rem ? 1 : 0)); u.part = 1; return true; }
        return false;
    }
    __device__ __forceinline__ bool next(int i, Unit& u) const {
        const bool ok = next_(i, u);
        u.pm = __builtin_amdgcn_readfirstlane(u.pm); u.pn = __builtin_amdgcn_readfirstlane(u.pn); u.k0 = __builtin_amdgcn_readfirstlane(u.k0);
        u.nk = __builtin_amdgcn_readfirstlane(u.nk); u.part = __builtin_amdgcn_readfirstlane(u.part); u.sp = __builtin_amdgcn_readfirstlane(u.sp);
        return __builtin_amdgcn_readfirstlane((int)ok) != 0;
    }
};

template <class Epi>
__device__ __forceinline__ void gemm_phase(LAS unsigned char* lds, const Gemm g, const StaticOrder& S, const Epi& E) {
    int tid = threadIdx.x; asm volatile("" : "+v"(tid));
    const int wid = __builtin_amdgcn_readfirstlane(tid >> 6), lane = tid & 63, wr = wid >> 2, wc = wid & 3, fr = lane & 15, fq = lane >> 4;
    const int K = g.K;
    unsigned voffA[2], voffB[2];
#pragma unroll
    for (int i = 0; i < 2; ++i) { int R, C; stage_rc(tid * 16 + i * 8192, R, C); const int Rb = Epi::PERM ? ((R & ~31) + perm32(R & 31)) : R;
        voffA[i] = (unsigned)(R * K + C) * 2u; voffB[i] = (unsigned)(Rb * K + C) * 2u; }
    const size_t kstep = (size_t)(BK * 2);
    const size_t hstep = (size_t)HALF * K * 2;
    const size_t tstep = 2 * hstep;
    const unsigned ldsw = (unsigned)wid * 1024u;
    const int aoff = lds_byte(wr * 64 + fr, fq * 8), boff = lds_byte(wc * 32 + fr, fq * 8);
#define PG8_SA(b, h) (((b) * 2 + (h)) * HTB)
#define PG8_SB(b, h) ((4 + (b) * 2 + (h)) * HTB)
#define PG8_STAGE(bufoff, gbase, voff) do { _Pragma("unroll") for (int _i = 0; _i < 2; ++_i) \
        __builtin_amdgcn_global_load_lds((const unsigned*)((const char*)(gbase) + (voff)[_i]), (LAS unsigned*)(lds + (bufoff) + ldsw + _i * 8192), 16, 0, 0); } while (0)
#define PG8_LDA(dst, b, h) do { _Pragma("unroll") for (int m = 0; m < 4; ++m) _Pragma("unroll") for (int k = 0; k < 2; ++k) dst[m][k] = *(const LAS bf16x8*)(lds + PG8_SA(b, h) + aoff + m * 2048 + k * 1024); } while (0)
#define PG8_LDB(dst, b, h) do { _Pragma("unroll") for (int n = 0; n < 2; ++n) _Pragma("unroll") for (int k = 0; k < 2; ++k) dst[n][k] = *(const LAS bf16x8*)(lds + PG8_SB(b, h) + boff + n * 2048 + k * 1024); } while (0)
#define PG8_MMA(ai, bj, At, Bt) do { __builtin_amdgcn_s_setprio(1); _Pragma("unroll") for (int m = 0; m < 4; ++m) _Pragma("unroll") for (int n = 0; n < 2; ++n) _Pragma("unroll") for (int k = 0; k < 2; ++k) \
        acc[ai][bj][m][n] = __builtin_amdgcn_mfma_f32_16x16x32_bf16(Bt[n][k], At[m][k], acc[ai][bj][m][n], 0, 0, 0); __builtin_amdgcn_s_setprio(0); } while (0)
#define PG8_WAIT_V(n) asm volatile("s_waitcnt vmcnt(" #n ")" ::: "memory")
#define PG8_WAIT_L(n) asm volatile("s_waitcnt lgkmcnt(" #n ")" ::: "memory")
#define PG8_BAR __builtin_amdgcn_s_barrier()
#define PG8_SCHED __builtin_amdgcn_sched_barrier(0)
    Unit cur, nxt; int ui = 0;
    if (!S.next(0, cur)) return;
    f32x4 acc[2][2][4][2];
#pragma unroll
    for (int a = 0; a < 2; ++a)
#pragma unroll
        for (int b = 0; b < 2; ++b)
#pragma unroll
            for (int m = 0; m < 4; ++m)
#pragma unroll
                for (int n = 0; n < 2; ++n) acc[a][b][m][n] = (f32x4){0.f, 0.f, 0.f, 0.f};
    bf16x8 At[4][2], B0[2][2], B1[2][2];
    const char* cA = (const char*)g.A + (size_t)cur.pm * tstep + (size_t)cur.k0 * kstep; const char* cB = (const char*)g.Bt + (size_t)cur.pn * tstep + (size_t)cur.k0 * kstep;
    PG8_STAGE(PG8_SB(0, 0), cB, voffB); PG8_STAGE(PG8_SA(0, 0), cA, voffA); PG8_STAGE(PG8_SB(0, 1), cB + hstep, voffB); PG8_STAGE(PG8_SA(0, 1), cA + hstep, voffA);
    if (wr == 1) PG8_BAR;
    PG8_WAIT_V(4); PG8_BAR;
    PG8_STAGE(PG8_SB(1, 0), cB + kstep, voffB); PG8_STAGE(PG8_SA(1, 0), cA + kstep, voffA); PG8_STAGE(PG8_SB(1, 1), cB + hstep + kstep, voffB);
    PG8_WAIT_V(6); PG8_BAR;
    for (;;) {
        const bool has_next = S.next(ui + 1, nxt);
        const char* nA = has_next ? (const char*)g.A + (size_t)nxt.pm * tstep + (size_t)nxt.k0 * kstep : cA; const char* nB = has_next ? (const char*)g.Bt + (size_t)nxt.pn * tstep + (size_t)nxt.k0 * kstep : cB;
        const int nt = cur.nk;
        for (int t = 0; t < nt; t += 2) {
            const bool last = (t == nt - 2);
            const char* a1 = cA + (size_t)(t + 1) * kstep;
            const char* a2 = last ? nA : cA + (size_t)(t + 2) * kstep; const char* b2 = last ? nB : cB + (size_t)(t + 2) * kstep;
            const char* a3 = a2 + kstep; const char* b3 = b2 + kstep;
            PG8_LDB(B0, 0, 0); PG8_SCHED; PG8_LDA(At, 0, 0); PG8_STAGE(PG8_SA(1, 1), a1 + hstep, voffA);
            PG8_WAIT_L(8); PG8_BAR; PG8_WAIT_L(0); PG8_MMA(0, 0, At, B0); PG8_BAR; PG8_SCHED;
            PG8_LDB(B1, 0, 1); PG8_STAGE(PG8_SB(0, 0), b2, voffB);
            PG8_BAR; PG8_WAIT_L(0); PG8_MMA(0, 1, At, B1); PG8_BAR;
            PG8_LDA(At, 0, 1); PG8_STAGE(PG8_SA(0, 0), a2, voffA);
            PG8_BAR; PG8_WAIT_L(0); PG8_MMA(1, 0, At, B0); PG8_BAR; PG8_SCHED;
            PG8_STAGE(PG8_SB(0, 1), b2 + hstep, voffB);
            PG8_WAIT_V(6); PG8_BAR; PG8_MMA(1, 1, At, B1); PG8_BAR;
            PG8_LDB(B0, 1, 0); PG8_SCHED; PG8_LDA(At, 1, 0); PG8_STAGE(PG8_SA(0, 1), a2 + hstep, voffA);
            PG8_WAIT_L(8); PG8_BAR; PG8_WAIT_L(0); PG8_MMA(0, 0, At, B0); PG8_BAR; PG8_SCHED;
            PG8_LDB(B1, 1, 1); PG8_STAGE(PG8_SB(1, 0), b3, voffB);
            PG8_BAR; PG8_WAIT_L(0); PG8_MMA(0, 1, At, B1); PG8_BAR;
            PG8_LDA(At, 1, 1); PG8_STAGE(PG8_SA(1, 0), a3, voffA);
            PG8_BAR; PG8_WAIT_L(0); PG8_MMA(1, 0, At, B0); PG8_BAR; PG8_SCHED;
            PG8_STAGE(PG8_SB(1, 1), b3 + hstep, voffB);
            PG8_WAIT_V(6); PG8_BAR; PG8_MMA(1, 1, At, B1); PG8_BAR;
        }
        E(acc, cur, wr, wc, fr, fq);
        if (!has_next) break;
#pragma unroll
        for (int a = 0; a < 2; ++a)
#pragma unroll
            for (int b = 0; b < 2; ++b)
#pragma unroll
                for (int m = 0; m < 4; ++m)
#pragma unroll
                    for (int n = 0; n < 2; ++n) acc[a][b][m][n] = (f32x4){0.f, 0.f, 0.f, 0.f};
        cur = nxt; cA = nA; cB = nB; ++ui;
    }
    PG8_WAIT_V(0);
    if (wr == 0) PG8_BAR;
    PG8_BAR;
#undef PG8_SA
#undef PG8_SB
#undef PG8_STAGE
#undef PG8_LDA
#undef PG8_LDB
#undef PG8_MMA
#undef PG8_WAIT_V
#undef PG8_WAIT_L
#undef PG8_BAR
#undef PG8_SCHED
}
}
using pg8::Unit;

struct EpiSwiglu {
    static constexpr bool PERM = true;
    bf16_t* H;
    __device__ __forceinline__ void operator()(const f32x4 (&acc)[2][2][4][2], const Unit& u, int wr, int wc, int fr, int fq) const {
        const int row0 = u.pm * 256 + wr * 64 + fr, col0 = u.pn * 128 + wc * 32 + 8 * fq;
#pragma unroll
        for (int ai = 0; ai < 2; ++ai)
#pragma unroll
            for (int m = 0; m < 4; ++m) {
                const f32x4 g0 = acc[ai][0][m][0], g1 = acc[ai][0][m][1], u0 = acc[ai][1][m][0], u1 = acc[ai][1][m][1];
                u32x4 o;
                o.x = pk2(siluf(g0[0]) * u0[0], siluf(g0[1]) * u0[1]); o.y = pk2(siluf(g0[2]) * u0[2], siluf(g0[3]) * u0[3]);
                o.z = pk2(siluf(g1[0]) * u1[0], siluf(g1[1]) * u1[1]); o.w = pk2(siluf(g1[2]) * u1[2], siluf(g1[3]) * u1[3]);
                *(u32x4*)(H + (size_t)(row0 + ai * 128 + m * 16) * DFF + col0) = o;
            }
    }
};
struct EpiResid {
    static constexpr bool PERM = false;
    bf16_t* R; const float* X0; const float* X1; float* P; float* P2; const bf16_t* XB; float scale;
    __device__ __forceinline__ void operator()(const f32x4 (&acc)[2][2][4][2], const Unit& u, int wr, int wc, int fr, int fq) const {
        float* const Pb = (u.sp < 4 ? P : P2) + (size_t)(u.sp & 3) * 512 * DM;
        const int row0 = u.pm * 256 + wr * 64 + fr, col0 = u.pn * 256 + wc * 32 + 4 * fq;
#pragma unroll
        for (int ai = 0; ai < 2; ++ai)
#pragma unroll
            for (int m = 0; m < 4; ++m) {
                const int row = row0 + ai * 128 + m * 16;
                const float* xr = (XB != nullptr) ? nullptr : (row < NPR ? X0 + (size_t)row * DM : X1 + (size_t)(row - NPR) * DM) + col0;
                bf16_t* rp = R + (size_t)row * DM + col0;
#pragma unroll
                for (int bj = 0; bj < 2; ++bj)
#pragma unroll
                    for (int n = 0; n < 2; ++n) {
                        if (!u.part) {
                            f32x4 xv;
                            if (XB != nullptr) { const u32x2 xb2 = *(const u32x2*)(XB + (size_t)row * DM + col0 + bj * 128 + n * 16); xv = (f32x4){bflo(xb2.x), bfhi(xb2.x), bflo(xb2.y), bfhi(xb2.y)}; }
                            else xv = *(const f32x4*)(xr + bj * 128 + n * 16);
                            const f32x4 rv = xv * ALPHA + acc[ai][bj][m][n] * scale;
                            u32x2 ro; ro.x = pk2(rv[0], rv[1]); ro.y = pk2(rv[2], rv[3]);
                            *(u32x2*)(rp + bj * 128 + n * 16) = ro;
                        } else {
                            *(f32x4*)(Pb + (size_t)(row - NPR) * DM + col0 + bj * 128 + n * 16) = acc[ai][bj][m][n] * scale;
                        }
                    }
            }
    }
};
struct EpiMixIn {
    static constexpr bool PERM = true;
    bf16_t* PB; float* BD;
    __device__ __forceinline__ void operator()(const f32x4 (&acc)[2][2][4][2], const Unit& u, int wr, int wc, int fr, int fq) const {
        const int row0 = u.pm * 256 + wr * 64 + fr;
        if (u.pn < 20) {
            const int col0 = u.pn * 256 + wc * 32 + 8 * fq;
#pragma unroll
            for (int ai = 0; ai < 2; ++ai)
#pragma unroll
                for (int m = 0; m < 4; ++m)
#pragma unroll
                    for (int bj = 0; bj < 2; ++bj) {
                        const f32x4 v0 = acc[ai][bj][m][0], v1 = acc[ai][bj][m][1];
                        u32x4 o; o.x = pk2(v0[0], v0[1]); o.y = pk2(v0[2], v0[3]); o.z = pk2(v1[0], v1[1]); o.w = pk2(v1[2], v1[3]);
                        *(u32x4*)(PB + (size_t)(row0 + ai * 128 + m * 16) * NPB + col0 + bj * 128) = o;
                    }
        } else if (wc == 0 && fq < 2) {
#pragma unroll
            for (int ai = 0; ai < 2; ++ai)
#pragma unroll
                for (int m = 0; m < 4; ++m) {
                    float* bp = BD + (size_t)(row0 + ai * 128 + m * 16) * 16 + 8 * fq;
                    *(f32x4*)(bp) = acc[ai][0][m][0]; *(f32x4*)(bp + 4) = acc[ai][0][m][1];
                }
        }
    }
};
struct EpiGlu {
    static constexpr bool PERM = true;
    bf16_t* YM; const bf16_t* ZB; const float* bias;
    __device__ __forceinline__ void operator()(const f32x4 (&acc)[2][2][4][2], const Unit& u, int wr, int wc, int fr, int fq) const {
        const int row0 = u.pm * 256 + wr * 64 + fr, col0 = u.pn * 256 + wc * 32 + 8 * fq;
#pragma unroll
        for (int bj = 0; bj < 2; ++bj) {
            const f32x4 b0 = *(const f32x4*)(bias + col0 + bj * 128), b1 = *(const f32x4*)(bias + col0 + bj * 128 + 4);
#pragma unroll
            for (int ai = 0; ai < 2; ++ai)
#pragma unroll
                for (int m = 0; m < 4; ++m) {
                    const int row = row0 + ai * 128 + m * 16;
                    const u32x4 zz = *(const u32x4*)(ZB + (size_t)row * 1024 + col0 + bj * 128);
                    const f32x4 v0 = acc[ai][bj][m][0] + b0, v1 = acc[ai][bj][m][1] + b1;
                    u32x4 o;
                    o.x = pk2(bflo(zz.x) * sigmf(v0[0]), bfhi(zz.x) * sigmf(v0[1])); o.y = pk2(bflo(zz.y) * sigmf(v0[2]), bfhi(zz.y) * sigmf(v0[3]));
                    o.z = pk2(bflo(zz.z) * sigmf(v1[0]), bfhi(zz.z) * sigmf(v1[1])); o.w = pk2(bflo(zz.w) * sigmf(v1[2]), bfhi(zz.w) * sigmf(v1[3]));
                    *(u32x4*)(YM + (size_t)row * DM + col0 + bj * 128) = o;
                }
        }
    }
};

__device__ __forceinline__ void transpose_tile(const float* __restrict__ W, int K, int N, bf16_t* __restrict__ WT, int kt, int nt, int mode, LAS float* tile) {
    int tid = threadIdx.x; asm volatile("" : "+v"(tid));
    const int k0 = kt * 64, n0 = nt * 256;
    f32x4 v[8];
#pragma unroll
    for (int i = 0; i < 8; ++i) {
        const int idx = tid + 512 * i, rr = idx >> 6, c4 = (idx & 63) * 4;
        v[i] = (f32x4){0.f, 0.f, 0.f, 0.f};
        if (n0 + c4 < N) v[i] = *(const f32x4*)(W + (size_t)(k0 + rr) * N + n0 + c4);
    }
#pragma unroll
    for (int i = 0; i < 8; ++i) {
        const int idx = tid + 512 * i, rr = idx >> 6, c4 = (idx & 63) * 4;
        tile[rr * 257 + c4 + 0] = v[i][0]; tile[rr * 257 + c4 + 1] = v[i][1]; tile[rr * 257 + c4 + 2] = v[i][2]; tile[rr * 257 + c4 + 3] = v[i][3];
    }
    __syncthreads();
#pragma unroll
    for (int j = 0; j < 4; ++j) {
        const int id = tid + 512 * j, n = id >> 3, kc = id & 7;
        float f[8];
#pragma unroll
        for (int e = 0; e < 8; ++e) f[e] = tile[(kc * 8 + e) * 257 + n];
        const int nn = n0 + n; int drow = nn;
        if (mode == 1) { const int isup = nn >= DFF; const int jj = isup ? nn - DFF : nn; drow = (jj >> 7) * 256 + isup * 128 + (jj & 127); }
        u32x4 o; o.x = pk2(f[0], f[1]); o.y = pk2(f[2], f[3]); o.z = pk2(f[4], f[5]); o.w = pk2(f[6], f[7]);
        *(u32x4*)(WT + (size_t)drow * K + k0 + kc * 8) = o;
    }
    __syncthreads();
}
__device__ __forceinline__ void transpose_matrix(const float* W, int K, int N, bf16_t* WT, int mode, LAS float* tile, int b0 = 0) {
    const int nkt = K / 64, nnt = (N + 255) / 256, tot = nkt * nnt;
    if ((int)blockIdx.x < b0) return;
    for (int t = blockIdx.x - b0; t < tot; t += gridDim.x - b0) transpose_tile(W, K, N, WT, t / nnt, t % nnt, mode, tile);
}

__device__ __forceinline__ void phase_convert0(const Params& p, LAS unsigned char* lds) {
    unsigned char* ws = p.ws;
    LAS float* tile = (LAS float*)lds;
    transpose_matrix(p.in[8], DM, 2 * DFF, (bf16_t*)(ws + OFF_W1T), 1, tile);
    transpose_matrix(p.in[9], DFF, DM, (bf16_t*)(ws + OFF_W1O), 0, tile);
    const size_t gtid = (size_t)blockIdx.x * 512 + threadIdx.x, gsz = (size_t)gridDim.x * 512;
    { bf16_t* xb = (bf16_t*)(ws + OFF_XNB); const size_t n8 = (size_t)NTOK * DM / 8, np8 = (size_t)NPR * DM / 8;
      for (size_t i = gtid; i < n8; i += gsz) {
          const float* s = (i < np8) ? p.in[0] + i * 8 : p.in[1] + (i - np8) * 8;
          const f32x4 a = *(const f32x4*)s, b = *(const f32x4*)(s + 4);
          u32x4 o; o.x = pk2(a[0], a[1]); o.y = pk2(a[2], a[3]); o.z = pk2(b[0], b[1]); o.w = pk2(b[2], b[3]);
          *(u32x4*)(xb + i * 8) = o; } }
    if (gtid < 4096) {
        const int g = (int)(gtid >> 6), pp = (int)(gtid & 63);
        const double dt = exp((double)p.in[13][g]);
        const double lr = (double)p.in[11][g * 64 + pp], li = (double)p.in[12][g * 64 + pp];
        const double mag = exp(lr * dt), abr = mag * cos(li * dt), abi = mag * sin(li * dt);
        const double nr = abr - 1.0, ni = abi, den = lr * lr + li * li;
        const double cr = (nr * lr + ni * li) / den, ci = (ni * lr - nr * li) / den;
        bf16_t* bbt = (bf16_t*)(ws + OFF_BBT) + (size_t)g * 128 * 16;
        for (int h = 0; h < 16; ++h) {
            const double bre = (double)p.in[14][(g * 64 + pp) * 16 + h], bim = (double)p.in[15][(g * 64 + pp) * 16 + h];
            bbt[pp * 16 + h] = f2bf((float)(cr * bre - ci * bim));
            bbt[(64 + pp) * 16 + h] = f2bf((float)(cr * bim + ci * bre));
        }
        float* ab = (float*)(ws + OFF_ABAR); ab[(g * 64 + pp) * 2] = (float)abr; ab[(g * 64 + pp) * 2 + 1] = (float)abi;
        bf16_t* ct = (bf16_t*)(ws + OFF_CT) + (size_t)g * 16 * 128;
        for (int o = 0; o < 16; ++o) {
            ct[o * 128 + pp] = f2bf(p.in[16][(g * 16 + o) * 64 + pp]);
            ct[o * 128 + 64 + pp] = f2bf(-p.in[17][(g * 16 + o) * 64 + pp]);
        }
    }
}
__device__ __forceinline__ void phase_convert_mid(const Params& p, LAS unsigned char* lds, int b0) {
    unsigned char* ws = p.ws;
    LAS float* tile = (LAS float*)lds;
    transpose_matrix(p.in[10], DM, NMIX, (bf16_t*)(ws + OFF_WMI), 0, tile, b0);
    transpose_matrix(p.in[19], 1024, 1024, (bf16_t*)(ws + OFF_GLU), 0, tile, b0);
    transpose_matrix(p.in[25], DM, DM, (bf16_t*)(ws + OFF_WMO), 0, tile, b0);
}
__device__ __forceinline__ void phase_convert1(const Params& p, LAS unsigned char* lds, int b0, bool skip_out) {
    LAS float* tile = (LAS float*)lds;
    transpose_matrix(p.in[28], DM, 2 * DFF, (bf16_t*)(p.ws + OFF_W1T), 1, tile, b0);
    if (!skip_out) transpose_matrix(p.in[29], DFF, DM, (bf16_t*)(p.ws + OFF_W1O), 0, tile, b0);
}

__device__ __forceinline__ void phase_ln(const bf16_t* R, const float* gam, const float* bet, float* outf, bf16_t* outb, const float* P, const float* XS, const bf16_t* XSB, const float* P2 = nullptr) {
    int lane = threadIdx.x; asm volatile("" : "+v"(lane)); lane &= 63;
    const int wave = __builtin_amdgcn_readfirstlane(threadIdx.x >> 6);
    for (int row = blockIdx.x * 8 + wave; row < NTOK; row += gridDim.x * 8) {
        const u32x2* rp = (const u32x2*)(R + (size_t)row * DM) + lane;
        f32x4 v[8]; float s = 0.f;
        if (P != nullptr && row >= NPR) {
#pragma unroll
            for (int j = 0; j < 8; ++j) {
                f32x4 xv;
                if (XSB != nullptr) { const u32x2 xb2 = *((const u32x2*)(XSB + (size_t)(row - NPR) * DM) + lane + 64 * j); xv = (f32x4){bflo(xb2.x), bfhi(xb2.x), bflo(xb2.y), bfhi(xb2.y)}; }
                else xv = ((const f32x4*)(XS + (size_t)(row - NPR) * DM) + lane)[64 * j];
                v[j] = xv * ALPHA;
            }
            const int nslab = (P2 != nullptr) ? 8 : 4;
#pragma unroll 1
            for (int k = 0; k < nslab; ++k) {
                const f32x4* pk = (const f32x4*)((k < 4 ? P : P2) + ((size_t)(k & 3) * 512 + (row - NPR)) * DM) + lane;
#pragma unroll
                for (int j = 0; j < 8; ++j) v[j] += pk[64 * j];
            }
        } else {
#pragma unroll
            for (int j = 0; j < 8; ++j) { const u32x2 rb = rp[64 * j]; v[j] = (f32x4){bflo(rb.x), bfhi(rb.x), bflo(rb.y), bfhi(rb.y)}; }
        }
#pragma unroll
        for (int j = 0; j < 8; ++j) s += (v[j][0] + v[j][1]) + (v[j][2] + v[j][3]);
        const float mean = wave_sum(s) * (1.f / DM); float s2 = 0.f;
#pragma unroll
        for (int j = 0; j < 8; ++j) { v[j] = v[j] - mean; s2 += (v[j][0] * v[j][0] + v[j][1] * v[j][1]) + (v[j][2] * v[j][2] + v[j][3] * v[j][3]); }
        const float rstd = 1.f / sqrtf(wave_sum(s2) * (1.f / DM) + 1e-5f);
#pragma unroll
        for (int j = 0; j < 8; ++j) {
            const int col = 4 * (lane + 64 * j);
            const f32x4 gg = *(const f32x4*)(gam + col), bb = *(const f32x4*)(bet + col);
            const f32x4 y = v[j] * rstd * gg + bb;
            if (outf) *(f32x4*)(outf + (size_t)row * DM + col) = y;
            if (outb) { u32x2 o; o.x = pk2(y[0], y[1]); o.y = pk2(y[2], y[3]); *(u32x2*)(outb + (size_t)row * DM + col) = o; }
        }
    }
}

constexpr int S5_SPLIT = 36;
__device__ __forceinline__ void s5_unit(const Params& p, int g, int tok_base, int nsub, bool sample, int b0, LAS unsigned char* wl, int hb_off, float& hr_io, float& hi_io, bool store_final);
__device__ __forceinline__ void phase_conv(const Params& p, LAS unsigned char* lds, float& s5r, float& s5i, bool split5) {
    unsigned char* ws = p.ws;
    int lane = threadIdx.x; asm volatile("" : "+v"(lane)); lane &= 63;
    const int wave = __builtin_amdgcn_readfirstlane(threadIdx.x >> 6);
    const bf16_t* PB = (const bf16_t*)(ws + OFF_PROJB);
    const float* BD = (const float*)(ws + OFF_BD);
    const float* cw = p.in[21];
    float* G = (float*)(ws + OFF_G); float* BT = (float*)(ws + OFF_BETA);
    bf16_t* QN = (bf16_t*)(ws + OFF_QN); bf16_t* KN = (bf16_t*)(ws + OFF_KN); float* VV = (float*)(ws + OFF_VV);
    bf16_t* KT = (bf16_t*)(ws + OFF_KT);
    float* QKVS = (float*)(ws + OFF_QKVS);
    const int NIT = 8192 + 1024;
    const int ncw = split5 ? 7 : 8;
    if (wave >= ncw) {
        const int u = blockIdx.x;
        if (u < 256) s5_unit(p, u & 63, (u >> 6) * 2048, S5_SPLIT, false, 0, lds, 16384, s5r, s5i, false);
        return;
    }
    for (int it = blockIdx.x * ncw + wave; it < NIT; it += gridDim.x * ncw) {
        if (it < 8192) {
            const int h = it & 7, tg = (it >> 3) & 255, b = it >> 11;
            const int t0 = tg * 8, tok0 = b * 2048 + t0;
            if (lane < 8) {
                const int tok = tok0 + lane;
                const float braw = BD[(size_t)tok * 16 + h], araw = BD[(size_t)tok * 16 + 8 + h];
                const float xx = araw + p.in[23][h];
                const float sp = xx > 20.f ? xx : log1pf(expf(xx));
                G[(size_t)tok * 8 + h] = -expf(p.in[22][h]) * sp;
                BT[(size_t)tok * 8 + h] = 1.f / (1.f + expf(-braw));
            }
            float x0[3][11], x1[3][11], w0[3][4], w1[3][4];
#pragma unroll
            for (int st = 0; st < 3; ++st) {
                const int col = st * 1024 + h * 128 + 2 * lane;
#pragma unroll
                for (int j = 0; j < 11; ++j) {
                    const int t = t0 - 3 + j;
                    unsigned v = 0u;
                    if (t >= 0) v = *(const unsigned*)(PB + (size_t)(b * 2048 + t) * NPB + 1024 + col);
                    x0[st][j] = bflo(v); x1[st][j] = bfhi(v);
                }
#pragma unroll
                for (int j = 0; j < 4; ++j) { w0[st][j] = cw[j * 3072 + col]; w1[st][j] = cw[j * 3072 + col + 1]; }
            }
            float y0[3][8], y1[3][8];
#pragma unroll
            for (int st = 0; st < 3; ++st)
#pragma unroll
                for (int t = 0; t < 8; ++t) {
                    float a0 = 0.f, a1 = 0.f;
#pragma unroll
                    for (int j = 0; j < 4; ++j) { a0 += x0[st][t + j] * w0[st][j]; a1 += x1[st][t + j] * w1[st][j]; }
                    y0[st][t] = siluf(a0); y1[st][t] = siluf(a1);
                }
            float ss[2][8];
#pragma unroll
            for (int st = 0; st < 2; ++st)
#pragma unroll
                for (int t = 0; t < 8; ++t) ss[st][t] = y0[st][t] * y0[st][t] + y1[st][t] * y1[st][t];
#pragma unroll
            for (int o = 1; o < 64; o <<= 1)
#pragma unroll
                for (int st = 0; st < 2; ++st)
#pragma unroll
                    for (int t = 0; t < 8; ++t) ss[st][t] += __shfl_xor(ss[st][t], o);
#pragma unroll
            for (int st = 0; st < 2; ++st)
#pragma unroll
                for (int t = 0; t < 8; ++t) {
                    float sc = 1.f / sqrtf(ss[st][t] + 1e-6f);
                    if (st == 0) sc *= 0.08838834764831845f;
                    y0[st][t] *= sc; y1[st][t] *= sc;
                }
#pragma unroll
            for (int t = 0; t < 8; ++t) {
                *(unsigned*)(QN + (size_t)(tok0 + t) * 1024 + h * 128 + 2 * lane) = pk2(y0[0][t], y1[0][t]);
                *(unsigned*)(KN + (size_t)(tok0 + t) * 1024 + h * 128 + 2 * lane) = pk2(y0[1][t], y1[1][t]);
                float* o = VV + (size_t)(tok0 + t) * 1024 + h * 128 + 2 * lane; o[0] = y0[2][t]; o[1] = y1[2][t];
            }
            {
                const int chunk = t0 >> 6, c0 = t0 & 63;
                bf16_t* base = KT + ((size_t)((b * 8 + h) * 32 + chunk) * 128 + 2 * lane) * 64 + c0;
                u32x4 o0, o1;
                o0.x = pk2(y0[1][0], y0[1][1]); o0.y = pk2(y0[1][2], y0[1][3]); o0.z = pk2(y0[1][4], y0[1][5]); o0.w = pk2(y0[1][6], y0[1][7]);
                o1.x = pk2(y1[1][0], y1[1][1]); o1.y = pk2(y1[1][2], y1[1][3]); o1.z = pk2(y1[1][4], y1[1][5]); o1.w = pk2(y1[1][6], y1[1][7]);
                *(u32x4*)base = o0; *(u32x4*)(base + 64) = o1;
            }
            if (tg == 255) {
#pragma unroll
                for (int st = 0; st < 3; ++st)
#pragma unroll
                    for (int j = 0; j < 3; ++j) {
                        float* o = p.out + O_PCONV + (size_t)(b * 3 + j) * 3072 + st * 1024 + h * 128 + 2 * lane;
                        o[0] = x0[st][8 + j]; o[1] = x1[st][8 + j];
                    }
            }
        } else {
            const int si = it - 8192, h = si & 7, b = si >> 3;
            const int tok0 = NPR + b * 4;
            if (lane < 4) {
                const int tok = tok0 + lane;
                const float braw = BD[(size_t)tok * 16 + h], araw = BD[(size_t)tok * 16 + 8 + h];
                const float xx = araw + p.in[23][h];
                const float sp = xx > 20.f ? xx : log1pf(expf(xx));
                G[(size_t)tok * 8 + h] = -expf(p.in[22][h]) * sp;
                BT[(size_t)tok * 8 + h] = 1.f / (1.f + expf(-braw));
            }
#pragma unroll
            for (int st = 0; st < 3; ++st) {
                const int col = st * 1024 + h * 128 + 2 * lane;
                float x0[7], x1[7];
#pragma unroll
                for (int j = 0; j < 3; ++j) { const float* s = p.in[5] + (size_t)(b * 3 + j) * 3072 + col; x0[j] = s[0]; x1[j] = s[1]; }
#pragma unroll
                for (int j = 0; j < 4; ++j) { const unsigned v = *(const unsigned*)(PB + (size_t)(tok0 + j) * NPB + 1024 + col); x0[3 + j] = bflo(v); x1[3 + j] = bfhi(v); }
                float w0[4], w1[4];
#pragma unroll
                for (int j = 0; j < 4; ++j) { w0[j] = cw[j * 3072 + col]; w1[j] = cw[j * 3072 + col + 1]; }
#pragma unroll
                for (int t = 0; t < 4; ++t) {
                    float a0 = 0.f, a1 = 0.f;
#pragma unroll
                    for (int j = 0; j < 4; ++j) { a0 += x0[t + j] * w0[j]; a1 += x1[t + j] * w1[j]; }
                    float y0 = siluf(a0), y1 = siluf(a1);
                    if (st < 2) {
                        const float ss = wave_sum(y0 * y0 + y1 * y1);
                        float sc = 1.f / sqrtf(ss + 1e-6f);
                        if (st == 0) sc *= 0.08838834764831845f;
                        y0 *= sc; y1 *= sc;
                    }
                    float* o = QKVS + (size_t)(b * 4 + t) * 3072 + col; o[0] = y0; o[1] = y1;
                }
#pragma unroll
                for (int j = 0; j < 3; ++j) {
                    float* o = p.out + O_SCONV + (size_t)(b * 3 + j) * 3072 + col;
                    o[0] = x0[4 + j]; o[1] = x1[4 + j];
                }
            }
        }
    }
}

__device__ __forceinline__ f32x16 mfma32(bf16x8 a, bf16x8 b, f32x16 c) { return __builtin_amdgcn_mfma_f32_32x32x16_bf16(a, b, c, 0, 0, 0); }
__device__ __forceinline__ f32x4 mfma16(bf16x8 a, bf16x8 b, f32x4 c) { return __builtin_amdgcn_mfma_f32_16x16x32_bf16(a, b, c, 0, 0, 0); }
__device__ __forceinline__ bf16x8 mk8(unsigned a, unsigned b, unsigned c, unsigned d) { u32x4 t = {a, b, c, d}; return __builtin_bit_cast(bf16x8, t); }
constexpr int MTP = 36;

template <int C> __device__ __forceinline__ void solve_col(float (&t)[64], const LAS float* MT, int lane) {
    float a0 = 0.f, a1 = 0.f, a2 = 0.f, a3 = 0.f;
    int mb = 0; if (C < 63) asm volatile("" : "+v"(mb) : "v"(t[C + 1]));
#pragma unroll
    for (int jj = (C + 1) / 4; jj < 16; ++jj) {
        const int j4 = jj * 4;
        if (jj == 8 && (C + 1) / 4 < 8) asm volatile("" : "+v"(mb) : "v"(a0), "v"(a1), "v"(a2), "v"(a3));
        const int ti = (j4 >> 5) + (C >> 5);
        const f32x4 m = *(const LAS f32x4*)(MT + mb + ti * 32 * MTP + (C & 31) * MTP + (j4 & 31));
        if (j4 + 0 > C) a0 += t[j4 + 0] * m[0];
        if (j4 + 1 > C) a1 += t[j4 + 1] * m[1];
        if (j4 + 2 > C) a2 += t[j4 + 2] * m[2];
        if (j4 + 3 > C) a3 += t[j4 + 3] * m[3];
    }
    t[C] = ((lane == C) ? 1.f : 0.f) - ((a0 + a1) + (a2 + a3));
    if constexpr (C > 0) solve_col<C - 1>(t, MT, lane);
}

__device__ __forceinline__ void gdn_prep_item(const Params& p, int it, LAS unsigned char* wl, LAS float* gcl_) {
    unsigned char* ws = p.ws;
    int lane = threadIdx.x; asm volatile("" : "+v"(lane)); lane &= 63;
    const int r = lane & 31, hh = lane >> 5;
    const int n = it & 31, bh = it >> 5, h = bh & 7, b = bh >> 3;
    const int tok0 = b * 2048 + n * 64;
    LAS float* MT = (LAS float*)wl;
    LAS float* gcL = gcl_;
    LAS float* btL = gcL + 64;
    const float* G = (const float*)(ws + OFF_G); const float* BT = (const float*)(ws + OFF_BETA);
    float gc = G[(size_t)(tok0 + lane) * 8 + h];
    const float bv = BT[(size_t)(tok0 + lane) * 8 + h];
#pragma unroll
    for (int o = 1; o < 64; o <<= 1) { const float t = __int_as_float(__builtin_amdgcn_ds_bpermute((lane - o) << 2, __float_as_int(gc))); if (lane >= o) gc += t; }
    const float gl = __int_as_float(__builtin_amdgcn_readlane(__float_as_int(gc), 63));
    gcL[lane] = gc; btL[lane] = bv;
    if (lane == 0) ((float*)(ws + OFF_GLAST))[it] = __expf(gl);
    WSYNC();
    const bf16_t* kp = (const bf16_t*)(ws + OFF_KN) + (size_t)tok0 * 1024 + h * 128;
    const bf16_t* qp = (const bf16_t*)(ws + OFF_QN) + (size_t)tok0 * 1024 + h * 128;
    bf16x8 Kf[2][8];
#pragma unroll
    for (int mt = 0; mt < 2; ++mt)
#pragma unroll
        for (int ks = 0; ks < 8; ++ks) Kf[mt][ks] = *(const bf16x8*)(kp + (size_t)(mt * 32 + r) * 1024 + ks * 16 + hh * 8);
    {
        bf16_t* KG = (bf16_t*)(ws + OFF_KG) + (size_t)it * 8192;
#pragma unroll
        for (int mt = 0; mt < 2; ++mt) {
            const float e = -__expf(gcL[mt * 32 + r]);
#pragma unroll
            for (int ks = 0; ks < 8; ++ks) {
                const u32x4 v = __builtin_bit_cast(u32x4, Kf[mt][ks]);
                u32x2 o0, o1; o0.x = pk2(bflo(v.x) * e, bfhi(v.x) * e); o0.y = pk2(bflo(v.y) * e, bfhi(v.y) * e);
                o1.x = pk2(bflo(v.z) * e, bfhi(v.z) * e); o1.y = pk2(bflo(v.w) * e, bfhi(v.w) * e);
                bf16_t* fp = KG + (mt * 8 + ks) * 512 + r * 8 + 4 * hh;
                *(u32x2*)fp = o0; *(u32x2*)(fp + 256) = o1;
            }
        }
    }
    __builtin_amdgcn_sched_barrier(0);
#pragma unroll
    for (int ti = 0; ti < 3; ++ti) {
        __builtin_amdgcn_sched_barrier(0);
        const int mi = (ti >= 1), ni = (ti == 2);
        f32x16 a = {};
#pragma unroll
        for (int ks = 0; ks < 8; ++ks) a = mfma32(Kf[mi][ks], Kf[ni][ks], a);
        const int j = ni * 32 + r; const float gcj = gcL[j];
#pragma unroll
        for (int qq = 0; qq < 4; ++qq) {
            const int i0 = mi * 32 + 8 * qq + 4 * hh;
            const f32x4 gci = *(const LAS f32x4*)(gcL + i0), bti = *(const LAS f32x4*)(btL + i0);
            f32x4 mv;
#pragma unroll
            for (int e = 0; e < 4; ++e) {
                const int i = i0 + e;
                const float dec = __expf(fminf(gci[e] - gcj, 0.f));
                mv[e] = (i > j) ? bti[e] * a[qq * 4 + e] * dec : 0.f;
            }
            *(LAS f32x4*)(MT + ti * 32 * MTP + r * MTP + 8 * qq + 4 * hh) = mv;
        }
    }
    bf16_t* ATT = (bf16_t*)(ws + OFF_ATT) + (size_t)it * 4096;
    bf16_t* QG = (bf16_t*)(ws + OFF_QG) + (size_t)it * 8192;
#pragma unroll
    for (int mi = 0; mi < 2; ++mi) {
        __builtin_amdgcn_sched_barrier(0);
        bf16x8 Qf[8];
#pragma unroll
        for (int ks = 0; ks < 8; ++ks) Qf[ks] = *(const bf16x8*)(qp + (size_t)(mi * 32 + r) * 1024 + ks * 16 + hh * 8);
#pragma unroll
        for (int ni = 0; ni <= mi; ++ni) {
            __builtin_amdgcn_sched_barrier(0);
            f32x16 q = {};
#pragma unroll
            for (int ks = 0; ks < 8; ++ks) q = mfma32(Qf[ks], Kf[ni][ks], q);
            const int j = ni * 32 + r; const float gcj = gcL[j];
#pragma unroll
            for (int qq = 0; qq < 4; ++qq) {
                const int i0 = mi * 32 + 8 * qq + 4 * hh;
                const f32x4 gci = *(const LAS f32x4*)(gcL + i0);
#pragma unroll
                for (int e = 0; e < 4; ++e) {
                    const int i = i0 + e;
                    const float dec = __expf(fminf(gci[e] - gcj, 0.f));
                    ATT[((mi * 2 + ni) * 2 + (r >> 4)) * 512 + (((r >> 2) & 1) * 32 + (i & 31)) * 8 + 4 * ((r >> 3) & 1) + (r & 3)] = f2bf((i >= j) ? q[qq * 4 + e] * dec : 0.f);
                }
            }
        }
        __builtin_amdgcn_sched_barrier(0);
        const float e = __expf(gcL[mi * 32 + r]);
#pragma unroll
        for (int ks = 0; ks < 8; ++ks) {
            const u32x4 v = __builtin_bit_cast(u32x4, Qf[ks]);
            u32x2 o0, o1; o0.x = pk2(bflo(v.x) * e, bfhi(v.x) * e); o0.y = pk2(bflo(v.y) * e, bfhi(v.y) * e);
            o1.x = pk2(bflo(v.z) * e, bfhi(v.z) * e); o1.y = pk2(bflo(v.w) * e, bfhi(v.w) * e);
            bf16_t* fp = QG + (mi * 8 + ks) * 512 + r * 8 + 4 * hh;
            *(u32x2*)fp = o0; *(u32x2*)(fp + 256) = o1;
        }
    }
    WSYNC();
    float t[64];
    solve_col<63>(t, MT, lane);
    WSYNC();
    int lane5 = lane; asm volatile("" : "+v"(lane5) : "v"(t[0]));
    const int r5 = lane5 & 31, h5 = lane5 >> 5;
    {
        bf16_t* TBt = (bf16_t*)(ws + OFF_TBT) + (size_t)it * 4096 + ((lane5 >> 5) * 4) * 512 + (lane5 & 31) * 8;
#pragma unroll
        for (int m2 = 0; m2 < 2; ++m2)
#pragma unroll
            for (int sx = 0; sx < 2; ++sx) {
                const int c0 = m2 * 32 + 16 * sx;
                const f32x4 b0 = *(const LAS f32x4*)(btL + c0), b1 = *(const LAS f32x4*)(btL + c0 + 4), b2 = *(const LAS f32x4*)(btL + c0 + 8), b3 = *(const LAS f32x4*)(btL + c0 + 12);
                u32x4 oa, ob;
                oa.x = pk2(t[c0 + 0] * b0[0], t[c0 + 1] * b0[1]); oa.y = pk2(t[c0 + 2] * b0[2], t[c0 + 3] * b0[3]);
                oa.z = pk2(t[c0 + 8] * b2[0], t[c0 + 9] * b2[1]); oa.w = pk2(t[c0 + 10] * b2[2], t[c0 + 11] * b2[3]);
                ob.x = pk2(t[c0 + 4] * b1[0], t[c0 + 5] * b1[1]); ob.y = pk2(t[c0 + 6] * b1[2], t[c0 + 7] * b1[3]);
                ob.z = pk2(t[c0 + 12] * b3[0], t[c0 + 13] * b3[1]); ob.w = pk2(t[c0 + 14] * b3[2], t[c0 + 15] * b3[3]);
                bf16_t* fp = TBt + (m2 * 2 + sx) * 512;
                *(u32x4*)fp = oa; *(u32x4*)(fp + 256) = ob;
            }
    }
    {
        const bf16_t* KT = (const bf16_t*)(ws + OFF_KT) + (size_t)it * 8192;
        bf16_t* KDT = (bf16_t*)(ws + OFF_KDT) + (size_t)it * 8192;
#pragma unroll
        for (int nt = 0; nt < 4; ++nt) {
            __builtin_amdgcn_sched_barrier(0);
#pragma unroll
            for (int ks = 0; ks < 4; ++ks) {
                const u32x4 v = *(const u32x4*)(KT + (size_t)(nt * 32 + r5) * 64 + ks * 16 + h5 * 8);
                const f32x4 g0 = *(const LAS f32x4*)(gcL + ks * 16 + h5 * 8), g1 = *(const LAS f32x4*)(gcL + ks * 16 + h5 * 8 + 4);
                u32x2 o0, o1;
                o0.x = pk2(bflo(v.x) * __expf(gl - g0[0]), bfhi(v.x) * __expf(gl - g0[1])); o0.y = pk2(bflo(v.y) * __expf(gl - g0[2]), bfhi(v.y) * __expf(gl - g0[3]));
                o1.x = pk2(bflo(v.z) * __expf(gl - g1[0]), bfhi(v.z) * __expf(gl - g1[1])); o1.y = pk2(bflo(v.w) * __expf(gl - g1[2]), bfhi(v.w) * __expf(gl - g1[3]));
                bf16_t* fp = KDT + (nt * 4 + ks) * 512 + r5 * 8 + 4 * h5;
                *(u32x2*)fp = o0; *(u32x2*)(fp + 256) = o1;
            }
        }
    }
    WSYNC();
}

__device__ __forceinline__ void gdn_sample_item(const Params& p, int it, LAS unsigned char* wl) {
    unsigned char* ws = p.ws;
    int lane = threadIdx.x; asm volatile("" : "+v"(lane)); lane &= 63;
    const int c = lane & 31, hh = lane >> 5;
    const int qd = it & 3, bh = it >> 2, h = bh & 7, b = bh >> 3;
    const int dv = qd * 32 + c;
    float s[64];
    { const float* sp = p.in[4] + (size_t)bh * 16384 + (size_t)(hh * 64) * 128 + dv;
#pragma unroll
      for (int i = 0; i < 64; ++i) s[i] = sp[i * 128]; }
    LAS float* kq = (LAS float*)wl;
    const float* QKVS = (const float*)(ws + OFF_QKVS);
    const float* G = (const float*)(ws + OFF_G); const float* BT = (const float*)(ws + OFF_BETA);
    bf16_t* O = (bf16_t*)(ws + OFF_O);
#pragma unroll
    for (int t = 0; t < 4; ++t) {
        const float* row = QKVS + (size_t)(b * 4 + t) * 3072 + h * 128;
        kq[t * 256 + lane] = row[1024 + lane]; kq[t * 256 + 64 + lane] = row[1024 + 64 + lane];
        kq[t * 256 + 128 + lane] = row[lane]; kq[t * 256 + 192 + lane] = row[64 + lane];
    }
    WSYNC();
#pragma unroll 1
    for (int t = 0; t < 4; ++t) {
        const int tok = NPR + b * 4 + t;
        const float al = __expf(G[(size_t)tok * 8 + h]), be = BT[(size_t)tok * 8 + h];
        const float v = QKVS[(size_t)(b * 4 + t) * 3072 + 2048 + h * 128 + dv];
        float d0 = 0.f, d1 = 0.f, d2 = 0.f, d3 = 0.f;
        int kb = t * 256 + hh * 64;
#pragma unroll
        for (int i = 0; i < 64; i += 4) {
            if ((i & 15) == 0) asm volatile("" : "+v"(kb) : "v"(d0), "v"(d1), "v"(d2), "v"(d3));
            const f32x4 kk = *(const LAS f32x4*)(kq + kb + i);
            s[i] *= al; s[i + 1] *= al; s[i + 2] *= al; s[i + 3] *= al;
            d0 += kk[0] * s[i]; d1 += kk[1] * s[i + 1]; d2 += kk[2] * s[i + 2]; d3 += kk[3] * s[i + 3];
        }
        float dd = (d0 + d1) + (d2 + d3);
        dd += __shfl_xor(dd, 32);
        const float rr = be * (v - dd);
        float o0 = 0.f, o1 = 0.f, o2 = 0.f, o3 = 0.f;
        asm volatile("" : "+v"(kb) : "v"(rr));
#pragma unroll
        for (int i = 0; i < 64; i += 4) {
            if ((i & 15) == 0) asm volatile("" : "+v"(kb) : "v"(o0), "v"(o1), "v"(o2), "v"(o3));
            const f32x4 kk = *(const LAS f32x4*)(kq + kb + i);
            const f32x4 qq = *(const LAS f32x4*)(kq + kb + 128 + i);
            s[i] += rr * kk[0]; s[i + 1] += rr * kk[1]; s[i + 2] += rr * kk[2]; s[i + 3] += rr * kk[3];
            o0 += qq[0] * s[i]; o1 += qq[1] * s[i + 1]; o2 += qq[2] * s[i + 2]; o3 += qq[3] * s[i + 3];
        }
        float oo = (o0 + o1) + (o2 + o3);
        oo += __shfl_xor(oo, 32);
        if (hh == 0) O[(size_t)tok * 1024 + h * 128 + dv] = f2bf(oo);
    }
    int dv2 = dv; asm volatile("" : "+v"(dv2));
    float* So = p.out + O_SGDN + (size_t)bh * 16384 + (size_t)(hh * 64) * 128 + dv2;
#pragma unroll
    for (int i = 0; i < 64; ++i) So[i * 128] = s[i];
    WSYNC();
}

__device__ __forceinline__ void gdn_sample_item_g(const Params& p, int it) {
    unsigned char* ws = p.ws;
    int lane = threadIdx.x; asm volatile("" : "+v"(lane)); lane &= 63;
    const int c = lane & 31, hh = lane >> 5;
    const int qd = it & 3, bh = it >> 2, h = bh & 7, b = bh >> 3;
    const int dv = qd * 32 + c;
    float s[64];
    { const float* sp = p.in[4] + (size_t)bh * 16384 + (size_t)(hh * 64) * 128 + dv;
#pragma unroll
      for (int i = 0; i < 64; ++i) s[i] = sp[i * 128]; }
    const float* QKVS = (const float*)(ws + OFF_QKVS);
    const float* G = (const float*)(ws + OFF_G); const float* BT = (const float*)(ws + OFF_BETA);
    bf16_t* O = (bf16_t*)(ws + OFF_O);
#pragma unroll 1
    for (int t = 0; t < 4; ++t) {
        const int tok = NPR + b * 4 + t;
        const float al = __expf(G[(size_t)tok * 8 + h]), be = BT[(size_t)tok * 8 + h];
        const float v = QKVS[(size_t)(b * 4 + t) * 3072 + 2048 + h * 128 + dv];
        float d0 = 0.f, d1 = 0.f, d2 = 0.f, d3 = 0.f;
        const float* krow = QKVS + (size_t)(b * 4 + t) * 3072 + 1024 + h * 128; const float* qrow = QKVS + (size_t)(b * 4 + t) * 3072 + h * 128;
        int kb = hh * 64;
#pragma unroll
        for (int i = 0; i < 64; i += 4) {
            if ((i & 15) == 0) asm volatile("" : "+v"(kb) : "v"(d0), "v"(d1), "v"(d2), "v"(d3));
            const f32x4 kk = *(const f32x4*)(krow + kb + i);
            s[i] *= al; s[i + 1] *= al; s[i + 2] *= al; s[i + 3] *= al;
            d0 += kk[0] * s[i]; d1 += kk[1] * s[i + 1]; d2 += kk[2] * s[i + 2]; d3 += kk[3] * s[i + 3];
        }
        float dd = (d0 + d1) + (d2 + d3);
        dd += __shfl_xor(dd, 32);
        const float rr = be * (v - dd);
        float o0 = 0.f, o1 = 0.f, o2 = 0.f, o3 = 0.f;
        asm volatile("" : "+v"(kb) : "v"(rr));
#pragma unroll
        for (int i = 0; i < 64; i += 4) {
            if ((i & 15) == 0) asm volatile("" : "+v"(kb) : "v"(o0), "v"(o1), "v"(o2), "v"(o3));
            const f32x4 kk = *(const f32x4*)(krow + kb + i);
            const f32x4 qq = *(const f32x4*)(qrow + kb + i);
            s[i] += rr * kk[0]; s[i + 1] += rr * kk[1]; s[i + 2] += rr * kk[2]; s[i + 3] += rr * kk[3];
            o0 += qq[0] * s[i]; o1 += qq[1] * s[i + 1]; o2 += qq[2] * s[i + 2]; o3 += qq[3] * s[i + 3];
        }
        float oo = (o0 + o1) + (o2 + o3);
        oo += __shfl_xor(oo, 32);
        if (hh == 0) O[(size_t)tok * 1024 + h * 128 + dv] = f2bf(oo);
    }
    int dv2 = dv; asm volatile("" : "+v"(dv2));
    float* So = p.out + O_SGDN + (size_t)bh * 16384 + (size_t)(hh * 64) * 128 + dv2;
#pragma unroll
    for (int i = 0; i < 64; ++i) So[i * 128] = s[i];
}

__device__ __forceinline__ void phase_gdn_prep(const Params& p, LAS unsigned char* lds) {
    const int wave = __builtin_amdgcn_readfirstlane(threadIdx.x >> 6);
    LAS unsigned char* wl = lds + wave * 16384;
    if (wave < 4) { for (int it = blockIdx.x * 4 + wave; it < 1024; it += gridDim.x * 4) gdn_prep_item(p, it, wl, (LAS float*)(lds + 143360 + wave * 512)); }
    else {
        for (int u = blockIdx.x * 4 + (wave - 4); u < 2048; u += gridDim.x * 4) { const int g = u & 63, bq = u >> 6; float zr = 0.f, zi = 0.f; s5_unit(p, g, NPR + bq * 16, 1, true, bq * 4, wl, 8192, zr, zi, false); }
    }
}

__device__ __forceinline__ bf16x8 ldperm(const bf16_t* p8, int hh) {
    const u32x2 lo = *(const u32x2*)(p8 + 4 * hh), hi = *(const u32x2*)(p8 + 8 + 4 * hh);
    return mk8(lo.x, lo.y, hi.x, hi.y);
}
constexpr int GDN_BUF = 61440, GDN_LDS0 = 21504;
__device__ __forceinline__ void gdn_dma_chunk(const unsigned char* ws, int it, LAS unsigned char* buf, int lane) {
    const bf16_t* KG = (const bf16_t*)(ws + OFF_KG) + (size_t)it * 8192 + lane * 8;
    const bf16_t* QG = (const bf16_t*)(ws + OFF_QG) + (size_t)it * 8192 + lane * 8;
    const bf16_t* KDT = (const bf16_t*)(ws + OFF_KDT) + (size_t)it * 8192 + lane * 8;
#pragma unroll
    for (int f = 0; f < 16; ++f) __builtin_amdgcn_global_load_lds((const unsigned*)(KG + f * 512), (LAS unsigned*)(buf + f * 1024), 16, 0, 0);
#pragma unroll
    for (int f = 0; f < 16; ++f) __builtin_amdgcn_global_load_lds((const unsigned*)(QG + f * 512), (LAS unsigned*)(buf + 16384 + f * 1024), 16, 0, 0);
#pragma unroll
    for (int f = 0; f < 16; ++f) __builtin_amdgcn_global_load_lds((const unsigned*)(KDT + f * 512), (LAS unsigned*)(buf + 32768 + f * 1024), 16, 0, 0);
    const bf16_t* TBt = (const bf16_t*)(ws + OFF_TBT) + (size_t)it * 4096 + lane * 8;
    const bf16_t* ATT = (const bf16_t*)(ws + OFF_ATT) + (size_t)it * 4096 + lane * 8;
#pragma unroll
    for (int k = 0; k < 6; ++k) { const int f = (k < 2) ? k : k + 2;
        __builtin_amdgcn_global_load_lds((const unsigned*)(TBt + f * 512), (LAS unsigned*)(buf + 49152 + k * 1024), 16, 0, 0);
        __builtin_amdgcn_global_load_lds((const unsigned*)(ATT + f * 512), (LAS unsigned*)(buf + 55296 + k * 1024), 16, 0, 0); }
}
__device__ __forceinline__ void gdn_store_o(bf16_t* O, const unsigned (&Opk)[16], int b, int nn, int h, int dv, int hh) {
#pragma unroll
    for (int k = 0; k < 16; ++k) {
        const int mt = k >> 3, q = 2 * (k & 7), i = mt * 32 + 8 * (q >> 2) + 4 * hh + (q & 3);
        bf16_t* o = O + (size_t)(b * 2048 + nn * 64 + i) * 1024 + h * 128 + dv;
        o[0] = (bf16_t)(Opk[k] & 0xffffu); o[1024] = (bf16_t)(Opk[k] >> 16);
    }
}
template <int PAR>
__device__ __forceinline__ void gdn_chunk(const Params& p, LAS unsigned char* gb, int n, int bh, int b, int h, int dv, int hh, int lane, f32x16 (&S)[4], unsigned (&Opk)[16]) {
    unsigned char* ws = p.ws;
    asm volatile("s_waitcnt vmcnt(0)" ::: "memory");
    const int it = bh * 32 + n;
    if (n > 0) gdn_store_o((bf16_t*)(ws + OFF_O), Opk, b, n - 1, h, dv, hh);
    const LAS unsigned char* cb = gb + PAR * GDN_BUF + lane * 16;
    const float* VV = (const float*)(ws + OFF_VV) + (size_t)(b * 2048 + n * 64) * 1024 + h * 128 + dv;
    const float gl = ((const float*)(ws + OFF_GLAST))[it];
    f32x16 v0, v1;
#pragma unroll
    for (int q = 0; q < 16; ++q) { const int i = 8 * (q >> 2) + 4 * hh + (q & 3); v0[q] = VV[(size_t)i * 1024]; v1[q] = VV[(size_t)(32 + i) * 1024]; }
    float pf8 = 0.f;
    if (n + 1 < 32) pf8 = VV[(size_t)(64 + lane) * 1024];
    if (n + 1 < 32) gdn_dma_chunk(ws, it + 1, gb + (1 - PAR) * GDN_BUF, lane);
    bf16x8 Sb[4][2];
#pragma unroll
    for (int kt = 0; kt < 4; ++kt)
#pragma unroll
        for (int s = 0; s < 2; ++s)
            Sb[kt][s] = mk8(pk2(S[kt][8 * s + 0], S[kt][8 * s + 1]), pk2(S[kt][8 * s + 2], S[kt][8 * s + 3]), pk2(S[kt][8 * s + 4], S[kt][8 * s + 5]), pk2(S[kt][8 * s + 6], S[kt][8 * s + 7]));
    bf16x8 Eb[2][2];
    {
        f32x16 a0 = {}, a1 = {};
#pragma unroll
        for (int kt = 0; kt < 4; ++kt)
#pragma unroll
            for (int s = 0; s < 2; ++s) {
                const u32x4 hv = __builtin_bit_cast(u32x4, Sb[kt][s]);
                const bf16x8 lo = mk8(pk2(S[kt][8 * s + 0] - bflo(hv.x), S[kt][8 * s + 1] - bfhi(hv.x)), pk2(S[kt][8 * s + 2] - bflo(hv.y), S[kt][8 * s + 3] - bfhi(hv.y)),
                                      pk2(S[kt][8 * s + 4] - bflo(hv.z), S[kt][8 * s + 5] - bfhi(hv.z)), pk2(S[kt][8 * s + 6] - bflo(hv.w), S[kt][8 * s + 7] - bfhi(hv.w)));
                const bf16x8 A0 = *(const LAS bf16x8*)(cb + (kt * 2 + s) * 1024);
                const bf16x8 A1 = *(const LAS bf16x8*)(cb + (8 + kt * 2 + s) * 1024);
                a0 = mfma32(A0, Sb[kt][s], a0); a1 = mfma32(A1, Sb[kt][s], a1);
                a0 = mfma32(A0, lo, a0); a1 = mfma32(A1, lo, a1);
            }
        a0 += v0; a1 += v1;
#pragma unroll
        for (int s = 0; s < 2; ++s) {
            Eb[0][s] = mk8(pk2(a0[8 * s + 0], a0[8 * s + 1]), pk2(a0[8 * s + 2], a0[8 * s + 3]), pk2(a0[8 * s + 4], a0[8 * s + 5]), pk2(a0[8 * s + 6], a0[8 * s + 7]));
            Eb[1][s] = mk8(pk2(a1[8 * s + 0], a1[8 * s + 1]), pk2(a1[8 * s + 2], a1[8 * s + 3]), pk2(a1[8 * s + 4], a1[8 * s + 5]), pk2(a1[8 * s + 6], a1[8 * s + 7]));
        }
    }
    bf16x8 Vb[2][2];
#pragma unroll
    for (int mt = 0; mt < 2; ++mt) {
        f32x16 a = {};
#pragma unroll
        for (int m2 = 0; m2 <= mt; ++m2)
#pragma unroll
            for (int s = 0; s < 2; ++s) a = mfma32(*(const LAS bf16x8*)(cb + 49152 + ((mt == 0) ? s : 2 + m2 * 2 + s) * 1024), Eb[m2][s], a);
#pragma unroll
        for (int s = 0; s < 2; ++s)
            Vb[mt][s] = mk8(pk2(a[8 * s + 0], a[8 * s + 1]), pk2(a[8 * s + 2], a[8 * s + 3]), pk2(a[8 * s + 4], a[8 * s + 5]), pk2(a[8 * s + 6], a[8 * s + 7]));
    }
#pragma unroll
    for (int mt = 0; mt < 2; ++mt) {
        f32x16 a = {};
#pragma unroll
        for (int kt = 0; kt < 4; ++kt)
#pragma unroll
            for (int s = 0; s < 2; ++s) a = mfma32(*(const LAS bf16x8*)(cb + 16384 + ((mt * 4 + kt) * 2 + s) * 1024), Sb[kt][s], a);
#pragma unroll
        for (int m2 = 0; m2 <= mt; ++m2)
#pragma unroll
            for (int s = 0; s < 2; ++s) a = mfma32(*(const LAS bf16x8*)(cb + 55296 + ((mt == 0) ? s : 2 + m2 * 2 + s) * 1024), Vb[m2][s], a);
#pragma unroll
        for (int k = 0; k < 8; ++k) Opk[mt * 8 + k] = pk2(a[2 * k], a[2 * k + 1]);
    }
#pragma unroll
    for (int kt = 0; kt < 4; ++kt) {
        f32x16 a = S[kt] * gl;
#pragma unroll
        for (int m2 = 0; m2 < 2; ++m2)
#pragma unroll
            for (int s = 0; s < 2; ++s) a = mfma32(*(const LAS bf16x8*)(cb + 32768 + ((kt * 2 + m2) * 2 + s) * 1024), Vb[m2][s], a);
        S[kt] = a;
    }
    asm volatile("" :: "v"(pf8));
}
__device__ __forceinline__ void gdn_scan_unit(const Params& p, int unit, LAS unsigned char* gb) {
    int lane = threadIdx.x; asm volatile("" : "+v"(lane)); lane &= 63;
    const int r = lane & 31, hh = lane >> 5;
    const int sl = unit & 3, bh = unit >> 2, h = bh & 7, b = bh >> 3;
    const int dv = sl * 32 + r;
    f32x16 S[4];
#pragma unroll
    for (int kt = 0; kt < 4; ++kt) S[kt] = (f32x16){};
    gdn_dma_chunk(p.ws, bh * 32, gb, lane);
    unsigned Opk[16];
#pragma unroll
    for (int k = 0; k < 16; ++k) Opk[k] = 0u;
#pragma unroll 1
    for (int n = 0; n < 32; n += 2) {
        gdn_chunk<0>(p, gb, n, bh, b, h, dv, hh, lane, S, Opk);
        gdn_chunk<1>(p, gb, n + 1, bh, b, h, dv, hh, lane, S, Opk);
    }
    gdn_store_o((bf16_t*)(p.ws + OFF_O), Opk, b, 31, h, dv, hh);
    int lane6 = threadIdx.x; asm volatile("" : "+v"(lane6)); lane6 &= 63;
    float* So = p.out + O_PGDN + (size_t)bh * 16384 + (sl * 32 + (lane6 & 31)) + (size_t)(4 * (lane6 >> 5)) * 128;
#pragma unroll
    for (int kt = 0; kt < 4; ++kt)
#pragma unroll
        for (int q = 0; q < 16; ++q) { const int dk = kt * 32 + 8 * (q >> 2) + (q & 3); So[(size_t)dk * 128] = S[kt][q]; }
}

__device__ __forceinline__ void s5_unit(const Params& p, int g, int tok_base, int nsub, bool sample, int b0, LAS unsigned char* wl, int hb_off, float& hr_io, float& hi_io, bool store_final) {
    unsigned char* ws = p.ws;
    int lane = threadIdx.x; asm volatile("" : "+v"(lane)); lane &= 63;
    const int l15 = lane & 15, l4 = lane >> 4;
    LAS bf16_t* HB = (LAS bf16_t*)(wl + hb_off);
    const bf16_t* PB = (const bf16_t*)(ws + OFF_PROJB);
    bf16_t* ZB = (bf16_t*)(ws + OFF_ZB);
    const float* AB = (const float*)(ws + OFF_ABAR);
    const float ar = AB[(g * 64 + lane) * 2], ai = AB[(g * 64 + lane) * 2 + 1];
    const bf16_t* bbt = (const bf16_t*)(ws + OFF_BBT) + (size_t)g * 2048;
    const bf16_t* ct = (const bf16_t*)(ws + OFF_CT) + (size_t)g * 2048;
    bf16x8 Bf[8], Cf[4];
    const bf16x8 zero8 = {0, 0, 0, 0, 0, 0, 0, 0};
#pragma unroll
    for (int nt = 0; nt < 8; ++nt) Bf[nt] = (l4 < 2) ? *(const bf16x8*)(bbt + (nt * 16 + l15) * 16 + 8 * l4) : zero8;
#pragma unroll
    for (int s = 0; s < 4; ++s) Cf[s] = *(const bf16x8*)(ct + l15 * 128 + 32 * s + 8 * l4);
    const float dskip = p.in[18][g * 16 + l15];
    float hr = hr_io, hi = hi_io;
    const int last_tok = tok_base + (nsub - 1) * 16;
    {
        const bf16x8 A0 = (l4 < 2) ? *(const bf16x8*)(PB + (size_t)(tok_base + l15) * NPB + g * 16 + 8 * l4) : zero8;
        LAS float* BU = (LAS float*)wl;
#pragma unroll
        for (int nt = 0; nt < 8; ++nt) {
            f32x4 a = {0.f, 0.f, 0.f, 0.f};
            a = mfma16(A0, Bf[nt], a);
#pragma unroll
            for (int q = 0; q < 4; ++q) BU[(4 * l4 + q) * 128 + nt * 16 + l15] = a[q];
        }
    }
    const int tok1 = (nsub > 1) ? tok_base + 16 : tok_base;
    bf16x8 Au = (l4 < 2) ? *(const bf16x8*)(PB + (size_t)(tok1 + l15) * NPB + g * 16 + 8 * l4) : zero8;
    float uu[4];
#pragma unroll
    for (int q = 0; q < 4; ++q) uu[q] = bf2f(PB[(size_t)(tok_base + 4 * l4 + q) * NPB + g * 16 + l15]);
    WSYNC();
#pragma unroll 1
    for (int sc = 0; sc < nsub; ++sc) {
        const int tok0 = tok_base + sc * 16;
        LAS float* BU = (LAS float*)(wl + (sc & 1) * 8192);
        LAS float* BUn = (LAS float*)(wl + ((sc + 1) & 1) * 8192);
        const int tok2 = (tok0 + 32 <= last_tok) ? tok0 + 32 : last_tok;
        const int tokn = (tok0 + 16 <= last_tok) ? tok0 + 16 : last_tok;
        const bf16x8 Au_n = (l4 < 2) ? *(const bf16x8*)(PB + (size_t)(tok2 + l15) * NPB + g * 16 + 8 * l4) : zero8;
        float uu_n[4];
#pragma unroll
        for (int q = 0; q < 4; ++q) uu_n[q] = bf2f(PB[(size_t)(tokn + 4 * l4 + q) * NPB + g * 16 + l15]);
        if (sc + 1 < nsub) {
#pragma unroll
            for (int nt = 0; nt < 8; ++nt) {
                f32x4 a = {0.f, 0.f, 0.f, 0.f};
                a = mfma16(Au, Bf[nt], a);
#pragma unroll
                for (int q = 0; q < 4; ++q) BUn[(4 * l4 + q) * 128 + nt * 16 + l15] = a[q];
            }
        }
#pragma unroll
        for (int t = 0; t < 16; ++t) {
            if (sample && (t & 3) == 0) {
                const int bb = b0 + (t >> 2);
                hr = p.in[2][((size_t)bb * 64 + g) * 64 + lane]; hi = p.in[3][((size_t)bb * 64 + g) * 64 + lane];
            }
            const float br = BU[t * 128 + lane], bi = BU[t * 128 + 64 + lane];
            const float nr = ar * hr - ai * hi + br, ni = ar * hi + ai * hr + bi;
            hr = nr; hi = ni;
            HB[t * 136 + lane] = f2bf(hr); HB[t * 136 + 64 + lane] = f2bf(hi);
            if (sample && (t & 3) == 3) {
                const int bb = b0 + (t >> 2);
                p.out[O_SRE + ((size_t)bb * 64 + g) * 64 + lane] = hr; p.out[O_SIM + ((size_t)bb * 64 + g) * 64 + lane] = hi;
            }
        }
        WSYNC();
        f32x4 y = {0.f, 0.f, 0.f, 0.f};
#pragma unroll
        for (int s = 0; s < 4; ++s) {
            const bf16x8 Ah = *(const LAS bf16x8*)(HB + l15 * 136 + 32 * s + 8 * l4);
            y = mfma16(Ah, Cf[s], y);
        }
#pragma unroll
        for (int q = 0; q < 4; ++q) {
            const int tok = tok0 + 4 * l4 + q;
            ZB[(size_t)tok * 1024 + g * 16 + l15] = f2bf(gelu_tanh(y[q] + dskip * uu[q]));
        }
        WSYNC();
        Au = Au_n;
#pragma unroll
        for (int q = 0; q < 4; ++q) uu[q] = uu_n[q];
    }
    hr_io = hr; hi_io = hi;
    if (!sample && store_final) {
        const int b = tok_base >> 11;
        p.out[O_PRE + ((size_t)b * 64 + g) * 64 + lane] = hr; p.out[O_PIM + ((size_t)b * 64 + g) * 64 + lane] = hi;
    }
}

__device__ __forceinline__ void phase_scan(const Params& p, LAS unsigned char* lds, float& s5r, float& s5i, bool split5) {
    const int wave = __builtin_amdgcn_readfirstlane(threadIdx.x >> 6);
    if (wave == 0) {
        for (int B = blockIdx.x; B < 128; B += gridDim.x) { const int xi = B & 7, idx = B >> 3; gdn_scan_unit(p, ((xi * 4 + (idx >> 2)) << 2) + (idx & 3), lds + GDN_LDS0); }
    }
    else if (wave < 7) { for (int it = blockIdx.x * 6 + (wave - 1); it < 4096; it += gridDim.x * 6) gdn_sample_item_g(p, it); }
    else if (wave == 7) {
        if (split5) { const int u = blockIdx.x; if (u < 256) s5_unit(p, u & 63, (u >> 6) * 2048 + S5_SPLIT * 16, 128 - S5_SPLIT, false, 0, lds, 16384, s5r, s5i, true); }
        else { for (int u = blockIdx.x; u < 256; u += gridDim.x) { float zr = 0.f, zi = 0.f; s5_unit(p, u & 63, (u >> 6) * 2048, 128, false, 0, lds, 16384, zr, zi, true); } }
    }
}

__device__ __forceinline__ void phase_onorm(const Params& p) {
    unsigned char* ws = p.ws;
    int lane = threadIdx.x; asm volatile("" : "+v"(lane)); lane &= 63;
    const int wave = __builtin_amdgcn_readfirstlane(threadIdx.x >> 6);
    const bf16_t* O = (const bf16_t*)(ws + OFF_O); const bf16_t* PB = (const bf16_t*)(ws + OFF_PROJB);
    bf16_t* YM = (bf16_t*)(ws + OFF_YMIX);
    const float nw0 = p.in[24][2 * lane], nw1 = p.in[24][2 * lane + 1];
    for (int it4 = blockIdx.x * 8 + wave; it4 < NTOK * 2; it4 += gridDim.x * 8) {
        unsigned ov[4], gv[4];
#pragma unroll
        for (int j = 0; j < 4; ++j) {
            const int it = it4 * 4 + j, h = it & 7, tok = it >> 3;
            ov[j] = *(const unsigned*)(O + (size_t)tok * 1024 + h * 128 + 2 * lane);
            gv[j] = *(const unsigned*)(PB + (size_t)tok * NPB + 4096 + h * 128 + 2 * lane);
        }
        float ss[4];
#pragma unroll
        for (int j = 0; j < 4; ++j) { const float o0 = bflo(ov[j]), o1 = bfhi(ov[j]); ss[j] = o0 * o0 + o1 * o1; }
#pragma unroll
        for (int o = 1; o < 64; o <<= 1) {
#pragma unroll
            for (int j = 0; j < 4; ++j) ss[j] += __shfl_xor(ss[j], o);
        }
#pragma unroll
        for (int j = 0; j < 4; ++j) {
            const int it = it4 * 4 + j, h = it & 7, tok = it >> 3;
            const float o0 = bflo(ov[j]), o1 = bfhi(ov[j]);
            const float rs = 1.f / sqrtf(ss[j] * (1.f / 128.f) + 1e-6f);
            *(unsigned*)(YM + (size_t)tok * DM + 1024 + h * 128 + 2 * lane) = pk2(o0 * rs * nw0 * siluf(bflo(gv[j])), o1 * rs * nw1 * siluf(bfhi(gv[j])));
        }
    }
}

#define XB_TMO      128
#define XB_XCNT(j)  (256  + 64 * (j))
#define XB_XSUB(j)  (1280 + 64 * (j))
#define XB_XGEN(j)  (2304 + 64 * (j))
#define XB_TOP      3328
#define XB_TOPGEN   3392
#define XCD_BAR_WORDS 3456
#define XB_SPIN_CAP (1u << 18)
__device__ __forceinline__ unsigned xb_ld(unsigned* p)              { return __hip_atomic_load(p, __ATOMIC_RELAXED, __HIP_MEMORY_SCOPE_AGENT); }
__device__ __forceinline__ unsigned xb_add(unsigned* p, unsigned v) { return __hip_atomic_fetch_add(p, v, __ATOMIC_RELAXED, __HIP_MEMORY_SCOPE_AGENT); }
__device__ __forceinline__ unsigned xb_xcc_id() { return (unsigned)__builtin_amdgcn_s_getreg((3 << 11) | 20) & 0xFu; }
#define XB_SPIN(cond, bar) do { unsigned _sp = 0; while (cond) { __builtin_amdgcn_s_sleep(1); \
    if ((++_sp & 255u) == 0u) { if (xb_ld(&(bar)[XB_TMO])) break; if (_sp > XB_SPIN_CAP) { atomicAdd(&(bar)[XB_TMO], 1u); break; } } } } while (0)
struct XcdBarrier { unsigned* bar; unsigned x; volatile LAS unsigned* st; };
__device__ __forceinline__ XcdBarrier xcd_barrier_post(unsigned* bar, volatile LAS unsigned* st) {
    XcdBarrier b; b.bar = bar; b.x = xb_xcc_id(); b.st = st;
    if (threadIdx.x == 0) (void)xb_add(&bar[XB_XCNT(b.x)], 1u);
    return b;
}
__device__ __forceinline__ void xcd_barrier_complete(unsigned* bar, unsigned x, unsigned& nloc, unsigned& nx) {
    const unsigned G = gridDim.x * gridDim.y * gridDim.z;
    unsigned sum, cnt, mine, sp = 0u;
    for (;;) {
        sum = 0u; cnt = 0u; mine = 0u;
#pragma unroll
        for (unsigned j = 0; j < 16; ++j) { const unsigned c = xb_ld(&bar[XB_XCNT(j)]); sum += c; cnt += (c > 0u) ? 1u : 0u; mine = (j == x) ? c : mine; }
        if (sum == G) break;
        __builtin_amdgcn_s_sleep(1);
        if ((++sp & 255u) == 0u) { if (xb_ld(&bar[XB_TMO])) break; if (sp > XB_SPIN_CAP) { atomicAdd(&bar[XB_TMO], 1u); break; } }
    }
    nloc = mine > 0u ? mine : 1u; nx = cnt > 0u ? cnt : 1u;
}
__device__ __forceinline__ void xcd_barrier(const XcdBarrier& b) {
    asm volatile("s_waitcnt vmcnt(0)" ::: "memory");
    __syncthreads();
    if (threadIdx.x == 0) {
        unsigned* bar = b.bar;
        __builtin_amdgcn_s_waitcnt(0);
        unsigned nloc = b.st[0], nx = b.st[1];
        if (nloc == 0u) { xcd_barrier_complete(bar, b.x, nloc, nx); b.st[0] = nloc; b.st[1] = nx; }
        const unsigned old = xb_add(&bar[XB_XSUB(b.x)], 1u);
        const unsigned gen = old / nloc;
        if (old + 1u == (gen + 1u) * nloc) {
            __builtin_amdgcn_fence(__ATOMIC_RELEASE, "agent");
            asm volatile("s_waitcnt vmcnt(0)" ::: "memory");
            const unsigned og = xb_add(&bar[XB_TOP], 1u);
            const unsigned tg = og / nx;
            if (og + 1u == (tg + 1u) * nx) xb_add(&bar[XB_TOPGEN], 1u);
            else XB_SPIN(xb_ld(&bar[XB_TOPGEN]) == tg, bar);
            __builtin_amdgcn_fence(__ATOMIC_ACQUIRE, "agent");
            xb_add(&bar[XB_XGEN(b.x)], 1u);
            asm volatile("s_waitcnt vmcnt(0)" ::: "memory");
        } else {
            XB_SPIN(xb_ld(&bar[XB_XGEN(b.x)]) == gen, bar);
            __builtin_amdgcn_fence(__ATOMIC_ACQUIRE, "agent");
            asm volatile("s_waitcnt vmcnt(0)" ::: "memory");
        }
    }
    __syncthreads();
}

__global__ void __launch_bounds__(512, 2) fwd_megakernel(Params p) {
    extern __shared__ __attribute__((aligned(16))) unsigned char shm[];
    LAS unsigned char* lds = (LAS unsigned char*)shm;
    cg::grid_group grid = cg::this_grid();
    unsigned char* ws = p.ws;
    pg8::StaticOrder S;
    volatile LAS unsigned* bst = (volatile LAS unsigned*)(lds + 147456 - 16);
    if (threadIdx.x == 0) { bst[0] = 0u; bst[1] = 0u; }
    __syncthreads();
    const XcdBarrier xb = xcd_barrier_post((unsigned*)(ws + OFF_BAR), bst);
    phase_convert0(p, lds);
    grid.sync();
    if (STOP_AFTER <= 0) return;
    { S.init(NTOK, 2 * DFF, DM, gridDim.x, blockIdx.x, false); pg8::Gemm g{(const bf16_t*)(ws + OFF_XNB), (const bf16_t*)(ws + OFF_W1T), NTOK, 2 * DFF, DM};
      EpiSwiglu E{(bf16_t*)(ws + OFF_H)}; pg8::gemm_phase(lds, g, S, E); }
    xcd_barrier(xb);
    { S.init(NTOK, DM, DFF, gridDim.x, blockIdx.x, true); pg8::Gemm g{(const bf16_t*)(ws + OFF_H), (const bf16_t*)(ws + OFF_W1O), NTOK, DM, DFF};
      EpiResid E{(bf16_t*)(ws + OFF_R), p.in[0], p.in[1], (float*)(ws + OFF_PART), nullptr, (const bf16_t*)(ws + OFF_XNB), 0.5f}; pg8::gemm_phase(lds, g, S, E); }
    __syncthreads();
    phase_convert_mid(p, lds, S.tail_busy());
    xcd_barrier(xb);
    phase_ln((const bf16_t*)(ws + OFF_R), p.in[6], p.in[7], nullptr, (bf16_t*)(ws + OFF_XRB), S.mode == 1 ? (const float*)(ws + OFF_PART) : nullptr, p.in[1], nullptr);
    xcd_barrier(xb);
    if (STOP_AFTER <= 3) return;
    { S.init(NTOK, NMIXP, DM, gridDim.x, blockIdx.x, false); pg8::Gemm g{(const bf16_t*)(ws + OFF_XRB), (const bf16_t*)(ws + OFF_WMI), NTOK, NMIXP, DM};
      EpiMixIn E{(bf16_t*)(ws + OFF_PROJB), (float*)(ws + OFF_BD)}; pg8::gemm_phase(lds, g, S, E); }
    xcd_barrier(xb);
    float s5r = 0.f, s5i = 0.f;
    const bool split5 = gridDim.x >= 256;
    phase_conv(p, lds, s5r, s5i, split5);
    xcd_barrier(xb);
    if (STOP_AFTER <= 4) return;
    phase_gdn_prep(p, lds);
    xcd_barrier(xb);
    phase_scan(p, lds, s5r, s5i, split5);
    xcd_barrier(xb);
    if (STOP_AFTER <= 5) return;
    phase_onorm(p);
    __syncthreads();
    { S.init(NTOK, 1024, 1024, gridDim.x, blockIdx.x, false); pg8::Gemm g{(const bf16_t*)(ws + OFF_ZB), (const bf16_t*)(ws + OFF_GLU), NTOK, 1024, 1024};
      EpiGlu E{(bf16_t*)(ws + OFF_YMIX), (const bf16_t*)(ws + OFF_ZB), p.in[20]}; pg8::gemm_phase(lds, g, S, E);
      __syncthreads();
      if (S.nwg < (int)gridDim.x) transpose_matrix(p.in[29], DFF, DM, (bf16_t*)(ws + OFF_W1O), 0, (LAS float*)lds, S.nwg); }
    xcd_barrier(xb);
    { S.init(NTOK, DM, DM, gridDim.x, blockIdx.x, true); pg8::Gemm g{(const bf16_t*)(ws + OFF_YMIX), (const bf16_t*)(ws + OFF_WMO), NTOK, DM, DM};
      EpiResid E{(bf16_t*)(ws + OFF_R), nullptr, nullptr, (float*)(ws + OFF_PART), nullptr, (const bf16_t*)(ws + OFF_XRB), 1.0f}; pg8::gemm_phase(lds, g, S, E); }
    __syncthreads();
    phase_convert1(p, lds, S.tail_busy(), gridDim.x > 136);
    xcd_barrier(xb);
    phase_ln((const bf16_t*)(ws + OFF_R), p.in[26], p.in[27], nullptr, (bf16_t*)(ws + OFF_XRB), S.mode == 1 ? (const float*)(ws + OFF_PART) : nullptr, nullptr, (const bf16_t*)(ws + OFF_XRB) + (size_t)NPR * DM);
    xcd_barrier(xb);
    { S.init(NTOK, 2 * DFF, DM, gridDim.x, blockIdx.x, false); pg8::Gemm g{(const bf16_t*)(ws + OFF_XRB), (const bf16_t*)(ws + OFF_W1T), NTOK, 2 * DFF, DM};
      EpiSwiglu E{(bf16_t*)(ws + OFF_H)}; pg8::gemm_phase(lds, g, S, E); }
    xcd_barrier(xb);
    { S.init(NTOK, DM, DFF, gridDim.x, blockIdx.x, true); if (S.mode == 1) S.nsp = 8; pg8::Gemm g{(const bf16_t*)(ws + OFF_H), (const bf16_t*)(ws + OFF_W1O), NTOK, DM, DFF};
      EpiResid E{(bf16_t*)(ws + OFF_R), nullptr, nullptr, (float*)(ws + OFF_PART), (float*)(ws + OFF_XNB), (const bf16_t*)(ws + OFF_XRB), 0.5f}; pg8::gemm_phase(lds, g, S, E); }
    xcd_barrier(xb);
    phase_ln((const bf16_t*)(ws + OFF_R), p.in[30], p.in[31], p.out + O_Y, nullptr, S.mode == 1 ? (const float*)(ws + OFF_PART) : nullptr, nullptr, (const bf16_t*)(ws + OFF_XRB) + (size_t)NPR * DM, (S.mode == 1 && S.nsp == 8) ? (const float*)(ws + OFF_XNB) : nullptr);
}

extern "C" void kernel_launch(void* const* d_in, const int* in_sizes, int n_in, void* d_out, int out_size, void* d_ws, size_t ws_size, hipStream_t stream) {
    constexpr int LDS_BYTES = 147456;
    static int grid_blocks = 0;
    if (grid_blocks == 0) {
        int dev = 0, cus = 0, per_cu = 0;
        hipGetDevice(&dev);
        hipDeviceGetAttribute(&cus, hipDeviceAttributeMultiprocessorCount, dev);
        hipFuncSetAttribute((const void*)fwd_megakernel, hipFuncAttributeMaxDynamicSharedMemorySize, LDS_BYTES);
        hipOccupancyMaxActiveBlocksPerMultiprocessor(&per_cu, (const void*)fwd_megakernel, 512, LDS_BYTES);
        if (per_cu < 1) { fprintf(stderr, "occupancy query returned %d\n", per_cu); per_cu = 1; }
        grid_blocks = cus * 1;
        if (ws_size < WS_END) fprintf(stderr, "workspace too small: %zu < %zu\n", ws_size, (size_t)WS_END);
    }
    (void)hipMemsetAsync((unsigned char*)d_ws + OFF_BAR, 0, XCD_BAR_WORDS * 4, stream);
    Params p{};
    for (int i = 0; i < 32; ++i) p.in[i] = (const float*)d_in[i];
    p.out = (float*)d_out; p.ws = (unsigned char*)d_ws;
    void* args[] = {&p};
    hipError_t e = hipLaunchCooperativeKernel((const void*)fwd_megakernel, dim3(grid_blocks), dim3(512), args, LDS_BYTES, stream);
    if (e != hipSuccess) fprintf(stderr, "cooperative launch failed: %s (grid %d)\n", hipGetErrorString(e), grid_blocks);
}
```
